# Optimizing an MI355X kernel written in HIP

```python
import math
import jax, jax.numpy as jnp
from jax import lax
import numpy as np


D_MODEL = 1024
BATCH = 16
SEQ = 2048
DEPTH = 1

CHUNK = 64
Q_BLOCK = 128
MLA_HEADS = 8
MLA_NOPE = 64
MLA_ROPE = 32
MLA_V = 64
MLA_Q_RANK = 384
MLA_KV_RANK = 256
ROPE_THETA = 10000.0
RWKV_HEADS = 8
RWKV_HEAD = 64
RWKV_WIDTH = RWKV_HEADS * RWKV_HEAD
DECAY_RANK = 64
AAA_RANK = 64
GATE_RANK = 128
GN_EPS = 64e-5
N_GROUPS = 4
EXPERTS_PER_GROUP = 8
N_EXPERTS = N_GROUPS * EXPERTS_PER_GROUP
TOP_K_IN_GROUP = 2
EXPERT_FF = 256
RMS_EPS = 1e-6
N_BRANCHES = 2
NEG_INF = -1e30

MLA_IN = MLA_Q_RANK + MLA_KV_RANK + MLA_ROPE
RWKV_IN = 3 * RWKV_WIDTH + DECAY_RANK + AAA_RANK + GATE_RANK
GATE_IN = N_BRANCHES * D_MODEL
IN_WIDTH = MLA_IN + RWKV_IN + GATE_IN
IN_SPLITS = (MLA_Q_RANK, MLA_Q_RANK + MLA_KV_RANK, MLA_IN, MLA_IN + RWKV_IN)
RWKV_SPLITS = (RWKV_WIDTH, 2 * RWKV_WIDTH, 3 * RWKV_WIDTH, 3 * RWKV_WIDTH + DECAY_RANK, 3 * RWKV_WIDTH + DECAY_RANK + AAA_RANK)

kernel_name = 'hybrid_mla_rwkv7_hmoe_block'


def _rmsnorm(x, g):
    xf = x.astype(jnp.float32)
    y = xf * lax.rsqrt(jnp.mean(xf * xf, axis=-1, keepdims=True) + RMS_EPS)
    return (y * g.astype(jnp.float32)).astype(x.dtype)


def _modulate(x, g, shift, scale):
    return _rmsnorm(x, g) * (1.0 + scale) + shift


def _rope_tables(positions):
    inv_freq = jnp.power(ROPE_THETA, -jnp.arange(0, MLA_ROPE, 2, dtype=jnp.float32) / MLA_ROPE)
    ang = positions.astype(jnp.float32)[..., None] * inv_freq
    return jnp.cos(ang), jnp.sin(ang)


def _apply_rope(x, cos, sin):
    xf = x.astype(jnp.float32)
    x1, x2 = jnp.split(xf, 2, axis=-1)
    return jnp.concatenate([x1 * cos - x2 * sin, x2 * cos + x1 * sin], axis=-1).astype(x.dtype)


def _mla_branch(cq, ckv, kr, cos, sin, g_cq, w_uq, g_ckv, w_ukv):
    b, s, _ = cq.shape
    q = (_rmsnorm(cq, g_cq) @ w_uq).reshape(b, s, MLA_HEADS, MLA_NOPE + MLA_ROPE)
    kv = (_rmsnorm(ckv, g_ckv) @ w_ukv).reshape(b, s, MLA_HEADS, MLA_NOPE + MLA_V)
    q_nope, q_rope = q[..., :MLA_NOPE], q[..., MLA_NOPE:]
    k_nope, v = kv[..., :MLA_NOPE], kv[..., MLA_NOPE:]
    q_rope = _apply_rope(q_rope, cos[:, :, None, :], sin[:, :, None, :])
    k_rope = _apply_rope(kr, cos, sin)
    scale = 1.0 / math.sqrt(MLA_NOPE + MLA_ROPE)
    outs = []
    for qb in range(s // Q_BLOCK):
        q0, k_end = qb * Q_BLOCK, (qb + 1) * Q_BLOCK
        scores = (jnp.einsum('bqhd,bkhd->bhqk', q_nope[:, q0:k_end], k_nope[:, :k_end])
                  + jnp.einsum('bqhr,bkr->bhqk', q_rope[:, q0:k_end], k_rope[:, :k_end]))
        scores = scores.astype(jnp.float32) * scale
        q_chunk = (q0 + jnp.arange(Q_BLOCK)) // CHUNK
        k_chunk = jnp.arange(k_end) // CHUNK
        mask = k_chunk[None, :] <= q_chunk[:, None]
        scores = jnp.where(mask, scores, NEG_INF)
        p = jax.nn.softmax(scores, axis=-1).astype(v.dtype)
        outs.append(jnp.einsum('bhqk,bkhd->bqhd', p, v[:, :k_end]))
    return jnp.concatenate(outs, axis=1).reshape(b, s, MLA_HEADS * MLA_V)


def _token_shift(z, mu):
    z_prev = jnp.pad(z, ((0, 0), (1, 0), (0, 0)))[:, :-1]
    return z + (z_prev - z) * mu


def _rwkv7_step(state, inp):
    r, w, k, v, kk, a = inp
    sa = jnp.einsum('bhvk,bhk->bhv', state, -kk)
    state = state * w[:, :, None, :] + sa[..., None] * (kk * a)[:, :, None, :] + v[..., None] * k[:, :, None, :]
    y = jnp.einsum('bhvk,bhk->bhv', state, r)
    return state, y


def _rwkv7_branch(zr, mu_shift, w_decay_up, decay_bias, w_a_up, a_bias, w_g_up, k_k, k_a, r_k, lnx_w, lnx_b):
    b, s, _ = zr.shape
    zs = _token_shift(zr, mu_shift).astype(jnp.float32)
    r, k, v, wd, ad, gd = jnp.split(zs, RWKV_SPLITS, axis=-1)
    w_log = -jax.nn.softplus(-(decay_bias + jnp.tanh(wd) @ w_decay_up)) - 0.5
    decay = jnp.exp(-jnp.exp(w_log))
    a = jax.nn.sigmoid(a_bias + ad @ w_a_up)
    g = jax.nn.sigmoid(gd) @ w_g_up

    def heads(t):
        return t.reshape(b, s, RWKV_HEADS, RWKV_HEAD)

    kk = heads(k * k_k)
    kk = kk / jnp.maximum(jnp.sqrt(jnp.sum(kk * kk, axis=-1, keepdims=True)), 1e-12)
    k = k * (1.0 + (a - 1.0) * k_a)
    r_h, k_h, v_h, w_h, a_h = heads(r), heads(k), heads(v), heads(decay), heads(a)
    xs = (jnp.swapaxes(r_h, 0, 1), jnp.swapaxes(w_h, 0, 1), jnp.swapaxes(k_h, 0, 1),
          jnp.swapaxes(v_h, 0, 1), jnp.swapaxes(kk, 0, 1), jnp.swapaxes(a_h, 0, 1))
    state0 = jnp.zeros((b, RWKV_HEADS, RWKV_HEAD, RWKV_HEAD), jnp.float32)
    _, y = lax.scan(_rwkv7_step, state0, xs)
    y = jnp.swapaxes(y, 0, 1)
    mean = jnp.mean(y, axis=-1, keepdims=True)
    var = jnp.mean(jnp.square(y - mean), axis=-1, keepdims=True)
    y = ((y - mean) * lax.rsqrt(var + GN_EPS)).reshape(b, s, RWKV_WIDTH) * lnx_w + lnx_b
    bonus = jnp.sum(r_h * k_h * r_k, axis=-1, keepdims=True) * v_h
    out = (y + bonus.reshape(b, s, RWKV_WIDTH)) * g
    return out.astype(zr.dtype)


def _hier_moe(h, w_rg, b_rg, w_re, b_re, w_gate, w_up, w_down):
    b, s, d = h.shape
    hf = h.reshape(b * s, d)
    g_logits = (hf @ w_rg).astype(jnp.float32) + b_rg.astype(jnp.float32)
    g_sel = jnp.argmax(g_logits, axis=-1)
    p_sel = jnp.max(jax.nn.softmax(g_logits, axis=-1), axis=-1, keepdims=True)
    e_logits = ((hf @ w_re).astype(jnp.float32) + b_re.astype(jnp.float32)).reshape(-1, N_GROUPS, EXPERTS_PER_GROUP)
    e_in_group = jnp.einsum('tge,tg->te', e_logits, jax.nn.one_hot(g_sel, N_GROUPS, dtype=jnp.float32))
    top_vals, top_idx = lax.top_k(e_in_group, TOP_K_IN_GROUP)
    weights = p_sel * jax.nn.softmax(top_vals, axis=-1)
    expert_id = g_sel[:, None] * EXPERTS_PER_GROUP + top_idx
    combine = jnp.einsum('tke,tk->te', jax.nn.one_hot(expert_id, N_EXPERTS, dtype=jnp.float32), weights).astype(h.dtype)
    y = jnp.zeros_like(hf)
    for e in range(N_EXPERTS):
        act = jax.nn.silu(hf @ w_gate[e]) * (hf @ w_up[e])
        y = y + combine[:, e:e + 1] * (act @ w_down[e])
    return y.reshape(b, s, d)


def _hybrid_layer(x, c, cos, sin, w_ada, b_ada, g_pre_mix, g_post_mix, g_pre_ffn, g_post_ffn,
                  w_in, g_cq, w_uq, g_ckv, w_ukv, w_o_mla, mu_shift, w_decay_up, decay_bias,
                  w_a_up, a_bias, w_g_up, k_k, k_a, r_k, lnx_w, lnx_b, w_o_rwkv, w_out,
                  w_router_group, b_router_group, w_router_expert, b_router_expert,
                  w_exp_gate, w_exp_up, w_exp_down):
    mod = jax.nn.silu(c) @ w_ada + b_ada
    shift1, scale1, gate1, shift2, scale2, gate2 = jnp.split(mod[:, None, :], 6, axis=-1)
    h = _modulate(x, g_pre_mix, shift1, scale1)
    z = h @ w_in
    cq, ckv, kr, zr, gate_logits = jnp.split(z, IN_SPLITS, axis=-1)
    o_mla = _mla_branch(cq, ckv, kr, cos, sin, g_cq, w_uq, g_ckv, w_ukv) @ w_o_mla
    o_rwkv = _rwkv7_branch(zr, mu_shift, w_decay_up, decay_bias, w_a_up, a_bias, w_g_up,
                           k_k, k_a, r_k, lnx_w, lnx_b) @ w_o_rwkv
    gate_a, gate_b = jnp.split(jax.nn.sigmoid(gate_logits), 2, axis=-1)
    y = (gate_a * o_mla + gate_b * o_rwkv) @ w_out
    x = x + gate1 * _rmsnorm(y, g_post_mix)
    h = _modulate(x, g_pre_ffn, shift2, scale2)
    y = _hier_moe(h, w_router_group, b_router_group, w_router_expert, b_router_expert,
                  w_exp_gate, w_exp_up, w_exp_down)
    return x + gate2 * _rmsnorm(y, g_post_ffn)


def setup_inputs(seed: int = 0) -> dict:
    key = jax.random.key(seed)
    ks = iter(jax.random.split(key, 40))
    L, D = DEPTH, D_MODEL

    def nrm(shape, scale):
        return jax.random.normal(next(ks), shape, jnp.float32) * scale

    def gain(shape):
        return 1.0 + nrm(shape, 0.02)

    x = nrm((BATCH, SEQ, D), 1.0)
    c = nrm((BATCH, D), 1.0)
    offsets = jax.random.randint(next(ks), (BATCH, 1), 0, 256, dtype=jnp.int32) * CHUNK
    positions = (offsets + jnp.arange(SEQ, dtype=jnp.int32)[None, :]).astype(jnp.int32)
    return {
        'x': x, 'c': c, 'positions': positions,
        'w_ada': nrm((L, D, 6 * D), 0.5 * D ** -0.5),
        'b_ada': nrm((L, 6 * D), 0.02),
        'g_pre_mix': gain((L, D)), 'g_post_mix': gain((L, D)),
        'g_pre_ffn': gain((L, D)), 'g_post_ffn': gain((L, D)),
        'w_in': nrm((L, D, IN_WIDTH), D ** -0.5),
        'g_cq': gain((L, MLA_Q_RANK)),
        'w_uq': nrm((L, MLA_Q_RANK, MLA_HEADS * (MLA_NOPE + MLA_ROPE)), MLA_Q_RANK ** -0.5),
        'g_ckv': gain((L, MLA_KV_RANK)),
        'w_ukv': nrm((L, MLA_KV_RANK, MLA_HEADS * (MLA_NOPE + MLA_V)), MLA_KV_RANK ** -0.5),
        'w_o_mla': nrm((L, MLA_HEADS * MLA_V, D), (MLA_HEADS * MLA_V) ** -0.5),
        'mu_shift': jax.random.uniform(next(ks), (L, RWKV_IN), jnp.float32),
        'w_decay_up': nrm((L, DECAY_RANK, RWKV_WIDTH), 0.1 * DECAY_RANK ** -0.5),
        'decay_bias': jax.random.uniform(next(ks), (L, RWKV_WIDTH), jnp.float32, -5.0, -1.0),
        'w_a_up': nrm((L, AAA_RANK, RWKV_WIDTH), AAA_RANK ** -0.5),
        'a_bias': nrm((L, RWKV_WIDTH), 0.1),
        'w_g_up': nrm((L, GATE_RANK, RWKV_WIDTH), GATE_RANK ** -0.5),
        'k_k': 0.85 + nrm((L, RWKV_WIDTH), 0.02),
        'k_a': gain((L, RWKV_WIDTH)),
        'r_k': nrm((L, RWKV_HEADS, RWKV_HEAD), 0.1),
        'lnx_w': gain((L, RWKV_WIDTH)),
        'lnx_b': nrm((L, RWKV_WIDTH), 0.02),
        'w_o_rwkv': nrm((L, RWKV_WIDTH, D), RWKV_WIDTH ** -0.5),
        'w_out': nrm((L, D, D), D ** -0.5),
        'w_router_group': nrm((L, D, N_GROUPS), D ** -0.5),
        'b_router_group': nrm((L, N_GROUPS), 0.01),
        'w_router_expert': nrm((L, D, N_EXPERTS), D ** -0.5),
        'b_router_expert': nrm((L, N_EXPERTS), 0.01),
        'w_exp_gate': nrm((L, N_EXPERTS, D, EXPERT_FF), D ** -0.5),
        'w_exp_up': nrm((L, N_EXPERTS, D, EXPERT_FF), D ** -0.5),
        'w_exp_down': nrm((L, N_EXPERTS, EXPERT_FF, D), EXPERT_FF ** -0.5),
    }


def reference(x, c, positions, w_ada, b_ada, g_pre_mix, g_post_mix, g_pre_ffn, g_post_ffn,
              w_in, g_cq, w_uq, g_ckv, w_ukv, w_o_mla, mu_shift, w_decay_up, decay_bias,
              w_a_up, a_bias, w_g_up, k_k, k_a, r_k, lnx_w, lnx_b, w_o_rwkv, w_out,
              w_router_group, b_router_group, w_router_expert, b_router_expert,
              w_exp_gate, w_exp_up, w_exp_down):
    cos, sin = _rope_tables(positions)
    for l in range(DEPTH):
        x = _hybrid_layer(x, c, cos, sin, w_ada[l], b_ada[l], g_pre_mix[l], g_post_mix[l],
                          g_pre_ffn[l], g_post_ffn[l], w_in[l], g_cq[l], w_uq[l], g_ckv[l],
                          w_ukv[l], w_o_mla[l], mu_shift[l], w_decay_up[l], decay_bias[l],
                          w_a_up[l], a_bias[l], w_g_up[l], k_k[l], k_a[l], r_k[l], lnx_w[l],
                          lnx_b[l], w_o_rwkv[l], w_out[l], w_router_group[l], b_router_group[l],
                          w_router_expert[l], b_router_expert[l], w_exp_gate[l], w_exp_up[l],
                          w_exp_down[l])
    return x
```

```cpp
#include <hip/hip_runtime.h>
#include <stdint.h>
#include <math.h>
#include <type_traits>

constexpr int NB = 16, SEQ = 2048, DM = 1024, T = NB * SEQ;
constexpr int NH = 8;
constexpr int QR = 384, KVR = 256, ROPE = 32, NOPE = 64, VD = 64, QK = NOPE + ROPE;
constexpr int RW = 512, DR = 64, AR = 64, GR = 128;
constexpr int MLA_IN = QR + KVR + ROPE;
constexpr int RWKV_IN = 3 * RW + DR + AR + GR;
constexpr int IN_W = MLA_IN + RWKV_IN + 2 * DM;
constexpr int NE = 32, EPG = 8, NG = 4, FF = 256;
constexpr float RMS_EPS = 1e-6f, GN_EPS = 64e-5f;
constexpr float QSCALE = 0.10206207261596577f * 1.4426950408889634f;

typedef unsigned short bf16_t;
__device__ __forceinline__ float bf2f(bf16_t h) { return __uint_as_float(((unsigned)h) << 16); }
__device__ __forceinline__ bf16_t f2bf(float f) { unsigned u = __float_as_uint(f); return (bf16_t)((u + 0x7fffu + ((u >> 16) & 1u)) >> 16); }
__device__ __forceinline__ float sigmoidf_(float x) { return 1.f / (1.f + __expf(-x)); }
typedef unsigned u32x2 __attribute__((ext_vector_type(2)));
typedef float f32x2_t __attribute__((ext_vector_type(2)));
typedef __bf16 bf16x2_t __attribute__((ext_vector_type(2)));
__device__ __forceinline__ unsigned cvtpk(float lo, float hi) { f32x2_t v = {lo, hi}; bf16x2_t b = __builtin_convertvector(v, bf16x2_t); return __builtin_bit_cast(unsigned, b); }
__device__ __forceinline__ float fsigmoid(float x) { return __builtin_amdgcn_rcpf(1.f + __expf(-x)); }
template <int CTRL> __device__ __forceinline__ float dpp_add_(float x) { return x + __builtin_bit_cast(float, __builtin_amdgcn_update_dpp(0, __builtin_bit_cast(int, x), CTRL, 0xf, 0xf, true)); }
__device__ __forceinline__ float wsum_dpp(float x) {
    x = dpp_add_<0xB1>(x); x = dpp_add_<0x4E>(x); x = dpp_add_<0x141>(x); x = dpp_add_<0x140>(x);
    x += __builtin_bit_cast(float, __builtin_amdgcn_update_dpp(0, __builtin_bit_cast(int, x), 0x142, 0xa, 0xf, false));
    x += __builtin_bit_cast(float, __builtin_amdgcn_update_dpp(0, __builtin_bit_cast(int, x), 0x143, 0xc, 0xf, false));
    return __builtin_bit_cast(float, __builtin_amdgcn_readlane(__builtin_bit_cast(int, x), 63));
}
__device__ __forceinline__ float sum8_dpp(float x) { x = dpp_add_<0xB1>(x); x = dpp_add_<0x4E>(x); x = dpp_add_<0x141>(x); return x; }
__device__ __forceinline__ float wave_sum(float v) {
#pragma unroll
    for (int o = 1; o < 64; o <<= 1) v += __shfl_xor(v, o);
    return v;
}

constexpr size_t MiB = 1u << 20;
constexpr size_t WS_MOD = 5 * MiB;
constexpr size_t WS_ROPE = 1 * MiB;
constexpr size_t WS_CTL = 0;
constexpr size_t CTL_ZERO_BYTES = 65536;
constexpr int MOE_SKIP = 1;
constexpr int CW_PFLAG = 15744;
constexpr int CW_RTFLAG = 15424;
constexpr int CW_GCNT = 15360;
constexpr size_t WS_H = 8 * MiB;
constexpr size_t WS_QF = 8 * MiB;
constexpr size_t WS_RWO = 8 * MiB;
constexpr size_t WS_ZM = 72 * MiB;
constexpr size_t WS_VF = 72 * MiB;
constexpr size_t WS_EBUF = 104 * MiB;
constexpr size_t WS_MIXED = 72 * MiB;
constexpr size_t WS_ACT = 72 * MiB;
constexpr size_t WS_ZR = 120 * MiB;
constexpr size_t WS_AV = 136 * MiB;
constexpr size_t WS_G = 168 * MiB;
constexpr size_t WS_Y = 200 * MiB;
constexpr size_t WS_YMIX = 136 * MiB;
constexpr size_t WS_CQN = 232 * MiB;
constexpr size_t WS_CKVN = 256 * MiB;
constexpr size_t WS_LORA = 272 * MiB;
constexpr size_t WS_ATT = 264 * MiB;
constexpr size_t WS_YSLOT = 264 * MiB;
constexpr size_t WS_H2LO = 264 * MiB;
constexpr size_t WS_X1B = 200 * MiB;
constexpr size_t WS_CGT = 8 * MiB, WS_CQT = 72 * MiB, WS_CHT = 200 * MiB, WS_CYL = 392 * MiB, WS_Y2 = 104 * MiB;
constexpr size_t WS_RKV = 296 * MiB;
constexpr size_t WS_KF = 392 * MiB;
constexpr size_t WS_MIX1 = 296 * MiB;
constexpr size_t WS_BONUS = 440 * MiB;
constexpr size_t WS_ROUTE = 442 * MiB;
constexpr size_t WS_LIST = 444 * MiB;
constexpr size_t WS_W = 448 * MiB;
constexpr size_t WS_QRAW = 448 * MiB;

struct Ctx {
    const float *x, *c; const int* pos;
    const float *w_ada, *b_ada, *g_pre_mix, *g_post_mix, *g_pre_ffn, *g_post_ffn;
    const float *w_in, *g_cq, *w_uq, *g_ckv, *w_ukv, *w_o_mla;
    const float *mu, *w_dec, *dec_bias, *w_a, *a_bias, *w_g, *k_k, *k_a, *r_k, *lnx_w, *lnx_b, *w_o_rwkv, *w_out;
    const float *w_rg, *b_rg, *w_re, *b_re, *w_eg, *w_eu, *w_ed;
    float* out; unsigned char* ws;
};

__device__ __forceinline__ void d_prep(const Ctx& C, int gw, int ngw, int lane) {
    typedef unsigned u32x4_ __attribute__((ext_vector_type(4)));
    const bf16_t* zm = (const bf16_t*)(C.ws + WS_ZM); const bf16_t* zr = (const bf16_t*)(C.ws + WS_ZR);
    bf16_t* cqn = (bf16_t*)(C.ws + WS_CQN); bf16_t* ckvn = (bf16_t*)(C.ws + WS_CKVN); bf16_t* lora = (bf16_t*)(C.ws + WS_LORA);
    bf16_t* rkv = (bf16_t*)(C.ws + WS_RKV); bf16_t* kf = (bf16_t*)(C.ws + WS_KF);
    const float2* rope = (const float2*)(C.ws + WS_ROPE);
#define UNPK8(W_, F_) do { F_[0] = __uint_as_float(W_[0] << 16); F_[1] = __uint_as_float(W_[0] & 0xffff0000u); F_[2] = __uint_as_float(W_[1] << 16); F_[3] = __uint_as_float(W_[1] & 0xffff0000u); \
        F_[4] = __uint_as_float(W_[2] << 16); F_[5] = __uint_as_float(W_[2] & 0xffff0000u); F_[6] = __uint_as_float(W_[3] << 16); F_[7] = __uint_as_float(W_[3] & 0xffff0000u); } while (0)
    for (int t0 = gw * 4; t0 < T; t0 += ngw * 4) {
        const int b = t0 / SEQ, s0 = t0 % SEQ;
        u32x4_ wq[4], wk[4], wz[5][4];
        const u32x4_ zero4 = {0u, 0u, 0u, 0u};
#pragma unroll
        for (int r = 0; r < 4; ++r) { const bf16_t* zrow = zm + (size_t)(t0 + r) * 768;
            wq[r] = lane < 48 ? *(const u32x4_*)(zrow + 8 * lane) : zero4; wk[r] = lane < 32 ? *(const u32x4_*)(zrow + QR + 8 * lane) : zero4; }
#pragma unroll
        for (int r = 0; r < 5; ++r)
#pragma unroll
            for (int j = 0; j < 4; ++j) { const int c = lane + 64 * j; const bool ok = (c < RWKV_IN / 8) && (r > 0 || s0 > 0);
                wz[r][j] = ok ? *(const u32x4_*)(zr + (size_t)(t0 + r - 1) * RWKV_IN + 8 * c) : zero4; }
        float rs1[4], rs2[4];
#pragma unroll
        for (int r = 0; r < 4; ++r) { float v[8], u[8]; UNPK8(wq[r], v); UNPK8(wk[r], u); float ss = 0.f, su = 0.f;
#pragma unroll
            for (int e = 0; e < 8; ++e) { ss += v[e] * v[e]; su += u[e] * u[e]; }
            rs1[r] = ss; rs2[r] = su; }
#pragma unroll
        for (int r = 0; r < 4; ++r) { rs1[r] = rsqrtf(wsum_dpp(rs1[r]) * (1.f / QR) + RMS_EPS); rs2[r] = rsqrtf(wsum_dpp(rs2[r]) * (1.f / KVR) + RMS_EPS); }
        if (lane < 48) { const float4 g0 = *(const float4*)(C.g_cq + 8 * lane), g1 = *(const float4*)(C.g_cq + 8 * lane + 4);
#pragma unroll
            for (int r = 0; r < 4; ++r) { float v[8]; UNPK8(wq[r], v); const float q = rs1[r];
                u32x4_ o; o.x = cvtpk(v[0] * q * g0.x, v[1] * q * g0.y); o.y = cvtpk(v[2] * q * g0.z, v[3] * q * g0.w); o.z = cvtpk(v[4] * q * g1.x, v[5] * q * g1.y); o.w = cvtpk(v[6] * q * g1.z, v[7] * q * g1.w);
                *(u32x4_*)(cqn + (size_t)(t0 + r) * QR + 8 * lane) = o; } }
        if (lane < 32) { const float4 g0 = *(const float4*)(C.g_ckv + 8 * lane), g1 = *(const float4*)(C.g_ckv + 8 * lane + 4);
#pragma unroll
            for (int r = 0; r < 4; ++r) { float u[8]; UNPK8(wk[r], u); const float q = rs2[r];
                u32x4_ o; o.x = cvtpk(u[0] * q * g0.x, u[1] * q * g0.y); o.y = cvtpk(u[2] * q * g0.z, u[3] * q * g0.w); o.z = cvtpk(u[4] * q * g1.x, u[5] * q * g1.y); o.w = cvtpk(u[6] * q * g1.z, u[7] * q * g1.w);
                *(u32x4_*)(ckvn + (size_t)(t0 + r) * KVR + 8 * lane) = o; } }
        {   const int h = lane >> 3, i2 = (lane & 7) * 2;
#pragma unroll
            for (int r = 0; r < 4; ++r) { const int t = t0 + r; const bf16_t* zrow = zm + (size_t)t * 768 + QR + KVR;
                const unsigned pa = *(const unsigned*)(zrow + i2), pb = *(const unsigned*)(zrow + 16 + i2);
                const float x1a = __uint_as_float(pa << 16), x1b = __uint_as_float(pa & 0xffff0000u), x2a = __uint_as_float(pb << 16), x2b = __uint_as_float(pb & 0xffff0000u);
                const float4 cc = *(const float4*)(rope + (size_t)t * 16 + i2);
                u32x2 o; o.x = cvtpk(x1a * cc.x - x2a * cc.y, x2a * cc.x + x1a * cc.y); o.y = cvtpk(x1b * cc.z - x2b * cc.w, x2b * cc.z + x1b * cc.w);
                *(u32x2*)(kf + (((size_t)b * NH + h) * SEQ + (s0 + r)) * QK + NOPE + 2 * i2) = o; } }
#pragma unroll
        for (int j = 0; j < 4; ++j) {
            const int c = lane + 64 * j;
            if (c < RWKV_IN / 8) {
                const float4 m0 = *(const float4*)(C.mu + 8 * c), m1 = *(const float4*)(C.mu + 8 * c + 4);
                const float mm[8] = {m0.x, m0.y, m0.z, m0.w, m1.x, m1.y, m1.z, m1.w};
                float p[8]; UNPK8(wz[0][j], p);
#pragma unroll
                for (int r = 0; r < 4; ++r) {
                    float z[8]; UNPK8(wz[r + 1][j], z);
                    float zs[8];
#pragma unroll
                    for (int e = 0; e < 8; ++e) { zs[e] = z[e] + (p[e] - z[e]) * mm[e]; p[e] = z[e]; }
                    bf16_t* dst;
                    if (c < 3 * RW / 8) dst = rkv + (size_t)(t0 + r) * 3 * RW + 8 * c;
                    else { dst = lora + (size_t)(t0 + r) * 256 + (8 * c - 3 * RW);
                        if (c < (3 * RW + DR) / 8) {
#pragma unroll
                            for (int e = 0; e < 8; ++e) { const float ex = __expf(2.f * zs[e]); zs[e] = 1.f - 2.f * __builtin_amdgcn_rcpf(ex + 1.f); } }
                        else if (c >= (3 * RW + DR + AR) / 8) {
#pragma unroll
                            for (int e = 0; e < 8; ++e) zs[e] = fsigmoid(zs[e]); } }
                    u32x4_ o; o.x = cvtpk(zs[0], zs[1]); o.y = cvtpk(zs[2], zs[3]); o.z = cvtpk(zs[4], zs[5]); o.w = cvtpk(zs[6], zs[7]);
                    *(u32x4_*)dst = o;
                }
            }
        }
    }
#undef UNPK8
}

__device__ __forceinline__ void d_rwkv_post(const Ctx& C, int gw, int ngw, int lane) {
    typedef unsigned u32x4_ __attribute__((ext_vector_type(4)));
    const bf16_t* y = (const bf16_t*)(C.ws + WS_Y2); const float* bonus = (const float*)(C.ws + WS_BONUS);
    const bf16_t* rkv = (const bf16_t*)(C.ws + WS_RKV); const bf16_t* g = (const bf16_t*)(C.ws + WS_G);
    bf16_t* rwo = (bf16_t*)(C.ws + WS_RWO);
    const int c0 = 8 * lane, h = lane >> 3;
    const float4 lw0 = *(const float4*)(C.lnx_w + c0), lw1 = *(const float4*)(C.lnx_w + c0 + 4), lb0 = *(const float4*)(C.lnx_b + c0), lb1 = *(const float4*)(C.lnx_b + c0 + 4);
    const float lw[8] = {lw0.x, lw0.y, lw0.z, lw0.w, lw1.x, lw1.y, lw1.z, lw1.w}, lb[8] = {lb0.x, lb0.y, lb0.z, lb0.w, lb1.x, lb1.y, lb1.z, lb1.w};
    for (int t0 = gw * 4; t0 < T; t0 += ngw * 4) {
        float4 ya[4], yb[4]; u32x4_ vv[4], gg[4]; float bn[4];
#pragma unroll
        for (int r = 0; r < 4; ++r) { const size_t t = t0 + r;
            { const u32x4_ yw = *(const u32x4_*)(y + t * RW + c0);
              ya[r] = make_float4(__uint_as_float(yw[0] << 16), __uint_as_float(yw[0] & 0xffff0000u), __uint_as_float(yw[1] << 16), __uint_as_float(yw[1] & 0xffff0000u));
              yb[r] = make_float4(__uint_as_float(yw[2] << 16), __uint_as_float(yw[2] & 0xffff0000u), __uint_as_float(yw[3] << 16), __uint_as_float(yw[3] & 0xffff0000u)); }
            vv[r] = *(const u32x4_*)(rkv + t * 1536 + 1024 + c0); gg[r] = *(const u32x4_*)(g + t * RW + c0); bn[r] = bonus[t * NH + h]; }
#pragma unroll
        for (int r = 0; r < 4; ++r) {
            const float yv[8] = {ya[r].x, ya[r].y, ya[r].z, ya[r].w, yb[r].x, yb[r].y, yb[r].z, yb[r].w};
            float sm = 0.f;
#pragma unroll
            for (int e = 0; e < 8; ++e) sm += yv[e];
            const float mean = sum8_dpp(sm) * (1.f / 64.f);
            float sq = 0.f;
#pragma unroll
            for (int e = 0; e < 8; ++e) { const float d = yv[e] - mean; sq += d * d; }
            const float rstd = rsqrtf(sum8_dpp(sq) * (1.f / 64.f) + GN_EPS);
            float o[8];
#pragma unroll
            for (int e = 0; e < 4; ++e) {
                const float v0 = __uint_as_float(vv[r][e] << 16), v1 = __uint_as_float(vv[r][e] & 0xffff0000u), g0 = __uint_as_float(gg[r][e] << 16), g1 = __uint_as_float(gg[r][e] & 0xffff0000u);
                o[2 * e] = ((yv[2 * e] - mean) * rstd * lw[2 * e] + lb[2 * e] + bn[r] * v0) * g0;
                o[2 * e + 1] = ((yv[2 * e + 1] - mean) * rstd * lw[2 * e + 1] + lb[2 * e + 1] + bn[r] * v1) * g1; }
            u32x4_ w; w.x = cvtpk(o[0], o[1]); w.y = cvtpk(o[2], o[3]); w.z = cvtpk(o[4], o[5]); w.w = cvtpk(o[6], o[7]);
            *(u32x4_*)(rwo + (size_t)(t0 + r) * RW + c0) = w;
        }
    }
}

#define LAS __attribute__((address_space(3)))
typedef short bf16x8 __attribute__((ext_vector_type(8)));
typedef float f32x4 __attribute__((ext_vector_type(4)));
typedef float f32x16 __attribute__((ext_vector_type(16)));
typedef unsigned u32x4 __attribute__((ext_vector_type(4)));

constexpr int NWAVES = 8, NTHR = NWAVES * 64;
constexpr int RING_BYTES = 131072;
constexpr int LDSCTL_OFF = RING_BYTES;
constexpr int LDS_BYTES = 163840;

namespace pg8 {
constexpr int BM = 256, BK = 64, HALF = 128, HTB = HALF * BK * 2, NXCD = 8, WGM = 8;
__host__ __device__ __forceinline__ int lds_byte(int r, int c) { const int st = (r >> 4) * 2 + (c >> 5), rr = r & 15, cc = c & 31, ob = rr * 64 + cc * 2; return st * 1024 + (ob ^ (((ob >> 9) & 1) << 5)); }
__host__ __device__ __forceinline__ void stage_rc(int b, int& R, int& C) { const int st = b / 1024, sb = b % 1024, swz = sb ^ (((sb >> 9) & 1) << 5); R = (st >> 1) * 16 + swz / 64; C = (st & 1) * 32 + (swz % 64) / 2; }
__host__ __device__ __forceinline__ int perm32(int rho) { const int n = rho >> 4, i = rho & 15; return 8 * (i >> 2) + 4 * n + (i & 3); }

struct Unit { int pm, pn, z; };

struct StaticOrder {
    int nM, nN, nwg, G, c, parts;
    __device__ void init(int M, int N, int G_, int c_, int parts_ = 1) { nM = M / BM; nN = N / BM; nwg = nM * nN; G = G_; c = c_; parts = parts_; }
    __device__ bool next(int i, Unit& u) const {
        const int it = i / parts; u.z = i - it * parts;
        const long L = (long)it * G + c; if (L >= nwg) return false;
        int wgid = (int)L; { const int q = nwg / NXCD, r = nwg % NXCD, xcd = wgid % NXCD, off = wgid / NXCD; wgid = (xcd < r ? xcd * (q + 1) : r * (q + 1) + (xcd - r) * q) + off; }
        const int nig = WGM * nN, gid = wgid / nig, fm = gid * WGM, gsz = (nM - fm) < WGM ? (nM - fm) : WGM;
        u.pm = fm + ((wgid % nig) % gsz); u.pn = (wgid % nig) / gsz; return true;
    }
};
struct Dense { static constexpr bool GATHER = false; const bf16_t* A; const bf16_t* Bt; int lda, ldb, K;
    __device__ __forceinline__ unsigned a_off(const Unit&, int R) const { return (unsigned)(R * lda) * 2u; }
    __device__ __forceinline__ const char* a_ptr(const Unit& u) const { return (const char*)(A + (size_t)u.pm * BM * lda); }
    __device__ __forceinline__ const char* b_ptr(const Unit& u) const { return (const char*)(Bt + (size_t)u.pn * BM * ldb); } };

template <class T, class = void> struct has_signal : std::false_type {};
template <class T> struct has_signal<T, std::void_t<decltype(T::SIGNAL)>> : std::true_type {};
template <class T, class = void> struct a_aux { static constexpr int value = 0; };
template <class T> struct a_aux<T, std::void_t<decltype(T::A_AUX)>> { static constexpr int value = T::A_AUX; };
template <bool ALIGN_EPI = true, class Epi, class Prob, class Sched>
__device__ __forceinline__ void gemm_phase(LAS unsigned char* lds, const Prob& P, const Sched& S, const Epi& E) {
    const int tid = threadIdx.x, wid = __builtin_amdgcn_readfirstlane(tid >> 6), lane = tid & 63, wr = wid >> 2, wc = wid & 3, fr = lane & 15, fq = lane >> 4;
    const int K = P.K, nt = K / BK;
    unsigned voffB[2]; int RA[2], CA[2];
#pragma unroll
    for (int i = 0; i < 2; ++i) { int R, C; stage_rc(tid * 16 + i * 8192, R, C); const int Rb = Epi::PERM ? ((R & ~31) + perm32(R & 31)) : R;
        RA[i] = R; CA[i] = C * 2; voffB[i] = (unsigned)(Rb * P.ldb + C) * 2u; }
    unsigned vAc[2][2], vAn[2][2];
#define PG8_FILLA(v, u) do { _Pragma("unroll") for (int h_ = 0; h_ < 2; ++h_) _Pragma("unroll") for (int i_ = 0; i_ < 2; ++i_) v[h_][i_] = P.a_off(u, RA[i_] + h_ * HALF) + (unsigned)CA[i_]; } while (0)
    const size_t kstep = (size_t)(BK * 2);
    const size_t hstepB = (size_t)HALF * P.ldb * 2;
    const unsigned ldsw = (unsigned)wid * 1024u;
    const int aoff = lds_byte(wr * 64 + fr, fq * 8), boff = lds_byte(wc * 32 + fr, fq * 8);
#define PG8_SA(b, h) (((b) * 2 + (h)) * HTB)
#define PG8_SB(b, h) ((4 + (b) * 2 + (h)) * HTB)
#define PG8_STAGE(bufoff, gbase, voff) do { _Pragma("unroll") for (int _i = 0; _i < 2; ++_i) \
        __builtin_amdgcn_global_load_lds((const unsigned*)((const char*)(gbase) + (voff)[_i]), (LAS unsigned*)(lds + (bufoff) + ldsw + _i * 8192), 16, 0, 0); } while (0)
#define PG8_STAGEA(bufoff, gbase, voff) do { _Pragma("unroll") for (int _i = 0; _i < 2; ++_i) \
        __builtin_amdgcn_global_load_lds((const unsigned*)((const char*)(gbase) + (voff)[_i]), (LAS unsigned*)(lds + (bufoff) + ldsw + _i * 8192), 16, 0, a_aux<Prob>::value); } while (0)
#define PG8_LDA(dst, b, h) do { _Pragma("unroll") for (int m = 0; m < 4; ++m) _Pragma("unroll") for (int k = 0; k < 2; ++k) dst[m][k] = *(const LAS bf16x8*)(lds + PG8_SA(b, h) + aoff + m * 2048 + k * 1024); } while (0)
#define PG8_LDB(dst, b, h) do { _Pragma("unroll") for (int n = 0; n < 2; ++n) _Pragma("unroll") for (int k = 0; k < 2; ++k) dst[n][k] = *(const LAS bf16x8*)(lds + PG8_SB(b, h) + boff + n * 2048 + k * 1024); } while (0)
#define PG8_MMA(ai, bj, At, Bt) do { __builtin_amdgcn_s_setprio(1); _Pragma("unroll") for (int m = 0; m < 4; ++m) _Pragma("unroll") for (int n = 0; n < 2; ++n) _Pragma("unroll") for (int k = 0; k < 2; ++k) \
        acc[ai][bj][m][n] = __builtin_amdgcn_mfma_f32_16x16x32_bf16(Bt[n][k], At[m][k], acc[ai][bj][m][n], 0, 0, 0); __builtin_amdgcn_s_setprio(0); } while (0)
#define PG8_WAIT_V(n) asm volatile("s_waitcnt vmcnt(" #n ")" ::: "memory")
#define PG8_WAIT_L(n) asm volatile("s_waitcnt lgkmcnt(" #n ")" ::: "memory")
#define PG8_BAR __builtin_amdgcn_s_barrier()
#define PG8_SCHED __builtin_amdgcn_sched_barrier(0)
    Unit cur, nxt; int ui = 0;
    if (!S.next(0, cur)) return;
    f32x4 acc[2][2][4][2];
#pragma unroll
    for (int a = 0; a < 2; ++a)
#pragma unroll
        for (int b = 0; b < 2; ++b)
#pragma unroll
            for (int m = 0; m < 4; ++m)
#pragma unroll
                for (int n = 0; n < 2; ++n) acc[a][b][m][n] = (f32x4){0.f, 0.f, 0.f, 0.f};
    bf16x8 At[4][2], B0[2][2], B1[2][2];
    const char* cA = P.a_ptr(cur); const char* cB = P.b_ptr(cur);
    PG8_FILLA(vAc, cur);
    PG8_STAGE(PG8_SB(0, 0), cB, voffB); PG8_STAGE(PG8_SB(0, 1), cB + hstepB, voffB); PG8_STAGEA(PG8_SA(0, 0), cA, vAc[0]); PG8_STAGEA(PG8_SA(0, 1), cA, vAc[1]);
    if (wr == 1) PG8_BAR;
    PG8_WAIT_V(2); PG8_BAR;
    PG8_STAGE(PG8_SB(1, 0), cB + kstep, voffB); PG8_STAGEA(PG8_SA(1, 0), cA + kstep, vAc[0]); PG8_STAGE(PG8_SB(1, 1), cB + hstepB + kstep, voffB);
    PG8_WAIT_V(6); PG8_BAR;
    for (;;) {
        const bool has_next = S.next(ui + 1, nxt);
        const char* nA = has_next ? P.a_ptr(nxt) : cA; const char* nB = has_next ? P.b_ptr(nxt) : cB;
        if (Prob::GATHER && has_next) { PG8_FILLA(vAn, nxt); }
        else {
#pragma unroll
            for (int h_ = 0; h_ < 2; ++h_)
#pragma unroll
                for (int i_ = 0; i_ < 2; ++i_) vAn[h_][i_] = vAc[h_][i_]; }
        for (int t = 0; t < nt; t += 2) {
            const bool last = (t == nt - 2);
            const char* a1 = cA + (size_t)(t + 1) * kstep;
            const char* a2 = last ? nA : cA + (size_t)(t + 2) * kstep; const char* b2 = last ? nB : cB + (size_t)(t + 2) * kstep;
            const char* a3 = a2 + kstep; const char* b3 = b2 + kstep;
            unsigned vA2[2][2];
#pragma unroll
            for (int h_ = 0; h_ < 2; ++h_)
#pragma unroll
                for (int i_ = 0; i_ < 2; ++i_) vA2[h_][i_] = (Prob::GATHER && last) ? vAn[h_][i_] : vAc[h_][i_];
            PG8_LDB(B0, 0, 0); PG8_LDB(B1, 0, 1); PG8_SCHED; PG8_LDA(At, 0, 0); PG8_STAGEA(PG8_SA(1, 1), a1, vAc[1]);
            PG8_WAIT_V(8); PG8_WAIT_L(0); PG8_BAR; PG8_MMA(0, 0, At, B0); PG8_MMA(0, 1, At, B1); PG8_BAR; PG8_SCHED;
            PG8_LDA(At, 0, 1); PG8_STAGE(PG8_SB(0, 0), b2, voffB); PG8_STAGE(PG8_SB(0, 1), b2 + hstepB, voffB); PG8_STAGEA(PG8_SA(0, 0), a2, vA2[0]);
            PG8_WAIT_V(8); PG8_WAIT_L(0); PG8_BAR; PG8_MMA(1, 0, At, B0); PG8_MMA(1, 1, At, B1); PG8_BAR; PG8_SCHED;
            PG8_LDB(B0, 1, 0); PG8_LDB(B1, 1, 1); PG8_SCHED; PG8_LDA(At, 1, 0); PG8_STAGEA(PG8_SA(0, 1), a2, vA2[1]);
            PG8_WAIT_V(8); PG8_WAIT_L(0); PG8_BAR; PG8_MMA(0, 0, At, B0); PG8_MMA(0, 1, At, B1); PG8_BAR; PG8_SCHED;
            PG8_LDA(At, 1, 1); PG8_STAGE(PG8_SB(1, 0), b3, voffB); PG8_STAGE(PG8_SB(1, 1), b3 + hstepB, voffB); PG8_STAGEA(PG8_SA(1, 0), a3, vA2[0]);
            PG8_WAIT_V(8); PG8_WAIT_L(0); PG8_BAR; PG8_MMA(1, 0, At, B0); PG8_MMA(1, 1, At, B1); PG8_BAR; PG8_SCHED;
        }
        if constexpr (ALIGN_EPI) { if (wr == 0) PG8_BAR; }
        E(acc, cur, wr, wc, fr, fq);
        if constexpr (has_signal<Epi>::value) { if (E.sig_now(cur)) { PG8_WAIT_V(0); PG8_BAR; if (tid == 0) E.signal(cur); } }
        if (!has_next) break;
        if (!E.keep(cur)) {
#pragma unroll
            for (int a = 0; a < 2; ++a)
#pragma unroll
                for (int b = 0; b < 2; ++b)
#pragma unroll
                    for (int m = 0; m < 4; ++m)
#pragma unroll
                        for (int n = 0; n < 2; ++n) acc[a][b][m][n] = (f32x4){0.f, 0.f, 0.f, 0.f};
        }
        cur = nxt; cA = nA; cB = nB; ++ui;
#pragma unroll
        for (int h_ = 0; h_ < 2; ++h_)
#pragma unroll
            for (int i_ = 0; i_ < 2; ++i_) vAc[h_][i_] = vAn[h_][i_];
        if constexpr (ALIGN_EPI) { if (wr == 1) PG8_BAR; }
    }
    PG8_WAIT_V(0);
    if constexpr (!ALIGN_EPI) { if (wr == 0) PG8_BAR; }
    PG8_BAR;
#undef PG8_FILLA
#undef PG8_SA
#undef PG8_SB
#undef PG8_STAGE
#undef PG8_STAGEA
#undef PG8_LDA
#undef PG8_LDB
#undef PG8_MMA
#undef PG8_WAIT_V
#undef PG8_WAIT_L
#undef PG8_BAR
#undef PG8_SCHED
}

struct EpiZ { static constexpr bool PERM = true; bf16_t *zm, *zr, *gates;
    __device__ __forceinline__ bool keep(const Unit&) const { return false; }
    __device__ __forceinline__ void operator()(f32x4 (&acc)[2][2][4][2], const Unit& u, int wr, int wc, int fr, int fq) const {
        bf16_t* base; int ldc, colt; bool sig = false;
        if (u.pn < 3) { base = zm; ldc = 768; colt = u.pn * 256; } else if (u.pn < 10) { base = zr; ldc = RWKV_IN; colt = (u.pn - 3) * 256; } else { base = gates; ldc = 2048; colt = (u.pn - 10) * 256; sig = true; }
        const int row0 = u.pm * BM + wr * 64 + fr, col0 = colt + wc * 32 + 8 * fq;
#pragma unroll
        for (int ai = 0; ai < 2; ++ai)
#pragma unroll
            for (int m = 0; m < 4; ++m) { bf16_t* rowp = base + (size_t)(row0 + ai * HALF + m * 16) * ldc + col0;
#pragma unroll
                for (int bj = 0; bj < 2; ++bj) { f32x4 v0 = acc[ai][bj][m][0], v1 = acc[ai][bj][m][1];
                    if (sig) {
#pragma unroll
                        for (int e = 0; e < 4; ++e) { v0[e] = fsigmoid(v0[e]); v1[e] = fsigmoid(v1[e]); } }
                    u32x4 w; w.x = cvtpk(v0[0], v0[1]); w.y = cvtpk(v0[2], v0[3]); w.z = cvtpk(v1[0], v1[1]); w.w = cvtpk(v1[2], v1[3]);
                    *(u32x4*)(rowp + bj * HALF) = w; } }
    } };

struct EpiQ { static constexpr bool PERM = true; bf16_t* qf; const float2* rope;
    __device__ __forceinline__ bool keep(const Unit&) const { return false; }
    __device__ __forceinline__ void operator()(f32x4 (&acc)[2][2][4][2], const Unit& u, int wr, int wc, int fr, int fq) const {
#pragma unroll
        for (int bj = 0; bj < 2; ++bj) {
            const int c0 = u.pn * BM + bj * HALF + wc * 32 + 8 * fq, h = c0 / QK, d0 = c0 - h * QK;
#pragma unroll
            for (int ai = 0; ai < 2; ++ai)
#pragma unroll
                for (int m = 0; m < 4; ++m) {
                    const int t = u.pm * BM + ai * HALF + wr * 64 + m * 16 + fr, b = t / SEQ, s_ = t - b * SEQ;
                    f32x4 v0 = acc[ai][bj][m][0], v1 = acc[ai][bj][m][1];
                    if (d0 >= NOPE) { const int i0 = (d0 - NOPE) >> 1; const float2* cs = rope + (size_t)t * 16 + i0;
                        const float2 c0_ = cs[0], c1_ = cs[1], c2_ = cs[2], c3_ = cs[3];
                        const f32x4 w0 = {v0[0] * c0_.x - v0[1] * c0_.y, v0[1] * c0_.x + v0[0] * c0_.y, v0[2] * c1_.x - v0[3] * c1_.y, v0[3] * c1_.x + v0[2] * c1_.y};
                        const f32x4 w1 = {v1[0] * c2_.x - v1[1] * c2_.y, v1[1] * c2_.x + v1[0] * c2_.y, v1[2] * c3_.x - v1[3] * c3_.y, v1[3] * c3_.x + v1[2] * c3_.y};
                        v0 = w0; v1 = w1; }
                    v0 = v0 * QSCALE; v1 = v1 * QSCALE;
                    u32x4 w; w.x = cvtpk(v0[0], v0[1]); w.y = cvtpk(v0[2], v0[3]); w.z = cvtpk(v1[0], v1[1]); w.w = cvtpk(v1[2], v1[3]);
                    *(u32x4*)(qf + (((size_t)b * NH + h) * SEQ + s_) * QK + d0) = w; } }
    } };
struct EpiKVp { static constexpr bool PERM = true; bf16_t *kf, *vf;
    __device__ __forceinline__ bool keep(const Unit&) const { return false; }
    __device__ __forceinline__ void operator()(f32x4 (&acc)[2][2][4][2], const Unit& u, int wr, int wc, int fr, int fq) const {
#pragma unroll
        for (int bj = 0; bj < 2; ++bj) {
            const int c0 = u.pn * BM + bj * HALF + wc * 32 + 8 * fq, h = c0 >> 7, c = c0 & 127;
#pragma unroll
            for (int ai = 0; ai < 2; ++ai)
#pragma unroll
                for (int m = 0; m < 4; ++m) {
                    const int t = u.pm * BM + ai * HALF + wr * 64 + m * 16 + fr, b = t / SEQ, s_ = t - b * SEQ;
                    const f32x4 v0 = acc[ai][bj][m][0], v1 = acc[ai][bj][m][1];
                    u32x4 w; w.x = cvtpk(v0[0], v0[1]); w.y = cvtpk(v0[2], v0[3]); w.z = cvtpk(v1[0], v1[1]); w.w = cvtpk(v1[2], v1[3]);
                    const size_t rowi = ((size_t)b * NH + h) * SEQ + s_;
                    if (c < 64) *(u32x4*)(kf + rowi * QK + c) = w; else *(u32x4*)(vf + rowi * VD + (c - 64)) = w; } }
    } };
struct EpiLora { static constexpr bool PERM = true; bf16_t *eb; const float *dbias, *abias;
    __device__ __forceinline__ bool keep(const Unit&) const { return false; }
    __device__ __forceinline__ void operator()(f32x4 (&acc)[2][2][4][2], const Unit& u, int wr, int wc, int fr, int fq) const {
        const int kind = u.pn >> 1; bf16_t* base = eb + (size_t)kind * ((size_t)T * RW);
        const float* bp = kind == 0 ? dbias : abias;
#pragma unroll
        for (int bj = 0; bj < 2; ++bj) {
            const int c0 = (u.pn & 1) * BM + bj * HALF + wc * 32 + 8 * fq;
            float bs[8];
#pragma unroll
            for (int e = 0; e < 8; ++e) bs[e] = kind < 2 ? bp[c0 + e] : 0.f;
#pragma unroll
            for (int ai = 0; ai < 2; ++ai)
#pragma unroll
                for (int m = 0; m < 4; ++m) {
                    const int t = u.pm * BM + ai * HALF + wr * 64 + m * 16 + fr;
                    float v[8];
#pragma unroll
                    for (int e = 0; e < 4; ++e) { v[e] = acc[ai][bj][m][0][e] + bs[e]; v[4 + e] = acc[ai][bj][m][1][e] + bs[4 + e]; }
                    if (kind == 0) {
#pragma unroll
                        for (int e = 0; e < 8; ++e) v[e] = 0.60653065971263342f * fsigmoid(v[e]); }
                    else if (kind == 1) {
#pragma unroll
                        for (int e = 0; e < 8; ++e) v[e] = fsigmoid(v[e]); }
                    u32x4 w; w.x = cvtpk(v[0], v[1]); w.y = cvtpk(v[2], v[3]); w.z = cvtpk(v[4], v[5]); w.w = cvtpk(v[6], v[7]);
                    *(u32x4*)(base + (size_t)t * RW + c0) = w; } }
    } };
struct DenseSC { static constexpr bool GATHER = false; static constexpr int A_AUX = 16; const bf16_t* A; const bf16_t* Bt; int lda, ldb, K;
    __device__ __forceinline__ unsigned a_off(const Unit&, int R) const { return (unsigned)(R * lda) * 2u; }
    __device__ __forceinline__ const char* a_ptr(const Unit& u) const { return (const char*)(A + (size_t)u.pm * BM * lda); }
    __device__ __forceinline__ const char* b_ptr(const Unit& u) const { return (const char*)(Bt + (size_t)u.pn * BM * ldb); } };
struct StaticOrderW { StaticOrder so; unsigned* flag; unsigned need;
    __device__ bool next(int i, Unit& u) const { if (!so.next(i, u)) return false;
        unsigned* f = flag + u.pm;
        for (unsigned sp = 0; __hip_atomic_load(f, __ATOMIC_RELAXED, __HIP_MEMORY_SCOPE_AGENT) < need && sp < (1u << 20); ++sp) __builtin_amdgcn_s_sleep(2);
        asm volatile("" ::: "memory");
        return true; } };
struct MixProb { static constexpr bool GATHER = false; const bf16_t *A0, *A1, *B0, *B1; int lda, ldb, K;
    __device__ __forceinline__ unsigned a_off(const Unit&, int R) const { return (unsigned)(R * lda) * 2u; }
    __device__ __forceinline__ const char* a_ptr(const Unit& u) const { return (const char*)((u.z ? A1 : A0) + (size_t)u.pm * BM * lda); }
    __device__ __forceinline__ const char* b_ptr(const Unit& u) const { return (const char*)((u.z ? B1 : B0) + (size_t)u.pn * BM * ldb); } };
struct EpiMix { static constexpr bool PERM = true; static constexpr bool SIGNAL = true; const bf16_t* gates; bf16_t* mixed; unsigned* flag;
    __device__ __forceinline__ bool keep(const Unit& u) const { return u.z == 0; }
    __device__ __forceinline__ bool sig_now(const Unit& u) const { return u.z != 0; }
    __device__ __forceinline__ void signal(const Unit& u) const { __hip_atomic_fetch_add(flag + u.pm, 1u, __ATOMIC_RELAXED, __HIP_MEMORY_SCOPE_AGENT); }
    __device__ __forceinline__ void operator()(f32x4 (&acc)[2][2][4][2], const Unit& u, int wr, int wc, int fr, int fq) const {
#pragma unroll
        for (int bj = 0; bj < 2; ++bj) {
            const int c0 = u.pn * BM + bj * HALF + wc * 32 + 8 * fq;
#pragma unroll
            for (int ai = 0; ai < 2; ++ai)
#pragma unroll
                for (int m = 0; m < 4; ++m) {
                    const int t = u.pm * BM + ai * HALF + wr * 64 + m * 16 + fr;
                    const u32x4 gbw = *(const u32x4*)(gates + (size_t)t * 2048 + DM + c0);
                    float gbv[8];
#pragma unroll
                    for (int e = 0; e < 4; ++e) { gbv[2 * e] = fmaxf(__uint_as_float(gbw[e] << 16), 1e-30f); gbv[2 * e + 1] = fmaxf(__uint_as_float(gbw[e] & 0xffff0000u), 1e-30f); }
                    if (u.z == 0) {
                        const u32x4 gaw = *(const u32x4*)(gates + (size_t)t * 2048 + c0);
#pragma unroll
                        for (int e = 0; e < 4; ++e) { const float ga0 = __uint_as_float(gaw[e] << 16), ga1 = __uint_as_float(gaw[e] & 0xffff0000u);
                            const float r0 = ga0 * __builtin_amdgcn_rcpf(gbv[2 * e]), r1 = ga1 * __builtin_amdgcn_rcpf(gbv[2 * e + 1]);
                            if (e < 2) { acc[ai][bj][m][0][2 * e] *= r0; acc[ai][bj][m][0][2 * e + 1] *= r1; } else { acc[ai][bj][m][1][2 * e - 4] *= r0; acc[ai][bj][m][1][2 * e - 3] *= r1; } }
                    } else {
                        float v[8];
#pragma unroll
                        for (int e = 0; e < 4; ++e) { v[e] = acc[ai][bj][m][0][e] * gbv[e]; v[4 + e] = acc[ai][bj][m][1][e] * gbv[4 + e]; }
                        u32x4 w; w.x = cvtpk(v[0], v[1]); w.y = cvtpk(v[2], v[3]); w.z = cvtpk(v[4], v[5]); w.w = cvtpk(v[6], v[7]);
                        asm volatile("global_store_dwordx4 %0, %1, off sc1\n\ts_nop 1" :: "v"(mixed + (size_t)t * DM + c0), "v"(w) : "memory"); } } }
    } };
struct EpiOutF { static constexpr bool PERM = true; bf16_t* y;
    __device__ __forceinline__ bool keep(const Unit&) const { return false; }
    __device__ __forceinline__ void operator()(f32x4 (&acc)[2][2][4][2], const Unit& u, int wr, int wc, int fr, int fq) const {
#pragma unroll
        for (int bj = 0; bj < 2; ++bj) {
            const int c0 = u.pn * BM + bj * HALF + wc * 32 + 8 * fq;
#pragma unroll
            for (int ai = 0; ai < 2; ++ai)
#pragma unroll
                for (int m = 0; m < 4; ++m) {
                    const int t = u.pm * BM + ai * HALF + wr * 64 + m * 16 + fr;
                    const f32x4 v0 = acc[ai][bj][m][0], v1 = acc[ai][bj][m][1];
                    u32x4 w; w.x = cvtpk(v0[0], v0[1]); w.y = cvtpk(v0[2], v0[3]); w.z = cvtpk(v1[0], v1[1]); w.w = cvtpk(v1[2], v1[3]);
                    *(u32x4*)(y + (size_t)t * DM + c0) = w; } }
    } };

constexpr int MOE_MAXU = 8;
struct MoeTab { const LAS int* desc; const LAS int* rowtab; };
struct MoeSched { MoeTab tb;
    __device__ __forceinline__ bool next(int i, Unit& u) const { if (i >= MOE_MAXU || tb.desc[i * 8 + 5] == 0) return false; u.pm = i; u.pn = tb.desc[i * 8 + 2]; u.z = tb.desc[i * 8 + 0]; return true; } };
struct MoeSched2 { MoeTab tb; unsigned* flag;
    __device__ __forceinline__ bool next(int i, Unit& u) const { if (i >= MOE_MAXU || tb.desc[i * 8 + 5] == 0) return false; u.pm = i; u.pn = tb.desc[i * 8 + 2]; u.z = tb.desc[i * 8 + 0];
        unsigned* f = flag + (tb.desc[i * 8 + 4] >> 8);
        for (unsigned sp = 0; __hip_atomic_load(f, __ATOMIC_RELAXED, __HIP_MEMORY_SCOPE_AGENT) < 2u && sp < (1u << 20); ++sp) __builtin_amdgcn_s_sleep(2);
        asm volatile("" ::: "memory");
        return true; } };
struct MoeProb1 { static constexpr bool GATHER = true; const bf16_t* h2; const bf16_t* wgu; MoeTab tb; int lda, ldb, K;
    __device__ __forceinline__ unsigned a_off(const Unit& u, int R) const { return (unsigned)((tb.rowtab[u.pm * 256 + R] >> 1) * lda) * 2u; }
    __device__ __forceinline__ const char* a_ptr(const Unit&) const { return (const char*)h2; }
    __device__ __forceinline__ const char* b_ptr(const Unit& u) const { return (const char*)(wgu + ((size_t)u.z * 512 + u.pn * BM) * ldb); } };
struct MoeProb2 { static constexpr bool GATHER = false; static constexpr int A_AUX = 16  ; const bf16_t* act; const bf16_t* wdn; MoeTab tb; int lda, ldb, K;
    __device__ __forceinline__ unsigned a_off(const Unit&, int R) const { return (unsigned)(R * lda) * 2u; }
    __device__ __forceinline__ const char* a_ptr(const Unit& u) const { return (const char*)(act + (size_t)tb.desc[u.pm * 8 + 4] * lda); }
    __device__ __forceinline__ const char* b_ptr(const Unit& u) const { return (const char*)(wdn + ((size_t)u.z * 1024 + u.pn * BM) * ldb); } };
struct EpiMoe1 { static constexpr bool PERM = true; static constexpr bool SIGNAL = true; bf16_t* act; const float* tokw; MoeTab tb; unsigned* flag;
    __device__ __forceinline__ bool keep(const Unit&) const { return false; }
    __device__ __forceinline__ bool sig_now(const Unit&) const { return true; }
    __device__ __forceinline__ void signal(const Unit& u) const {
        __hip_atomic_fetch_add(flag + (tb.desc[u.pm * 8 + 4] >> 8), 1u, __ATOMIC_RELAXED, __HIP_MEMORY_SCOPE_AGENT); }
    __device__ __forceinline__ void operator()(f32x4 (&acc)[2][2][4][2], const Unit& u, int wr, int wc, int fr, int fq) const {
        const int nvalid = tb.desc[u.pm * 8 + 3], arow0 = tb.desc[u.pm * 8 + 4];
        const int f0 = u.pn * HALF + wc * 32 + 8 * fq;
#pragma unroll
        for (int ai = 0; ai < 2; ++ai)
#pragma unroll
            for (int m = 0; m < 4; ++m) {
                const int r = ai * HALF + wr * 64 + m * 16 + fr;
                if (r < nvalid) {
                    const float w = tokw[tb.rowtab[u.pm * 256 + r]];
                    float v[8];
#pragma unroll
                    for (int e = 0; e < 4; ++e) { const float g0 = acc[ai][0][m][0][e], g1 = acc[ai][0][m][1][e];
                        v[e] = g0 * fsigmoid(g0) * acc[ai][1][m][0][e] * w; v[4 + e] = g1 * fsigmoid(g1) * acc[ai][1][m][1][e] * w; }
                    u32x4 o; o.x = cvtpk(v[0], v[1]); o.y = cvtpk(v[2], v[3]); o.z = cvtpk(v[4], v[5]); o.w = cvtpk(v[6], v[7]);
                    asm volatile("global_store_dwordx4 %0, %1, off sc1\n\ts_nop 1" :: "v"(act + (size_t)(arow0 + r) * FF + f0), "v"(o) : "memory"); } }
    } };
struct EpiMoe2 { static constexpr bool PERM = true; bf16_t* ys; MoeTab tb;
    __device__ __forceinline__ bool keep(const Unit&) const { return false; }
    __device__ __forceinline__ void operator()(f32x4 (&acc)[2][2][4][2], const Unit& u, int wr, int wc, int fr, int fq) const {
        const int nvalid = tb.desc[u.pm * 8 + 3];
#pragma unroll
        for (int ai = 0; ai < 2; ++ai)
#pragma unroll
            for (int m = 0; m < 4; ++m) {
                const int r = ai * HALF + wr * 64 + m * 16 + fr;
                if (r < nvalid) {
                    bf16_t* rowp = ys + (size_t)tb.rowtab[u.pm * 256 + r] * DM + u.pn * BM + wc * 32 + 8 * fq;
#pragma unroll
                    for (int bj = 0; bj < 2; ++bj) { const f32x4 v0 = acc[ai][bj][m][0], v1 = acc[ai][bj][m][1];
                        u32x4 o; o.x = cvtpk(v0[0], v0[1]); o.y = cvtpk(v0[2], v0[3]); o.z = cvtpk(v1[0], v1[1]); o.w = cvtpk(v1[2], v1[3]);
                        *(u32x4*)(rowp + bj * HALF) = o; } } }
    } };
}

struct TrItem { const float* W; bf16_t* WT; int ldw, ksrc0, ldt, kdst0, ndst0, kind, off, pad; };
__device__ __forceinline__ int tr_map(int kind, int off, int r) {
    if (kind == 0) return r - off;
    if (kind == 1) return r < MLA_IN ? r : (r < 768 ? -1 : r - 96);
    if (kind == 2) { const int h = r / QK, d = r % QK; if (d < NOPE) return r; const int i = (d - NOPE) >> 1, odd = (d - NOPE) & 1; return h * QK + NOPE + i + 16 * odd; }
    return ((r >> 8) << 7) + (r & 127);
}
__device__ __forceinline__ void tr_load(const TrItem& d, float (&v)[32], int lane) {
    const int n = lane & 31; const int sc = d.W ? tr_map(d.kind, d.off, d.ndst0 + n) : -1;
    const float* p = d.W + (size_t)(d.ksrc0 + (lane >> 5)) * d.ldw + (sc >= 0 ? sc : 0);
#pragma unroll
    for (int i = 0; i < 32; ++i) v[i] = (sc >= 0) ? p[(size_t)(2 * i) * d.ldw] : 0.f;
}
__device__ __forceinline__ void tr_store(const TrItem& d, const float (&v)[32], LAS float* scr, int lane) {
    const int n = lane & 31;
#pragma unroll
    for (int i = 0; i < 32; ++i) scr[(2 * i + (lane >> 5)) * 33 + n] = v[i];
    asm volatile("s_waitcnt lgkmcnt(0)" ::: "memory");
    const int c = lane & 7;
#pragma unroll
    for (int j = 0; j < 4; ++j) { const int nn = (lane >> 3) + 8 * j; const LAS float* s_ = scr + (8 * c) * 33 + nn;
        u32x4 o; o.x = cvtpk(s_[0 * 33], s_[1 * 33]); o.y = cvtpk(s_[2 * 33], s_[3 * 33]); o.z = cvtpk(s_[4 * 33], s_[5 * 33]); o.w = cvtpk(s_[6 * 33], s_[7 * 33]);
        *(u32x4*)(d.WT + (size_t)(d.ndst0 + nn) * d.ldt + d.kdst0 + 8 * c) = o; }
    asm volatile("s_waitcnt lgkmcnt(0)" ::: "memory");
}

constexpr size_t WO_IN = 0;
constexpr size_t WO_UQ = WO_IN + (size_t)4608 * 1024 * 2;
constexpr size_t WO_UKV = WO_UQ + (size_t)768 * 384 * 2;
constexpr size_t WO_LORA = WO_UKV + (size_t)1024 * 256 * 2;
constexpr size_t WO_OM = WO_LORA + (size_t)1536 * 256 * 2;
constexpr size_t WO_OR = WO_OM + (size_t)1024 * 512 * 2;
constexpr size_t WO_OUT = WO_OR + (size_t)1024 * 512 * 2;
constexpr size_t WO_GU = WO_OUT + (size_t)1024 * 1024 * 2;
constexpr size_t WO_DN = WO_GU + (size_t)32 * 512 * 1024 * 2;
constexpr size_t WO_END = WO_DN + (size_t)32 * 1024 * 256 * 2;
constexpr size_t WO_RH = WO_END;
constexpr size_t WO_RL = WO_RH + (size_t)48 * 1024 * 2;
static_assert(WO_RL + (size_t)48 * 1024 * 2 <= 64 * MiB, "weights region");
constexpr int TR_I_IN = 16 * 144, TR_I_UQ = 6 * 24, TR_I_UKV = 4 * 32, TR_I_LORA = 4 * 48, TR_I_OM = 8 * 32, TR_I_OR = 8 * 32, TR_I_OUT = 16 * 32, TR_I_GU = 32 * 16 * 16, TR_I_DN = 32 * 4 * 32;
constexpr int TR_NITEMS = TR_I_IN + TR_I_UQ + TR_I_UKV + TR_I_LORA + TR_I_OM + TR_I_OR + TR_I_OUT + TR_I_GU + TR_I_DN;
__device__ __forceinline__ TrItem tr_desc(const Ctx& C, int it) {
    bf16_t* wb = (bf16_t*)(C.ws + WS_W);
    TrItem d; d.kind = 0; d.off = 0; d.pad = 0;
    int r = it;
    if (r < TR_I_IN) { const int kb = r / 144, nb = r % 144; d.W = C.w_in; d.ldw = IN_W; d.ksrc0 = 64 * kb; d.WT = wb + WO_IN / 2; d.ldt = 1024; d.kdst0 = 64 * kb; d.ndst0 = 32 * nb; d.kind = 1; return d; } r -= TR_I_IN;
    if (r < TR_I_UQ) { const int kb = r / 24, nb = r % 24; d.W = C.w_uq; d.ldw = 768; d.ksrc0 = 64 * kb; d.WT = wb + WO_UQ / 2; d.ldt = QR; d.kdst0 = 64 * kb; d.ndst0 = 32 * nb; d.kind = 2; return d; } r -= TR_I_UQ;
    if (r < TR_I_UKV) { const int kb = r / 32, nb = r % 32; d.W = C.w_ukv; d.ldw = 1024; d.ksrc0 = 64 * kb; d.WT = wb + WO_UKV / 2; d.ldt = KVR; d.kdst0 = 64 * kb; d.ndst0 = 32 * nb; return d; } r -= TR_I_UKV;
    if (r < TR_I_LORA) { const int kb = r / 48, nb = r % 48;
        d.W = nullptr; d.ksrc0 = 0; d.ldw = RW;
        if (nb < 16) { if (kb == 0) d.W = C.w_dec; d.off = 0; }
        else if (nb < 32) { if (kb == 1) d.W = C.w_a; d.off = 512; }
        else { if (kb >= 2) { d.W = C.w_g; d.ksrc0 = 64 * (kb - 2); } d.off = 1024; }
        d.WT = wb + WO_LORA / 2; d.ldt = 256; d.kdst0 = 64 * kb; d.ndst0 = 32 * nb; return d; } r -= TR_I_LORA;
    if (r < TR_I_OM) { const int kb = r / 32, nb = r % 32; d.W = C.w_o_mla; d.ldw = DM; d.ksrc0 = 64 * kb; d.WT = wb + WO_OM / 2; d.ldt = RW; d.kdst0 = 64 * kb; d.ndst0 = 32 * nb; return d; } r -= TR_I_OM;
    if (r < TR_I_OR) { const int kb = r / 32, nb = r % 32; d.W = C.w_o_rwkv; d.ldw = DM; d.ksrc0 = 64 * kb; d.WT = wb + WO_OR / 2; d.ldt = RW; d.kdst0 = 64 * kb; d.ndst0 = 32 * nb; return d; } r -= TR_I_OR;
    if (r < TR_I_OUT) { const int kb = r / 32, nb = r % 32; d.W = C.w_out; d.ldw = DM; d.ksrc0 = 64 * kb; d.WT = wb + WO_OUT / 2; d.ldt = DM; d.kdst0 = 64 * kb; d.ndst0 = 32 * nb; return d; } r -= TR_I_OUT;
    if (r < TR_I_GU) { const int e = r / 256, q = r % 256, kb = q / 16, nb = q % 16;
        d.W = (((32 * nb) & 128) ? C.w_eu : C.w_eg) + (size_t)e * DM * FF; d.ldw = FF; d.ksrc0 = 64 * kb; d.WT = wb + WO_GU / 2 + (size_t)e * 512 * 1024; d.ldt = 1024; d.kdst0 = 64 * kb; d.ndst0 = 32 * nb; d.kind = 3; return d; } r -= TR_I_GU;
    { const int e = r / 128, q = r % 128, kb = q / 32, nb = q % 32;
      d.W = C.w_ed + (size_t)e * FF * DM; d.ldw = DM; d.ksrc0 = 64 * kb; d.WT = wb + WO_DN / 2 + (size_t)e * 1024 * 256; d.ldt = 256; d.kdst0 = 64 * kb; d.ndst0 = 32 * nb; return d; }
}


namespace att {
constexpr int KROW = 208, KBUF = 64 * KROW, VBUF = 8192, BUF = KBUF + VBUF;
typedef short v4i16_t __attribute__((ext_vector_type(4)));
__device__ __forceinline__ v4i16_t vtr(const LAS unsigned char* p) { return __builtin_amdgcn_ds_read_tr16_b64_v4i16((LAS v4i16_t*)p); }
__device__ __forceinline__ float hmax(float x) { auto rr = __builtin_amdgcn_permlane32_swap(__float_as_uint(x), __float_as_uint(x), false, false); return fmaxf(__uint_as_float(rr[0]), __uint_as_float(rr[1])); }
__device__ __forceinline__ float hsum(float x) { auto rr = __builtin_amdgcn_permlane32_swap(__float_as_uint(x), __float_as_uint(x), false, false); return __uint_as_float(rr[0]) + __uint_as_float(rr[1]); }

__device__ __forceinline__ void attn_unit(const Ctx& C, LAS unsigned char* lds, int bh, int qb, int tid, int lane, int wave) {
    const int r32 = lane & 31, hi = lane >> 5;
    const bf16_t* qf = (const bf16_t*)(C.ws + WS_QF) + ((size_t)bh * SEQ + qb * 256 + wave * 32 + r32) * QK;
    const unsigned char* kbase = (const unsigned char*)((const bf16_t*)(C.ws + WS_KF) + (size_t)bh * SEQ * QK);
    const unsigned char* vbase = (const unsigned char*)((const bf16_t*)(C.ws + WS_VF) + (size_t)bh * SEQ * VD);
    bf16x8 qr[6];
#pragma unroll
    for (int s = 0; s < 6; ++s) qr[s] = *(const bf16x8*)(qf + 16 * s + 8 * hi);
    const int kc1 = 512 + tid;
    const int koff0 = (tid / 12) * KROW + (tid % 12) * 16, koff1 = (kc1 / 12) * KROW + (kc1 % 12) * 16;
    const int vkey = tid >> 3, vj = tid & 7;
    const int voff = KBUF + (vj >> 2) * 4096 + (vkey >> 4) * 1024 + (vkey & 15) * 64 + (vj & 3) * 16;
    const int NT = 4 * qb + 4, cw = 4 * qb + (wave >> 1);
    const bool has_k1 = tid < 256;
    u32x4 k0r, k1r = {0u, 0u, 0u, 0u}, v0r;
    k0r = *(const u32x4*)(kbase + (size_t)tid * 16); if (has_k1) k1r = *(const u32x4*)(kbase + (size_t)kc1 * 16); v0r = *(const u32x4*)(vbase + (size_t)tid * 16);
    *(LAS u32x4*)(lds + koff0) = k0r; if (has_k1) *(LAS u32x4*)(lds + koff1) = k1r; *(LAS u32x4*)(lds + voff) = v0r;
    if (NT > 1) { k0r = *(const u32x4*)(kbase + 12288 + (size_t)tid * 16); if (has_k1) k1r = *(const u32x4*)(kbase + 12288 + (size_t)kc1 * 16); v0r = *(const u32x4*)(vbase + 8192 + (size_t)tid * 16); }
    __syncthreads();
    f32x16 o0, o1, negm;
#pragma unroll
    for (int r = 0; r < 16; ++r) { o0[r] = 0.f; o1[r] = 0.f; negm[r] = 0.f; }
    float m = 0.f, l = 0.f;
    const int kfrag = r32 * KROW + hi * 16;
    const int vfrag = KBUF + ((lane >> 4) & 1) * 32 + (lane & 3) * 8 + (4 * hi + ((lane & 15) >> 2)) * 64;
    for (int t = 0; t < NT; ++t) {
        const LAS unsigned char* cur = lds + (t & 1) * BUF;
        if (t + 1 < NT) { LAS unsigned char* nb = lds + ((t + 1) & 1) * BUF;
            *(LAS u32x4*)(nb + koff0) = k0r; if (has_k1) *(LAS u32x4*)(nb + koff1) = k1r; *(LAS u32x4*)(nb + voff) = v0r; }
        if (t + 2 < NT) { const unsigned char* kb = kbase + (size_t)(t + 2) * 12288; const unsigned char* vb = vbase + (size_t)(t + 2) * 8192;
            k0r = *(const u32x4*)(kb + (size_t)tid * 16); if (has_k1) k1r = *(const u32x4*)(kb + (size_t)kc1 * 16); v0r = *(const u32x4*)(vb + (size_t)tid * 16); }
        if (t <= cw) {
            f32x16 p0, p1;
            const LAS unsigned char* kp = cur + kfrag;
#pragma unroll
            for (int s = 0; s < 6; ++s) {
                const bf16x8 a0 = *(const LAS bf16x8*)(kp + s * 32), a1 = *(const LAS bf16x8*)(kp + 32 * KROW + s * 32);
                if (s == 0) { p0 = __builtin_amdgcn_mfma_f32_32x32x16_bf16(a0, qr[0], negm, 0, 0, 0); p1 = __builtin_amdgcn_mfma_f32_32x32x16_bf16(a1, qr[0], negm, 0, 0, 0); }
                else { p0 = __builtin_amdgcn_mfma_f32_32x32x16_bf16(a0, qr[s], p0, 0, 0, 0); p1 = __builtin_amdgcn_mfma_f32_32x32x16_bf16(a1, qr[s], p1, 0, 0, 0); }
            }
            float mx = fmaxf(fmaxf(p0[0], p1[0]), fmaxf(p0[1], p1[1]));
#pragma unroll
            for (int r = 2; r < 16; r += 2) mx = fmaxf(mx, fmaxf(fmaxf(p0[r], p1[r]), fmaxf(p0[r + 1], p1[r + 1])));
            mx = hmax(mx);
            if (t == 0) {
                m = mx;
#pragma unroll
                for (int r = 0; r < 16; ++r) { p0[r] -= mx; p1[r] -= mx; negm[r] = -mx; }
            } else if (__any(mx > 8.0f)) {
                const float dl = fmaxf(mx, 0.f), alpha = __builtin_amdgcn_exp2f(-dl);
                m += dl; l *= alpha;
#pragma unroll
                for (int r = 0; r < 16; ++r) { p0[r] -= dl; p1[r] -= dl; o0[r] *= alpha; o1[r] *= alpha; negm[r] = -m; }
            }
            float ps0 = 0.f, ps1 = 0.f;
#pragma unroll
            for (int r = 0; r < 16; ++r) { p0[r] = __builtin_amdgcn_exp2f(p0[r]); p1[r] = __builtin_amdgcn_exp2f(p1[r]); ps0 += p0[r]; ps1 += p1[r]; }
            l += ps0 + ps1;
            u32x4 pw0, pw1, pw2, pw3;
            pw0 = (u32x4){cvtpk(p0[0], p0[1]), cvtpk(p0[2], p0[3]), cvtpk(p0[4], p0[5]), cvtpk(p0[6], p0[7])};
            pw1 = (u32x4){cvtpk(p0[8], p0[9]), cvtpk(p0[10], p0[11]), cvtpk(p0[12], p0[13]), cvtpk(p0[14], p0[15])};
            pw2 = (u32x4){cvtpk(p1[0], p1[1]), cvtpk(p1[2], p1[3]), cvtpk(p1[4], p1[5]), cvtpk(p1[6], p1[7])};
            pw3 = (u32x4){cvtpk(p1[8], p1[9]), cvtpk(p1[10], p1[11]), cvtpk(p1[12], p1[13]), cvtpk(p1[14], p1[15])};
            const LAS unsigned char* vp = cur + vfrag;
#define ATT_PV(OD, D0, KS, PW) do { const v4i16_t lo_ = vtr(vp + (D0) * 4096 + (KS) * 1024), hi_ = vtr(vp + (D0) * 4096 + (KS) * 1024 + 512); \
                const bf16x8 vf_ = {lo_[0], lo_[1], lo_[2], lo_[3], hi_[0], hi_[1], hi_[2], hi_[3]}; \
                OD = __builtin_amdgcn_mfma_f32_32x32x16_bf16(vf_, __builtin_bit_cast(bf16x8, PW), OD, 0, 0, 0); } while (0)
            ATT_PV(o0, 0, 0, pw0); ATT_PV(o1, 1, 0, pw0); ATT_PV(o0, 0, 1, pw1); ATT_PV(o1, 1, 1, pw1);
            ATT_PV(o0, 0, 2, pw2); ATT_PV(o1, 1, 2, pw2); ATT_PV(o0, 0, 3, pw3); ATT_PV(o1, 1, 3, pw3);
#undef ATT_PV
        }
        asm volatile("s_waitcnt lgkmcnt(0)" ::: "memory"); __builtin_amdgcn_s_barrier(); asm volatile("" ::: "memory");
    }
    const float rl = 1.f / hsum(l);
    const int b = bh / NH, h = bh - b * NH;
    bf16_t* op = (bf16_t*)(C.ws + WS_ATT) + ((size_t)b * SEQ + qb * 256 + wave * 32 + r32) * RW + h * VD + 4 * hi;
#pragma unroll
    for (int g = 0; g < 4; ++g) {
        u32x2 w0, w1;
        w0.x = cvtpk(o0[4 * g] * rl, o0[4 * g + 1] * rl); w0.y = cvtpk(o0[4 * g + 2] * rl, o0[4 * g + 3] * rl);
        w1.x = cvtpk(o1[4 * g] * rl, o1[4 * g + 1] * rl); w1.y = cvtpk(o1[4 * g + 2] * rl, o1[4 * g + 3] * rl);
        *(u32x2*)(op + 8 * g) = w0; *(u32x2*)(op + 32 + 8 * g) = w1;
    }
}
__device__ __forceinline__ void attn_phase(const Ctx& C, LAS unsigned char* lds, int G, int bx, int tid, int lane, int wave) {
    const int v0 = (G % 8 == 0) ? (bx % 8) * (G / 8) + bx / 8 : bx;
    for (int v = v0; v < 256; v += G) {
        const int bh = v >> 1, odd = v & 1;
#pragma unroll 1
        for (int i = 0; i < 4; ++i) {
            const int qb = (i == 0) ? 7 - odd : (i == 1) ? odd : (i == 2) ? 4 + odd : 3 - odd;
            attn_unit(C, lds, bh, qb, tid, lane, wave);
        }
    }
}
}


namespace cscan {
constexpr int CH = 32, NCH = SEQ / CH;
constexpr int RS = 144;
constexpr int RS2 = 80;
constexpr int L_AT = 0, L_BT = 4608, L_RT = 9216, L_KT = 13824, L_BTV = 18432, L_VV = 22528, L_MAB = 26624, L_MAK = 30720, L_GC = 34816, L_MBRT = 35072, L_WAVE = 37632;
constexpr int L_P = L_AT, L_MAKT = L_MAK;
typedef short v4i16_t __attribute__((ext_vector_type(4)));
typedef float f32x2s __attribute__((ext_vector_type(2)));
#define CS_MF(a, b, c) __builtin_amdgcn_mfma_f32_32x32x16_bf16(a, b, c, 0, 0, 0)
template <int CTRL> __device__ __forceinline__ float dpp_add(float x) { return x + __builtin_bit_cast(float, __builtin_amdgcn_update_dpp(0, __builtin_bit_cast(int, x), CTRL, 0xf, 0xf, true)); }
__device__ __forceinline__ float wsum(float x) {
    x = dpp_add<0xB1>(x); x = dpp_add<0x4E>(x); x = dpp_add<0x141>(x); x = dpp_add<0x140>(x);
    x += __builtin_bit_cast(float, __builtin_amdgcn_update_dpp(0, __builtin_bit_cast(int, x), 0x142, 0xa, 0xf, false));
    x += __builtin_bit_cast(float, __builtin_amdgcn_update_dpp(0, __builtin_bit_cast(int, x), 0x143, 0xc, 0xf, false));
    return __builtin_bit_cast(float, __builtin_amdgcn_readlane(__builtin_bit_cast(int, x), 63));
}
__device__ __forceinline__ int crow(int r, int hi) { return (r & 3) + 8 * (r >> 2) + 4 * hi; }
__device__ __forceinline__ bf16x8 pack8(const f32x16& p, int s) {
    u32x4 w; w.x = cvtpk(p[8 * s], p[8 * s + 1]); w.y = cvtpk(p[8 * s + 2], p[8 * s + 3]); w.z = cvtpk(p[8 * s + 4], p[8 * s + 5]); w.w = cvtpk(p[8 * s + 6], p[8 * s + 7]);
    return __builtin_bit_cast(bf16x8, w); }
__device__ __forceinline__ bf16x8 rd_nat(const LAS unsigned char* p) { return *(const LAS bf16x8*)p; }
__device__ __forceinline__ bf16x8 rd_perm(const LAS unsigned char* p) { const u32x2 a = *(const LAS u32x2*)p, b = *(const LAS u32x2*)(p + 16);
    u32x4 w; w.x = a.x; w.y = a.y; w.z = b.x; w.w = b.y; return __builtin_bit_cast(bf16x8, w); }
__device__ __forceinline__ bf16x8 rd_tr(const LAS unsigned char* p) { const v4i16_t lo = __builtin_amdgcn_ds_read_tr16_b64_v4i16((LAS v4i16_t*)p), hi = __builtin_amdgcn_ds_read_tr16_b64_v4i16((LAS v4i16_t*)(p + 512));
    return (bf16x8){lo[0], lo[1], lo[2], lo[3], hi[0], hi[1], hi[2], hi[3]}; }
__device__ __forceinline__ float bfl(unsigned w) { return __uint_as_float(w << 16); }
__device__ __forceinline__ float bfh(unsigned w) { return __uint_as_float(w & 0xffff0000u); }

#define CS_BAR() do { asm volatile("s_waitcnt lgkmcnt(0)" ::: "memory"); __builtin_amdgcn_s_barrier(); asm volatile("" ::: "memory"); } while (0)
__device__ __forceinline__ void pair_bar(LAS unsigned* cnt, unsigned& ord, int lane) {
    asm volatile("s_waitcnt lgkmcnt(0)" ::: "memory");
    ord += 2u;
    if (lane == 0) __hip_atomic_fetch_add(cnt, 1u, __ATOMIC_RELAXED, __HIP_MEMORY_SCOPE_WORKGROUP);
    for (unsigned spins = 0; spins < (1u << 22); ++spins) {
        const unsigned v = __builtin_amdgcn_readfirstlane(__hip_atomic_load(cnt, __ATOMIC_RELAXED, __HIP_MEMORY_SCOPE_WORKGROUP));
        if ((int)(v - ord) >= 0) break;
        __builtin_amdgcn_s_sleep(1);
    }
    asm volatile("" ::: "memory");
}
struct RawRegs { u32x4 r[2], k[2], v[2], a[2], e[2]; };
__device__ __forceinline__ void rawLoad(const Ctx& C, RawRegs& R, int task, int lane, int role) {
    const int c = task & (NCH - 1), bh = task >> 6, b = bh / NH, h = bh - b * NH;
    const size_t trow0 = (size_t)b * SEQ + (size_t)c * CH + 16 * role + (lane >> 3);
    const bf16_t* rkv = (const bf16_t*)(C.ws + WS_RKV) + trow0 * 1536 + h * 64 + (lane & 7) * 8;
    const bf16_t* av = (const bf16_t*)(C.ws + WS_AV) + trow0 * RW + h * 64 + (lane & 7) * 8;
    const bf16_t* eb = (const bf16_t*)(C.ws + WS_EBUF) + trow0 * RW + h * 64 + (lane & 7) * 8;
#pragma unroll
    for (int q = 0; q < 2; ++q) { R.r[q] = *(const u32x4*)(rkv + (size_t)q * 8 * 1536); R.k[q] = *(const u32x4*)(rkv + (size_t)q * 8 * 1536 + 512); R.v[q] = *(const u32x4*)(rkv + (size_t)q * 8 * 1536 + 1024);
        R.a[q] = *(const u32x4*)(av + (size_t)q * 8 * RW); R.e[q] = *(const u32x4*)(eb + (size_t)q * 8 * RW); }
}
__device__ __forceinline__ void taskA(const Ctx& C, LAS unsigned char* L, int task, int lane, int role, bool valid, RawRegs& R, int next_task, bool next_valid, LAS unsigned* pcnt, unsigned& pord) {
    asm volatile("" : "+v"(lane));
    const int c = task & (NCH - 1), bh = task >> 6, b = bh / NH, h = bh - b * NH;
    const int r32 = lane & 31, hi = lane >> 5;
    const size_t trow0 = (size_t)b * SEQ + (size_t)c * CH;
    if (valid) {
        const int jg = lane & 7;
        const float4 kw0 = *(const float4*)(C.k_k + h * 64 + 8 * jg), kw1 = *(const float4*)(C.k_k + h * 64 + 8 * jg + 4), ka0 = *(const float4*)(C.k_a + h * 64 + 8 * jg), ka1 = *(const float4*)(C.k_a + h * 64 + 8 * jg + 4);
        const float4 rk0 = *(const float4*)(C.r_k + h * 64 + 8 * jg), rk1 = *(const float4*)(C.r_k + h * 64 + 8 * jg + 4);
        const float kkw[8] = {kw0.x, kw0.y, kw0.z, kw0.w, kw1.x, kw1.y, kw1.z, kw1.w}, kaw[8] = {ka0.x, ka0.y, ka0.z, ka0.w, ka1.x, ka1.y, ka1.z, ka1.w};
        const float rkw[8] = {rk0.x, rk0.y, rk0.z, rk0.w, rk1.x, rk1.y, rk1.z, rk1.w};
        float* bonus = (float*)(C.ws + WS_BONUS) + trow0 * NH + h;
#pragma unroll
        for (int q = 0; q < 2; ++q) { const int t = 16 * role + 8 * q + (lane >> 3);
            float kf[8], rf[8], af[8], kk0[8], kp[8];
#pragma unroll
            for (int e = 0; e < 4; ++e) { kf[2 * e] = bfl(R.k[q][e]); kf[2 * e + 1] = bfh(R.k[q][e]); rf[2 * e] = bfl(R.r[q][e]); rf[2 * e + 1] = bfh(R.r[q][e]); af[2 * e] = bfl(R.a[q][e]); af[2 * e + 1] = bfh(R.a[q][e]); }
            float n2 = 0.f, bn = 0.f;
#pragma unroll
            for (int e = 0; e < 8; ++e) { kk0[e] = kf[e] * kkw[e]; n2 += kk0[e] * kk0[e]; kp[e] = kf[e] * (1.f + (af[e] - 1.f) * kaw[e]); bn += rf[e] * kp[e] * rkw[e]; }
            n2 = sum8_dpp(n2); bn = sum8_dpp(bn);
            const float rn = __builtin_amdgcn_rsqf(fmaxf(n2, 1e-24f));
            u32x4 wkk, wkp;
            wkk.x = cvtpk(kk0[0] * rn, kk0[1] * rn); wkk.y = cvtpk(kk0[2] * rn, kk0[3] * rn); wkk.z = cvtpk(kk0[4] * rn, kk0[5] * rn); wkk.w = cvtpk(kk0[6] * rn, kk0[7] * rn);
            wkp.x = cvtpk(kp[0], kp[1]); wkp.y = cvtpk(kp[2], kp[3]); wkp.z = cvtpk(kp[4], kp[5]); wkp.w = cvtpk(kp[6], kp[7]);
            if (jg == 0) bonus[(size_t)t * NH] = bn;
            *(LAS u32x4*)(L + L_RT + t * RS + jg * 16) = R.r[q]; *(LAS u32x4*)(L + L_KT + t * RS + jg * 16) = wkp; *(LAS u32x4*)(L + L_AT + t * RS + jg * 16) = wkk;
            *(LAS u32x4*)(L + L_MAK + t * 128 + jg * 16) = R.a[q]; *(LAS u32x4*)(L + L_MAB + t * 128 + jg * 16) = R.e[q];
            *(LAS u32x4*)(L + L_VV + (jg >> 2) * 2048 + (t >> 4) * 1024 + (t & 15) * 64 + (jg & 3) * 16) = R.v[q]; }
    }
    if (next_valid) rawLoad(C, R, next_task, lane, role);
    pair_bar(pcnt, pord, lane);
    if (valid) {
        float Lc = 0.f;
        if (role == 1) {
#pragma unroll
            for (int t = 0; t < 16; ++t) Lc -= bf2f(*(const LAS bf16_t*)(L + L_MAB + t * 128 + lane * 2)); }
        float gprev = __expf(Lc);
        const int vbase = (lane >> 5) * 2048 + (lane & 31) * 2;
#pragma unroll 4
        for (int tt = 0; tt < 16; ++tt) {
            const int t = 16 * role + tt; const int ro = t * RS + lane * 2;
            const float r = bf2f(*(const LAS bf16_t*)(L + L_RT + ro)), kp = bf2f(*(const LAS bf16_t*)(L + L_KT + ro)), kk = bf2f(*(const LAS bf16_t*)(L + L_AT + ro));
            const float a = bf2f(*(const LAS bf16_t*)(L + L_MAK + t * 128 + lane * 2)), e = bf2f(*(const LAS bf16_t*)(L + L_MAB + t * 128 + lane * 2));
            Lc -= e; const float gam = __expf(Lc), ginv = __expf(-Lc);
            const unsigned w1 = cvtpk(-kk * gprev, r * gam), w2 = cvtpk(kp * ginv, kk * a * ginv);
            *(LAS bf16_t*)(L + L_AT + ro) = (bf16_t)w1; *(LAS bf16_t*)(L + L_RT + ro) = (bf16_t)(w1 >> 16); *(LAS bf16_t*)(L + L_KT + ro) = (bf16_t)w2;
            *(LAS bf16_t*)(L + L_BT + ro) = (bf16_t)(w2 >> 16); *(LAS bf16_t*)(L + L_BTV + vbase + (t >> 4) * 1024 + (t & 15) * 64) = (bf16_t)(w2 >> 16);
            gprev = gam;
        }
        if (role == 1) *(LAS float*)(L + L_GC + lane * 4) = gprev;
    }
    pair_bar(pcnt, pord, lane);
    f32x16 mkr;
#pragma unroll
    for (int q = 0; q < 16; ++q) mkr[q] = 0.f;
    if (valid) {
        f32x16 m0;
#pragma unroll
        for (int q = 0; q < 16; ++q) m0[q] = 0.f;
        const int bt_ = role == 0 ? L_AT : L_RT;
#pragma unroll
        for (int s_ = 0; s_ < 4; ++s_) {
            const int ko = r32 * RS + (16 * s_ + 8 * hi) * 2;
            const bf16x8 aB = rd_nat(L + L_BT + ko), aK = rd_nat(L + L_KT + ko), bX = rd_nat(L + bt_ + ko);
            m0 = CS_MF(aB, bX, m0); mkr = CS_MF(aK, bX, mkr);
        }
        const float base_ = (float)(r32 - 4 * hi) + (role == 0 ? 0.f : 1.f);
#pragma unroll
        for (int q = 0; q < 16; ++q) { const float mk_ = __builtin_amdgcn_fmed3f(base_ - (float)((q & 3) + 8 * (q >> 2)), 0.f, 1.f); m0[q] *= mk_; mkr[q] *= mk_; }
        if (role == 0) {
#pragma unroll
            for (int g = 0; g < 4; ++g) {
                *(LAS f32x4*)(L + L_MAB + r32 * 128 + (8 * g + 4 * hi) * 4) = (f32x4){m0[4 * g], m0[4 * g + 1], m0[4 * g + 2], m0[4 * g + 3]};
                *(LAS f32x4*)(L + L_MAK + r32 * 128 + (8 * g + 4 * hi) * 4) = (f32x4){mkr[4 * g], mkr[4 * g + 1], mkr[4 * g + 2], mkr[4 * g + 3]}; }
        } else {
#pragma unroll
            for (int g = 0; g < 4; ++g) { u32x2 w; w.x = cvtpk(m0[4 * g], m0[4 * g + 1]); w.y = cvtpk(m0[4 * g + 2], m0[4 * g + 3]);
                *(LAS u32x2*)(L + L_MBRT + r32 * RS2 + (8 * g + 4 * hi) * 2) = w; }
        }
    }
    pair_bar(pcnt, pord, lane);
    if (valid) {
        float xa[16], xb[16];
#pragma unroll
        for (int t = 0; t < 16; ++t) { xa[t] = 0.f; xb[t] = 0.f; }
#pragma unroll
        for (int t = 0; t < 16; ++t) {
            float ap = role == 0 ? bf2f(*(const LAS bf16_t*)(L + L_AT + t * RS + lane * 2)) : *(const LAS float*)(L + L_MAK + t * 128 + r32 * 4);
            float aq = 0.f;
#pragma unroll
            for (int i4 = 0; i4 < (t + 3) / 4; ++i4) { const f32x4 m4 = *(const LAS f32x4*)(L + L_MAB + t * 128 + i4 * 16);
                ap += xa[4 * i4] * m4[0]; aq += xa[4 * i4 + 1] * m4[1]; ap += xa[4 * i4 + 2] * m4[2]; aq += xa[4 * i4 + 3] * m4[3]; }
            xa[t] = ap + aq;
            asm volatile("" : "+v"(xa[t]) :: "memory");
        }
#pragma unroll
        for (int t = 0; t < 16; ++t) {
            float ap = role == 0 ? bf2f(*(const LAS bf16_t*)(L + L_AT + (16 + t) * RS + lane * 2)) : *(const LAS float*)(L + L_MAK + (16 + t) * 128 + r32 * 4);
            float aq = 0.f;
#pragma unroll
            for (int i4 = 0; i4 < 4; ++i4) { const f32x4 m4 = *(const LAS f32x4*)(L + L_MAB + (16 + t) * 128 + i4 * 16);
                ap += xa[4 * i4] * m4[0]; aq += xa[4 * i4 + 1] * m4[1]; ap += xa[4 * i4 + 2] * m4[2]; aq += xa[4 * i4 + 3] * m4[3]; }
#pragma unroll
            for (int i4 = 0; i4 < (t + 3) / 4; ++i4) { const f32x4 m4 = *(const LAS f32x4*)(L + L_MAB + (16 + t) * 128 + 64 + i4 * 16);
                ap += xb[4 * i4] * m4[0]; aq += xb[4 * i4 + 1] * m4[1]; ap += xb[4 * i4 + 2] * m4[2]; aq += xb[4 * i4 + 3] * m4[3]; }
            xb[t] = ap + aq;
            asm volatile("" : "+v"(xb[t]) :: "memory");
        }
        u32x4 w0, w1, w2, w3;
        w0.x = cvtpk(xa[0], xa[1]); w0.y = cvtpk(xa[2], xa[3]); w0.z = cvtpk(xa[4], xa[5]); w0.w = cvtpk(xa[6], xa[7]);
        w1.x = cvtpk(xa[8], xa[9]); w1.y = cvtpk(xa[10], xa[11]); w1.z = cvtpk(xa[12], xa[13]); w1.w = cvtpk(xa[14], xa[15]);
        w2.x = cvtpk(xb[0], xb[1]); w2.y = cvtpk(xb[2], xb[3]); w2.z = cvtpk(xb[4], xb[5]); w2.w = cvtpk(xb[6], xb[7]);
        w3.x = cvtpk(xb[8], xb[9]); w3.y = cvtpk(xb[10], xb[11]); w3.z = cvtpk(xb[12], xb[13]); w3.w = cvtpk(xb[14], xb[15]);
        if (role == 0) { LAS u32x4* d = (LAS u32x4*)(L + L_P + lane * RS2); d[0] = w0; d[1] = w1; d[2] = w2; d[3] = w3; }
        else if (hi == 0) { LAS u32x4* d = (LAS u32x4*)(L + L_MAKT + r32 * RS2); d[0] = w0; d[1] = w1; d[2] = w2; d[3] = w3; }
    }
    pair_bar(pcnt, pord, lane);
    if (valid) {
        const int trf = ((lane >> 4) & 1) * 32 + (lane & 3) * 8 + (4 * hi + ((lane & 15) >> 2)) * 64;
        if (role == 0) {
            bf16_t* gQT = (bf16_t*)(C.ws + WS_CQT) + (size_t)task * (CH * 64);
            bf16_t* gGT = (bf16_t*)(C.ws + WS_CGT) + (size_t)task * (64 * 64);
            {
                f32x16 q0, q1;
#pragma unroll
                for (int q = 0; q < 16; ++q) { q0[q] = 0.f; q1[q] = 0.f; }
#pragma unroll
                for (int s_ = 0; s_ < 2; ++s_) { const int ko = (16 * s_ + 8 * hi) * 2; const bf16x8 bM = rd_nat(L + L_MBRT + r32 * RS2 + ko);
                    q0 = CS_MF(rd_nat(L + L_P + r32 * RS2 + ko), bM, q0); q1 = CS_MF(rd_nat(L + L_P + (32 + r32) * RS2 + ko), bM, q1); }
#pragma unroll
                for (int g = 0; g < 4; ++g) {
                    const u32x2 ra = *(const LAS u32x2*)(L + L_RT + r32 * RS + (8 * g + 4 * hi) * 2), rb = *(const LAS u32x2*)(L + L_RT + r32 * RS + (32 + 8 * g + 4 * hi) * 2);
                    u32x2 w0, w1;
                    w0.x = cvtpk(q0[4 * g] + bfl(ra.x), q0[4 * g + 1] + bfh(ra.x)); w0.y = cvtpk(q0[4 * g + 2] + bfl(ra.y), q0[4 * g + 3] + bfh(ra.y));
                    w1.x = cvtpk(q1[4 * g] + bfl(rb.x), q1[4 * g + 1] + bfh(rb.x)); w1.y = cvtpk(q1[4 * g + 2] + bfl(rb.y), q1[4 * g + 3] + bfh(rb.y));
                    *(u32x2*)(gQT + r32 * 64 + 8 * g + 4 * hi) = w0; *(u32x2*)(gQT + r32 * 64 + 32 + 8 * g + 4 * hi) = w1; }
            }
            __builtin_amdgcn_sched_barrier(0);
#define CS_G(N_) do { const float gc_ = *(const LAS float*)(L + L_GC + ((N_) * 32 + r32) * 4); \
                f32x16 ga_, gb_; _Pragma("unroll") for (int q = 0; q < 16; ++q) { ga_[q] = 0.f; gb_[q] = 0.f; } \
                _Pragma("unroll") for (int s_ = 0; s_ < 2; ++s_) { const int ko = (16 * s_ + 4 * hi) * 2; const bf16x8 bb_ = rd_tr(L + L_BTV + trf + (N_) * 2048 + s_ * 1024); \
                    ga_ = CS_MF(rd_perm(L + L_P + r32 * RS2 + ko), bb_, ga_); gb_ = CS_MF(rd_perm(L + L_P + (32 + r32) * RS2 + ko), bb_, gb_); } \
                { const float base_ = (float)(r32 - 4 * hi); \
                _Pragma("unroll") for (int q = 0; q < 16; ++q) { const float dl_ = __builtin_amdgcn_fmed3f(1.f - __builtin_fabsf(base_ - (float)((q & 3) + 8 * (q >> 2))), 0.f, 1.f); \
                    ga_[q] = (ga_[q] + ((N_) == 0 ? dl_ : 0.f)) * gc_; gb_[q] = (gb_[q] + ((N_) == 1 ? dl_ : 0.f)) * gc_; } } \
                _Pragma("unroll") for (int g = 0; g < 4; ++g) { u32x2 w; \
                    w.x = cvtpk(ga_[4 * g], ga_[4 * g + 1]); w.y = cvtpk(ga_[4 * g + 2], ga_[4 * g + 3]); *(u32x2*)(gGT + ((N_) * 32 + r32) * 64 + 8 * g + 4 * hi) = w; \
                    w.x = cvtpk(gb_[4 * g], gb_[4 * g + 1]); w.y = cvtpk(gb_[4 * g + 2], gb_[4 * g + 3]); *(u32x2*)(gGT + ((N_) * 32 + r32) * 64 + 32 + 8 * g + 4 * hi) = w; } \
                __builtin_amdgcn_sched_barrier(0); } while (0)
            CS_G(0); CS_G(1);
#undef CS_G
        } else {
            bf16_t* gHT = (bf16_t*)(C.ws + WS_CHT) + (size_t)task * (64 * 64);
            bf16_t* gYL = (bf16_t*)(C.ws + WS_CYL) + (size_t)task * (64 * CH);
            f32x16 z = mkr, x0, x1;
#pragma unroll
            for (int s_ = 0; s_ < 2; ++s_) { const int ko = (16 * s_ + 8 * hi) * 2;
                z = CS_MF(rd_nat(L + L_MAKT + r32 * RS2 + ko), rd_nat(L + L_MBRT + r32 * RS2 + ko), z); }
#define CS_X(N_, XN_) do { const float gc_ = *(const LAS float*)(L + L_GC + ((N_) * 32 + r32) * 4); \
                _Pragma("unroll") for (int q = 0; q < 16; ++q) XN_[q] = 0.f; \
                _Pragma("unroll") for (int s_ = 0; s_ < 2; ++s_) { const int ko = (16 * s_ + 4 * hi) * 2; \
                    XN_ = CS_MF(rd_perm(L + L_MAKT + r32 * RS2 + ko), rd_tr(L + L_BTV + trf + (N_) * 2048 + s_ * 1024), XN_); } \
                { const LAS unsigned char* kb_ = L + L_KT + 4 * hi * RS + ((N_) * 32 + r32) * 2; \
                _Pragma("unroll") for (int q = 0; q < 16; ++q) XN_[q] = (XN_[q] + bf2f(*(const LAS bf16_t*)(kb_ + ((q & 3) + 8 * (q >> 2)) * RS))) * gc_; } } while (0)
            CS_X(0, x0); CS_X(1, x1);
#undef CS_X
            const bf16x8 ax00 = pack8(x0, 0), ax01 = pack8(x0, 1), ax10 = pack8(x1, 0), ax11 = pack8(x1, 1), az0 = pack8(z, 0), az1 = pack8(z, 1);
#define CS_HY(N_) do { \
                f32x16 ha_, hb_, yy_; _Pragma("unroll") for (int q = 0; q < 16; ++q) { ha_[q] = 0.f; hb_[q] = 0.f; yy_[q] = 0.f; } \
                const bf16x8 va_ = rd_tr(L + L_VV + trf + (N_) * 2048), vb_ = rd_tr(L + L_VV + trf + (N_) * 2048 + 1024); \
                ha_ = CS_MF(ax00, va_, ha_); ha_ = CS_MF(ax01, vb_, ha_); hb_ = CS_MF(ax10, va_, hb_); hb_ = CS_MF(ax11, vb_, hb_); yy_ = CS_MF(az0, va_, yy_); yy_ = CS_MF(az1, vb_, yy_); \
                _Pragma("unroll") for (int g = 0; g < 4; ++g) { u32x2 w; \
                    w.x = cvtpk(ha_[4 * g], ha_[4 * g + 1]); w.y = cvtpk(ha_[4 * g + 2], ha_[4 * g + 3]); *(u32x2*)(gHT + ((N_) * 32 + r32) * 64 + 8 * g + 4 * hi) = w; \
                    w.x = cvtpk(hb_[4 * g], hb_[4 * g + 1]); w.y = cvtpk(hb_[4 * g + 2], hb_[4 * g + 3]); *(u32x2*)(gHT + ((N_) * 32 + r32) * 64 + 32 + 8 * g + 4 * hi) = w; \
                    w.x = cvtpk(yy_[4 * g], yy_[4 * g + 1]); w.y = cvtpk(yy_[4 * g + 2], yy_[4 * g + 3]); *(u32x2*)(gYL + ((N_) * 32 + r32) * CH + 8 * g + 4 * hi) = w; } \
                __builtin_amdgcn_sched_barrier(0); } while (0)
            CS_HY(0); CS_HY(1);
#undef CS_HY
        }
    }
    pair_bar(pcnt, pord, lane);
}
__device__ __forceinline__ void phaseA(const Ctx& C, LAS unsigned char* lds, int G, int bx, int lane, int wave) {
    LAS unsigned char* L = lds + (wave >> 1) * L_WAVE; const int role = wave & 1;
    LAS unsigned* pcnt = (LAS unsigned*)(lds + 4 * L_WAVE) + (wave >> 1) * 32;
    if (role == 0 && lane == 0) *pcnt = 0u;
    __syncthreads();
    unsigned pord = 0u;
    constexpr int NTASK = NB * NH * NCH;
    const int rounds = (NTASK + 4 * G - 1) / (4 * G);
    RawRegs R;
    int task = bx * 4 + (wave >> 1);
    if (task < NTASK) rawLoad(C, R, task, lane, role);
#pragma unroll 1
    for (int k = 0; k < rounds; ++k) { const int nt = task + 4 * G; taskA(C, L, task, lane, role, task < NTASK, R, nt, (k + 1 < rounds) && nt < NTASK, pcnt, pord); task = nt; }
    __syncthreads();
}
constexpr int K_QT = 0, K_GT = 4608, K_YL = 13824, K_HT = 16384, K_BUF = 20992;
constexpr int K_FR = 2 * K_BUF;
__device__ __forceinline__ void chain_unit(const Ctx& C, LAS unsigned char* lds, int unit, int tid, int lane, int wave) {
    const int bh = unit >> 1, half = unit & 1, b = bh / NH, h = bh - b * NH;
    const int r32 = lane & 31, hi = lane >> 5;
    const unsigned char* gQT = (const unsigned char*)((const bf16_t*)(C.ws + WS_CQT) + (size_t)bh * NCH * (CH * 64));
    const unsigned char* gGT = (const unsigned char*)((const bf16_t*)(C.ws + WS_CGT) + (size_t)bh * NCH * (64 * 64));
    const unsigned char* gHT = (const unsigned char*)((const bf16_t*)(C.ws + WS_CHT) + (size_t)bh * NCH * (64 * 64) + half * 32 * 64);
    const unsigned char* gYL = (const unsigned char*)((const bf16_t*)(C.ws + WS_CYL) + (size_t)bh * NCH * (64 * CH) + half * 32 * CH);
    bf16_t* yout = (bf16_t*)(C.ws + WS_Y2) + (size_t)b * SEQ * RW + h * 64 + half * 32 + r32;
    const int lt = tid - 192;
    const unsigned char* src[4]; int dst[4]; size_t cstep[4];
#pragma unroll
    for (int q_ = 0; q_ < 4; ++q_) { const int p0_ = (lt < 0 ? 0 : lt) + 320 * q_; const int p_ = p0_ < 1152 ? p0_ : 1151;
        if (p_ < 256) { src[q_] = gQT + p_ * 16; dst[q_] = K_QT + (p_ >> 3) * 144 + (p_ & 7) * 16; cstep[q_] = 4096; }
        else if (p_ < 768) { const int r_ = p_ - 256; src[q_] = gGT + r_ * 16; dst[q_] = K_GT + (r_ >> 3) * 144 + (r_ & 7) * 16; cstep[q_] = 8192; }
        else if (p_ < 896) { const int r_ = p_ - 768; src[q_] = gYL + r_ * 16; dst[q_] = K_YL + (r_ >> 2) * 80 + (r_ & 3) * 16; cstep[q_] = 4096; }
        else { const int r_ = p_ - 896; src[q_] = gHT + r_ * 16; dst[q_] = K_HT + (r_ >> 3) * 144 + (r_ & 7) * 16; cstep[q_] = 8192; } }
    const bool ldr = lt >= 0;
    u32x4 sA[4], sB[4], sC[4];
#define CH_LD1(dst_, p_) asm volatile("global_load_dwordx4 %0, %1, off" : "=v"(dst_) : "v"(p_) : "memory")
#define CH_LD(S_, cc) do { if (ldr) { const size_t cc_ = (cc) < NCH ? (cc) : NCH - 1; CH_LD1(S_[0], src[0] + cc_ * cstep[0]); CH_LD1(S_[1], src[1] + cc_ * cstep[1]); \
        CH_LD1(S_[2], src[2] + cc_ * cstep[2]); CH_LD1(S_[3], src[3] + cc_ * cstep[3]); } } while (0)
#define CH_WR(S_, cc) do { if (ldr) { asm volatile("s_waitcnt vmcnt(8)" : "+v"(S_[0]), "+v"(S_[1]), "+v"(S_[2]), "+v"(S_[3]) :: "memory"); __builtin_amdgcn_sched_barrier(0); \
        const int bo_ = ((cc) & 1) * K_BUF; *(LAS u32x4*)(lds + bo_ + dst[0]) = S_[0]; *(LAS u32x4*)(lds + bo_ + dst[1]) = S_[1]; *(LAS u32x4*)(lds + bo_ + dst[2]) = S_[2]; \
        *(LAS u32x4*)(lds + bo_ + dst[3]) = S_[3]; } } while (0)
    if (tid < 256) *(LAS u32x4*)(lds + K_FR + tid * 16) = (u32x4){0u, 0u, 0u, 0u};
#define CH_STEP(c, SW_) do { \
        CH_WR(SW_, (c) + 1); CH_LD(SW_, (c) + 4); \
        if (wave < 3 && (c) < NCH) { \
            const LAS unsigned char* B_ = lds + ((c) & 1) * K_BUF; const LAS unsigned char* F_ = lds + K_FR + ((c) & 1) * 4096 + lane * 16; \
            const bf16x8 sb0 = *(const LAS bf16x8*)(F_), sb1 = *(const LAS bf16x8*)(F_ + 1024), sb2 = *(const LAS bf16x8*)(F_ + 2048), sb3 = *(const LAS bf16x8*)(F_ + 3072); \
            f32x16 acc_; \
            if (wave < 2) {         \
                _Pragma("unroll") for (int g = 0; g < 4; ++g) { const u32x2 i0 = *(const LAS u32x2*)(B_ + K_HT + r32 * 144 + (wave * 32 + 8 * g + 4 * hi) * 2); \
                    acc_[4 * g] = bfl(i0.x); acc_[4 * g + 1] = bfh(i0.x); acc_[4 * g + 2] = bfl(i0.y); acc_[4 * g + 3] = bfh(i0.y); } \
                const LAS unsigned char* ag_ = B_ + K_GT + (wave * 32 + r32) * 144 + 8 * hi; \
                acc_ = __builtin_amdgcn_mfma_f32_32x32x16_bf16(rd_perm(ag_), sb0, acc_, 0, 0, 0); acc_ = __builtin_amdgcn_mfma_f32_32x32x16_bf16(rd_perm(ag_ + 32), sb1, acc_, 0, 0, 0); \
                acc_ = __builtin_amdgcn_mfma_f32_32x32x16_bf16(rd_perm(ag_ + 64), sb2, acc_, 0, 0, 0); acc_ = __builtin_amdgcn_mfma_f32_32x32x16_bf16(rd_perm(ag_ + 96), sb3, acc_, 0, 0, 0); \
                LAS unsigned char* FN_ = lds + K_FR + (((c) + 1) & 1) * 4096 + wave * 2048 + lane * 16; \
                *(LAS bf16x8*)(FN_) = pack8(acc_, 0); *(LAS bf16x8*)(FN_ + 1024) = pack8(acc_, 1); \
            } else {                \
                _Pragma("unroll") for (int g = 0; g < 4; ++g) { const u32x2 iy = *(const LAS u32x2*)(B_ + K_YL + r32 * 80 + (8 * g + 4 * hi) * 2); \
                    acc_[4 * g] = bfl(iy.x); acc_[4 * g + 1] = bfh(iy.x); acc_[4 * g + 2] = bfl(iy.y); acc_[4 * g + 3] = bfh(iy.y); } \
                const LAS unsigned char* aq_ = B_ + K_QT + r32 * 144 + 8 * hi; \
                acc_ = __builtin_amdgcn_mfma_f32_32x32x16_bf16(rd_perm(aq_), sb0, acc_, 0, 0, 0); acc_ = __builtin_amdgcn_mfma_f32_32x32x16_bf16(rd_perm(aq_ + 32), sb1, acc_, 0, 0, 0); \
                acc_ = __builtin_amdgcn_mfma_f32_32x32x16_bf16(rd_perm(aq_ + 64), sb2, acc_, 0, 0, 0); acc_ = __builtin_amdgcn_mfma_f32_32x32x16_bf16(rd_perm(aq_ + 96), sb3, acc_, 0, 0, 0); \
                bf16_t* yp = yout + (size_t)(c) * CH * RW; \
                _Pragma("unroll") for (int q = 0; q < 16; ++q) yp[(size_t)crow(q, hi) * RW] = (bf16_t)cvtpk(acc_[q], acc_[q]); \
            } \
        } \
        CS_BAR(); } while (0)
    CH_LD(sA, 0); CH_LD(sB, 1); CH_LD(sC, 2);
    CH_WR(sA, 0); CH_LD(sA, 3);
    CS_BAR();
#pragma unroll 1
    for (int c3 = 0; c3 < NCH + 2; c3 += 3) { CH_STEP(c3, sB); CH_STEP(c3 + 1, sC); CH_STEP(c3 + 2, sA); }
#undef CH_STEP
#undef CH_LD
#undef CH_LD1
#undef CH_WR
}
__device__ __forceinline__ void chain_phase(const Ctx& C, LAS unsigned char* lds, int G, int bx, int tid, int lane, int wave) {
    const int v0 = (G % 8 == 0) ? (bx % 8) * (G / 8) + bx / 8 : bx;
    for (int v = v0; v < 256; v += G) chain_unit(C, lds, v, tid, lane, wave);
}
#undef CS_BAR
#undef CS_MF
}

struct Frame { LAS unsigned char* lds; int tid, lane, wave, G, bx; };

__device__ __forceinline__ void p0_prologue(const Ctx& C, const Frame& F) {
    {
        LAS float* sc = (LAS float*)F.lds;
        LAS float* red = (LAS float*)(F.lds + 65536);
        for (int i = F.tid; i < NB * DM; i += NTHR) { const float cv = C.c[i]; sc[i] = cv / (1.f + __expf(-cv)); }
        __syncthreads();
        float* mod = (float*)(C.ws + WS_MOD);
        for (int cb = F.bx; cb < 6 * DM / 24; cb += F.G) {
            const int n0 = cb * 24;
            if (F.tid < 384) {
                const int kg = F.tid / 24, j = F.tid % 24;
                float acc[NB];
#pragma unroll
                for (int b = 0; b < NB; ++b) acc[b] = 0.f;
                for (int k = kg; k < DM; k += 16) { const float w = C.w_ada[(size_t)k * 6 * DM + n0 + j];
#pragma unroll
                    for (int b = 0; b < NB; ++b) acc[b] += sc[b * DM + k] * w; }
#pragma unroll
                for (int b = 0; b < NB; ++b) red[(kg * NB + b) * 24 + j] = acc[b];
            }
            __syncthreads();
            if (F.tid < 384) { const int b = F.tid / 24, j = F.tid % 24; float s = C.b_ada[n0 + j];
#pragma unroll
                for (int kg = 0; kg < 16; ++kg) s += red[(kg * NB + b) * 24 + j];
                mod[b * 6 * DM + n0 + j] = s; }
            __syncthreads();
        }
    }
    for (int o = F.bx * NTHR + F.tid; o < T * 16; o += F.G * NTHR) {
        const int t = o >> 4, i = o & 15;
        const float inv = powf(10000.0f, -(float)(2 * i) / 32.0f);
        float s, c; sincosf((float)C.pos[t] * inv, &s, &c);
        ((float2*)(C.ws + WS_ROPE))[o] = make_float2(c, s);
    }
    for (int o = F.bx * NTHR + F.tid; o < 48 * DM; o += F.G * NTHR) {
        const int j = o & 7, ln = (o >> 3) & 63, pc = o >> 9, nb = pc % 3, ks = pc / 3;
        const int n = 16 * nb + (ln & 15), k = 32 * ks + 8 * (ln >> 4) + j;
        const float w = n < NG ? C.w_rg[k * NG + n] : (n < NG + NE ? C.w_re[k * NE + (n - NG)] : 0.f);
        const bf16_t hi = f2bf(w);
        ((bf16_t*)(C.ws + WS_W + WO_RH))[o] = hi; ((bf16_t*)(C.ws + WS_W + WO_RL))[o] = f2bf(w - bf2f(hi));
    }
    __syncthreads();
    {
        LAS float* scr = (LAS float*)(F.lds + F.wave * 16384);
        const int gw = F.bx * NWAVES + F.wave, NGW = F.G * NWAVES;
        float va[32], vb[32];
        TrItem da, db;
        int it = gw;
        if (it < TR_NITEMS) { da = tr_desc(C, it); tr_load(da, va, F.lane); }
        for (; it < TR_NITEMS; it += 2 * NGW) {
            const bool hb = it + NGW < TR_NITEMS;
            if (hb) { db = tr_desc(C, it + NGW); tr_load(db, vb, F.lane); }
            tr_store(da, va, scr, F.lane);
            if (hb) {
                if (it + 2 * NGW < TR_NITEMS) { da = tr_desc(C, it + 2 * NGW); tr_load(da, va, F.lane); }
                tr_store(db, vb, scr, F.lane);
            }
        }
    }
}

__device__ __forceinline__ void p1_modulate(const Ctx& C, const Frame& F) {
    const float* mod = (const float*)(C.ws + WS_MOD);
    bf16_t* h1 = (bf16_t*)(C.ws + WS_H);
    const int lane = F.lane;
    for (int row0 = (F.bx * NWAVES + F.wave) * 4; row0 < T; row0 += F.G * NWAVES * 4) {
        const int b = row0 / SEQ;
        float4 v[4][4]; float ss[4];
#pragma unroll
        for (int r = 0; r < 4; ++r) { const float4* xr = (const float4*)(C.x + (size_t)(row0 + r) * DM);
#pragma unroll
            for (int j = 0; j < 4; ++j) v[r][j] = xr[lane + 64 * j]; }
#pragma unroll
        for (int r = 0; r < 4; ++r) { float a = 0.f;
#pragma unroll
            for (int j = 0; j < 4; ++j) a += v[r][j].x * v[r][j].x + v[r][j].y * v[r][j].y + v[r][j].z * v[r][j].z + v[r][j].w * v[r][j].w;
            ss[r] = a; }
#pragma unroll
        for (int r = 0; r < 4; ++r) ss[r] = rsqrtf(wsum_dpp(ss[r]) * (1.f / DM) + RMS_EPS);
#pragma unroll
        for (int j = 0; j < 4; ++j) {
            const int col = 4 * (lane + 64 * j);
            const float4 g = *(const float4*)(C.g_pre_mix + col);
            const float4 sh = *(const float4*)(mod + b * 6 * DM + col), sc = *(const float4*)(mod + b * 6 * DM + DM + col);
            const float m0 = g.x * (1.f + sc.x), m1 = g.y * (1.f + sc.y), m2 = g.z * (1.f + sc.z), m3 = g.w * (1.f + sc.w);
#pragma unroll
            for (int r = 0; r < 4; ++r) { const float rs = ss[r];
                u32x2 w; w.x = cvtpk(v[r][j].x * rs * m0 + sh.x, v[r][j].y * rs * m1 + sh.y); w.y = cvtpk(v[r][j].z * rs * m2 + sh.z, v[r][j].w * rs * m3 + sh.w);
                *(u32x2*)(h1 + (size_t)(row0 + r) * DM + col) = w; }
        }
    }
}

__device__ __forceinline__ void d_post_mix(const Ctx& C, int G, int bx, int tid, int lane, int wave, LAS unsigned char* lds, bool dry) {
    const float* mod = (const float*)(C.ws + WS_MOD); const bf16_t* ym = (const bf16_t*)(C.ws + WS_YMIX);
    bf16_t* h2 = (bf16_t*)(C.ws + WS_H); bf16_t* x1b = (bf16_t*)(C.ws + WS_X1B);
    const bf16_t* wrh = (const bf16_t*)(C.ws + WS_W + WO_RH); const bf16_t* wrl = (const bf16_t*)(C.ws + WS_W + WO_RL);
    float* tokw = (float*)(C.ws + WS_ROUTE);
    unsigned* gcnt = (unsigned*)(C.ws + WS_CTL) + CW_GCNT;
    int* list = (int*)(C.ws + WS_LIST);
    LAS int* le = (LAS int*)lds; LAS float* lg = (LAS float*)(lds + 1024) + wave * 16 * 48;
    LAS unsigned char* lw = lds + 25600;
    for (int q = 0; q < 16; ++q) { const int idx = wave * 16 + q, hl = idx & 1, nb = (idx >> 1) & 1, ks = idx >> 2;
        __builtin_amdgcn_global_load_lds((const unsigned*)((hl ? wrl : wrh) + (ks * 3 + nb) * 512 + lane * 8), (LAS unsigned*)(lw + idx * 1024), 16, 0, 0); }
    for (int grp = bx; grp < T / 128; grp += G) {
      const int r0 = grp * 128 + wave * 16;
      for (int rr = 0; rr < 16; rr += 4) {
        const int row = r0 + rr;
        const int b = row / SEQ; const float* mb = mod + b * 6 * DM;
        float4 yq[4][4], xq[4][4]; float rs[4], rs2[4];
#pragma unroll
        for (int u = 0; u < 4; ++u)
#pragma unroll
            for (int j = 0; j < 4; ++j) { const u32x2 yw = *(const u32x2*)(ym + (size_t)(row + u) * DM + 4 * (lane + 64 * j));
                yq[u][j] = make_float4(__uint_as_float(yw.x << 16), __uint_as_float(yw.x & 0xffff0000u), __uint_as_float(yw.y << 16), __uint_as_float(yw.y & 0xffff0000u)); xq[u][j] = *(const float4*)(C.x + (size_t)(row + u) * DM + 4 * (lane + 64 * j)); }
#pragma unroll
        for (int u = 0; u < 4; ++u) { float a = 0.f;
#pragma unroll
            for (int j = 0; j < 4; ++j) a += yq[u][j].x * yq[u][j].x + yq[u][j].y * yq[u][j].y + yq[u][j].z * yq[u][j].z + yq[u][j].w * yq[u][j].w;
            rs[u] = a; }
#pragma unroll
        for (int u = 0; u < 4; ++u) rs[u] = rsqrtf(wsum_dpp(rs[u]) * (1.f / DM) + RMS_EPS);
#pragma unroll
        for (int u = 0; u < 4; ++u) rs2[u] = 0.f;
#pragma unroll
        for (int j = 0; j < 4; ++j) { const int col = 4 * (lane + 64 * j);
            const float4 g1 = *(const float4*)(mb + 2 * DM + col), gp = *(const float4*)(C.g_post_mix + col);
            const float m0 = g1.x * gp.x, m1 = g1.y * gp.y, m2 = g1.z * gp.z, m3 = g1.w * gp.w;
#pragma unroll
            for (int u = 0; u < 4; ++u) { float4 x1 = xq[u][j];
                x1.x += m0 * (yq[u][j].x * rs[u]); x1.y += m1 * (yq[u][j].y * rs[u]); x1.z += m2 * (yq[u][j].z * rs[u]); x1.w += m3 * (yq[u][j].w * rs[u]);
                xq[u][j] = x1; rs2[u] += x1.x * x1.x + x1.y * x1.y + x1.z * x1.z + x1.w * x1.w;
                u32x2 xw; xw.x = cvtpk(x1.x, x1.y); xw.y = cvtpk(x1.z, x1.w); *(u32x2*)(x1b + (size_t)(row + u) * DM + col) = xw; } }
#pragma unroll
        for (int u = 0; u < 4; ++u) rs2[u] = rsqrtf(wsum_dpp(rs2[u]) * (1.f / DM) + RMS_EPS);
#pragma unroll
        for (int j = 0; j < 4; ++j) { const int col = 4 * (lane + 64 * j);
            const float4 gf = *(const float4*)(C.g_pre_ffn + col), sc = *(const float4*)(mb + 4 * DM + col), sh = *(const float4*)(mb + 3 * DM + col);
            const float m0 = gf.x * (1.f + sc.x), m1 = gf.y * (1.f + sc.y), m2 = gf.z * (1.f + sc.z), m3 = gf.w * (1.f + sc.w);
#pragma unroll
            for (int u = 0; u < 4; ++u) {
                const float h0 = xq[u][j].x * rs2[u] * m0 + sh.x, h1 = xq[u][j].y * rs2[u] * m1 + sh.y, h2_ = xq[u][j].z * rs2[u] * m2 + sh.z, h3 = xq[u][j].w * rs2[u] * m3 + sh.w;
                u32x2 wh; wh.x = cvtpk(h0, h1); wh.y = cvtpk(h2_, h3);
                *(u32x2*)(h2 + (size_t)(row + u) * DM + col) = wh; } }
      }
      asm volatile("s_waitcnt vmcnt(0)" ::: "memory");
      __syncthreads();
      {
        f32x4 acc0 = {0.f, 0.f, 0.f, 0.f}, acc1 = acc0, acc2 = acc0;
        const int fr = lane & 15, fq = lane >> 4;
        const bf16_t* ah = h2 + (size_t)(r0 + fr) * DM + 8 * fq;
        const bf16_t* bh = wrh + lane * 8; const bf16_t* bl = wrl + lane * 8;
#pragma unroll 8
        for (int ks = 0; ks < 32; ++ks) {
            const bf16x8 a_h = *(const bf16x8*)(ah + 32 * ks);
            const LAS unsigned char* lp = lw + ks * 4096 + lane * 16;
            const bf16x8 b0h = *(const LAS bf16x8*)(lp), b0l = *(const LAS bf16x8*)(lp + 1024), b1h = *(const LAS bf16x8*)(lp + 2048), b1l = *(const LAS bf16x8*)(lp + 3072);
            const bf16x8 b2h = *(const bf16x8*)(bh + ks * 1536 + 1024), b2l = *(const bf16x8*)(bl + ks * 1536 + 1024);
            acc0 = __builtin_amdgcn_mfma_f32_16x16x32_bf16(a_h, b0h, acc0, 0, 0, 0); acc0 = __builtin_amdgcn_mfma_f32_16x16x32_bf16(a_h, b0l, acc0, 0, 0, 0);
            acc1 = __builtin_amdgcn_mfma_f32_16x16x32_bf16(a_h, b1h, acc1, 0, 0, 0); acc1 = __builtin_amdgcn_mfma_f32_16x16x32_bf16(a_h, b1l, acc1, 0, 0, 0);
            acc2 = __builtin_amdgcn_mfma_f32_16x16x32_bf16(a_h, b2h, acc2, 0, 0, 0); acc2 = __builtin_amdgcn_mfma_f32_16x16x32_bf16(a_h, b2l, acc2, 0, 0, 0);
        }
#pragma unroll
        for (int e = 0; e < 4; ++e) { lg[(4 * fq + e) * 48 + fr] = acc0[e]; lg[(4 * fq + e) * 48 + 16 + fr] = acc1[e]; lg[(4 * fq + e) * 48 + 32 + fr] = acc2[e]; }
      }
      asm volatile("s_waitcnt lgkmcnt(0)" ::: "memory");
      if (lane < 16) {
            float gl[NG], el[NE];
#pragma unroll
            for (int c = 0; c < NG; ++c) gl[c] = lg[lane * 48 + c] + C.b_rg[c];
#pragma unroll
            for (int c = 0; c < NE; ++c) el[c] = lg[lane * 48 + NG + c] + C.b_re[c];
            int gs = 0; float gm = gl[0];
#pragma unroll
            for (int c = 1; c < NG; ++c) if (gl[c] > gm) { gm = gl[c]; gs = c; }
            float den = 0.f;
#pragma unroll
            for (int c = 0; c < NG; ++c) den += __expf(gl[c] - gm);
            const float psel = 1.f / den;
            float eg[EPG];
#pragma unroll
            for (int c = 0; c < EPG; ++c) eg[c] = gs == 0 ? el[c] : (gs == 1 ? el[EPG + c] : (gs == 2 ? el[2 * EPG + c] : el[3 * EPG + c]));
            int i0 = 0; float v0 = eg[0];
#pragma unroll
            for (int c = 1; c < EPG; ++c) if (eg[c] > v0) { v0 = eg[c]; i0 = c; }
            int i1 = -1; float v1 = -INFINITY;
#pragma unroll
            for (int c = 0; c < EPG; ++c) if (c != i0 && eg[c] > v1) { v1 = eg[c]; i1 = c; }
            const float e1 = __expf(v1 - v0), w0 = 1.f / (1.f + e1), w1 = e1 / (1.f + e1);
            le[(wave * 16 + lane) * 2] = gs * EPG + i0; le[(wave * 16 + lane) * 2 + 1] = gs * EPG + i1;
            *(float2*)(tokw + (size_t)(r0 + lane) * 2) = make_float2(psel * w0, psel * w1);
      }
      __syncthreads();
      if (tid < NE && !dry) {
          int cnt = 0;
          for (int k = 0; k < 256; ++k) cnt += (le[k] == tid) ? 1 : 0;
          if (cnt) { const unsigned base = __hip_atomic_fetch_add(gcnt + tid, (unsigned)cnt, __ATOMIC_RELAXED, __HIP_MEMORY_SCOPE_AGENT);
              int j = 0;
              for (int k = 0; k < 256; ++k) if (le[k] == tid) { list[(size_t)tid * T + base + j] = grp * 256 + k; ++j; } }
      }
      __syncthreads();
    }
}
template <int NPN, bool BAL = false>
__device__ __forceinline__ pg8::MoeTab moe_setup(const Ctx& C, int G, int bx, int tid, __attribute__((address_space(3))) int* ctl) {
    const unsigned* gcnt = (const unsigned*)(C.ws + WS_CTL) + CW_GCNT;
    const int* list = (const int*)(C.ws + WS_LIST);
    __syncthreads();
    if (tid == 0) { int acc = 0; for (int e = 0; e < NE; ++e) { const int c = (int)__hip_atomic_load(gcnt + e, __ATOMIC_RELAXED, __HIP_MEMORY_SCOPE_AGENT); ctl[64 + e] = c; ctl[e] = acc; acc += (c + 255) >> 8; } ctl[NE] = acc; }
    __syncthreads();
    if (tid < pg8::MOE_MAXU) {
        const int total = ctl[NE] * NPN; long L = (long)tid * G + bx;
        if constexpr (BAL) { const int s_ = (ctl[NE] * 2) % G;
            constexpr int SK = MOE_SKIP;
            if (s_ > 0) { if (bx >= s_) L = tid < SK ? (long)tid * (G - s_) + (bx - s_) : (long)SK * (G - s_) + (long)(tid - SK) * G + (bx - s_);
                          else L = (long)SK * (G - s_) + (long)tid * G + (G - s_ + bx); } }
        int* d = nullptr; (void)d;
        if (L < total) { const int pn = (int)(L % NPN), rt = (int)(L / NPN); int e = 0;
            for (int q = 1; q < NE; ++q) if (ctl[q] <= rt) e = q;
            const int m = rt - ctl[e]; int nv = ctl[64 + e] - m * 256; nv = nv > 256 ? 256 : nv;
            ctl[128 + tid * 8 + 0] = e; ctl[128 + tid * 8 + 1] = m; ctl[128 + tid * 8 + 2] = pn; ctl[128 + tid * 8 + 3] = nv; ctl[128 + tid * 8 + 4] = rt * 256; ctl[128 + tid * 8 + 5] = 1; }
        else ctl[128 + tid * 8 + 5] = 0;
    }
    __syncthreads();
    for (int i = 0; i < pg8::MOE_MAXU; ++i) {
        if (ctl[128 + i * 8 + 5] && tid < 256) { const int e = ctl[128 + i * 8 + 0], m = ctl[128 + i * 8 + 1], nv = ctl[128 + i * 8 + 3];
            const int r = tid < nv ? tid : nv - 1;
            ctl[256 + i * 256 + tid] = list[(size_t)e * T + m * 256 + r]; }
    }
    __syncthreads();
    pg8::MoeTab tb; tb.desc = ctl + 128; tb.rowtab = ctl + 256; return tb;
}
__device__ __forceinline__ void d_final(const Ctx& C, int gw, int ngw, int lane) {
    const float* mod = (const float*)(C.ws + WS_MOD); const bf16_t* ys = (const bf16_t*)(C.ws + WS_YSLOT); const bf16_t* x1b = (const bf16_t*)(C.ws + WS_X1B);
    for (int row0 = gw * 4; row0 < T; row0 += ngw * 4) {
        const int b = row0 / SEQ; const float* mb = mod + b * 6 * DM;
        u32x2 ya[4][4], yb[4][4]; float4 x1[4][4]; float rs[4];
#pragma unroll
        for (int r = 0; r < 4; ++r)
#pragma unroll
            for (int j = 0; j < 4; ++j) { const int col = 4 * (lane + 64 * j);
                ya[r][j] = *(const u32x2*)(ys + (size_t)(row0 + r) * 2 * DM + col); yb[r][j] = *(const u32x2*)(ys + (size_t)(row0 + r) * 2 * DM + DM + col);
                { const u32x2 xw = *(const u32x2*)(x1b + (size_t)(row0 + r) * DM + col); x1[r][j] = make_float4(__uint_as_float(xw.x << 16), __uint_as_float(xw.x & 0xffff0000u), __uint_as_float(xw.y << 16), __uint_as_float(xw.y & 0xffff0000u)); } }
        float yv[4][16];
#pragma unroll
        for (int r = 0; r < 4; ++r) { float a = 0.f;
#pragma unroll
            for (int j = 0; j < 4; ++j) {
                yv[r][4 * j] = __uint_as_float(ya[r][j].x << 16) + __uint_as_float(yb[r][j].x << 16); yv[r][4 * j + 1] = __uint_as_float(ya[r][j].x & 0xffff0000u) + __uint_as_float(yb[r][j].x & 0xffff0000u);
                yv[r][4 * j + 2] = __uint_as_float(ya[r][j].y << 16) + __uint_as_float(yb[r][j].y << 16); yv[r][4 * j + 3] = __uint_as_float(ya[r][j].y & 0xffff0000u) + __uint_as_float(yb[r][j].y & 0xffff0000u);
                a += yv[r][4 * j] * yv[r][4 * j] + yv[r][4 * j + 1] * yv[r][4 * j + 1] + yv[r][4 * j + 2] * yv[r][4 * j + 2] + yv[r][4 * j + 3] * yv[r][4 * j + 3]; }
            rs[r] = a; }
#pragma unroll
        for (int r = 0; r < 4; ++r) rs[r] = rsqrtf(wsum_dpp(rs[r]) * (1.f / DM) + RMS_EPS);
#pragma unroll
        for (int j = 0; j < 4; ++j) { const int col = 4 * (lane + 64 * j);
            const float4 g = *(const float4*)(C.g_post_ffn + col), g2 = *(const float4*)(mb + 5 * DM + col);
            const float m0 = g.x * g2.x, m1 = g.y * g2.y, m2 = g.z * g2.z, m3 = g.w * g2.w;
#pragma unroll
            for (int r = 0; r < 4; ++r) { float4 o = x1[r][j];
                o.x += m0 * (yv[r][4 * j] * rs[r]); o.y += m1 * (yv[r][4 * j + 1] * rs[r]); o.z += m2 * (yv[r][4 * j + 2] * rs[r]); o.w += m3 * (yv[r][4 * j + 3] * rs[r]);
                *(float4*)(C.out + (size_t)(row0 + r) * DM + col) = o; } }
    }
}

#define XB_TMO      128
#define XB_XCNT(j)  (256  + 64 * (j))
#define XB_XSUB(j)  (1280 + 64 * (j))
#define XB_XGEN(j)  (2304 + 64 * (j))
#define XB_TOP      3328
#define XB_TOPGEN   3392
#define XCD_BAR_WORDS 3456
#define XB_SPIN_CAP (1u << 18)
__device__ __forceinline__ unsigned xb_ld(unsigned* p)              { return __hip_atomic_load(p, __ATOMIC_RELAXED, __HIP_MEMORY_SCOPE_AGENT); }
__device__ __forceinline__ unsigned xb_add(unsigned* p, unsigned v) { return __hip_atomic_fetch_add(p, v, __ATOMIC_RELAXED, __HIP_MEMORY_SCOPE_AGENT); }
__device__ __forceinline__ unsigned xb_xcc_id() { return (unsigned)__builtin_amdgcn_s_getreg((3 << 11) | 20) & 0xFu; }
#define XB_SPIN(cond, bar) do { unsigned _sp = 0; while (cond) { __builtin_amdgcn_s_sleep(1); \
    if ((++_sp & 255u) == 0u) { if (xb_ld(&(bar)[XB_TMO])) break; if (_sp > XB_SPIN_CAP) { atomicAdd(&(bar)[XB_TMO], 1u); break; } } } } while (0)
struct XcdBarrier { unsigned* bar; unsigned x; volatile LAS unsigned* st; };
__device__ __forceinline__ XcdBarrier xcd_barrier_post(unsigned* bar, volatile LAS unsigned* st) {
    XcdBarrier b; b.bar = bar; b.x = xb_xcc_id(); b.st = st;
    if (threadIdx.x == 0) (void)xb_add(&bar[XB_XCNT(b.x)], 1u);
    return b;
}
__device__ __forceinline__ void xcd_barrier_complete(unsigned* bar, unsigned x, unsigned& nloc, unsigned& nx) {
    const unsigned G = gridDim.x * gridDim.y * gridDim.z;
    unsigned sum, cnt, mine, sp = 0u;
    for (;;) {
        sum = 0u; cnt = 0u; mine = 0u;
#pragma unroll
        for (unsigned j = 0; j < 16; ++j) { const unsigned c = xb_ld(&bar[XB_XCNT(j)]); sum += c; cnt += (c > 0u) ? 1u : 0u; mine = (j == x) ? c : mine; }
        if (sum == G) break;
        __builtin_amdgcn_s_sleep(1);
        if ((++sp & 255u) == 0u) { if (xb_ld(&bar[XB_TMO])) break; if (sp > XB_SPIN_CAP) { atomicAdd(&bar[XB_TMO], 1u); break; } }
    }
    nloc = mine > 0u ? mine : 1u; nx = cnt > 0u ? cnt : 1u;
}
__device__ __forceinline__ void xcd_barrier(const XcdBarrier& b) {
    asm volatile("s_waitcnt vmcnt(0)" ::: "memory");
    __syncthreads();
    if (threadIdx.x == 0) {
        unsigned* bar = b.bar;
        __builtin_amdgcn_s_waitcnt(0);
        unsigned nloc = b.st[0], nx = b.st[1];
        if (nloc == 0u) { xcd_barrier_complete(bar, b.x, nloc, nx); b.st[0] = nloc; b.st[1] = nx; }
        const unsigned old = xb_add(&bar[XB_XSUB(b.x)], 1u);
        const unsigned gen = old / nloc;
        if (old + 1u == (gen + 1u) * nloc) {
            __builtin_amdgcn_fence(__ATOMIC_RELEASE, "agent");
            asm volatile("s_waitcnt vmcnt(0)" ::: "memory");
            const unsigned og = xb_add(&bar[XB_TOP], 1u);
            const unsigned tg = og / nx;
            if (og + 1u == (tg + 1u) * nx) xb_add(&bar[XB_TOPGEN], 1u);
            else XB_SPIN(xb_ld(&bar[XB_TOPGEN]) == tg, bar);
            __builtin_amdgcn_fence(__ATOMIC_ACQUIRE, "agent");
            xb_add(&bar[XB_XGEN(b.x)], 1u);
            asm volatile("s_waitcnt vmcnt(0)" ::: "memory");
        } else {
            XB_SPIN(xb_ld(&bar[XB_XGEN(b.x)]) == gen, bar);
            __builtin_amdgcn_fence(__ATOMIC_ACQUIRE, "agent");
            asm volatile("s_waitcnt vmcnt(0)" ::: "memory");
        }
    }
    __syncthreads();
}

struct Args { Ctx C; int ph_lo, ph_hi, sub, breg; };
__global__ void __launch_bounds__(NTHR, 2) mk(Args args) {
    extern __shared__ __attribute__((aligned(16))) unsigned char lds_raw[];
    const Ctx& C = args.C;
    Frame F; F.lds = (LAS unsigned char*)lds_raw; F.tid = threadIdx.x; F.lane = F.tid & 63; F.wave = __builtin_amdgcn_readfirstlane(F.tid >> 6); F.G = gridDim.x; F.bx = blockIdx.x;
    const int lo = args.ph_lo, hi = args.ph_hi;
    volatile LAS unsigned* xbw = (volatile LAS unsigned*)(F.lds + LDS_BYTES - 16);
    if (F.tid < 4) xbw[F.tid] = 0u;
    __syncthreads();
    unsigned* barw = (unsigned*)(C.ws + WS_CTL) + args.breg * XCD_BAR_WORDS;
    XcdBarrier bar; bar.bar = barw; bar.x = 0; bar.st = xbw;
    if (hi - lo > 1) bar = xcd_barrier_post(barw, xbw);
#define IN(k) (lo <= (k) && (k) < hi)
#define SEAM(k) do { if (IN(k) && IN((k) + 1)) xcd_barrier(bar); } while (0)
    if (IN(0)) { p0_prologue(C, F); }
    SEAM(0);
    if (IN(1)) { p1_modulate(C, F); }
    SEAM(1);
    if (IN(2)) {
        pg8::Dense P{(const bf16_t*)(C.ws + WS_H), (const bf16_t*)(C.ws + WS_W + WO_IN), DM, DM, DM};
        pg8::StaticOrder S; S.init(T, 4608, F.G, F.bx);
        pg8::EpiZ E{(bf16_t*)(C.ws + WS_ZM), (bf16_t*)(C.ws + WS_ZR), (bf16_t*)C.out};
        pg8::gemm_phase(F.lds, P, S, E);
    }
    SEAM(2);
    if (IN(3)) { d_prep(C, F.bx * NWAVES + F.wave, F.G * NWAVES, F.lane); }
    SEAM(3);
    if (IN(4)) {
        const bf16_t* wb = (const bf16_t*)(C.ws + WS_W);
        {   pg8::Dense P{(const bf16_t*)(C.ws + WS_CQN), wb + WO_UQ / 2, QR, QR, QR};
            pg8::StaticOrder S; S.init(T, 768, F.G, F.bx);
            pg8::EpiQ E{(bf16_t*)(C.ws + WS_QF), (const float2*)(C.ws + WS_ROPE)};
            pg8::gemm_phase(F.lds, P, S, E); }
        {   pg8::Dense P{(const bf16_t*)(C.ws + WS_CKVN), wb + WO_UKV / 2, KVR, KVR, KVR};
            pg8::StaticOrder S; S.init(T, 1024, F.G, F.bx);
            pg8::EpiKVp E{(bf16_t*)(C.ws + WS_KF), (bf16_t*)(C.ws + WS_VF)};
            pg8::gemm_phase(F.lds, P, S, E); }
        {   pg8::Dense P{(const bf16_t*)(C.ws + WS_LORA), wb + WO_LORA / 2, 256, 256, 256};
            pg8::StaticOrder S; S.init(T, 1536, F.G, F.bx);
            static_assert(WS_AV == WS_EBUF + (size_t)T * RW * 2 && WS_G == WS_AV + (size_t)T * RW * 2, "ebuf|av|g contiguous");
            pg8::EpiLora E{(bf16_t*)(C.ws + WS_EBUF), C.dec_bias, C.a_bias};
            pg8::gemm_phase(F.lds, P, S, E); }
    }
    SEAM(4);
    if (IN(5)) { att::attn_phase(C, F.lds, F.G, F.bx, F.tid, F.lane, F.wave); }
    SEAM(5);
    if (IN(6)) { cscan::phaseA(C, F.lds, F.G, F.bx, F.lane, F.wave); }
    SEAM(6);
    if (IN(7)) { cscan::chain_phase(C, F.lds, F.G, F.bx, F.tid, F.lane, F.wave); }
    SEAM(7);
    if (IN(8)) { d_rwkv_post(C, F.bx * NWAVES + F.wave, F.G * NWAVES, F.lane); }
    SEAM(8);
    if (IN(9)) {
        const bf16_t* wb = (const bf16_t*)(C.ws + WS_W);
        pg8::MixProb P{(const bf16_t*)(C.ws + WS_ATT), (const bf16_t*)(C.ws + WS_RWO), wb + WO_OM / 2, wb + WO_OR / 2, RW, RW, RW};
        pg8::StaticOrder S; S.init(T, DM, F.G, F.bx, 2);
        pg8::EpiMix E{(const bf16_t*)C.out, (bf16_t*)(C.ws + WS_MIXED), (unsigned*)(C.ws + WS_CTL) + CW_PFLAG};
        pg8::gemm_phase(F.lds, P, S, E);
    }
    if (IN(10)) {
        const bf16_t* wb = (const bf16_t*)(C.ws + WS_W);
        pg8::DenseSC P{(const bf16_t*)(C.ws + WS_MIXED), wb + WO_OUT / 2, DM, DM, DM};
        pg8::StaticOrderW S; S.so.init(T, DM, F.G, F.bx); S.flag = (unsigned*)(C.ws + WS_CTL) + CW_PFLAG; S.need = 4u;
        pg8::EpiOutF E{(bf16_t*)(C.ws + WS_YMIX)};
        pg8::gemm_phase(F.lds, P, S, E);
    }
    SEAM(10);
    if (IN(11)) { d_post_mix(C, F.G, F.bx, F.tid, F.lane, F.wave, F.lds, (args.sub & 4) != 0); }
    SEAM(11);
    if (IN(12)) {
        const pg8::MoeTab tb = moe_setup<2>(C, F.G, F.bx, F.tid, (LAS int*)(F.lds + LDSCTL_OFF));
        pg8::MoeProb1 P{(const bf16_t*)(C.ws + WS_H), (const bf16_t*)(C.ws + WS_W + WO_GU), tb, DM, DM, DM};
        pg8::MoeSched S{tb};
        pg8::EpiMoe1 E{(bf16_t*)(C.ws + WS_ACT), (const float*)(C.ws + WS_ROUTE), tb, (unsigned*)(C.ws + WS_CTL) + CW_RTFLAG};
        pg8::gemm_phase(F.lds, P, S, E);
    }
    if (IN(13)) {
        const pg8::MoeTab tb = moe_setup<4, true>(C, F.G, F.bx, F.tid, (LAS int*)(F.lds + LDSCTL_OFF));
        pg8::MoeProb2 P{(const bf16_t*)(C.ws + WS_ACT), (const bf16_t*)(C.ws + WS_W + WO_DN), tb, FF, FF, FF};
        pg8::MoeSched2 S{tb, (unsigned*)(C.ws + WS_CTL) + CW_RTFLAG};
        pg8::EpiMoe2 E{(bf16_t*)(C.ws + WS_YSLOT), tb};
        pg8::gemm_phase(F.lds, P, S, E);
    }
    SEAM(13);
    if (IN(14)) { d_final(C, F.bx * NWAVES + F.wave, F.G * NWAVES, F.lane); }
#undef IN
#undef SEAM
}

static int g_grid = 0;
static int g_breg = 0;
static void launch_mk(const Ctx& C, int lo, int hi, hipStream_t stream, int sub = 3) {
    Args a{}; a.C = C; a.ph_lo = lo; a.ph_hi = hi; a.sub = sub; a.breg = g_breg++;
    hipLaunchKernelGGL(mk, dim3(g_grid), dim3(NTHR), LDS_BYTES, stream, a);
}
extern "C" void kernel_launch(void* const* d_in, const int* in_sizes, int n_in, void* d_out, int out_size, void* d_ws, size_t ws_size, hipStream_t stream) {
    if (g_grid == 0) {
        int dev = 0, cus = 0; hipGetDevice(&dev); hipDeviceGetAttribute(&cus, hipDeviceAttributeMultiprocessorCount, dev);
        hipFuncSetAttribute((const void*)mk, hipFuncAttributeMaxDynamicSharedMemorySize, LDS_BYTES);
        g_grid = cus > 0 ? cus : 256;
    }
    Ctx C{};
    const float* const* f = (const float* const*)d_in;
    C.x = f[0]; C.c = f[1]; C.pos = (const int*)d_in[2];
    C.w_ada = f[3]; C.b_ada = f[4]; C.g_pre_mix = f[5]; C.g_post_mix = f[6]; C.g_pre_ffn = f[7]; C.g_post_ffn = f[8];
    C.w_in = f[9]; C.g_cq = f[10]; C.w_uq = f[11]; C.g_ckv = f[12]; C.w_ukv = f[13]; C.w_o_mla = f[14];
    C.mu = f[15]; C.w_dec = f[16]; C.dec_bias = f[17]; C.w_a = f[18]; C.a_bias = f[19]; C.w_g = f[20];
    C.k_k = f[21]; C.k_a = f[22]; C.r_k = f[23]; C.lnx_w = f[24]; C.lnx_b = f[25]; C.w_o_rwkv = f[26]; C.w_out = f[27];
    C.w_rg = f[28]; C.b_rg = f[29]; C.w_re = f[30]; C.b_re = f[31]; C.w_eg = f[32]; C.w_eu = f[33]; C.w_ed = f[34];
    C.out = (float*)d_out; C.ws = (unsigned char*)d_ws;

    g_breg = 0;
    hipMemsetAsync((char*)d_ws + WS_CTL, 0, CTL_ZERO_BYTES, stream);
    launch_mk(C, 0, 15, stream);
}
```

```cpp
#include <hip/hip_runtime.h>
#include <stdint.h>
#include <math.h>
#include <type_traits>

constexpr int NB = 16, SEQ = 2048, DM = 1024, T = NB * SEQ;
constexpr int NH = 8;
constexpr int QR = 384, KVR = 256, ROPE = 32, NOPE = 64, VD = 64, QK = NOPE + ROPE;
constexpr int RW = 512, DR = 64, AR = 64, GR = 128;
constexpr int MLA_IN = QR + KVR + ROPE;
constexpr int RWKV_IN = 3 * RW + DR + AR + GR;
constexpr int IN_W = MLA_IN + RWKV_IN + 2 * DM;
constexpr int NE = 32, EPG = 8, NG = 4, FF = 256;
constexpr float RMS_EPS = 1e-6f, GN_EPS = 64e-5f;
constexpr float QSCALE = 0.10206207261596577f * 1.4426950408889634f;

typedef unsigned short bf16_t;
__device__ __forceinline__ float bf2f(bf16_t h) { return __uint_as_float(((unsigned)h) << 16); }
__device__ __forceinline__ bf16_t f2bf(float f) { unsigned u = __float_as_uint(f); return (bf16_t)((u + 0x7fffu + ((u >> 16) & 1u)) >> 16); }
__device__ __forceinline__ float sigmoidf_(float x) { return 1.f / (1.f + __expf(-x)); }
typedef unsigned u32x2 __attribute__((ext_vector_type(2)));
typedef float f32x2_t __attribute__((ext_vector_type(2)));
typedef __bf16 bf16x2_t __attribute__((ext_vector_type(2)));
__device__ __forceinline__ unsigned cvtpk(float lo, float hi) { f32x2_t v = {lo, hi}; bf16x2_t b = __builtin_convertvector(v, bf16x2_t); return __builtin_bit_cast(unsigned, b); }
__device__ __forceinline__ float fsigmoid(float x) { return __builtin_amdgcn_rcpf(1.f + __expf(-x)); }
template <int CTRL> __device__ __forceinline__ float dpp_add_(float x) { return x + __builtin_bit_cast(float, __builtin_amdgcn_update_dpp(0, __builtin_bit_cast(int, x), CTRL, 0xf, 0xf, true)); }
__device__ __forceinline__ float wsum_dpp(float x) {
    x = dpp_add_<0xB1>(x); x = dpp_add_<0x4E>(x); x = dpp_add_<0x141>(x); x = dpp_add_<0x140>(x);
    x += __builtin_bit_cast(float, __builtin_amdgcn_update_dpp(0, __builtin_bit_cast(int, x), 0x142, 0xa, 0xf, false));
    x += __builtin_bit_cast(float, __builtin_amdgcn_update_dpp(0, __builtin_bit_cast(int, x), 0x143, 0xc, 0xf, false));
    return __builtin_bit_cast(float, __builtin_amdgcn_readlane(__builtin_bit_cast(int, x), 63));
}
__device__ __forceinline__ float sum8_dpp(float x) { x = dpp_add_<0xB1>(x); x = dpp_add_<0x4E>(x); x = dpp_add_<0x141>(x); return x; }
__device__ __forceinline__ float wave_sum(float v) {
#pragma unroll
    for (int o = 1; o < 64; o <<= 1) v += __shfl_xor(v, o);
    return v;
}

constexpr size_t MiB = 1u << 20;
constexpr size_t WS_MOD = 5 * MiB;
constexpr size_t WS_ROPE = 1 * MiB;
constexpr size_t WS_CTL = 0;
constexpr size_t CTL_ZERO_BYTES = 65536;
constexpr int MOE_SKIP = 1;
constexpr int CW_RTFLAG = 15424;
constexpr int CW_GCNT = 15360;
constexpr size_t WS_H = 8 * MiB;
constexpr size_t WS_QF = 8 * MiB;
constexpr size_t WS_RWO = 8 * MiB;
constexpr size_t WS_ZM = 72 * MiB;
constexpr size_t WS_VF = 72 * MiB;
constexpr size_t WS_EBUF = 104 * MiB;
constexpr size_t WS_MIXED = 72 * MiB;
constexpr size_t WS_ACT = 72 * MiB;
constexpr size_t WS_ZR = 120 * MiB;
constexpr size_t WS_AV = 136 * MiB;
constexpr size_t WS_G = 168 * MiB;
constexpr size_t WS_Y = 200 * MiB;
constexpr size_t WS_YMIX = 136 * MiB;
constexpr size_t WS_CQN = 232 * MiB;
constexpr size_t WS_CKVN = 256 * MiB;
constexpr size_t WS_LORA = 272 * MiB;
constexpr size_t WS_ATT = 264 * MiB;
constexpr size_t WS_YSLOT = 264 * MiB;
constexpr size_t WS_H2LO = 264 * MiB;
constexpr size_t WS_X1B = 200 * MiB;
constexpr size_t WS_CGT = 8 * MiB, WS_CQT = 72 * MiB, WS_CHT = 200 * MiB, WS_CYL = 392 * MiB, WS_Y2 = 104 * MiB;
constexpr size_t WS_RKV = 296 * MiB;
constexpr size_t WS_KF = 392 * MiB;
constexpr size_t WS_MIX1 = 296 * MiB;
constexpr size_t WS_BONUS = 440 * MiB;
constexpr size_t WS_ROUTE = 442 * MiB;
constexpr size_t WS_LIST = 444 * MiB;
constexpr size_t WS_W = 448 * MiB;
constexpr size_t WS_QRAW = 448 * MiB;

struct Ctx {
    const float *x, *c; const int* pos;
    const float *w_ada, *b_ada, *g_pre_mix, *g_post_mix, *g_pre_ffn, *g_post_ffn;
    const float *w_in, *g_cq, *w_uq, *g_ckv, *w_ukv, *w_o_mla;
    const float *mu, *w_dec, *dec_bias, *w_a, *a_bias, *w_g, *k_k, *k_a, *r_k, *lnx_w, *lnx_b, *w_o_rwkv, *w_out;
    const float *w_rg, *b_rg, *w_re, *b_re, *w_eg, *w_eu, *w_ed;
    float* out; unsigned char* ws;
};

__device__ __forceinline__ void d_prep(const Ctx& C, int gw, int ngw, int lane) {
    typedef unsigned u32x4_ __attribute__((ext_vector_type(4)));
    const bf16_t* zm = (const bf16_t*)(C.ws + WS_ZM); const bf16_t* zr = (const bf16_t*)(C.ws + WS_ZR);
    bf16_t* cqn = (bf16_t*)(C.ws + WS_CQN); bf16_t* ckvn = (bf16_t*)(C.ws + WS_CKVN); bf16_t* lora = (bf16_t*)(C.ws + WS_LORA);
    bf16_t* rkv = (bf16_t*)(C.ws + WS_RKV); bf16_t* kf = (bf16_t*)(C.ws + WS_KF);
    const float2* rope = (const float2*)(C.ws + WS_ROPE);
#define UNPK8(W_, F_) do { F_[0] = __uint_as_float(W_[0] << 16); F_[1] = __uint_as_float(W_[0] & 0xffff0000u); F_[2] = __uint_as_float(W_[1] << 16); F_[3] = __uint_as_float(W_[1] & 0xffff0000u); \
        F_[4] = __uint_as_float(W_[2] << 16); F_[5] = __uint_as_float(W_[2] & 0xffff0000u); F_[6] = __uint_as_float(W_[3] << 16); F_[7] = __uint_as_float(W_[3] & 0xffff0000u); } while (0)
    for (int t0 = gw * 4; t0 < T; t0 += ngw * 4) {
        const int b = t0 / SEQ, s0 = t0 % SEQ;
        u32x4_ wq[4], wk[4], wz[5][4];
        const u32x4_ zero4 = {0u, 0u, 0u, 0u};
#pragma unroll
        for (int r = 0; r < 4; ++r) { const bf16_t* zrow = zm + (size_t)(t0 + r) * 768;
            wq[r] = lane < 48 ? *(const u32x4_*)(zrow + 8 * lane) : zero4; wk[r] = lane < 32 ? *(const u32x4_*)(zrow + QR + 8 * lane) : zero4; }
#pragma unroll
        for (int r = 0; r < 5; ++r)
#pragma unroll
            for (int j = 0; j < 4; ++j) { const int c = lane + 64 * j; const bool ok = (c < RWKV_IN / 8) && (r > 0 || s0 > 0);
                wz[r][j] = ok ? *(const u32x4_*)(zr + (size_t)(t0 + r - 1) * RWKV_IN + 8 * c) : zero4; }
        float rs1[4], rs2[4];
#pragma unroll
        for (int r = 0; r < 4; ++r) { float v[8], u[8]; UNPK8(wq[r], v); UNPK8(wk[r], u); float ss = 0.f, su = 0.f;
#pragma unroll
            for (int e = 0; e < 8; ++e) { ss += v[e] * v[e]; su += u[e] * u[e]; }
            rs1[r] = ss; rs2[r] = su; }
#pragma unroll
        for (int r = 0; r < 4; ++r) { rs1[r] = rsqrtf(wsum_dpp(rs1[r]) * (1.f / QR) + RMS_EPS); rs2[r] = rsqrtf(wsum_dpp(rs2[r]) * (1.f / KVR) + RMS_EPS); }
        if (lane < 48) { const float4 g0 = *(const float4*)(C.g_cq + 8 * lane), g1 = *(const float4*)(C.g_cq + 8 * lane + 4);
#pragma unroll
            for (int r = 0; r < 4; ++r) { float v[8]; UNPK8(wq[r], v); const float q = rs1[r];
                u32x4_ o; o.x = cvtpk(v[0] * q * g0.x, v[1] * q * g0.y); o.y = cvtpk(v[2] * q * g0.z, v[3] * q * g0.w); o.z = cvtpk(v[4] * q * g1.x, v[5] * q * g1.y); o.w = cvtpk(v[6] * q * g1.z, v[7] * q * g1.w);
                *(u32x4_*)(cqn + (size_t)(t0 + r) * QR + 8 * lane) = o; } }
        if (lane < 32) { const float4 g0 = *(const float4*)(C.g_ckv + 8 * lane), g1 = *(const float4*)(C.g_ckv + 8 * lane + 4);
#pragma unroll
            for (int r = 0; r < 4; ++r) { float u[8]; UNPK8(wk[r], u); const float q = rs2[r];
                u32x4_ o; o.x = cvtpk(u[0] * q * g0.x, u[1] * q * g0.y); o.y = cvtpk(u[2] * q * g0.z, u[3] * q * g0.w); o.z = cvtpk(u[4] * q * g1.x, u[5] * q * g1.y); o.w = cvtpk(u[6] * q * g1.z, u[7] * q * g1.w);
                *(u32x4_*)(ckvn + (size_t)(t0 + r) * KVR + 8 * lane) = o; } }
        {   const int h = lane >> 3, i2 = (lane & 7) * 2;
#pragma unroll
            for (int r = 0; r < 4; ++r) { const int t = t0 + r; const bf16_t* zrow = zm + (size_t)t * 768 + QR + KVR;
                const unsigned pa = *(const unsigned*)(zrow + i2), pb = *(const unsigned*)(zrow + 16 + i2);
                const float x1a = __uint_as_float(pa << 16), x1b = __uint_as_float(pa & 0xffff0000u), x2a = __uint_as_float(pb << 16), x2b = __uint_as_float(pb & 0xffff0000u);
                const float4 cc = *(const float4*)(rope + (size_t)t * 16 + i2);
                u32x2 o; o.x = cvtpk(x1a * cc.x - x2a * cc.y, x2a * cc.x + x1a * cc.y); o.y = cvtpk(x1b * cc.z - x2b * cc.w, x2b * cc.z + x1b * cc.w);
                *(u32x2*)(kf + (((size_t)b * NH + h) * SEQ + (s0 + r)) * QK + NOPE + 2 * i2) = o; } }
#pragma unroll
        for (int j = 0; j < 4; ++j) {
            const int c = lane + 64 * j;
            if (c < RWKV_IN / 8) {
                const float4 m0 = *(const float4*)(C.mu + 8 * c), m1 = *(const float4*)(C.mu + 8 * c + 4);
                const float mm[8] = {m0.x, m0.y, m0.z, m0.w, m1.x, m1.y, m1.z, m1.w};
                float p[8]; UNPK8(wz[0][j], p);
#pragma unroll
                for (int r = 0; r < 4; ++r) {
                    float z[8]; UNPK8(wz[r + 1][j], z);
                    float zs[8];
#pragma unroll
                    for (int e = 0; e < 8; ++e) { zs[e] = z[e] + (p[e] - z[e]) * mm[e]; p[e] = z[e]; }
                    bf16_t* dst;
                    if (c < 3 * RW / 8) dst = rkv + (size_t)(t0 + r) * 3 * RW + 8 * c;
                    else { dst = lora + (size_t)(t0 + r) * 256 + (8 * c - 3 * RW);
                        if (c < (3 * RW + DR) / 8) {
#pragma unroll
                            for (int e = 0; e < 8; ++e) { const float ex = __expf(2.f * zs[e]); zs[e] = 1.f - 2.f * __builtin_amdgcn_rcpf(ex + 1.f); } }
                        else if (c >= (3 * RW + DR + AR) / 8) {
#pragma unroll
                            for (int e = 0; e < 8; ++e) zs[e] = fsigmoid(zs[e]); } }
                    u32x4_ o; o.x = cvtpk(zs[0], zs[1]); o.y = cvtpk(zs[2], zs[3]); o.z = cvtpk(zs[4], zs[5]); o.w = cvtpk(zs[6], zs[7]);
                    *(u32x4_*)dst = o;
                }
            }
        }
    }
#undef UNPK8
}

__device__ __forceinline__ void d_rwkv_post(const Ctx& C, int gw, int ngw, int lane) {
    typedef unsigned u32x4_ __attribute__((ext_vector_type(4)));
    const bf16_t* y = (const bf16_t*)(C.ws + WS_Y2); const float* bonus = (const float*)(C.ws + WS_BONUS);
    const bf16_t* rkv = (const bf16_t*)(C.ws + WS_RKV); const bf16_t* g = (const bf16_t*)(C.ws + WS_G);
    bf16_t* rwo = (bf16_t*)(C.ws + WS_RWO);
    const int c0 = 8 * lane, h = lane >> 3;
    const float4 lw0 = *(const float4*)(C.lnx_w + c0), lw1 = *(const float4*)(C.lnx_w + c0 + 4), lb0 = *(const float4*)(C.lnx_b + c0), lb1 = *(const float4*)(C.lnx_b + c0 + 4);
    const float lw[8] = {lw0.x, lw0.y, lw0.z, lw0.w, lw1.x, lw1.y, lw1.z, lw1.w}, lb[8] = {lb0.x, lb0.y, lb0.z, lb0.w, lb1.x, lb1.y, lb1.z, lb1.w};
    for (int t0 = gw * 4; t0 < T; t0 += ngw * 4) {
        float4 ya[4], yb[4]; u32x4_ vv[4], gg[4]; float bn[4];
#pragma unroll
        for (int r = 0; r < 4; ++r) { const size_t t = t0 + r;
            { const u32x4_ yw = *(const u32x4_*)(y + t * RW + c0);
              ya[r] = make_float4(__uint_as_float(yw[0] << 16), __uint_as_float(yw[0] & 0xffff0000u), __uint_as_float(yw[1] << 16), __uint_as_float(yw[1] & 0xffff0000u));
              yb[r] = make_float4(__uint_as_float(yw[2] << 16), __uint_as_float(yw[2] & 0xffff0000u), __uint_as_float(yw[3] << 16), __uint_as_float(yw[3] & 0xffff0000u)); }
            vv[r] = *(const u32x4_*)(rkv + t * 1536 + 1024 + c0); gg[r] = *(const u32x4_*)(g + t * RW + c0); bn[r] = bonus[t * NH + h]; }
#pragma unroll
        for (int r = 0; r < 4; ++r) {
            const float yv[8] = {ya[r].x, ya[r].y, ya[r].z, ya[r].w, yb[r].x, yb[r].y, yb[r].z, yb[r].w};
            float sm = 0.f;
#pragma unroll
            for (int e = 0; e < 8; ++e) sm += yv[e];
            const float mean = sum8_dpp(sm) * (1.f / 64.f);
            float sq = 0.f;
#pragma unroll
            for (int e = 0; e < 8; ++e) { const float d = yv[e] - mean; sq += d * d; }
            const float rstd = rsqrtf(sum8_dpp(sq) * (1.f / 64.f) + GN_EPS);
            float o[8];
#pragma unroll
            for (int e = 0; e < 4; ++e) {
                const float v0 = __uint_as_float(vv[r][e] << 16), v1 = __uint_as_float(vv[r][e] & 0xffff0000u), g0 = __uint_as_float(gg[r][e] << 16), g1 = __uint_as_float(gg[r][e] & 0xffff0000u);
                o[2 * e] = ((yv[2 * e] - mean) * rstd * lw[2 * e] + lb[2 * e] + bn[r] * v0) * g0;
                o[2 * e + 1] = ((yv[2 * e + 1] - mean) * rstd * lw[2 * e + 1] + lb[2 * e + 1] + bn[r] * v1) * g1; }
            u32x4_ w; w.x = cvtpk(o[0], o[1]); w.y = cvtpk(o[2], o[3]); w.z = cvtpk(o[4], o[5]); w.w = cvtpk(o[6], o[7]);
            *(u32x4_*)(rwo + (size_t)(t0 + r) * RW + c0) = w;
        }
    }
}

#define LAS __attribute__((address_space(3)))
typedef short bf16x8 __attribute__((ext_vector_type(8)));
typedef float f32x4 __attribute__((ext_vector_type(4)));
typedef float f32x16 __attribute__((ext_vector_type(16)));
typedef unsigned u32x4 __attribute__((ext_vector_type(4)));

constexpr int NWAVES = 8, NTHR = NWAVES * 64;
constexpr int RING_BYTES = 131072;
constexpr int LDSCTL_OFF = RING_BYTES;
constexpr int LDS_BYTES = 163840;

namespace pg8 {
constexpr int BM = 256, BK = 64, HALF = 128, HTB = HALF * BK * 2, NXCD = 8, WGM = 8;
__host__ __device__ __forceinline__ int lds_byte(int r, int c) { const int st = (r >> 4) * 2 + (c >> 5), rr = r & 15, cc = c & 31, ob = rr * 64 + cc * 2; return st * 1024 + (ob ^ (((ob >> 9) & 1) << 5)); }
__host__ __device__ __forceinline__ void stage_rc(int b, int& R, int& C) { const int st = b / 1024, sb = b % 1024, swz = sb ^ (((sb >> 9) & 1) << 5); R = (st >> 1) * 16 + swz / 64; C = (st & 1) * 32 + (swz % 64) / 2; }
__host__ __device__ __forceinline__ int perm32(int rho) { const int n = rho >> 4, i = rho & 15; return 8 * (i >> 2) + 4 * n + (i & 3); }

struct Unit { int pm, pn, z; };

struct StaticOrder {
    int nM, nN, nwg, G, c, parts;
    __device__ void init(int M, int N, int G_, int c_, int parts_ = 1) { nM = M / BM; nN = N / BM; nwg = nM * nN; G = G_; c = c_; parts = parts_; }
    __device__ bool next(int i, Unit& u) const {
        const int it = i / parts; u.z = i - it * parts;
        const long L = (long)it * G + c; if (L >= nwg) return false;
        int wgid = (int)L; { const int q = nwg / NXCD, r = nwg % NXCD, xcd = wgid % NXCD, off = wgid / NXCD; wgid = (xcd < r ? xcd * (q + 1) : r * (q + 1) + (xcd - r) * q) + off; }
        const int nig = WGM * nN, gid = wgid / nig, fm = gid * WGM, gsz = (nM - fm) < WGM ? (nM - fm) : WGM;
        u.pm = fm + ((wgid % nig) % gsz); u.pn = (wgid % nig) / gsz; return true;
    }
};
struct Dense { static constexpr bool GATHER = false; const bf16_t* A; const bf16_t* Bt; int lda, ldb, K;
    __device__ __forceinline__ unsigned a_off(const Unit&, int R) const { return (unsigned)(R * lda) * 2u; }
    __device__ __forceinline__ const char* a_ptr(const Unit& u) const { return (const char*)(A + (size_t)u.pm * BM * lda); }
    __device__ __forceinline__ const char* b_ptr(const Unit& u) const { return (const char*)(Bt + (size_t)u.pn * BM * ldb); } };

template <class T, class = void> struct has_signal : std::false_type {};
template <class T> struct has_signal<T, std::void_t<decltype(T::SIGNAL)>> : std::true_type {};
template <class T, class = void> struct a_aux { static constexpr int value = 0; };
template <class T> struct a_aux<T, std::void_t<decltype(T::A_AUX)>> { static constexpr int value = T::A_AUX; };
template <bool ALIGN_EPI = true, class Epi, class Prob, class Sched>
__device__ __forceinline__ void gemm_phase(LAS unsigned char* lds, const Prob& P, const Sched& S, const Epi& E) {
    const int tid = threadIdx.x, wid = __builtin_amdgcn_readfirstlane(tid >> 6), lane = tid & 63, wr = wid >> 2, wc = wid & 3, fr = lane & 15, fq = lane >> 4;
    const int K = P.K, nt = K / BK;
    unsigned voffB[2]; int RA[2], CA[2];
#pragma unroll
    for (int i = 0; i < 2; ++i) { int R, C; stage_rc(tid * 16 + i * 8192, R, C); const int Rb = Epi::PERM ? ((R & ~31) + perm32(R & 31)) : R;
        RA[i] = R; CA[i] = C * 2; voffB[i] = (unsigned)(Rb * P.ldb + C) * 2u; }
    unsigned vAc[2][2], vAn[2][2];
#define PG8_FILLA(v, u) do { _Pragma("unroll") for (int h_ = 0; h_ < 2; ++h_) _Pragma("unroll") for (int i_ = 0; i_ < 2; ++i_) v[h_][i_] = P.a_off(u, RA[i_] + h_ * HALF) + (unsigned)CA[i_]; } while (0)
    const size_t kstep = (size_t)(BK * 2);
    const size_t hstepB = (size_t)HALF * P.ldb * 2;
    const unsigned ldsw = (unsigned)wid * 1024u;
    const int aoff = lds_byte(wr * 64 + fr, fq * 8), boff = lds_byte(wc * 32 + fr, fq * 8);
#define PG8_SA(b, h) (((b) * 2 + (h)) * HTB)
#define PG8_SB(b, h) ((4 + (b) * 2 + (h)) * HTB)
#define PG8_STAGE(bufoff, gbase, voff) do { _Pragma("unroll") for (int _i = 0; _i < 2; ++_i) \
        __builtin_amdgcn_global_load_lds((const unsigned*)((const char*)(gbase) + (voff)[_i]), (LAS unsigned*)(lds + (bufoff) + ldsw + _i * 8192), 16, 0, 0); } while (0)
#define PG8_STAGEA(bufoff, gbase, voff) do { _Pragma("unroll") for (int _i = 0; _i < 2; ++_i) \
        __builtin_amdgcn_global_load_lds((const unsigned*)((const char*)(gbase) + (voff)[_i]), (LAS unsigned*)(lds + (bufoff) + ldsw + _i * 8192), 16, 0, a_aux<Prob>::value); } while (0)
#define PG8_LDA(dst, b, h) do { _Pragma("unroll") for (int m = 0; m < 4; ++m) _Pragma("unroll") for (int k = 0; k < 2; ++k) dst[m][k] = *(const LAS bf16x8*)(lds + PG8_SA(b, h) + aoff + m * 2048 + k * 1024); } while (0)
#define PG8_LDB(dst, b, h) do { _Pragma("unroll") for (int n = 0; n < 2; ++n) _Pragma("unroll") for (int k = 0; k < 2; ++k) dst[n][k] = *(const LAS bf16x8*)(lds + PG8_SB(b, h) + boff + n * 2048 + k * 1024); } while (0)
#define PG8_MMA(ai, bj, At, Bt) do { __builtin_amdgcn_s_setprio(1); _Pragma("unroll") for (int m = 0; m < 4; ++m) _Pragma("unroll") for (int n = 0; n < 2; ++n) _Pragma("unroll") for (int k = 0; k < 2; ++k) \
        acc[ai][bj][m][n] = __builtin_amdgcn_mfma_f32_16x16x32_bf16(Bt[n][k], At[m][k], acc[ai][bj][m][n], 0, 0, 0); __builtin_amdgcn_s_setprio(0); } while (0)
#define PG8_WAIT_V(n) asm volatile("s_waitcnt vmcnt(" #n ")" ::: "memory")
#define PG8_WAIT_L(n) asm volatile("s_waitcnt lgkmcnt(" #n ")" ::: "memory")
#define PG8_BAR __builtin_amdgcn_s_barrier()
#define PG8_SCHED __builtin_amdgcn_sched_barrier(0)
    Unit cur, nxt; int ui = 0;
    if (!S.next(0, cur)) return;
    f32x4 acc[2][2][4][2];
#pragma unroll
    for (int a = 0; a < 2; ++a)
#pragma unroll
        for (int b = 0; b < 2; ++b)
#pragma unroll
            for (int m = 0; m < 4; ++m)
#pragma unroll
                for (int n = 0; n < 2; ++n) acc[a][b][m][n] = (f32x4){0.f, 0.f, 0.f, 0.f};
    bf16x8 At[4][2], B0[2][2], B1[2][2];
    const char* cA = P.a_ptr(cur); const char* cB = P.b_ptr(cur);
    PG8_FILLA(vAc, cur);
    PG8_STAGE(PG8_SB(0, 0), cB, voffB); PG8_STAGE(PG8_SB(0, 1), cB + hstepB, voffB); PG8_STAGEA(PG8_SA(0, 0), cA, vAc[0]); PG8_STAGEA(PG8_SA(0, 1), cA, vAc[1]);
    if (wr == 1) PG8_BAR;
    PG8_WAIT_V(2); PG8_BAR;
    PG8_STAGE(PG8_SB(1, 0), cB + kstep, voffB); PG8_STAGEA(PG8_SA(1, 0), cA + kstep, vAc[0]); PG8_STAGE(PG8_SB(1, 1), cB + hstepB + kstep, voffB);
    PG8_WAIT_V(6); PG8_BAR;
    for (;;) {
        const bool has_next = S.next(ui + 1, nxt);
        const char* nA = has_next ? P.a_ptr(nxt) : cA; const char* nB = has_next ? P.b_ptr(nxt) : cB;
        if (Prob::GATHER && has_next) { PG8_FILLA(vAn, nxt); }
        else {
#pragma unroll
            for (int h_ = 0; h_ < 2; ++h_)
#pragma unroll
                for (int i_ = 0; i_ < 2; ++i_) vAn[h_][i_] = vAc[h_][i_]; }
        for (int t = 0; t < nt; t += 2) {
            const bool last = (t == nt - 2);
            const char* a1 = cA + (size_t)(t + 1) * kstep;
            const char* a2 = last ? nA : cA + (size_t)(t + 2) * kstep; const char* b2 = last ? nB : cB + (size_t)(t + 2) * kstep;
            const char* a3 = a2 + kstep; const char* b3 = b2 + kstep;
            unsigned vA2[2][2];
#pragma unroll
            for (int h_ = 0; h_ < 2; ++h_)
#pragma unroll
                for (int i_ = 0; i_ < 2; ++i_) vA2[h_][i_] = (Prob::GATHER && last) ? vAn[h_][i_] : vAc[h_][i_];
            PG8_LDB(B0, 0, 0); PG8_LDB(B1, 0, 1); PG8_SCHED; PG8_LDA(At, 0, 0); PG8_STAGEA(PG8_SA(1, 1), a1, vAc[1]);
            PG8_WAIT_V(8); PG8_WAIT_L(0); PG8_BAR; PG8_MMA(0, 0, At, B0); PG8_MMA(0, 1, At, B1); PG8_BAR; PG8_SCHED;
            PG8_LDA(At, 0, 1); PG8_STAGE(PG8_SB(0, 0), b2, voffB); PG8_STAGE(PG8_SB(0, 1), b2 + hstepB, voffB); PG8_STAGEA(PG8_SA(0, 0), a2, vA2[0]);
            PG8_WAIT_V(8); PG8_WAIT_L(0); PG8_BAR; PG8_MMA(1, 0, At, B0); PG8_MMA(1, 1, At, B1); PG8_BAR; PG8_SCHED;
            PG8_LDB(B0, 1, 0); PG8_LDB(B1, 1, 1); PG8_SCHED; PG8_LDA(At, 1, 0); PG8_STAGEA(PG8_SA(0, 1), a2, vA2[1]);
            PG8_WAIT_V(8); PG8_WAIT_L(0); PG8_BAR; PG8_MMA(0, 0, At, B0); PG8_MMA(0, 1, At, B1); PG8_BAR; PG8_SCHED;
            PG8_LDA(At, 1, 1); PG8_STAGE(PG8_SB(1, 0), b3, voffB); PG8_STAGE(PG8_SB(1, 1), b3 + hstepB, voffB); PG8_STAGEA(PG8_SA(1, 0), a3, vA2[0]);
            PG8_WAIT_V(8); PG8_WAIT_L(0); PG8_BAR; PG8_MMA(1, 0, At, B0); PG8_MMA(1, 1, At, B1); PG8_BAR; PG8_SCHED;
        }
        if constexpr (ALIGN_EPI) { if (wr == 0) PG8_BAR; }
        E(acc, cur, wr, wc, fr, fq);
        if constexpr (has_signal<Epi>::value) { PG8_WAIT_V(0); PG8_BAR; if (tid == 0) E.signal(cur); }
        if (!has_next) break;
        if (!E.keep(cur)) {
#pragma unroll
            for (int a = 0; a < 2; ++a)
#pragma unroll
                for (int b = 0; b < 2; ++b)
#pragma unroll
                    for (int m = 0; m < 4; ++m)
#pragma unroll
                        for (int n = 0; n < 2; ++n) acc[a][b][m][n] = (f32x4){0.f, 0.f, 0.f, 0.f};
        }
        cur = nxt; cA = nA; cB = nB; ++ui;
#pragma unroll
        for (int h_ = 0; h_ < 2; ++h_)
#pragma unroll
            for (int i_ = 0; i_ < 2; ++i_) vAc[h_][i_] = vAn[h_][i_];
        if constexpr (ALIGN_EPI) { if (wr == 1) PG8_BAR; }
    }
    PG8_WAIT_V(0);
    if constexpr (!ALIGN_EPI) { if (wr == 0) PG8_BAR; }
    PG8_BAR;
#undef PG8_FILLA
#undef PG8_SA
#undef PG8_SB
#undef PG8_STAGE
#undef PG8_STAGEA
#undef PG8_LDA
#undef PG8_LDB
#undef PG8_MMA
#undef PG8_WAIT_V
#undef PG8_WAIT_L
#undef PG8_BAR
#undef PG8_SCHED
}

struct EpiZ { static constexpr bool PERM = true; bf16_t *zm, *zr, *gates;
    __device__ __forceinline__ bool keep(const Unit&) const { return false; }
    __device__ __forceinline__ void operator()(f32x4 (&acc)[2][2][4][2], const Unit& u, int wr, int wc, int fr, int fq) const {
        bf16_t* base; int ldc, colt; bool sig = false;
        if (u.pn < 3) { base = zm; ldc = 768; colt = u.pn * 256; } else if (u.pn < 10) { base = zr; ldc = RWKV_IN; colt = (u.pn - 3) * 256; } else { base = gates; ldc = 2048; colt = (u.pn - 10) * 256; sig = true; }
        const int row0 = u.pm * BM + wr * 64 + fr, col0 = colt + wc * 32 + 8 * fq;
#pragma unroll
        for (int ai = 0; ai < 2; ++ai)
#pragma unroll
            for (int m = 0; m < 4; ++m) { bf16_t* rowp = base + (size_t)(row0 + ai * HALF + m * 16) * ldc + col0;
#pragma unroll
                for (int bj = 0; bj < 2; ++bj) { f32x4 v0 = acc[ai][bj][m][0], v1 = acc[ai][bj][m][1];
                    if (sig) {
#pragma unroll
                        for (int e = 0; e < 4; ++e) { v0[e] = fsigmoid(v0[e]); v1[e] = fsigmoid(v1[e]); } }
                    u32x4 w; w.x = cvtpk(v0[0], v0[1]); w.y = cvtpk(v0[2], v0[3]); w.z = cvtpk(v1[0], v1[1]); w.w = cvtpk(v1[2], v1[3]);
                    *(u32x4*)(rowp + bj * HALF) = w; } }
    } };

struct EpiQ { static constexpr bool PERM = true; bf16_t* qf; const float2* rope;
    __device__ __forceinline__ bool keep(const Unit&) const { return false; }
    __device__ __forceinline__ void operator()(f32x4 (&acc)[2][2][4][2], const Unit& u, int wr, int wc, int fr, int fq) const {
#pragma unroll
        for (int bj = 0; bj < 2; ++bj) {
            const int c0 = u.pn * BM + bj * HALF + wc * 32 + 8 * fq, h = c0 / QK, d0 = c0 - h * QK;
#pragma unroll
            for (int ai = 0; ai < 2; ++ai)
#pragma unroll
                for (int m = 0; m < 4; ++m) {
                    const int t = u.pm * BM + ai * HALF + wr * 64 + m * 16 + fr, b = t / SEQ, s_ = t - b * SEQ;
                    f32x4 v0 = acc[ai][bj][m][0], v1 = acc[ai][bj][m][1];
                    if (d0 >= NOPE) { const int i0 = (d0 - NOPE) >> 1; const float2* cs = rope + (size_t)t * 16 + i0;
                        const float2 c0_ = cs[0], c1_ = cs[1], c2_ = cs[2], c3_ = cs[3];
                        const f32x4 w0 = {v0[0] * c0_.x - v0[1] * c0_.y, v0[1] * c0_.x + v0[0] * c0_.y, v0[2] * c1_.x - v0[3] * c1_.y, v0[3] * c1_.x + v0[2] * c1_.y};
                        const f32x4 w1 = {v1[0] * c2_.x - v1[1] * c2_.y, v1[1] * c2_.x + v1[0] * c2_.y, v1[2] * c3_.x - v1[3] * c3_.y, v1[3] * c3_.x + v1[2] * c3_.y};
                        v0 = w0; v1 = w1; }
                    v0 = v0 * QSCALE; v1 = v1 * QSCALE;
                    u32x4 w; w.x = cvtpk(v0[0], v0[1]); w.y = cvtpk(v0[2], v0[3]); w.z = cvtpk(v1[0], v1[1]); w.w = cvtpk(v1[2], v1[3]);
                    *(u32x4*)(qf + (((size_t)b * NH + h) * SEQ + s_) * QK + d0) = w; } }
    } };
struct EpiKVp { static constexpr bool PERM = true; bf16_t *kf, *vf;
    __device__ __forceinline__ bool keep(const Unit&) const { return false; }
    __device__ __forceinline__ void operator()(f32x4 (&acc)[2][2][4][2], const Unit& u, int wr, int wc, int fr, int fq) const {
#pragma unroll
        for (int bj = 0; bj < 2; ++bj) {
            const int c0 = u.pn * BM + bj * HALF + wc * 32 + 8 * fq, h = c0 >> 7, c = c0 & 127;
#pragma unroll
            for (int ai = 0; ai < 2; ++ai)
#pragma unroll
                for (int m = 0; m < 4; ++m) {
                    const int t = u.pm * BM + ai * HALF + wr * 64 + m * 16 + fr, b = t / SEQ, s_ = t - b * SEQ;
                    const f32x4 v0 = acc[ai][bj][m][0], v1 = acc[ai][bj][m][1];
                    u32x4 w; w.x = cvtpk(v0[0], v0[1]); w.y = cvtpk(v0[2], v0[3]); w.z = cvtpk(v1[0], v1[1]); w.w = cvtpk(v1[2], v1[3]);
                    const size_t rowi = ((size_t)b * NH + h) * SEQ + s_;
                    if (c < 64) *(u32x4*)(kf + rowi * QK + c) = w; else *(u32x4*)(vf + rowi * VD + (c - 64)) = w; } }
    } };
struct EpiLora { static constexpr bool PERM = true; bf16_t *eb; const float *dbias, *abias;
    __device__ __forceinline__ bool keep(const Unit&) const { return false; }
    __device__ __forceinline__ void operator()(f32x4 (&acc)[2][2][4][2], const Unit& u, int wr, int wc, int fr, int fq) const {
        const int kind = u.pn >> 1; bf16_t* base = eb + (size_t)kind * ((size_t)T * RW);
        const float* bp = kind == 0 ? dbias : abias;
#pragma unroll
        for (int bj = 0; bj < 2; ++bj) {
            const int c0 = (u.pn & 1) * BM + bj * HALF + wc * 32 + 8 * fq;
            float bs[8];
#pragma unroll
            for (int e = 0; e < 8; ++e) bs[e] = kind < 2 ? bp[c0 + e] : 0.f;
#pragma unroll
            for (int ai = 0; ai < 2; ++ai)
#pragma unroll
                for (int m = 0; m < 4; ++m) {
                    const int t = u.pm * BM + ai * HALF + wr * 64 + m * 16 + fr;
                    float v[8];
#pragma unroll
                    for (int e = 0; e < 4; ++e) { v[e] = acc[ai][bj][m][0][e] + bs[e]; v[4 + e] = acc[ai][bj][m][1][e] + bs[4 + e]; }
                    if (kind == 0) {
#pragma unroll
                        for (int e = 0; e < 8; ++e) v[e] = 0.60653065971263342f * fsigmoid(v[e]); }
                    else if (kind == 1) {
#pragma unroll
                        for (int e = 0; e < 8; ++e) v[e] = fsigmoid(v[e]); }
                    u32x4 w; w.x = cvtpk(v[0], v[1]); w.y = cvtpk(v[2], v[3]); w.z = cvtpk(v[4], v[5]); w.w = cvtpk(v[6], v[7]);
                    *(u32x4*)(base + (size_t)t * RW + c0) = w; } }
    } };
struct MixProb { static constexpr bool GATHER = false; const bf16_t *A0, *A1, *B0, *B1; int lda, ldb, K;
    __device__ __forceinline__ unsigned a_off(const Unit&, int R) const { return (unsigned)(R * lda) * 2u; }
    __device__ __forceinline__ const char* a_ptr(const Unit& u) const { return (const char*)((u.z ? A1 : A0) + (size_t)u.pm * BM * lda); }
    __device__ __forceinline__ const char* b_ptr(const Unit& u) const { return (const char*)((u.z ? B1 : B0) + (size_t)u.pn * BM * ldb); } };
struct EpiMix { static constexpr bool PERM = true; const bf16_t* gates; bf16_t* mixed;
    __device__ __forceinline__ bool keep(const Unit& u) const { return u.z == 0; }
    __device__ __forceinline__ void operator()(f32x4 (&acc)[2][2][4][2], const Unit& u, int wr, int wc, int fr, int fq) const {
#pragma unroll
        for (int bj = 0; bj < 2; ++bj) {
            const int c0 = u.pn * BM + bj * HALF + wc * 32 + 8 * fq;
#pragma unroll
            for (int ai = 0; ai < 2; ++ai)
#pragma unroll
                for (int m = 0; m < 4; ++m) {
                    const int t = u.pm * BM + ai * HALF + wr * 64 + m * 16 + fr;
                    const u32x4 gbw = *(const u32x4*)(gates + (size_t)t * 2048 + DM + c0);
                    float gbv[8];
#pragma unroll
                    for (int e = 0; e < 4; ++e) { gbv[2 * e] = fmaxf(__uint_as_float(gbw[e] << 16), 1e-30f); gbv[2 * e + 1] = fmaxf(__uint_as_float(gbw[e] & 0xffff0000u), 1e-30f); }
                    if (u.z == 0) {
                        const u32x4 gaw = *(const u32x4*)(gates + (size_t)t * 2048 + c0);
#pragma unroll
                        for (int e = 0; e < 4; ++e) { const float ga0 = __uint_as_float(gaw[e] << 16), ga1 = __uint_as_float(gaw[e] & 0xffff0000u);
                            const float r0 = ga0 * __builtin_amdgcn_rcpf(gbv[2 * e]), r1 = ga1 * __builtin_amdgcn_rcpf(gbv[2 * e + 1]);
                            if (e < 2) { acc[ai][bj][m][0][2 * e] *= r0; acc[ai][bj][m][0][2 * e + 1] *= r1; } else { acc[ai][bj][m][1][2 * e - 4] *= r0; acc[ai][bj][m][1][2 * e - 3] *= r1; } }
                    } else {
                        float v[8];
#pragma unroll
                        for (int e = 0; e < 4; ++e) { v[e] = acc[ai][bj][m][0][e] * gbv[e]; v[4 + e] = acc[ai][bj][m][1][e] * gbv[4 + e]; }
                        u32x4 w; w.x = cvtpk(v[0], v[1]); w.y = cvtpk(v[2], v[3]); w.z = cvtpk(v[4], v[5]); w.w = cvtpk(v[6], v[7]);
                        *(u32x4*)(mixed + (size_t)t * DM + c0) = w; } } }
    } };
struct EpiOutF { static constexpr bool PERM = true; bf16_t* y;
    __device__ __forceinline__ bool keep(const Unit&) const { return false; }
    __device__ __forceinline__ void operator()(f32x4 (&acc)[2][2][4][2], const Unit& u, int wr, int wc, int fr, int fq) const {
#pragma unroll
        for (int bj = 0; bj < 2; ++bj) {
            const int c0 = u.pn * BM + bj * HALF + wc * 32 + 8 * fq;
#pragma unroll
            for (int ai = 0; ai < 2; ++ai)
#pragma unroll
                for (int m = 0; m < 4; ++m) {
                    const int t = u.pm * BM + ai * HALF + wr * 64 + m * 16 + fr;
                    const f32x4 v0 = acc[ai][bj][m][0], v1 = acc[ai][bj][m][1];
                    u32x4 w; w.x = cvtpk(v0[0], v0[1]); w.y = cvtpk(v0[2], v0[3]); w.z = cvtpk(v1[0], v1[1]); w.w = cvtpk(v1[2], v1[3]);
                    *(u32x4*)(y + (size_t)t * DM + c0) = w; } }
    } };

constexpr int MOE_MAXU = 8;
struct MoeTab { const LAS int* desc; const LAS int* rowtab; };
struct MoeSched { MoeTab tb;
    __device__ __forceinline__ bool next(int i, Unit& u) const { if (i >= MOE_MAXU || tb.desc[i * 8 + 5] == 0) return false; u.pm = i; u.pn = tb.desc[i * 8 + 2]; u.z = tb.desc[i * 8 + 0]; return true; } };
struct MoeSched2 { MoeTab tb; unsigned* flag;
    __device__ __forceinline__ bool next(int i, Unit& u) const { if (i >= MOE_MAXU || tb.desc[i * 8 + 5] == 0) return false; u.pm = i; u.pn = tb.desc[i * 8 + 2]; u.z = tb.desc[i * 8 + 0];
        unsigned* f = flag + (tb.desc[i * 8 + 4] >> 8);
        for (unsigned sp = 0; __hip_atomic_load(f, __ATOMIC_RELAXED, __HIP_MEMORY_SCOPE_AGENT) < 2u && sp < (1u << 20); ++sp) __builtin_amdgcn_s_sleep(2);
        asm volatile("" ::: "memory");
        return true; } };
struct MoeProb1 { static constexpr bool GATHER = true; const bf16_t* h2; const bf16_t* wgu; MoeTab tb; int lda, ldb, K;
    __device__ __forceinline__ unsigned a_off(const Unit& u, int R) const { return (unsigned)((tb.rowtab[u.pm * 256 + R] >> 1) * lda) * 2u; }
    __device__ __forceinline__ const char* a_ptr(const Unit&) const { return (const char*)h2; }
    __device__ __forceinline__ const char* b_ptr(const Unit& u) const { return (const char*)(wgu + ((size_t)u.z * 512 + u.pn * BM) * ldb); } };
struct MoeProb2 { static constexpr bool GATHER = false; static constexpr int A_AUX = 16  ; const bf16_t* act; const bf16_t* wdn; MoeTab tb; int lda, ldb, K;
    __device__ __forceinline__ unsigned a_off(const Unit&, int R) const { return (unsigned)(R * lda) * 2u; }
    __device__ __forceinline__ const char* a_ptr(const Unit& u) const { return (const char*)(act + (size_t)tb.desc[u.pm * 8 + 4] * lda); }
    __device__ __forceinline__ const char* b_ptr(const Unit& u) const { return (const char*)(wdn + ((size_t)u.z * 1024 + u.pn * BM) * ldb); } };
struct EpiMoe1 { static constexpr bool PERM = true; static constexpr bool SIGNAL = true; bf16_t* act; const float* tokw; MoeTab tb; unsigned* flag;
    __device__ __forceinline__ bool keep(const Unit&) const { return false; }
    __device__ __forceinline__ void signal(const Unit& u) const {
        __hip_atomic_fetch_add(flag + (tb.desc[u.pm * 8 + 4] >> 8), 1u, __ATOMIC_RELAXED, __HIP_MEMORY_SCOPE_AGENT); }
    __device__ __forceinline__ void operator()(f32x4 (&acc)[2][2][4][2], const Unit& u, int wr, int wc, int fr, int fq) const {
        const int nvalid = tb.desc[u.pm * 8 + 3], arow0 = tb.desc[u.pm * 8 + 4];
        const int f0 = u.pn * HALF + wc * 32 + 8 * fq;
#pragma unroll
        for (int ai = 0; ai < 2; ++ai)
#pragma unroll
            for (int m = 0; m < 4; ++m) {
                const int r = ai * HALF + wr * 64 + m * 16 + fr;
                if (r < nvalid) {
                    const float w = tokw[tb.rowtab[u.pm * 256 + r]];
                    float v[8];
#pragma unroll
                    for (int e = 0; e < 4; ++e) { const float g0 = acc[ai][0][m][0][e], g1 = acc[ai][0][m][1][e];
                        v[e] = g0 * fsigmoid(g0) * acc[ai][1][m][0][e] * w; v[4 + e] = g1 * fsigmoid(g1) * acc[ai][1][m][1][e] * w; }
                    u32x4 o; o.x = cvtpk(v[0], v[1]); o.y = cvtpk(v[2], v[3]); o.z = cvtpk(v[4], v[5]); o.w = cvtpk(v[6], v[7]);
                    asm volatile("global_store_dwordx4 %0, %1, off sc1\n\ts_nop 1" :: "v"(act + (size_t)(arow0 + r) * FF + f0), "v"(o) : "memory"); } }
    } };
struct EpiMoe2 { static constexpr bool PERM = true; bf16_t* ys; MoeTab tb;
    __device__ __forceinline__ bool keep(const Unit&) const { return false; }
    __device__ __forceinline__ void operator()(f32x4 (&acc)[2][2][4][2], const Unit& u, int wr, int wc, int fr, int fq) const {
        const int nvalid = tb.desc[u.pm * 8 + 3];
#pragma unroll
        for (int ai = 0; ai < 2; ++ai)
#pragma unroll
            for (int m = 0; m < 4; ++m) {
                const int r = ai * HALF + wr * 64 + m * 16 + fr;
                if (r < nvalid) {
                    bf16_t* rowp = ys + (size_t)tb.rowtab[u.pm * 256 + r] * DM + u.pn * BM + wc * 32 + 8 * fq;
#pragma unroll
                    for (int bj = 0; bj < 2; ++bj) { const f32x4 v0 = acc[ai][bj][m][0], v1 = acc[ai][bj][m][1];
                        u32x4 o; o.x = cvtpk(v0[0], v0[1]); o.y = cvtpk(v0[2], v0[3]); o.z = cvtpk(v1[0], v1[1]); o.w = cvtpk(v1[2], v1[3]);
                        *(u32x4*)(rowp + bj * HALF) = o; } } }
    } };
}

struct TrItem { const float* W; bf16_t* WT; int ldw, ksrc0, ldt, kdst0, ndst0, kind, off, pad; };
__device__ __forceinline__ int tr_map(int kind, int off, int r) {
    if (kind == 0) return r - off;
    if (kind == 1) return r < MLA_IN ? r : (r < 768 ? -1 : r - 96);
    if (kind == 2) { const int h = r / QK, d = r % QK; if (d < NOPE) return r; const int i = (d - NOPE) >> 1, odd = (d - NOPE) & 1; return h * QK + NOPE + i + 16 * odd; }
    return ((r >> 8) << 7) + (r & 127);
}
__device__ __forceinline__ void tr_load(const TrItem& d, float (&v)[32], int lane) {
    const int n = lane & 31; const int sc = d.W ? tr_map(d.kind, d.off, d.ndst0 + n) : -1;
    const float* p = d.W + (size_t)(d.ksrc0 + (lane >> 5)) * d.ldw + (sc >= 0 ? sc : 0);
#pragma unroll
    for (int i = 0; i < 32; ++i) v[i] = (sc >= 0) ? p[(size_t)(2 * i) * d.ldw] : 0.f;
}
__device__ __forceinline__ void tr_store(const TrItem& d, const float (&v)[32], LAS float* scr, int lane) {
    const int n = lane & 31;
#pragma unroll
    for (int i = 0; i < 32; ++i) scr[(2 * i + (lane >> 5)) * 33 + n] = v[i];
    asm volatile("s_waitcnt lgkmcnt(0)" ::: "memory");
    const int c = lane & 7;
#pragma unroll
    for (int j = 0; j < 4; ++j) { const int nn = (lane >> 3) + 8 * j; const LAS float* s_ = scr + (8 * c) * 33 + nn;
        u32x4 o; o.x = cvtpk(s_[0 * 33], s_[1 * 33]); o.y = cvtpk(s_[2 * 33], s_[3 * 33]); o.z = cvtpk(s_[4 * 33], s_[5 * 33]); o.w = cvtpk(s_[6 * 33], s_[7 * 33]);
        *(u32x4*)(d.WT + (size_t)(d.ndst0 + nn) * d.ldt + d.kdst0 + 8 * c) = o; }
    asm volatile("s_waitcnt lgkmcnt(0)" ::: "memory");
}

constexpr size_t WO_IN = 0;
constexpr size_t WO_UQ = WO_IN + (size_t)4608 * 1024 * 2;
constexpr size_t WO_UKV = WO_UQ + (size_t)768 * 384 * 2;
constexpr size_t WO_LORA = WO_UKV + (size_t)1024 * 256 * 2;
constexpr size_t WO_OM = WO_LORA + (size_t)1536 * 256 * 2;
constexpr size_t WO_OR = WO_OM + (size_t)1024 * 512 * 2;
constexpr size_t WO_OUT = WO_OR + (size_t)1024 * 512 * 2;
constexpr size_t WO_GU = WO_OUT + (size_t)1024 * 1024 * 2;
constexpr size_t WO_DN = WO_GU + (size_t)32 * 512 * 1024 * 2;
constexpr size_t WO_END = WO_DN + (size_t)32 * 1024 * 256 * 2;
constexpr size_t WO_RH = WO_END;
constexpr size_t WO_RL = WO_RH + (size_t)48 * 1024 * 2;
static_assert(WO_RL + (size_t)48 * 1024 * 2 <= 64 * MiB, "weights region");
constexpr int TR_I_IN = 16 * 144, TR_I_UQ = 6 * 24, TR_I_UKV = 4 * 32, TR_I_LORA = 4 * 48, TR_I_OM = 8 * 32, TR_I_OR = 8 * 32, TR_I_OUT = 16 * 32, TR_I_GU = 32 * 16 * 16, TR_I_DN = 32 * 4 * 32;
constexpr int TR_NITEMS = TR_I_IN + TR_I_UQ + TR_I_UKV + TR_I_LORA + TR_I_OM + TR_I_OR + TR_I_OUT + TR_I_GU + TR_I_DN;
__device__ __forceinline__ TrItem tr_desc(const Ctx& C, int it) {
    bf16_t* wb = (bf16_t*)(C.ws + WS_W);
    TrItem d; d.kind = 0; d.off = 0; d.pad = 0;
    int r = it;
    if (r < TR_I_IN) { const int kb = r / 144, nb = r % 144; d.W = C.w_in; d.ldw = IN_W; d.ksrc0 = 64 * kb; d.WT = wb + WO_IN / 2; d.ldt = 1024; d.kdst0 = 64 * kb; d.ndst0 = 32 * nb; d.kind = 1; return d; } r -= TR_I_IN;
    if (r < TR_I_UQ) { const int kb = r / 24, nb = r % 24; d.W = C.w_uq; d.ldw = 768; d.ksrc0 = 64 * kb; d.WT = wb + WO_UQ / 2; d.ldt = QR; d.kdst0 = 64 * kb; d.ndst0 = 32 * nb; d.kind = 2; return d; } r -= TR_I_UQ;
    if (r < TR_I_UKV) { const int kb = r / 32, nb = r % 32; d.W = C.w_ukv; d.ldw = 1024; d.ksrc0 = 64 * kb; d.WT = wb + WO_UKV / 2; d.ldt = KVR; d.kdst0 = 64 * kb; d.ndst0 = 32 * nb; return d; } r -= TR_I_UKV;
    if (r < TR_I_LORA) { const int kb = r / 48, nb = r % 48;
        d.W = nullptr; d.ksrc0 = 0; d.ldw = RW;
        if (nb < 16) { if (kb == 0) d.W = C.w_dec; d.off = 0; }
        else if (nb < 32) { if (kb == 1) d.W = C.w_a; d.off = 512; }
        else { if (kb >= 2) { d.W = C.w_g; d.ksrc0 = 64 * (kb - 2); } d.off = 1024; }
        d.WT = wb + WO_LORA / 2; d.ldt = 256; d.kdst0 = 64 * kb; d.ndst0 = 32 * nb; return d; } r -= TR_I_LORA;
    if (r < TR_I_OM) { const int kb = r / 32, nb = r % 32; d.W = C.w_o_mla; d.ldw = DM; d.ksrc0 = 64 * kb; d.WT = wb + WO_OM / 2; d.ldt = RW; d.kdst0 = 64 * kb; d.ndst0 = 32 * nb; return d; } r -= TR_I_OM;
    if (r < TR_I_OR) { const int kb = r / 32, nb = r % 32; d.W = C.w_o_rwkv; d.ldw = DM; d.ksrc0 = 64 * kb; d.WT = wb + WO_OR / 2; d.ldt = RW; d.kdst0 = 64 * kb; d.ndst0 = 32 * nb; return d; } r -= TR_I_OR;
    if (r < TR_I_OUT) { const int kb = r / 32, nb = r % 32; d.W = C.w_out; d.ldw = DM; d.ksrc0 = 64 * kb; d.WT = wb + WO_OUT / 2; d.ldt = DM; d.kdst0 = 64 * kb; d.ndst0 = 32 * nb; return d; } r -= TR_I_OUT;
    if (r < TR_I_GU) { const int e = r / 256, q = r % 256, kb = q / 16, nb = q % 16;
        d.W = (((32 * nb) & 128) ? C.w_eu : C.w_eg) + (size_t)e * DM * FF; d.ldw = FF; d.ksrc0 = 64 * kb; d.WT = wb + WO_GU / 2 + (size_t)e * 512 * 1024; d.ldt = 1024; d.kdst0 = 64 * kb; d.ndst0 = 32 * nb; d.kind = 3; return d; } r -= TR_I_GU;
    { const int e = r / 128, q = r % 128, kb = q / 32, nb = q % 32;
      d.W = C.w_ed + (size_t)e * FF * DM; d.ldw = DM; d.ksrc0 = 64 * kb; d.WT = wb + WO_DN / 2 + (size_t)e * 1024 * 256; d.ldt = 256; d.kdst0 = 64 * kb; d.ndst0 = 32 * nb; return d; }
}


namespace att {
constexpr int KROW = 208, KBUF = 64 * KROW, VBUF = 8192, BUF = KBUF + VBUF;
typedef short v4i16_t __attribute__((ext_vector_type(4)));
__device__ __forceinline__ v4i16_t vtr(const LAS unsigned char* p) { return __builtin_amdgcn_ds_read_tr16_b64_v4i16((LAS v4i16_t*)p); }
__device__ __forceinline__ float hmax(float x) { auto rr = __builtin_amdgcn_permlane32_swap(__float_as_uint(x), __float_as_uint(x), false, false); return fmaxf(__uint_as_float(rr[0]), __uint_as_float(rr[1])); }
__device__ __forceinline__ float hsum(float x) { auto rr = __builtin_amdgcn_permlane32_swap(__float_as_uint(x), __float_as_uint(x), false, false); return __uint_as_float(rr[0]) + __uint_as_float(rr[1]); }

__device__ __forceinline__ void attn_unit(const Ctx& C, LAS unsigned char* lds, int bh, int qb, int tid, int lane, int wave) {
    const int r32 = lane & 31, hi = lane >> 5;
    const bf16_t* qf = (const bf16_t*)(C.ws + WS_QF) + ((size_t)bh * SEQ + qb * 256 + wave * 32 + r32) * QK;
    const unsigned char* kbase = (const unsigned char*)((const bf16_t*)(C.ws + WS_KF) + (size_t)bh * SEQ * QK);
    const unsigned char* vbase = (const unsigned char*)((const bf16_t*)(C.ws + WS_VF) + (size_t)bh * SEQ * VD);
    bf16x8 qr[6];
#pragma unroll
    for (int s = 0; s < 6; ++s) qr[s] = *(const bf16x8*)(qf + 16 * s + 8 * hi);
    const int kc1 = 512 + tid;
    const int koff0 = (tid / 12) * KROW + (tid % 12) * 16, koff1 = (kc1 / 12) * KROW + (kc1 % 12) * 16;
    const int vkey = tid >> 3, vj = tid & 7;
    const int voff = KBUF + (vj >> 2) * 4096 + (vkey >> 4) * 1024 + (vkey & 15) * 64 + (vj & 3) * 16;
    const int NT = 4 * qb + 4, cw = 4 * qb + (wave >> 1);
    const bool has_k1 = tid < 256;
    u32x4 k0r, k1r = {0u, 0u, 0u, 0u}, v0r;
    k0r = *(const u32x4*)(kbase + (size_t)tid * 16); if (has_k1) k1r = *(const u32x4*)(kbase + (size_t)kc1 * 16); v0r = *(const u32x4*)(vbase + (size_t)tid * 16);
    *(LAS u32x4*)(lds + koff0) = k0r; if (has_k1) *(LAS u32x4*)(lds + koff1) = k1r; *(LAS u32x4*)(lds + voff) = v0r;
    if (NT > 1) { k0r = *(const u32x4*)(kbase + 12288 + (size_t)tid * 16); if (has_k1) k1r = *(const u32x4*)(kbase + 12288 + (size_t)kc1 * 16); v0r = *(const u32x4*)(vbase + 8192 + (size_t)tid * 16); }
    __syncthreads();
    f32x16 o0, o1, negm;
#pragma unroll
    for (int r = 0; r < 16; ++r) { o0[r] = 0.f; o1[r] = 0.f; negm[r] = 0.f; }
    float m = 0.f, l = 0.f;
    const int kfrag = r32 * KROW + hi * 16;
    const int vfrag = KBUF + ((lane >> 4) & 1) * 32 + (lane & 3) * 8 + (4 * hi + ((lane & 15) >> 2)) * 64;
    for (int t = 0; t < NT; ++t) {
        const LAS unsigned char* cur = lds + (t & 1) * BUF;
        if (t + 1 < NT) { LAS unsigned char* nb = lds + ((t + 1) & 1) * BUF;
            *(LAS u32x4*)(nb + koff0) = k0r; if (has_k1) *(LAS u32x4*)(nb + koff1) = k1r; *(LAS u32x4*)(nb + voff) = v0r; }
        if (t + 2 < NT) { const unsigned char* kb = kbase + (size_t)(t + 2) * 12288; const unsigned char* vb = vbase + (size_t)(t + 2) * 8192;
            k0r = *(const u32x4*)(kb + (size_t)tid * 16); if (has_k1) k1r = *(const u32x4*)(kb + (size_t)kc1 * 16); v0r = *(const u32x4*)(vb + (size_t)tid * 16); }
        if (t <= cw) {
            f32x16 p0, p1;
            const LAS unsigned char* kp = cur + kfrag;
#pragma unroll
            for (int s = 0; s < 6; ++s) {
                const bf16x8 a0 = *(const LAS bf16x8*)(kp + s * 32), a1 = *(const LAS bf16x8*)(kp + 32 * KROW + s * 32);
                if (s == 0) { p0 = __builtin_amdgcn_mfma_f32_32x32x16_bf16(a0, qr[0], negm, 0, 0, 0); p1 = __builtin_amdgcn_mfma_f32_32x32x16_bf16(a1, qr[0], negm, 0, 0, 0); }
                else { p0 = __builtin_amdgcn_mfma_f32_32x32x16_bf16(a0, qr[s], p0, 0, 0, 0); p1 = __builtin_amdgcn_mfma_f32_32x32x16_bf16(a1, qr[s], p1, 0, 0, 0); }
            }
            float mx = fmaxf(fmaxf(p0[0], p1[0]), fmaxf(p0[1], p1[1]));
#pragma unroll
            for (int r = 2; r < 16; r += 2) mx = fmaxf(mx, fmaxf(fmaxf(p0[r], p1[r]), fmaxf(p0[r + 1], p1[r + 1])));
            mx = hmax(mx);
            if (t == 0) {
                m = mx;
#pragma unroll
                for (int r = 0; r < 16; ++r) { p0[r] -= mx; p1[r] -= mx; negm[r] = -mx; }
            } else if (__any(mx > 8.0f)) {
                const float dl = fmaxf(mx, 0.f), alpha = __builtin_amdgcn_exp2f(-dl);
                m += dl; l *= alpha;
#pragma unroll
                for (int r = 0; r < 16; ++r) { p0[r] -= dl; p1[r] -= dl; o0[r] *= alpha; o1[r] *= alpha; negm[r] = -m; }
            }
            float ps0 = 0.f, ps1 = 0.f;
#pragma unroll
            for (int r = 0; r < 16; ++r) { p0[r] = __builtin_amdgcn_exp2f(p0[r]); p1[r] = __builtin_amdgcn_exp2f(p1[r]); ps0 += p0[r]; ps1 += p1[r]; }
            l += ps0 + ps1;
            u32x4 pw0, pw1, pw2, pw3;
            pw0 = (u32x4){cvtpk(p0[0], p0[1]), cvtpk(p0[2], p0[3]), cvtpk(p0[4], p0[5]), cvtpk(p0[6], p0[7])};
            pw1 = (u32x4){cvtpk(p0[8], p0[9]), cvtpk(p0[10], p0[11]), cvtpk(p0[12], p0[13]), cvtpk(p0[14], p0[15])};
            pw2 = (u32x4){cvtpk(p1[0], p1[1]), cvtpk(p1[2], p1[3]), cvtpk(p1[4], p1[5]), cvtpk(p1[6], p1[7])};
            pw3 = (u32x4){cvtpk(p1[8], p1[9]), cvtpk(p1[10], p1[11]), cvtpk(p1[12], p1[13]), cvtpk(p1[14], p1[15])};
            const LAS unsigned char* vp = cur + vfrag;
#define ATT_PV(OD, D0, KS, PW) do { const v4i16_t lo_ = vtr(vp + (D0) * 4096 + (KS) * 1024), hi_ = vtr(vp + (D0) * 4096 + (KS) * 1024 + 512); \
                const bf16x8 vf_ = {lo_[0], lo_[1], lo_[2], lo_[3], hi_[0], hi_[1], hi_[2], hi_[3]}; \
                OD = __builtin_amdgcn_mfma_f32_32x32x16_bf16(vf_, __builtin_bit_cast(bf16x8, PW), OD, 0, 0, 0); } while (0)
            ATT_PV(o0, 0, 0, pw0); ATT_PV(o1, 1, 0, pw0); ATT_PV(o0, 0, 1, pw1); ATT_PV(o1, 1, 1, pw1);
            ATT_PV(o0, 0, 2, pw2); ATT_PV(o1, 1, 2, pw2); ATT_PV(o0, 0, 3, pw3); ATT_PV(o1, 1, 3, pw3);
#undef ATT_PV
        }
        asm volatile("s_waitcnt lgkmcnt(0)" ::: "memory"); __builtin_amdgcn_s_barrier(); asm volatile("" ::: "memory");
    }
    const float rl = 1.f / hsum(l);
    const int b = bh / NH, h = bh - b * NH;
    bf16_t* op = (bf16_t*)(C.ws + WS_ATT) + ((size_t)b * SEQ + qb * 256 + wave * 32 + r32) * RW + h * VD + 4 * hi;
#pragma unroll
    for (int g = 0; g < 4; ++g) {
        u32x2 w0, w1;
        w0.x = cvtpk(o0[4 * g] * rl, o0[4 * g + 1] * rl); w0.y = cvtpk(o0[4 * g + 2] * rl, o0[4 * g + 3] * rl);
        w1.x = cvtpk(o1[4 * g] * rl, o1[4 * g + 1] * rl); w1.y = cvtpk(o1[4 * g + 2] * rl, o1[4 * g + 3] * rl);
        *(u32x2*)(op + 8 * g) = w0; *(u32x2*)(op + 32 + 8 * g) = w1;
    }
}
__device__ __forceinline__ void attn_phase(const Ctx& C, LAS unsigned char* lds, int G, int bx, int tid, int lane, int wave) {
    const int v0 = (G % 8 == 0) ? (bx % 8) * (G / 8) + bx / 8 : bx;
    for (int v = v0; v < 256; v += G) {
        const int bh = v >> 1, odd = v & 1;
#pragma unroll 1
        for (int i = 0; i < 4; ++i) {
            const int qb = (i == 0) ? 7 - odd : (i == 1) ? odd : (i == 2) ? 4 + odd : 3 - odd;
            attn_unit(C, lds, bh, qb, tid, lane, wave);
        }
    }
}
}


namespace cscan {
constexpr int CH = 32, NCH = SEQ / CH;
constexpr int RS = 144;
constexpr int RS2 = 80;
constexpr int L_AT = 0, L_BT = 4608, L_RT = 9216, L_KT = 13824, L_BTV = 18432, L_VV = 22528, L_MAB = 26624, L_MAK = 30720, L_GC = 34816, L_MBRT = 35072, L_WAVE = 37632;
constexpr int L_P = L_AT, L_MAKT = L_MAK;
typedef short v4i16_t __attribute__((ext_vector_type(4)));
typedef float f32x2s __attribute__((ext_vector_type(2)));
#define CS_MF(a, b, c) __builtin_amdgcn_mfma_f32_32x32x16_bf16(a, b, c, 0, 0, 0)
template <int CTRL> __device__ __forceinline__ float dpp_add(float x) { return x + __builtin_bit_cast(float, __builtin_amdgcn_update_dpp(0, __builtin_bit_cast(int, x), CTRL, 0xf, 0xf, true)); }
__device__ __forceinline__ float wsum(float x) {
    x = dpp_add<0xB1>(x); x = dpp_add<0x4E>(x); x = dpp_add<0x141>(x); x = dpp_add<0x140>(x);
    x += __builtin_bit_cast(float, __builtin_amdgcn_update_dpp(0, __builtin_bit_cast(int, x), 0x142, 0xa, 0xf, false));
    x += __builtin_bit_cast(float, __builtin_amdgcn_update_dpp(0, __builtin_bit_cast(int, x), 0x143, 0xc, 0xf, false));
    return __builtin_bit_cast(float, __builtin_amdgcn_readlane(__builtin_bit_cast(int, x), 63));
}
__device__ __forceinline__ int crow(int r, int hi) { return (r & 3) + 8 * (r >> 2) + 4 * hi; }
__device__ __forceinline__ bf16x8 pack8(const f32x16& p, int s) {
    u32x4 w; w.x = cvtpk(p[8 * s], p[8 * s + 1]); w.y = cvtpk(p[8 * s + 2], p[8 * s + 3]); w.z = cvtpk(p[8 * s + 4], p[8 * s + 5]); w.w = cvtpk(p[8 * s + 6], p[8 * s + 7]);
    return __builtin_bit_cast(bf16x8, w); }
__device__ __forceinline__ bf16x8 rd_nat(const LAS unsigned char* p) { return *(const LAS bf16x8*)p; }
__device__ __forceinline__ bf16x8 rd_perm(const LAS unsigned char* p) { const u32x2 a = *(const LAS u32x2*)p, b = *(const LAS u32x2*)(p + 16);
    u32x4 w; w.x = a.x; w.y = a.y; w.z = b.x; w.w = b.y; return __builtin_bit_cast(bf16x8, w); }
__device__ __forceinline__ bf16x8 rd_tr(const LAS unsigned char* p) { const v4i16_t lo = __builtin_amdgcn_ds_read_tr16_b64_v4i16((LAS v4i16_t*)p), hi = __builtin_amdgcn_ds_read_tr16_b64_v4i16((LAS v4i16_t*)(p + 512));
    return (bf16x8){lo[0], lo[1], lo[2], lo[3], hi[0], hi[1], hi[2], hi[3]}; }
__device__ __forceinline__ float bfl(unsigned w) { return __uint_as_float(w << 16); }
__device__ __forceinline__ float bfh(unsigned w) { return __uint_as_float(w & 0xffff0000u); }

#define CS_BAR() do { asm volatile("s_waitcnt lgkmcnt(0)" ::: "memory"); __builtin_amdgcn_s_barrier(); asm volatile("" ::: "memory"); } while (0)
__device__ __forceinline__ void pair_bar(LAS unsigned* cnt, unsigned& ord, int lane) {
    asm volatile("s_waitcnt lgkmcnt(0)" ::: "memory");
    ord += 2u;
    if (lane == 0) __hip_atomic_fetch_add(cnt, 1u, __ATOMIC_RELAXED, __HIP_MEMORY_SCOPE_WORKGROUP);
    for (unsigned spins = 0; spins < (1u << 22); ++spins) {
        const unsigned v = __builtin_amdgcn_readfirstlane(__hip_atomic_load(cnt, __ATOMIC_RELAXED, __HIP_MEMORY_SCOPE_WORKGROUP));
        if ((int)(v - ord) >= 0) break;
        __builtin_amdgcn_s_sleep(1);
    }
    asm volatile("" ::: "memory");
}
struct RawRegs { u32x4 r[2], k[2], v[2], a[2], e[2]; };
__device__ __forceinline__ void rawLoad(const Ctx& C, RawRegs& R, int task, int lane, int role) {
    const int c = task & (NCH - 1), bh = task >> 6, b = bh / NH, h = bh - b * NH;
    const size_t trow0 = (size_t)b * SEQ + (size_t)c * CH + 16 * role + (lane >> 3);
    const bf16_t* rkv = (const bf16_t*)(C.ws + WS_RKV) + trow0 * 1536 + h * 64 + (lane & 7) * 8;
    const bf16_t* av = (const bf16_t*)(C.ws + WS_AV) + trow0 * RW + h * 64 + (lane & 7) * 8;
    const bf16_t* eb = (const bf16_t*)(C.ws + WS_EBUF) + trow0 * RW + h * 64 + (lane & 7) * 8;
#pragma unroll
    for (int q = 0; q < 2; ++q) { R.r[q] = *(const u32x4*)(rkv + (size_t)q * 8 * 1536); R.k[q] = *(const u32x4*)(rkv + (size_t)q * 8 * 1536 + 512); R.v[q] = *(const u32x4*)(rkv + (size_t)q * 8 * 1536 + 1024);
        R.a[q] = *(const u32x4*)(av + (size_t)q * 8 * RW); R.e[q] = *(const u32x4*)(eb + (size_t)q * 8 * RW); }
}
__device__ __forceinline__ void taskA(const Ctx& C, LAS unsigned char* L, int task, int lane, int role, bool valid, RawRegs& R, int next_task, bool next_valid, LAS unsigned* pcnt, unsigned& pord) {
    asm volatile("" : "+v"(lane));
    const int c = task & (NCH - 1), bh = task >> 6, b = bh / NH, h = bh - b * NH;
    const int r32 = lane & 31, hi = lane >> 5;
    const size_t trow0 = (size_t)b * SEQ + (size_t)c * CH;
    if (valid) {
        const int jg = lane & 7;
        const float4 kw0 = *(const float4*)(C.k_k + h * 64 + 8 * jg), kw1 = *(const float4*)(C.k_k + h * 64 + 8 * jg + 4), ka0 = *(const float4*)(C.k_a + h * 64 + 8 * jg), ka1 = *(const float4*)(C.k_a + h * 64 + 8 * jg + 4);
        const float4 rk0 = *(const float4*)(C.r_k + h * 64 + 8 * jg), rk1 = *(const float4*)(C.r_k + h * 64 + 8 * jg + 4);
        const float kkw[8] = {kw0.x, kw0.y, kw0.z, kw0.w, kw1.x, kw1.y, kw1.z, kw1.w}, kaw[8] = {ka0.x, ka0.y, ka0.z, ka0.w, ka1.x, ka1.y, ka1.z, ka1.w};
        const float rkw[8] = {rk0.x, rk0.y, rk0.z, rk0.w, rk1.x, rk1.y, rk1.z, rk1.w};
        float* bonus = (float*)(C.ws + WS_BONUS) + trow0 * NH + h;
#pragma unroll
        for (int q = 0; q < 2; ++q) { const int t = 16 * role + 8 * q + (lane >> 3);
            float kf[8], rf[8], af[8], kk0[8], kp[8];
#pragma unroll
            for (int e = 0; e < 4; ++e) { kf[2 * e] = bfl(R.k[q][e]); kf[2 * e + 1] = bfh(R.k[q][e]); rf[2 * e] = bfl(R.r[q][e]); rf[2 * e + 1] = bfh(R.r[q][e]); af[2 * e] = bfl(R.a[q][e]); af[2 * e + 1] = bfh(R.a[q][e]); }
            float n2 = 0.f, bn = 0.f;
#pragma unroll
            for (int e = 0; e < 8; ++e) { kk0[e] = kf[e] * kkw[e]; n2 += kk0[e] * kk0[e]; kp[e] = kf[e] * (1.f + (af[e] - 1.f) * kaw[e]); bn += rf[e] * kp[e] * rkw[e]; }
            n2 = sum8_dpp(n2); bn = sum8_dpp(bn);
            const float rn = __builtin_amdgcn_rsqf(fmaxf(n2, 1e-24f));
            u32x4 wkk, wkp;
            wkk.x = cvtpk(kk0[0] * rn, kk0[1] * rn); wkk.y = cvtpk(kk0[2] * rn, kk0[3] * rn); wkk.z = cvtpk(kk0[4] * rn, kk0[5] * rn); wkk.w = cvtpk(kk0[6] * rn, kk0[7] * rn);
            wkp.x = cvtpk(kp[0], kp[1]); wkp.y = cvtpk(kp[2], kp[3]); wkp.z = cvtpk(kp[4], kp[5]); wkp.w = cvtpk(kp[6], kp[7]);
            if (jg == 0) bonus[(size_t)t * NH] = bn;
            *(LAS u32x4*)(L + L_RT + t * RS + jg * 16) = R.r[q]; *(LAS u32x4*)(L + L_KT + t * RS + jg * 16) = wkp; *(LAS u32x4*)(L + L_AT + t * RS + jg * 16) = wkk;
            *(LAS u32x4*)(L + L_MAK + t * 128 + jg * 16) = R.a[q]; *(LAS u32x4*)(L + L_MAB + t * 128 + jg * 16) = R.e[q];
            *(LAS u32x4*)(L + L_VV + (jg >> 2) * 2048 + (t >> 4) * 1024 + (t & 15) * 64 + (jg & 3) * 16) = R.v[q]; }
    }
    if (next_valid) rawLoad(C, R, next_task, lane, role);
    pair_bar(pcnt, pord, lane);
    if (valid) {
        float Lc = 0.f;
        if (role == 1) {
#pragma unroll
            for (int t = 0; t < 16; ++t) Lc -= bf2f(*(const LAS bf16_t*)(L + L_MAB + t * 128 + lane * 2)); }
        float gprev = __expf(Lc);
        const int vbase = (lane >> 5) * 2048 + (lane & 31) * 2;
#pragma unroll 4
        for (int tt = 0; tt < 16; ++tt) {
            const int t = 16 * role + tt; const int ro = t * RS + lane * 2;
            const float r = bf2f(*(const LAS bf16_t*)(L + L_RT + ro)), kp = bf2f(*(const LAS bf16_t*)(L + L_KT + ro)), kk = bf2f(*(const LAS bf16_t*)(L + L_AT + ro));
            const float a = bf2f(*(const LAS bf16_t*)(L + L_MAK + t * 128 + lane * 2)), e = bf2f(*(const LAS bf16_t*)(L + L_MAB + t * 128 + lane * 2));
            Lc -= e; const float gam = __expf(Lc), ginv = __expf(-Lc);
            const unsigned w1 = cvtpk(-kk * gprev, r * gam), w2 = cvtpk(kp * ginv, kk * a * ginv);
            *(LAS bf16_t*)(L + L_AT + ro) = (bf16_t)w1; *(LAS bf16_t*)(L + L_RT + ro) = (bf16_t)(w1 >> 16); *(LAS bf16_t*)(L + L_KT + ro) = (bf16_t)w2;
            *(LAS bf16_t*)(L + L_BT + ro) = (bf16_t)(w2 >> 16); *(LAS bf16_t*)(L + L_BTV + vbase + (t >> 4) * 1024 + (t & 15) * 64) = (bf16_t)(w2 >> 16);
            gprev = gam;
        }
        if (role == 1) *(LAS float*)(L + L_GC + lane * 4) = gprev;
    }
    pair_bar(pcnt, pord, lane);
    f32x16 mkr;
#pragma unroll
    for (int q = 0; q < 16; ++q) mkr[q] = 0.f;
    if (valid) {
        f32x16 m0;
#pragma unroll
        for (int q = 0; q < 16; ++q) m0[q] = 0.f;
        const int bt_ = role == 0 ? L_AT : L_RT;
#pragma unroll
        for (int s_ = 0; s_ < 4; ++s_) {
            const int ko = r32 * RS + (16 * s_ + 8 * hi) * 2;
            const bf16x8 aB = rd_nat(L + L_BT + ko), aK = rd_nat(L + L_KT + ko), bX = rd_nat(L + bt_ + ko);
            m0 = CS_MF(aB, bX, m0); mkr = CS_MF(aK, bX, mkr);
        }
        const float base_ = (float)(r32 - 4 * hi) + (role == 0 ? 0.f : 1.f);
#pragma unroll
        for (int q = 0; q < 16; ++q) { const float mk_ = __builtin_amdgcn_fmed3f(base_ - (float)((q & 3) + 8 * (q >> 2)), 0.f, 1.f); m0[q] *= mk_; mkr[q] *= mk_; }
        if (role == 0) {
#pragma unroll
            for (int g = 0; g < 4; ++g) {
                *(LAS f32x4*)(L + L_MAB + r32 * 128 + (8 * g + 4 * hi) * 4) = (f32x4){m0[4 * g], m0[4 * g + 1], m0[4 * g + 2], m0[4 * g + 3]};
                *(LAS f32x4*)(L + L_MAK + r32 * 128 + (8 * g + 4 * hi) * 4) = (f32x4){mkr[4 * g], mkr[4 * g + 1], mkr[4 * g + 2], mkr[4 * g + 3]}; }
        } else {
#pragma unroll
            for (int g = 0; g < 4; ++g) { u32x2 w; w.x = cvtpk(m0[4 * g], m0[4 * g + 1]); w.y = cvtpk(m0[4 * g + 2], m0[4 * g + 3]);
                *(LAS u32x2*)(L + L_MBRT + r32 * RS2 + (8 * g + 4 * hi) * 2) = w; }
        }
    }
    pair_bar(pcnt, pord, lane);
    if (valid) {
        float xa[16], xb[16];
#pragma unroll
        for (int t = 0; t < 16; ++t) { xa[t] = 0.f; xb[t] = 0.f; }
#pragma unroll
        for (int t = 0; t < 16; ++t) {
            float ap = role == 0 ? bf2f(*(const LAS bf16_t*)(L + L_AT + t * RS + lane * 2)) : *(const LAS float*)(L + L_MAK + t * 128 + r32 * 4);
            float aq = 0.f;
#pragma unroll
            for (int i4 = 0; i4 < (t + 3) / 4; ++i4) { const f32x4 m4 = *(const LAS f32x4*)(L + L_MAB + t * 128 + i4 * 16);
                ap += xa[4 * i4] * m4[0]; aq += xa[4 * i4 + 1] * m4[1]; ap += xa[4 * i4 + 2] * m4[2]; aq += xa[4 * i4 + 3] * m4[3]; }
            xa[t] = ap + aq;
            asm volatile("" : "+v"(xa[t]) :: "memory");
        }
#pragma unroll
        for (int t = 0; t < 16; ++t) {
            float ap = role == 0 ? bf2f(*(const LAS bf16_t*)(L + L_AT + (16 + t) * RS + lane * 2)) : *(const LAS float*)(L + L_MAK + (16 + t) * 128 + r32 * 4);
            float aq = 0.f;
#pragma unroll
            for (int i4 = 0; i4 < 4; ++i4) { const f32x4 m4 = *(const LAS f32x4*)(L + L_MAB + (16 + t) * 128 + i4 * 16);
                ap += xa[4 * i4] * m4[0]; aq += xa[4 * i4 + 1] * m4[1]; ap += xa[4 * i4 + 2] * m4[2]; aq += xa[4 * i4 + 3] * m4[3]; }
#pragma unroll
            for (int i4 = 0; i4 < (t + 3) / 4; ++i4) { const f32x4 m4 = *(const LAS f32x4*)(L + L_MAB + (16 + t) * 128 + 64 + i4 * 16);
                ap += xb[4 * i4] * m4[0]; aq += xb[4 * i4 + 1] * m4[1]; ap += xb[4 * i4 + 2] * m4[2]; aq += xb[4 * i4 + 3] * m4[3]; }
            xb[t] = ap + aq;
            asm volatile("" : "+v"(xb[t]) :: "memory");
        }
        u32x4 w0, w1, w2, w3;
        w0.x = cvtpk(xa[0], xa[1]); w0.y = cvtpk(xa[2], xa[3]); w0.z = cvtpk(xa[4], xa[5]); w0.w = cvtpk(xa[6], xa[7]);
        w1.x = cvtpk(xa[8], xa[9]); w1.y = cvtpk(xa[10], xa[11]); w1.z = cvtpk(xa[12], xa[13]); w1.w = cvtpk(xa[14], xa[15]);
        w2.x = cvtpk(xb[0], xb[1]); w2.y = cvtpk(xb[2], xb[3]); w2.z = cvtpk(xb[4], xb[5]); w2.w = cvtpk(xb[6], xb[7]);
        w3.x = cvtpk(xb[8], xb[9]); w3.y = cvtpk(xb[10], xb[11]); w3.z = cvtpk(xb[12], xb[13]); w3.w = cvtpk(xb[14], xb[15]);
        if (role == 0) { LAS u32x4* d = (LAS u32x4*)(L + L_P + lane * RS2); d[0] = w0; d[1] = w1; d[2] = w2; d[3] = w3; }
        else if (hi == 0) { LAS u32x4* d = (LAS u32x4*)(L + L_MAKT + r32 * RS2); d[0] = w0; d[1] = w1; d[2] = w2; d[3] = w3; }
    }
    pair_bar(pcnt, pord, lane);
    if (valid) {
        const int trf = ((lane >> 4) & 1) * 32 + (lane & 3) * 8 + (4 * hi + ((lane & 15) >> 2)) * 64;
        if (role == 0) {
            bf16_t* gQT = (bf16_t*)(C.ws + WS_CQT) + (size_t)task * (CH * 64);
            bf16_t* gGT = (bf16_t*)(C.ws + WS_CGT) + (size_t)task * (64 * 64);
            {
                f32x16 q0, q1;
#pragma unroll
                for (int q = 0; q < 16; ++q) { q0[q] = 0.f; q1[q] = 0.f; }
#pragma unroll
                for (int s_ = 0; s_ < 2; ++s_) { const int ko = (16 * s_ + 8 * hi) * 2; const bf16x8 bM = rd_nat(L + L_MBRT + r32 * RS2 + ko);
                    q0 = CS_MF(rd_nat(L + L_P + r32 * RS2 + ko), bM, q0); q1 = CS_MF(rd_nat(L + L_P + (32 + r32) * RS2 + ko), bM, q1); }
#pragma unroll
                for (int g = 0; g < 4; ++g) {
                    const u32x2 ra = *(const LAS u32x2*)(L + L_RT + r32 * RS + (8 * g + 4 * hi) * 2), rb = *(const LAS u32x2*)(L + L_RT + r32 * RS + (32 + 8 * g + 4 * hi) * 2);
                    u32x2 w0, w1;
                    w0.x = cvtpk(q0[4 * g] + bfl(ra.x), q0[4 * g + 1] + bfh(ra.x)); w0.y = cvtpk(q0[4 * g + 2] + bfl(ra.y), q0[4 * g + 3] + bfh(ra.y));
                    w1.x = cvtpk(q1[4 * g] + bfl(rb.x), q1[4 * g + 1] + bfh(rb.x)); w1.y = cvtpk(q1[4 * g + 2] + bfl(rb.y), q1[4 * g + 3] + bfh(rb.y));
                    *(u32x2*)(gQT + r32 * 64 + 8 * g + 4 * hi) = w0; *(u32x2*)(gQT + r32 * 64 + 32 + 8 * g + 4 * hi) = w1; }
            }
            __builtin_amdgcn_sched_barrier(0);
#define CS_G(N_) do { const float gc_ = *(const LAS float*)(L + L_GC + ((N_) * 32 + r32) * 4); \
                f32x16 ga_, gb_; _Pragma("unroll") for (int q = 0; q < 16; ++q) { ga_[q] = 0.f; gb_[q] = 0.f; } \
                _Pragma("unroll") for (int s_ = 0; s_ < 2; ++s_) { const int ko = (16 * s_ + 4 * hi) * 2; const bf16x8 bb_ = rd_tr(L + L_BTV + trf + (N_) * 2048 + s_ * 1024); \
                    ga_ = CS_MF(rd_perm(L + L_P + r32 * RS2 + ko), bb_, ga_); gb_ = CS_MF(rd_perm(L + L_P + (32 + r32) * RS2 + ko), bb_, gb_); } \
                { const float base_ = (float)(r32 - 4 * hi); \
                _Pragma("unroll") for (int q = 0; q < 16; ++q) { const float dl_ = __builtin_amdgcn_fmed3f(1.f - __builtin_fabsf(base_ - (float)((q & 3) + 8 * (q >> 2))), 0.f, 1.f); \
                    ga_[q] = (ga_[q] + ((N_) == 0 ? dl_ : 0.f)) * gc_; gb_[q] = (gb_[q] + ((N_) == 1 ? dl_ : 0.f)) * gc_; } } \
                _Pragma("unroll") for (int g = 0; g < 4; ++g) { u32x2 w; \
                    w.x = cvtpk(ga_[4 * g], ga_[4 * g + 1]); w.y = cvtpk(ga_[4 * g + 2], ga_[4 * g + 3]); *(u32x2*)(gGT + ((N_) * 32 + r32) * 64 + 8 * g + 4 * hi) = w; \
                    w.x = cvtpk(gb_[4 * g], gb_[4 * g + 1]); w.y = cvtpk(gb_[4 * g + 2], gb_[4 * g + 3]); *(u32x2*)(gGT + ((N_) * 32 + r32) * 64 + 32 + 8 * g + 4 * hi) = w; } \
                __builtin_amdgcn_sched_barrier(0); } while (0)
            CS_G(0); CS_G(1);
#undef CS_G
        } else {
            bf16_t* gHT = (bf16_t*)(C.ws + WS_CHT) + (size_t)task * (64 * 64);
            bf16_t* gYL = (bf16_t*)(C.ws + WS_CYL) + (size_t)task * (64 * CH);
            f32x16 z = mkr, x0, x1;
#pragma unroll
            for (int s_ = 0; s_ < 2; ++s_) { const int ko = (16 * s_ + 8 * hi) * 2;
                z = CS_MF(rd_nat(L + L_MAKT + r32 * RS2 + ko), rd_nat(L + L_MBRT + r32 * RS2 + ko), z); }
#define CS_X(N_, XN_) do { const float gc_ = *(const LAS float*)(L + L_GC + ((N_) * 32 + r32) * 4); \
                _Pragma("unroll") for (int q = 0; q < 16; ++q) XN_[q] = 0.f; \
                _Pragma("unroll") for (int s_ = 0; s_ < 2; ++s_) { const int ko = (16 * s_ + 4 * hi) * 2; \
                    XN_ = CS_MF(rd_perm(L + L_MAKT + r32 * RS2 + ko), rd_tr(L + L_BTV + trf + (N_) * 2048 + s_ * 1024), XN_); } \
                { const LAS unsigned char* kb_ = L + L_KT + 4 * hi * RS + ((N_) * 32 + r32) * 2; \
                _Pragma("unroll") for (int q = 0; q < 16; ++q) XN_[q] = (XN_[q] + bf2f(*(const LAS bf16_t*)(kb_ + ((q & 3) + 8 * (q >> 2)) * RS))) * gc_; } } while (0)
            CS_X(0, x0); CS_X(1, x1);
#undef CS_X
            const bf16x8 ax00 = pack8(x0, 0), ax01 = pack8(x0, 1), ax10 = pack8(x1, 0), ax11 = pack8(x1, 1), az0 = pack8(z, 0), az1 = pack8(z, 1);
#define CS_HY(N_) do { \
                f32x16 ha_, hb_, yy_; _Pragma("unroll") for (int q = 0; q < 16; ++q) { ha_[q] = 0.f; hb_[q] = 0.f; yy_[q] = 0.f; } \
                const bf16x8 va_ = rd_tr(L + L_VV + trf + (N_) * 2048), vb_ = rd_tr(L + L_VV + trf + (N_) * 2048 + 1024); \
                ha_ = CS_MF(ax00, va_, ha_); ha_ = CS_MF(ax01, vb_, ha_); hb_ = CS_MF(ax10, va_, hb_); hb_ = CS_MF(ax11, vb_, hb_); yy_ = CS_MF(az0, va_, yy_); yy_ = CS_MF(az1, vb_, yy_); \
                _Pragma("unroll") for (int g = 0; g < 4; ++g) { u32x2 w; \
                    w.x = cvtpk(ha_[4 * g], ha_[4 * g + 1]); w.y = cvtpk(ha_[4 * g + 2], ha_[4 * g + 3]); *(u32x2*)(gHT + ((N_) * 32 + r32) * 64 + 8 * g + 4 * hi) = w; \
                    w.x = cvtpk(hb_[4 * g], hb_[4 * g + 1]); w.y = cvtpk(hb_[4 * g + 2], hb_[4 * g + 3]); *(u32x2*)(gHT + ((N_) * 32 + r32) * 64 + 32 + 8 * g + 4 * hi) = w; \
                    w.x = cvtpk(yy_[4 * g], yy_[4 * g + 1]); w.y = cvtpk(yy_[4 * g + 2], yy_[4 * g + 3]); *(u32x2*)(gYL + ((N_) * 32 + r32) * CH + 8 * g + 4 * hi) = w; } \
                __builtin_amdgcn_sched_barrier(0); } while (0)
            CS_HY(0); CS_HY(1);
#undef CS_HY
        }
    }
    pair_bar(pcnt, pord, lane);
}
__device__ __forceinline__ void phaseA(const Ctx& C, LAS unsigned char* lds, int G, int bx, int lane, int wave) {
    LAS unsigned char* L = lds + (wave >> 1) * L_WAVE; const int role = wave & 1;
    LAS unsigned* pcnt = (LAS unsigned*)(lds + 4 * L_WAVE) + (wave >> 1) * 32;
    if (role == 0 && lane == 0) *pcnt = 0u;
    __syncthreads();
    unsigned pord = 0u;
    constexpr int NTASK = NB * NH * NCH;
    const int rounds = (NTASK + 4 * G - 1) / (4 * G);
    RawRegs R;
    int task = bx * 4 + (wave >> 1);
    if (task < NTASK) rawLoad(C, R, task, lane, role);
#pragma unroll 1
    for (int k = 0; k < rounds; ++k) { const int nt = task + 4 * G; taskA(C, L, task, lane, role, task < NTASK, R, nt, (k + 1 < rounds) && nt < NTASK, pcnt, pord); task = nt; }
    __syncthreads();
}
constexpr int K_QT = 0, K_GT = 4608, K_YL = 13824, K_HT = 16384, K_BUF = 20992;
constexpr int K_FR = 2 * K_BUF;
__device__ __forceinline__ void chain_unit(const Ctx& C, LAS unsigned char* lds, int unit, int tid, int lane, int wave) {
    const int bh = unit >> 1, half = unit & 1, b = bh / NH, h = bh - b * NH;
    const int r32 = lane & 31, hi = lane >> 5;
    const unsigned char* gQT = (const unsigned char*)((const bf16_t*)(C.ws + WS_CQT) + (size_t)bh * NCH * (CH * 64));
    const unsigned char* gGT = (const unsigned char*)((const bf16_t*)(C.ws + WS_CGT) + (size_t)bh * NCH * (64 * 64));
    const unsigned char* gHT = (const unsigned char*)((const bf16_t*)(C.ws + WS_CHT) + (size_t)bh * NCH * (64 * 64) + half * 32 * 64);
    const unsigned char* gYL = (const unsigned char*)((const bf16_t*)(C.ws + WS_CYL) + (size_t)bh * NCH * (64 * CH) + half * 32 * CH);
    bf16_t* yout = (bf16_t*)(C.ws + WS_Y2) + (size_t)b * SEQ * RW + h * 64 + half * 32 + r32;
    const int lt = tid - 192;
    const unsigned char* src[4]; int dst[4]; size_t cstep[4];
#pragma unroll
    for (int q_ = 0; q_ < 4; ++q_) { const int p0_ = (lt < 0 ? 0 : lt) + 320 * q_; const int p_ = p0_ < 1152 ? p0_ : 1151;
        if (p_ < 256) { src[q_] = gQT + p_ * 16; dst[q_] = K_QT + (p_ >> 3) * 144 + (p_ & 7) * 16; cstep[q_] = 4096; }
        else if (p_ < 768) { const int r_ = p_ - 256; src[q_] = gGT + r_ * 16; dst[q_] = K_GT + (r_ >> 3) * 144 + (r_ & 7) * 16; cstep[q_] = 8192; }
        else if (p_ < 896) { const int r_ = p_ - 768; src[q_] = gYL + r_ * 16; dst[q_] = K_YL + (r_ >> 2) * 80 + (r_ & 3) * 16; cstep[q_] = 4096; }
        else { const int r_ = p_ - 896; src[q_] = gHT + r_ * 16; dst[q_] = K_HT + (r_ >> 3) * 144 + (r_ & 7) * 16; cstep[q_] = 8192; } }
    const bool ldr = lt >= 0;
    u32x4 sA[4], sB[4], sC[4];
#define CH_LD1(dst_, p_) asm volatile("global_load_dwordx4 %0, %1, off" : "=v"(dst_) : "v"(p_) : "memory")
#define CH_LD(S_, cc) do { if (ldr) { const size_t cc_ = (cc) < NCH ? (cc) : NCH - 1; CH_LD1(S_[0], src[0] + cc_ * cstep[0]); CH_LD1(S_[1], src[1] + cc_ * cstep[1]); \
        CH_LD1(S_[2], src[2] + cc_ * cstep[2]); CH_LD1(S_[3], src[3] + cc_ * cstep[3]); } } while (0)
#define CH_WR(S_, cc) do { if (ldr) { asm volatile("s_waitcnt vmcnt(8)" : "+v"(S_[0]), "+v"(S_[1]), "+v"(S_[2]), "+v"(S_[3]) :: "memory"); __builtin_amdgcn_sched_barrier(0); \
        const int bo_ = ((cc) & 1) * K_BUF; *(LAS u32x4*)(lds + bo_ + dst[0]) = S_[0]; *(LAS u32x4*)(lds + bo_ + dst[1]) = S_[1]; *(LAS u32x4*)(lds + bo_ + dst[2]) = S_[2]; \
        *(LAS u32x4*)(lds + bo_ + dst[3]) = S_[3]; } } while (0)
    if (tid < 256) *(LAS u32x4*)(lds + K_FR + tid * 16) = (u32x4){0u, 0u, 0u, 0u};
#define CH_STEP(c, SW_) do { \
        CH_WR(SW_, (c) + 1); CH_LD(SW_, (c) + 4); \
        if (wave < 3 && (c) < NCH) { \
            const LAS unsigned char* B_ = lds + ((c) & 1) * K_BUF; const LAS unsigned char* F_ = lds + K_FR + ((c) & 1) * 4096 + lane * 16; \
            const bf16x8 sb0 = *(const LAS bf16x8*)(F_), sb1 = *(const LAS bf16x8*)(F_ + 1024), sb2 = *(const LAS bf16x8*)(F_ + 2048), sb3 = *(const LAS bf16x8*)(F_ + 3072); \
            f32x16 acc_; \
            if (wave < 2) {         \
                _Pragma("unroll") for (int g = 0; g < 4; ++g) { const u32x2 i0 = *(const LAS u32x2*)(B_ + K_HT + r32 * 144 + (wave * 32 + 8 * g + 4 * hi) * 2); \
                    acc_[4 * g] = bfl(i0.x); acc_[4 * g + 1] = bfh(i0.x); acc_[4 * g + 2] = bfl(i0.y); acc_[4 * g + 3] = bfh(i0.y); } \
                const LAS unsigned char* ag_ = B_ + K_GT + (wave * 32 + r32) * 144 + 8 * hi; \
                acc_ = __builtin_amdgcn_mfma_f32_32x32x16_bf16(rd_perm(ag_), sb0, acc_, 0, 0, 0); acc_ = __builtin_amdgcn_mfma_f32_32x32x16_bf16(rd_perm(ag_ + 32), sb1, acc_, 0, 0, 0); \
                acc_ = __builtin_amdgcn_mfma_f32_32x32x16_bf16(rd_perm(ag_ + 64), sb2, acc_, 0, 0, 0); acc_ = __builtin_amdgcn_mfma_f32_32x32x16_bf16(rd_perm(ag_ + 96), sb3, acc_, 0, 0, 0); \
                LAS unsigned char* FN_ = lds + K_FR + (((c) + 1) & 1) * 4096 + wave * 2048 + lane * 16; \
                *(LAS bf16x8*)(FN_) = pack8(acc_, 0); *(LAS bf16x8*)(FN_ + 1024) = pack8(acc_, 1); \
            } else {                \
                _Pragma("unroll") for (int g = 0; g < 4; ++g) { const u32x2 iy = *(const LAS u32x2*)(B_ + K_YL + r32 * 80 + (8 * g + 4 * hi) * 2); \
                    acc_[4 * g] = bfl(iy.x); acc_[4 * g + 1] = bfh(iy.x); acc_[4 * g + 2] = bfl(iy.y); acc_[4 * g + 3] = bfh(iy.y); } \
                const LAS unsigned char* aq_ = B_ + K_QT + r32 * 144 + 8 * hi; \
                acc_ = __builtin_amdgcn_mfma_f32_32x32x16_bf16(rd_perm(aq_), sb0, acc_, 0, 0, 0); acc_ = __builtin_amdgcn_mfma_f32_32x32x16_bf16(rd_perm(aq_ + 32), sb1, acc_, 0, 0, 0); \
                acc_ = __builtin_amdgcn_mfma_f32_32x32x16_bf16(rd_perm(aq_ + 64), sb2, acc_, 0, 0, 0); acc_ = __builtin_amdgcn_mfma_f32_32x32x16_bf16(rd_perm(aq_ + 96), sb3, acc_, 0, 0, 0); \
                bf16_t* yp = yout + (size_t)(c) * CH * RW; \
                _Pragma("unroll") for (int q = 0; q < 16; ++q) yp[(size_t)crow(q, hi) * RW] = (bf16_t)cvtpk(acc_[q], acc_[q]); \
            } \
        } \
        CS_BAR(); } while (0)
    CH_LD(sA, 0); CH_LD(sB, 1); CH_LD(sC, 2);
    CH_WR(sA, 0); CH_LD(sA, 3);
    CS_BAR();
#pragma unroll 1
    for (int c3 = 0; c3 < NCH + 2; c3 += 3) { CH_STEP(c3, sB); CH_STEP(c3 + 1, sC); CH_STEP(c3 + 2, sA); }
#undef CH_STEP
#undef CH_LD
#undef CH_LD1
#undef CH_WR
}
__device__ __forceinline__ void chain_phase(const Ctx& C, LAS unsigned char* lds, int G, int bx, int tid, int lane, int wave) {
    const int v0 = (G % 8 == 0) ? (bx % 8) * (G / 8) + bx / 8 : bx;
    for (int v = v0; v < 256; v += G) chain_unit(C, lds, v, tid, lane, wave);
}
#undef CS_BAR
#undef CS_MF
}

struct Frame { LAS unsigned char* lds; int tid, lane, wave, G, bx; };

__device__ __forceinline__ void p0_prologue(const Ctx& C, const Frame& F) {
    {
        LAS float* sc = (LAS float*)F.lds;
        LAS float* red = (LAS float*)(F.lds + 65536);
        for (int i = F.tid; i < NB * DM; i += NTHR) { const float cv = C.c[i]; sc[i] = cv / (1.f + __expf(-cv)); }
        __syncthreads();
        float* mod = (float*)(C.ws + WS_MOD);
        for (int cb = F.bx; cb < 6 * DM / 24; cb += F.G) {
            const int n0 = cb * 24;
            if (F.tid < 384) {
                const int kg = F.tid / 24, j = F.tid % 24;
                float acc[NB];
#pragma unroll
                for (int b = 0; b < NB; ++b) acc[b] = 0.f;
                for (int k = kg; k < DM; k += 16) { const float w = C.w_ada[(size_t)k * 6 * DM + n0 + j];
#pragma unroll
                    for (int b = 0; b < NB; ++b) acc[b] += sc[b * DM + k] * w; }
#pragma unroll
                for (int b = 0; b < NB; ++b) red[(kg * NB + b) * 24 + j] = acc[b];
            }
            __syncthreads();
            if (F.tid < 384) { const int b = F.tid / 24, j = F.tid % 24; float s = C.b_ada[n0 + j];
#pragma unroll
                for (int kg = 0; kg < 16; ++kg) s += red[(kg * NB + b) * 24 + j];
                mod[b * 6 * DM + n0 + j] = s; }
            __syncthreads();
        }
    }
    for (int o = F.bx * NTHR + F.tid; o < T * 16; o += F.G * NTHR) {
        const int t = o >> 4, i = o & 15;
        const float inv = powf(10000.0f, -(float)(2 * i) / 32.0f);
        float s, c; sincosf((float)C.pos[t] * inv, &s, &c);
        ((float2*)(C.ws + WS_ROPE))[o] = make_float2(c, s);
    }
    for (int o = F.bx * NTHR + F.tid; o < 48 * DM; o += F.G * NTHR) {
        const int j = o & 7, ln = (o >> 3) & 63, pc = o >> 9, nb = pc % 3, ks = pc / 3;
        const int n = 16 * nb + (ln & 15), k = 32 * ks + 8 * (ln >> 4) + j;
        const float w = n < NG ? C.w_rg[k * NG + n] : (n < NG + NE ? C.w_re[k * NE + (n - NG)] : 0.f);
        const bf16_t hi = f2bf(w);
        ((bf16_t*)(C.ws + WS_W + WO_RH))[o] = hi; ((bf16_t*)(C.ws + WS_W + WO_RL))[o] = f2bf(w - bf2f(hi));
    }
    __syncthreads();
    {
        LAS float* scr = (LAS float*)(F.lds + F.wave * 16384);
        const int gw = F.bx * NWAVES + F.wave, NGW = F.G * NWAVES;
        float va[32], vb[32];
        TrItem da, db;
        int it = gw;
        if (it < TR_NITEMS) { da = tr_desc(C, it); tr_load(da, va, F.lane); }
        for (; it < TR_NITEMS; it += 2 * NGW) {
            const bool hb = it + NGW < TR_NITEMS;
            if (hb) { db = tr_desc(C, it + NGW); tr_load(db, vb, F.lane); }
            tr_store(da, va, scr, F.lane);
            if (hb) {
                if (it + 2 * NGW < TR_NITEMS) { da = tr_desc(C, it + 2 * NGW); tr_load(da, va, F.lane); }
                tr_store(db, vb, scr, F.lane);
            }
        }
    }
}

__device__ __forceinline__ void p1_modulate(const Ctx& C, const Frame& F) {
    const float* mod = (const float*)(C.ws + WS_MOD);
    bf16_t* h1 = (bf16_t*)(C.ws + WS_H);
    const int lane = F.lane;
    for (int row0 = (F.bx * NWAVES + F.wave) * 4; row0 < T; row0 += F.G * NWAVES * 4) {
        const int b = row0 / SEQ;
        float4 v[4][4]; float ss[4];
#pragma unroll
        for (int r = 0; r < 4; ++r) { const float4* xr = (const float4*)(C.x + (size_t)(row0 + r) * DM);
#pragma unroll
            for (int j = 0; j < 4; ++j) v[r][j] = xr[lane + 64 * j]; }
#pragma unroll
        for (int r = 0; r < 4; ++r) { float a = 0.f;
#pragma unroll
            for (int j = 0; j < 4; ++j) a += v[r][j].x * v[r][j].x + v[r][j].y * v[r][j].y + v[r][j].z * v[r][j].z + v[r][j].w * v[r][j].w;
            ss[r] = a; }
#pragma unroll
        for (int r = 0; r < 4; ++r) ss[r] = rsqrtf(wsum_dpp(ss[r]) * (1.f / DM) + RMS_EPS);
#pragma unroll
        for (int j = 0; j < 4; ++j) {
            const int col = 4 * (lane + 64 * j);
            const float4 g = *(const float4*)(C.g_pre_mix + col);
            const float4 sh = *(const float4*)(mod + b * 6 * DM + col), sc = *(const float4*)(mod + b * 6 * DM + DM + col);
            const float m0 = g.x * (1.f + sc.x), m1 = g.y * (1.f + sc.y), m2 = g.z * (1.f + sc.z), m3 = g.w * (1.f + sc.w);
#pragma unroll
            for (int r = 0; r < 4; ++r) { const float rs = ss[r];
                u32x2 w; w.x = cvtpk(v[r][j].x * rs * m0 + sh.x, v[r][j].y * rs * m1 + sh.y); w.y = cvtpk(v[r][j].z * rs * m2 + sh.z, v[r][j].w * rs * m3 + sh.w);
                *(u32x2*)(h1 + (size_t)(row0 + r) * DM + col) = w; }
        }
    }
}

__device__ __forceinline__ void d_post_mix(const Ctx& C, int G, int bx, int tid, int lane, int wave, LAS unsigned char* lds, bool dry) {
    const float* mod = (const float*)(C.ws + WS_MOD); const bf16_t* ym = (const bf16_t*)(C.ws + WS_YMIX);
    bf16_t* h2 = (bf16_t*)(C.ws + WS_H); bf16_t* x1b = (bf16_t*)(C.ws + WS_X1B);
    const bf16_t* wrh = (const bf16_t*)(C.ws + WS_W + WO_RH); const bf16_t* wrl = (const bf16_t*)(C.ws + WS_W + WO_RL);
    float* tokw = (float*)(C.ws + WS_ROUTE);
    unsigned* gcnt = (unsigned*)(C.ws + WS_CTL) + CW_GCNT;
    int* list = (int*)(C.ws + WS_LIST);
    LAS int* le = (LAS int*)lds; LAS float* lg = (LAS float*)(lds + 1024) + wave * 16 * 48;
    LAS unsigned char* lw = lds + 25600;
    for (int q = 0; q < 16; ++q) { const int idx = wave * 16 + q, hl = idx & 1, nb = (idx >> 1) & 1, ks = idx >> 2;
        __builtin_amdgcn_global_load_lds((const unsigned*)((hl ? wrl : wrh) + (ks * 3 + nb) * 512 + lane * 8), (LAS unsigned*)(lw + idx * 1024), 16, 0, 0); }
    for (int grp = bx; grp < T / 128; grp += G) {
      const int r0 = grp * 128 + wave * 16;
      for (int rr = 0; rr < 16; rr += 4) {
        const int row = r0 + rr;
        const int b = row / SEQ; const float* mb = mod + b * 6 * DM;
        float4 yq[4][4], xq[4][4]; float rs[4], rs2[4];
#pragma unroll
        for (int u = 0; u < 4; ++u)
#pragma unroll
            for (int j = 0; j < 4; ++j) { const u32x2 yw = *(const u32x2*)(ym + (size_t)(row + u) * DM + 4 * (lane + 64 * j));
                yq[u][j] = make_float4(__uint_as_float(yw.x << 16), __uint_as_float(yw.x & 0xffff0000u), __uint_as_float(yw.y << 16), __uint_as_float(yw.y & 0xffff0000u)); xq[u][j] = *(const float4*)(C.x + (size_t)(row + u) * DM + 4 * (lane + 64 * j)); }
#pragma unroll
        for (int u = 0; u < 4; ++u) { float a = 0.f;
#pragma unroll
            for (int j = 0; j < 4; ++j) a += yq[u][j].x * yq[u][j].x + yq[u][j].y * yq[u][j].y + yq[u][j].z * yq[u][j].z + yq[u][j].w * yq[u][j].w;
            rs[u] = a; }
#pragma unroll
        for (int u = 0; u < 4; ++u) rs[u] = rsqrtf(wsum_dpp(rs[u]) * (1.f / DM) + RMS_EPS);
#pragma unroll
        for (int u = 0; u < 4; ++u) rs2[u] = 0.f;
#pragma unroll
        for (int j = 0; j < 4; ++j) { const int col = 4 * (lane + 64 * j);
            const float4 g1 = *(const float4*)(mb + 2 * DM + col), gp = *(const float4*)(C.g_post_mix + col);
            const float m0 = g1.x * gp.x, m1 = g1.y * gp.y, m2 = g1.z * gp.z, m3 = g1.w * gp.w;
#pragma unroll
            for (int u = 0; u < 4; ++u) { float4 x1 = xq[u][j];
                x1.x += m0 * (yq[u][j].x * rs[u]); x1.y += m1 * (yq[u][j].y * rs[u]); x1.z += m2 * (yq[u][j].z * rs[u]); x1.w += m3 * (yq[u][j].w * rs[u]);
                xq[u][j] = x1; rs2[u] += x1.x * x1.x + x1.y * x1.y + x1.z * x1.z + x1.w * x1.w;
                u32x2 xw; xw.x = cvtpk(x1.x, x1.y); xw.y = cvtpk(x1.z, x1.w); *(u32x2*)(x1b + (size_t)(row + u) * DM + col) = xw; } }
#pragma unroll
        for (int u = 0; u < 4; ++u) rs2[u] = rsqrtf(wsum_dpp(rs2[u]) * (1.f / DM) + RMS_EPS);
#pragma unroll
        for (int j = 0; j < 4; ++j) { const int col = 4 * (lane + 64 * j);
            const float4 gf = *(const float4*)(C.g_pre_ffn + col), sc = *(const float4*)(mb + 4 * DM + col), sh = *(const float4*)(mb + 3 * DM + col);
            const float m0 = gf.x * (1.f + sc.x), m1 = gf.y * (1.f + sc.y), m2 = gf.z * (1.f + sc.z), m3 = gf.w * (1.f + sc.w);
#pragma unroll
            for (int u = 0; u < 4; ++u) {
                const float h0 = xq[u][j].x * rs2[u] * m0 + sh.x, h1 = xq[u][j].y * rs2[u] * m1 + sh.y, h2_ = xq[u][j].z * rs2[u] * m2 + sh.z, h3 = xq[u][j].w * rs2[u] * m3 + sh.w;
                u32x2 wh; wh.x = cvtpk(h0, h1); wh.y = cvtpk(h2_, h3);
                *(u32x2*)(h2 + (size_t)(row + u) * DM + col) = wh; } }
      }
      asm volatile("s_waitcnt vmcnt(0)" ::: "memory");
      __syncthreads();
      {
        f32x4 acc0 = {0.f, 0.f, 0.f, 0.f}, acc1 = acc0, acc2 = acc0;
        const int fr = lane & 15, fq = lane >> 4;
        const bf16_t* ah = h2 + (size_t)(r0 + fr) * DM + 8 * fq;
        const bf16_t* bh = wrh + lane * 8; const bf16_t* bl = wrl + lane * 8;
#pragma unroll 8
        for (int ks = 0; ks < 32; ++ks) {
            const bf16x8 a_h = *(const bf16x8*)(ah + 32 * ks);
            const LAS unsigned char* lp = lw + ks * 4096 + lane * 16;
            const bf16x8 b0h = *(const LAS bf16x8*)(lp), b0l = *(const LAS bf16x8*)(lp + 1024), b1h = *(const LAS bf16x8*)(lp + 2048), b1l = *(const LAS bf16x8*)(lp + 3072);
            const bf16x8 b2h = *(const bf16x8*)(bh + ks * 1536 + 1024), b2l = *(const bf16x8*)(bl + ks * 1536 + 1024);
            acc0 = __builtin_amdgcn_mfma_f32_16x16x32_bf16(a_h, b0h, acc0, 0, 0, 0); acc0 = __builtin_amdgcn_mfma_f32_16x16x32_bf16(a_h, b0l, acc0, 0, 0, 0);
            acc1 = __builtin_amdgcn_mfma_f32_16x16x32_bf16(a_h, b1h, acc1, 0, 0, 0); acc1 = __builtin_amdgcn_mfma_f32_16x16x32_bf16(a_h, b1l, acc1, 0, 0, 0);
            acc2 = __builtin_amdgcn_mfma_f32_16x16x32_bf16(a_h, b2h, acc2, 0, 0, 0); acc2 = __builtin_amdgcn_mfma_f32_16x16x32_bf16(a_h, b2l, acc2, 0, 0, 0);
        }
#pragma unroll
        for (int e = 0; e < 4; ++e) { lg[(4 * fq + e) * 48 + fr] = acc0[e]; lg[(4 * fq + e) * 48 + 16 + fr] = acc1[e]; lg[(4 * fq + e) * 48 + 32 + fr] = acc2[e]; }
      }
      asm volatile("s_waitcnt lgkmcnt(0)" ::: "memory");
      if (lane < 16) {
            float gl[NG], el[NE];
#pragma unroll
            for (int c = 0; c < NG; ++c) gl[c] = lg[lane * 48 + c] + C.b_rg[c];
#pragma unroll
            for (int c = 0; c < NE; ++c) el[c] = lg[lane * 48 + NG + c] + C.b_re[c];
            int gs = 0; float gm = gl[0];
#pragma unroll
            for (int c = 1; c < NG; ++c) if (gl[c] > gm) { gm = gl[c]; gs = c; }
            float den = 0.f;
#pragma unroll
            for (int c = 0; c < NG; ++c) den += __expf(gl[c] - gm);
            const float psel = 1.f / den;
            float eg[EPG];
#pragma unroll
            for (int c = 0; c < EPG; ++c) eg[c] = gs == 0 ? el[c] : (gs == 1 ? el[EPG + c] : (gs == 2 ? el[2 * EPG + c] : el[3 * EPG + c]));
            int i0 = 0; float v0 = eg[0];
#pragma unroll
            for (int c = 1; c < EPG; ++c) if (eg[c] > v0) { v0 = eg[c]; i0 = c; }
            int i1 = -1; float v1 = -INFINITY;
#pragma unroll
            for (int c = 0; c < EPG; ++c) if (c != i0 && eg[c] > v1) { v1 = eg[c]; i1 = c; }
            const float e1 = __expf(v1 - v0), w0 = 1.f / (1.f + e1), w1 = e1 / (1.f + e1);
            le[(wave * 16 + lane) * 2] = gs * EPG + i0; le[(wave * 16 + lane) * 2 + 1] = gs * EPG + i1;
            *(float2*)(tokw + (size_t)(r0 + lane) * 2) = make_float2(psel * w0, psel * w1);
      }
      __syncthreads();
      if (tid < NE && !dry) {
          int cnt = 0;
          for (int k = 0; k < 256; ++k) cnt += (le[k] == tid) ? 1 : 0;
          if (cnt) { const unsigned base = __hip_atomic_fetch_add(gcnt + tid, (unsigned)cnt, __ATOMIC_RELAXED, __HIP_MEMORY_SCOPE_AGENT);
              int j = 0;
              for (int k = 0; k < 256; ++k) if (le[k] == tid) { list[(size_t)tid * T + base + j] = grp * 256 + k; ++j; } }
      }
      __syncthreads();
    }
}
template <int NPN, bool BAL = false>
__device__ __forceinline__ pg8::MoeTab moe_setup(const Ctx& C, int G, int bx, int tid, __attribute__((address_space(3))) int* ctl) {
    const unsigned* gcnt = (const unsigned*)(C.ws + WS_CTL) + CW_GCNT;
    const int* list = (const int*)(C.ws + WS_LIST);
    __syncthreads();
    if (tid == 0) { int acc = 0; for (int e = 0; e < NE; ++e) { const int c = (int)__hip_atomic_load(gcnt + e, __ATOMIC_RELAXED, __HIP_MEMORY_SCOPE_AGENT); ctl[64 + e] = c; ctl[e] = acc; acc += (c + 255) >> 8; } ctl[NE] = acc; }
    __syncthreads();
    if (tid < pg8::MOE_MAXU) {
        const int total = ctl[NE] * NPN; long L = (long)tid * G + bx;
        if constexpr (BAL) { const int s_ = (ctl[NE] * 2) % G;
            constexpr int SK = MOE_SKIP;
            if (s_ > 0) { if (bx >= s_) L = tid < SK ? (long)tid * (G - s_) + (bx - s_) : (long)SK * (G - s_) + (long)(tid - SK) * G + (bx - s_);
                          else L = (long)SK * (G - s_) + (long)tid * G + (G - s_ + bx); } }
        int* d = nullptr; (void)d;
        if (L < total) { const int pn = (int)(L % NPN), rt = (int)(L / NPN); int e = 0;
            for (int q = 1; q < NE; ++q) if (ctl[q] <= rt) e = q;
            const int m = rt - ctl[e]; int nv = ctl[64 + e] - m * 256; nv = nv > 256 ? 256 : nv;
            ctl[128 + tid * 8 + 0] = e; ctl[128 + tid * 8 + 1] = m; ctl[128 + tid * 8 + 2] = pn; ctl[128 + tid * 8 + 3] = nv; ctl[128 + tid * 8 + 4] = rt * 256; ctl[128 + tid * 8 + 5] = 1; }
        else ctl[128 + tid * 8 + 5] = 0;
    }
    __syncthreads();
    for (int i = 0; i < pg8::MOE_MAXU; ++i) {
        if (ctl[128 + i * 8 + 5] && tid < 256) { const int e = ctl[128 + i * 8 + 0], m = ctl[128 + i * 8 + 1], nv = ctl[128 + i * 8 + 3];
            const int r = tid < nv ? tid : nv - 1;
            ctl[256 + i * 256 + tid] = list[(size_t)e * T + m * 256 + r]; }
    }
    __syncthreads();
    pg8::MoeTab tb; tb.desc = ctl + 128; tb.rowtab = ctl + 256; return tb;
}
__device__ __forceinline__ void d_final(const Ctx& C, int gw, int ngw, int lane) {
    const float* mod = (const float*)(C.ws + WS_MOD); const bf16_t* ys = (const bf16_t*)(C.ws + WS_YSLOT); const bf16_t* x1b = (const bf16_t*)(C.ws + WS_X1B);
    for (int row0 = gw * 4; row0 < T; row0 += ngw * 4) {
        const int b = row0 / SEQ; const float* mb = mod + b * 6 * DM;
        u32x2 ya[4][4], yb[4][4]; float4 x1[4][4]; float rs[4];
#pragma unroll
        for (int r = 0; r < 4; ++r)
#pragma unroll
            for (int j = 0; j < 4; ++j) { const int col = 4 * (lane + 64 * j);
                ya[r][j] = *(const u32x2*)(ys + (size_t)(row0 + r) * 2 * DM + col); yb[r][j] = *(const u32x2*)(ys + (size_t)(row0 + r) * 2 * DM + DM + col);
                { const u32x2 xw = *(const u32x2*)(x1b + (size_t)(row0 + r) * DM + col); x1[r][j] = make_float4(__uint_as_float(xw.x << 16), __uint_as_float(xw.x & 0xffff0000u), __uint_as_float(xw.y << 16), __uint_as_float(xw.y & 0xffff0000u)); } }
        float yv[4][16];
#pragma unroll
        for (int r = 0; r < 4; ++r) { float a = 0.f;
#pragma unroll
            for (int j = 0; j < 4; ++j) {
                yv[r][4 * j] = __uint_as_float(ya[r][j].x << 16) + __uint_as_float(yb[r][j].x << 16); yv[r][4 * j + 1] = __uint_as_float(ya[r][j].x & 0xffff0000u) + __uint_as_float(yb[r][j].x & 0xffff0000u);
                yv[r][4 * j + 2] = __uint_as_float(ya[r][j].y << 16) + __uint_as_float(yb[r][j].y << 16); yv[r][4 * j + 3] = __uint_as_float(ya[r][j].y & 0xffff0000u) + __uint_as_float(yb[r][j].y & 0xffff0000u);
                a += yv[r][4 * j] * yv[r][4 * j] + yv[r][4 * j + 1] * yv[r][4 * j + 1] + yv[r][4 * j + 2] * yv[r][4 * j + 2] + yv[r][4 * j + 3] * yv[r][4 * j + 3]; }
            rs[r] = a; }
#pragma unroll
        for (int r = 0; r < 4; ++r) rs[r] = rsqrtf(wsum_dpp(rs[r]) * (1.f / DM) + RMS_EPS);
#pragma unroll
        for (int j = 0; j < 4; ++j) { const int col = 4 * (lane + 64 * j);
            const float4 g = *(const float4*)(C.g_post_ffn + col), g2 = *(const float4*)(mb + 5 * DM + col);
            const float m0 = g.x * g2.x, m1 = g.y * g2.y, m2 = g.z * g2.z, m3 = g.w * g2.w;
#pragma unroll
            for (int r = 0; r < 4; ++r) { float4 o = x1[r][j];
                o.x += m0 * (yv[r][4 * j] * rs[r]); o.y += m1 * (yv[r][4 * j + 1] * rs[r]); o.z += m2 * (yv[r][4 * j + 2] * rs[r]); o.w += m3 * (yv[r][4 * j + 3] * rs[r]);
                *(float4*)(C.out + (size_t)(row0 + r) * DM + col) = o; } }
    }
}

#define XB_TMO      128
#define XB_XCNT(j)  (256  + 64 * (j))
#define XB_XSUB(j)  (1280 + 64 * (j))
#define XB_XGEN(j)  (2304 + 64 * (j))
#define XB_TOP      3328
#define XB_TOPGEN   3392
#define XCD_BAR_WORDS 3456
#define XB_SPIN_CAP (1u << 18)
__device__ __forceinline__ unsigned xb_ld(unsigned* p)              { return __hip_atomic_load(p, __ATOMIC_RELAXED, __HIP_MEMORY_SCOPE_AGENT); }
__device__ __forceinline__ unsigned xb_add(unsigned* p, unsigned v) { return __hip_atomic_fetch_add(p, v, __ATOMIC_RELAXED, __HIP_MEMORY_SCOPE_AGENT); }
__device__ __forceinline__ unsigned xb_xcc_id() { return (unsigned)__builtin_amdgcn_s_getreg((3 << 11) | 20) & 0xFu; }
#define XB_SPIN(cond, bar) do { unsigned _sp = 0; while (cond) { __builtin_amdgcn_s_sleep(1); \
    if ((++_sp & 255u) == 0u) { if (xb_ld(&(bar)[XB_TMO])) break; if (_sp > XB_SPIN_CAP) { atomicAdd(&(bar)[XB_TMO], 1u); break; } } } } while (0)
struct XcdBarrier { unsigned* bar; unsigned x; volatile LAS unsigned* st; };
__device__ __forceinline__ XcdBarrier xcd_barrier_post(unsigned* bar, volatile LAS unsigned* st) {
    XcdBarrier b; b.bar = bar; b.x = xb_xcc_id(); b.st = st;
    if (threadIdx.x == 0) (void)xb_add(&bar[XB_XCNT(b.x)], 1u);
    return b;
}
__device__ __forceinline__ void xcd_barrier_complete(unsigned* bar, unsigned x, unsigned& nloc, unsigned& nx) {
    const unsigned G = gridDim.x * gridDim.y * gridDim.z;
    unsigned sum, cnt, mine, sp = 0u;
    for (;;) {
        sum = 0u; cnt = 0u; mine = 0u;
#pragma unroll
        for (unsigned j = 0; j < 16; ++j) { const unsigned c = xb_ld(&bar[XB_XCNT(j)]); sum += c; cnt += (c > 0u) ? 1u : 0u; mine = (j == x) ? c : mine; }
        if (sum == G) break;
        __builtin_amdgcn_s_sleep(1);
        if ((++sp & 255u) == 0u) { if (xb_ld(&bar[XB_TMO])) break; if (sp > XB_SPIN_CAP) { atomicAdd(&bar[XB_TMO], 1u); break; } }
    }
    nloc = mine > 0u ? mine : 1u; nx = cnt > 0u ? cnt : 1u;
}
__device__ __forceinline__ void xcd_barrier(const XcdBarrier& b) {
    asm volatile("s_waitcnt vmcnt(0)" ::: "memory");
    __syncthreads();
    if (threadIdx.x == 0) {
        unsigned* bar = b.bar;
        __builtin_amdgcn_s_waitcnt(0);
        unsigned nloc = b.st[0], nx = b.st[1];
        if (nloc == 0u) { xcd_barrier_complete(bar, b.x, nloc, nx); b.st[0] = nloc; b.st[1] = nx; }
        const unsigned old = xb_add(&bar[XB_XSUB(b.x)], 1u);
        const unsigned gen = old / nloc;
        if (old + 1u == (gen + 1u) * nloc) {
            __builtin_amdgcn_fence(__ATOMIC_RELEASE, "agent");
            asm volatile("s_waitcnt vmcnt(0)" ::: "memory");
            const unsigned og = xb_add(&bar[XB_TOP], 1u);
            const unsigned tg = og / nx;
            if (og + 1u == (tg + 1u) * nx) xb_add(&bar[XB_TOPGEN], 1u);
            else XB_SPIN(xb_ld(&bar[XB_TOPGEN]) == tg, bar);
            __builtin_amdgcn_fence(__ATOMIC_ACQUIRE, "agent");
            xb_add(&bar[XB_XGEN(b.x)], 1u);
            asm volatile("s_waitcnt vmcnt(0)" ::: "memory");
        } else {
            XB_SPIN(xb_ld(&bar[XB_XGEN(b.x)]) == gen, bar);
            __builtin_amdgcn_fence(__ATOMIC_ACQUIRE, "agent");
            asm volatile("s_waitcnt vmcnt(0)" ::: "memory");
        }
    }
    __syncthreads();
}

struct Args { Ctx C; int ph_lo, ph_hi, sub, breg; };
__global__ void __launch_bounds__(NTHR, 2) mk(Args args) {
    extern __shared__ __attribute__((aligned(16))) unsigned char lds_raw[];
    const Ctx& C = args.C;
    Frame F; F.lds = (LAS unsigned char*)lds_raw; F.tid = threadIdx.x; F.lane = F.tid & 63; F.wave = __builtin_amdgcn_readfirstlane(F.tid >> 6); F.G = gridDim.x; F.bx = blockIdx.x;
    const int lo = args.ph_lo, hi = args.ph_hi;
    volatile LAS unsigned* xbw = (volatile LAS unsigned*)(F.lds + LDS_BYTES - 16);
    if (F.tid < 4) xbw[F.tid] = 0u;
    __syncthreads();
    unsigned* barw = (unsigned*)(C.ws + WS_CTL) + args.breg * XCD_BAR_WORDS;
    XcdBarrier bar; bar.bar = barw; bar.x = 0; bar.st = xbw;
    if (hi - lo > 1) bar = xcd_barrier_post(barw, xbw);
#define IN(k) (lo <= (k) && (k) < hi)
#define SEAM(k) do { if (IN(k) && IN((k) + 1)) xcd_barrier(bar); } while (0)
    if (IN(0)) { p0_prologue(C, F); }
    SEAM(0);
    if (IN(1)) { p1_modulate(C, F); }
    SEAM(1);
    if (IN(2)) {
        pg8::Dense P{(const bf16_t*)(C.ws + WS_H), (const bf16_t*)(C.ws + WS_W + WO_IN), DM, DM, DM};
        pg8::StaticOrder S; S.init(T, 4608, F.G, F.bx);
        pg8::EpiZ E{(bf16_t*)(C.ws + WS_ZM), (bf16_t*)(C.ws + WS_ZR), (bf16_t*)C.out};
        pg8::gemm_phase(F.lds, P, S, E);
    }
    SEAM(2);
    if (IN(3)) { d_prep(C, F.bx * NWAVES + F.wave, F.G * NWAVES, F.lane); }
    SEAM(3);
    if (IN(4)) {
        const bf16_t* wb = (const bf16_t*)(C.ws + WS_W);
        {   pg8::Dense P{(const bf16_t*)(C.ws + WS_CQN), wb + WO_UQ / 2, QR, QR, QR};
            pg8::StaticOrder S; S.init(T, 768, F.G, F.bx);
            pg8::EpiQ E{(bf16_t*)(C.ws + WS_QF), (const float2*)(C.ws + WS_ROPE)};
            pg8::gemm_phase(F.lds, P, S, E); }
        {   pg8::Dense P{(const bf16_t*)(C.ws + WS_CKVN), wb + WO_UKV / 2, KVR, KVR, KVR};
            pg8::StaticOrder S; S.init(T, 1024, F.G, F.bx);
            pg8::EpiKVp E{(bf16_t*)(C.ws + WS_KF), (bf16_t*)(C.ws + WS_VF)};
            pg8::gemm_phase(F.lds, P, S, E); }
        {   pg8::Dense P{(const bf16_t*)(C.ws + WS_LORA), wb + WO_LORA / 2, 256, 256, 256};
            pg8::StaticOrder S; S.init(T, 1536, F.G, F.bx);
            static_assert(WS_AV == WS_EBUF + (size_t)T * RW * 2 && WS_G == WS_AV + (size_t)T * RW * 2, "ebuf|av|g contiguous");
            pg8::EpiLora E{(bf16_t*)(C.ws + WS_EBUF), C.dec_bias, C.a_bias};
            pg8::gemm_phase(F.lds, P, S, E); }
    }
    SEAM(4);
    if (IN(5)) { att::attn_phase(C, F.lds, F.G, F.bx, F.tid, F.lane, F.wave); }
    SEAM(5);
    if (IN(6)) { cscan::phaseA(C, F.lds, F.G, F.bx, F.lane, F.wave); }
    SEAM(6);
    if (IN(7)) { cscan::chain_phase(C, F.lds, F.G, F.bx, F.tid, F.lane, F.wave); }
    SEAM(7);
    if (IN(8)) { d_rwkv_post(C, F.bx * NWAVES + F.wave, F.G * NWAVES, F.lane); }
    SEAM(8);
    if (IN(9)) {
        const bf16_t* wb = (const bf16_t*)(C.ws + WS_W);
        pg8::MixProb P{(const bf16_t*)(C.ws + WS_ATT), (const bf16_t*)(C.ws + WS_RWO), wb + WO_OM / 2, wb + WO_OR / 2, RW, RW, RW};
        pg8::StaticOrder S; S.init(T, DM, F.G, F.bx, 2);
        pg8::EpiMix E{(const bf16_t*)C.out, (bf16_t*)(C.ws + WS_MIXED)};
        pg8::gemm_phase(F.lds, P, S, E);
    }
    SEAM(9);
    if (IN(10)) {
        const bf16_t* wb = (const bf16_t*)(C.ws + WS_W);
        pg8::Dense P{(const bf16_t*)(C.ws + WS_MIXED), wb + WO_OUT / 2, DM, DM, DM};
        pg8::StaticOrder S; S.init(T, DM, F.G, F.bx);
        pg8::EpiOutF E{(bf16_t*)(C.ws + WS_YMIX)};
        pg8::gemm_phase(F.lds, P, S, E);
    }
    SEAM(10);
    if (IN(11)) { d_post_mix(C, F.G, F.bx, F.tid, F.lane, F.wave, F.lds, (args.sub & 4) != 0); }
    SEAM(11);
    if (IN(12)) {
        const pg8::MoeTab tb = moe_setup<2>(C, F.G, F.bx, F.tid, (LAS int*)(F.lds + LDSCTL_OFF));
        pg8::MoeProb1 P{(const bf16_t*)(C.ws + WS_H), (const bf16_t*)(C.ws + WS_W + WO_GU), tb, DM, DM, DM};
        pg8::MoeSched S{tb};
        pg8::EpiMoe1 E{(bf16_t*)(C.ws + WS_ACT), (const float*)(C.ws + WS_ROUTE), tb, (unsigned*)(C.ws + WS_CTL) + CW_RTFLAG};
        pg8::gemm_phase(F.lds, P, S, E);
    }
    if (IN(13)) {
        const pg8::MoeTab tb = moe_setup<4, true>(C, F.G, F.bx, F.tid, (LAS int*)(F.lds + LDSCTL_OFF));
        pg8::MoeProb2 P{(const bf16_t*)(C.ws + WS_ACT), (const bf16_t*)(C.ws + WS_W + WO_DN), tb, FF, FF, FF};
        pg8::MoeSched2 S{tb, (unsigned*)(C.ws + WS_CTL) + CW_RTFLAG};
        pg8::EpiMoe2 E{(bf16_t*)(C.ws + WS_YSLOT), tb};
        pg8::gemm_phase(F.lds, P, S, E);
    }
    SEAM(13);
    if (IN(14)) { d_final(C, F.bx * NWAVES + F.wave, F.G * NWAVES, F.lane); }
#undef IN
#undef SEAM
}

static int g_grid = 0;
static int g_breg = 0;
static void launch_mk(const Ctx& C, int lo, int hi, hipStream_t stream, int sub = 3) {
    Args a{}; a.C = C; a.ph_lo = lo; a.ph_hi = hi; a.sub = sub; a.breg = g_breg++;
    hipLaunchKernelGGL(mk, dim3(g_grid), dim3(NTHR), LDS_BYTES, stream, a);
}
extern "C" void kernel_launch(void* const* d_in, const int* in_sizes, int n_in, void* d_out, int out_size, void* d_ws, size_t ws_size, hipStream_t stream) {
    if (g_grid == 0) {
        int dev = 0, cus = 0; hipGetDevice(&dev); hipDeviceGetAttribute(&cus, hipDeviceAttributeMultiprocessorCount, dev);
        hipFuncSetAttribute((const void*)mk, hipFuncAttributeMaxDynamicSharedMemorySize, LDS_BYTES);
        g_grid = cus > 0 ? cus : 256;
    }
    Ctx C{};
    const float* const* f = (const float* const*)d_in;
    C.x = f[0]; C.c = f[1]; C.pos = (const int*)d_in[2];
    C.w_ada = f[3]; C.b_ada = f[4]; C.g_pre_mix = f[5]; C.g_post_mix = f[6]; C.g_pre_ffn = f[7]; C.g_post_ffn = f[8];
    C.w_in = f[9]; C.g_cq = f[10]; C.w_uq = f[11]; C.g_ckv = f[12]; C.w_ukv = f[13]; C.w_o_mla = f[14];
    C.mu = f[15]; C.w_dec = f[16]; C.dec_bias = f[17]; C.w_a = f[18]; C.a_bias = f[19]; C.w_g = f[20];
    C.k_k = f[21]; C.k_a = f[22]; C.r_k = f[23]; C.lnx_w = f[24]; C.lnx_b = f[25]; C.w_o_rwkv = f[26]; C.w_out = f[27];
    C.w_rg = f[28]; C.b_rg = f[29]; C.w_re = f[30]; C.b_re = f[31]; C.w_eg = f[32]; C.w_eu = f[33]; C.w_ed = f[34];
    C.out = (float*)d_out; C.ws = (unsigned char*)d_ws;

    g_breg = 0;
    hipMemsetAsync((char*)d_ws + WS_CTL, 0, CTL_ZERO_BYTES, stream);
    launch_mk(C, 0, 15, stream);
}
```

```cpp
#include <hip/hip_runtime.h>
#include <stdint.h>
#include <math.h>
#include <type_traits>

constexpr int NB = 16, SEQ = 2048, DM = 1024, T = NB * SEQ;
constexpr int NH = 8;
constexpr int QR = 384, KVR = 256, ROPE = 32, NOPE = 64, VD = 64, QK = NOPE + ROPE;
constexpr int RW = 512, DR = 64, AR = 64, GR = 128;
constexpr int MLA_IN = QR + KVR + ROPE;
constexpr int RWKV_IN = 3 * RW + DR + AR + GR;
constexpr int IN_W = MLA_IN + RWKV_IN + 2 * DM;
constexpr int NE = 32, EPG = 8, NG = 4, FF = 256;
constexpr float RMS_EPS = 1e-6f, GN_EPS = 64e-5f;
constexpr float QSCALE = 0.10206207261596577f * 1.4426950408889634f;

typedef unsigned short bf16_t;
__device__ __forceinline__ float bf2f(bf16_t h) { return __uint_as_float(((unsigned)h) << 16); }
__device__ __forceinline__ bf16_t f2bf(float f) { unsigned u = __float_as_uint(f); return (bf16_t)((u + 0x7fffu + ((u >> 16) & 1u)) >> 16); }
__device__ __forceinline__ float sigmoidf_(float x) { return 1.f / (1.f + __expf(-x)); }
typedef unsigned u32x2 __attribute__((ext_vector_type(2)));
typedef float f32x2_t __attribute__((ext_vector_type(2)));
typedef __bf16 bf16x2_t __attribute__((ext_vector_type(2)));
__device__ __forceinline__ unsigned cvtpk(float lo, float hi) { f32x2_t v = {lo, hi}; bf16x2_t b = __builtin_convertvector(v, bf16x2_t); return __builtin_bit_cast(unsigned, b); }
__device__ __forceinline__ float fsigmoid(float x) { return __builtin_amdgcn_rcpf(1.f + __expf(-x)); }
template <int CTRL> __device__ __forceinline__ float dpp_add_(float x) { return x + __builtin_bit_cast(float, __builtin_amdgcn_update_dpp(0, __builtin_bit_cast(int, x), CTRL, 0xf, 0xf, true)); }
__device__ __forceinline__ float wsum_dpp(float x) {
    x = dpp_add_<0xB1>(x); x = dpp_add_<0x4E>(x); x = dpp_add_<0x141>(x); x = dpp_add_<0x140>(x);
    x += __builtin_bit_cast(float, __builtin_amdgcn_update_dpp(0, __builtin_bit_cast(int, x), 0x142, 0xa, 0xf, false));
    x += __builtin_bit_cast(float, __builtin_amdgcn_update_dpp(0, __builtin_bit_cast(int, x), 0x143, 0xc, 0xf, false));
    return __builtin_bit_cast(float, __builtin_amdgcn_readlane(__builtin_bit_cast(int, x), 63));
}
__device__ __forceinline__ float sum8_dpp(float x) { x = dpp_add_<0xB1>(x); x = dpp_add_<0x4E>(x); x = dpp_add_<0x141>(x); return x; }
__device__ __forceinline__ float wave_sum(float v) {
#pragma unroll
    for (int o = 1; o < 64; o <<= 1) v += __shfl_xor(v, o);
    return v;
}

constexpr size_t MiB = 1u << 20;
constexpr size_t WS_MOD = 5 * MiB;
constexpr size_t WS_ROPE = 1 * MiB;
constexpr size_t WS_CTL = 0;
constexpr size_t CTL_ZERO_BYTES = 65536;
constexpr int MOE_SKIP = 1;
constexpr int CW_PFLAG = 15744;
constexpr int CW_RTFLAG = 15424;
constexpr int CW_GCNT = 15360;
constexpr size_t WS_H = 8 * MiB;
constexpr size_t WS_QF = 8 * MiB;
constexpr size_t WS_RWO = 8 * MiB;
constexpr size_t WS_ZM = 72 * MiB;
constexpr size_t WS_VF = 72 * MiB;
constexpr size_t WS_EBUF = 104 * MiB;
constexpr size_t WS_MIXED = 72 * MiB;
constexpr size_t WS_ACT = 72 * MiB;
constexpr size_t WS_ZL = 120 * MiB;
constexpr size_t WS_AV = 136 * MiB;
constexpr size_t WS_G = 168 * MiB;
constexpr size_t WS_Y = 200 * MiB;
constexpr size_t WS_YMIX = 136 * MiB;
constexpr size_t WS_CQN = 232 * MiB;
constexpr size_t WS_CKVN = 256 * MiB;
constexpr size_t WS_LORA = 272 * MiB;
constexpr size_t WS_ATT = 264 * MiB;
constexpr size_t WS_YSLOT = 264 * MiB;
constexpr size_t WS_H2LO = 264 * MiB;
constexpr size_t WS_X1B = 200 * MiB;
constexpr size_t WS_CGT = 8 * MiB, WS_CQT = 72 * MiB, WS_CHT = 200 * MiB, WS_CYL = 392 * MiB, WS_Y2 = 104 * MiB;
constexpr size_t WS_RKV = 296 * MiB;
constexpr size_t WS_KF = 392 * MiB;
constexpr size_t WS_MIX1 = 296 * MiB;
constexpr size_t WS_BONUS = 440 * MiB;
constexpr size_t WS_ROUTE = 442 * MiB;
constexpr size_t WS_LIST = 444 * MiB;
constexpr size_t WS_W = 448 * MiB;
constexpr size_t WS_QRAW = 448 * MiB;

struct Ctx {
    const float *x, *c; const int* pos;
    const float *w_ada, *b_ada, *g_pre_mix, *g_post_mix, *g_pre_ffn, *g_post_ffn;
    const float *w_in, *g_cq, *w_uq, *g_ckv, *w_ukv, *w_o_mla;
    const float *mu, *w_dec, *dec_bias, *w_a, *a_bias, *w_g, *k_k, *k_a, *r_k, *lnx_w, *lnx_b, *w_o_rwkv, *w_out;
    const float *w_rg, *b_rg, *w_re, *b_re, *w_eg, *w_eu, *w_ed;
    float* out; unsigned char* ws;
};

__device__ __forceinline__ void d_prep(const Ctx& C, int gw, int ngw, int lane) {
    typedef unsigned u32x4_ __attribute__((ext_vector_type(4)));
    const bf16_t* zm = (const bf16_t*)(C.ws + WS_ZM); const bf16_t* zl = (const bf16_t*)(C.ws + WS_ZL);
    bf16_t* cqn = (bf16_t*)(C.ws + WS_CQN); bf16_t* ckvn = (bf16_t*)(C.ws + WS_CKVN); bf16_t* lora = (bf16_t*)(C.ws + WS_LORA);
    bf16_t* kf = (bf16_t*)(C.ws + WS_KF);
    const float2* rope = (const float2*)(C.ws + WS_ROPE);
#define UNPK8(W_, F_) do { F_[0] = __uint_as_float(W_[0] << 16); F_[1] = __uint_as_float(W_[0] & 0xffff0000u); F_[2] = __uint_as_float(W_[1] << 16); F_[3] = __uint_as_float(W_[1] & 0xffff0000u); \
        F_[4] = __uint_as_float(W_[2] << 16); F_[5] = __uint_as_float(W_[2] & 0xffff0000u); F_[6] = __uint_as_float(W_[3] << 16); F_[7] = __uint_as_float(W_[3] & 0xffff0000u); } while (0)
    for (int t0 = gw * 4; t0 < T; t0 += ngw * 4) {
        const int b = t0 / SEQ, s0 = t0 % SEQ;
        u32x4_ wq[4], wk[4], wz[5];
        const u32x4_ zero4 = {0u, 0u, 0u, 0u};
#pragma unroll
        for (int r = 0; r < 4; ++r) { const bf16_t* zrow = zm + (size_t)(t0 + r) * 768;
            wq[r] = lane < 48 ? *(const u32x4_*)(zrow + 8 * lane) : zero4; wk[r] = lane < 32 ? *(const u32x4_*)(zrow + QR + 8 * lane) : zero4; }
#pragma unroll
        for (int r = 0; r < 5; ++r) { const bool ok = (lane < 32) && (r > 0 || s0 > 0);
            wz[r] = ok ? *(const u32x4_*)(zl + (size_t)(t0 + r - 1) * 256 + 8 * lane) : zero4; }
        float rs1[4], rs2[4];
#pragma unroll
        for (int r = 0; r < 4; ++r) { float v[8], u[8]; UNPK8(wq[r], v); UNPK8(wk[r], u); float ss = 0.f, su = 0.f;
#pragma unroll
            for (int e = 0; e < 8; ++e) { ss += v[e] * v[e]; su += u[e] * u[e]; }
            rs1[r] = ss; rs2[r] = su; }
#pragma unroll
        for (int r = 0; r < 4; ++r) { rs1[r] = rsqrtf(wsum_dpp(rs1[r]) * (1.f / QR) + RMS_EPS); rs2[r] = rsqrtf(wsum_dpp(rs2[r]) * (1.f / KVR) + RMS_EPS); }
        if (lane < 48) { const float4 g0 = *(const float4*)(C.g_cq + 8 * lane), g1 = *(const float4*)(C.g_cq + 8 * lane + 4);
#pragma unroll
            for (int r = 0; r < 4; ++r) { float v[8]; UNPK8(wq[r], v); const float q = rs1[r];
                u32x4_ o; o.x = cvtpk(v[0] * q * g0.x, v[1] * q * g0.y); o.y = cvtpk(v[2] * q * g0.z, v[3] * q * g0.w); o.z = cvtpk(v[4] * q * g1.x, v[5] * q * g1.y); o.w = cvtpk(v[6] * q * g1.z, v[7] * q * g1.w);
                *(u32x4_*)(cqn + (size_t)(t0 + r) * QR + 8 * lane) = o; } }
        if (lane < 32) { const float4 g0 = *(const float4*)(C.g_ckv + 8 * lane), g1 = *(const float4*)(C.g_ckv + 8 * lane + 4);
#pragma unroll
            for (int r = 0; r < 4; ++r) { float u[8]; UNPK8(wk[r], u); const float q = rs2[r];
                u32x4_ o; o.x = cvtpk(u[0] * q * g0.x, u[1] * q * g0.y); o.y = cvtpk(u[2] * q * g0.z, u[3] * q * g0.w); o.z = cvtpk(u[4] * q * g1.x, u[5] * q * g1.y); o.w = cvtpk(u[6] * q * g1.z, u[7] * q * g1.w);
                *(u32x4_*)(ckvn + (size_t)(t0 + r) * KVR + 8 * lane) = o; } }
        {   const int h = lane >> 3, i2 = (lane & 7) * 2;
#pragma unroll
            for (int r = 0; r < 4; ++r) { const int t = t0 + r; const bf16_t* zrow = zm + (size_t)t * 768 + QR + KVR;
                const unsigned pa = *(const unsigned*)(zrow + i2), pb = *(const unsigned*)(zrow + 16 + i2);
                const float x1a = __uint_as_float(pa << 16), x1b = __uint_as_float(pa & 0xffff0000u), x2a = __uint_as_float(pb << 16), x2b = __uint_as_float(pb & 0xffff0000u);
                const float4 cc = *(const float4*)(rope + (size_t)t * 16 + i2);
                u32x2 o; o.x = cvtpk(x1a * cc.x - x2a * cc.y, x2a * cc.x + x1a * cc.y); o.y = cvtpk(x1b * cc.z - x2b * cc.w, x2b * cc.z + x1b * cc.w);
                *(u32x2*)(kf + (((size_t)b * NH + h) * SEQ + (s0 + r)) * QK + NOPE + 2 * i2) = o; } }
        if (lane < 32) {
            const int c = 3 * RW / 8 + lane;
            const float4 m0 = *(const float4*)(C.mu + 8 * c), m1 = *(const float4*)(C.mu + 8 * c + 4);
            const float mm[8] = {m0.x, m0.y, m0.z, m0.w, m1.x, m1.y, m1.z, m1.w};
            float p[8]; UNPK8(wz[0], p);
#pragma unroll
            for (int r = 0; r < 4; ++r) {
                float z[8]; UNPK8(wz[r + 1], z);
                float zs[8];
#pragma unroll
                for (int e = 0; e < 8; ++e) { zs[e] = z[e] + (p[e] - z[e]) * mm[e]; p[e] = z[e]; }
                if (c < (3 * RW + DR) / 8) {
#pragma unroll
                    for (int e = 0; e < 8; ++e) { const float ex = __expf(2.f * zs[e]); zs[e] = 1.f - 2.f * __builtin_amdgcn_rcpf(ex + 1.f); } }
                else if (c >= (3 * RW + DR + AR) / 8) {
#pragma unroll
                    for (int e = 0; e < 8; ++e) zs[e] = fsigmoid(zs[e]); }
                u32x4_ o; o.x = cvtpk(zs[0], zs[1]); o.y = cvtpk(zs[2], zs[3]); o.z = cvtpk(zs[4], zs[5]); o.w = cvtpk(zs[6], zs[7]);
                *(u32x4_*)(lora + (size_t)(t0 + r) * 256 + 8 * lane) = o;
            }
        }
    }
#undef UNPK8
}

__device__ __forceinline__ void d_rwkv_post(const Ctx& C, int gw, int ngw, int lane) {
    typedef unsigned u32x4_ __attribute__((ext_vector_type(4)));
    const bf16_t* y = (const bf16_t*)(C.ws + WS_Y2); const float* bonus = (const float*)(C.ws + WS_BONUS);
    const bf16_t* rkv = (const bf16_t*)(C.ws + WS_RKV); const bf16_t* g = (const bf16_t*)(C.ws + WS_G);
    bf16_t* rwo = (bf16_t*)(C.ws + WS_RWO);
    const int c0 = 8 * lane, h = lane >> 3;
    const float4 lw0 = *(const float4*)(C.lnx_w + c0), lw1 = *(const float4*)(C.lnx_w + c0 + 4), lb0 = *(const float4*)(C.lnx_b + c0), lb1 = *(const float4*)(C.lnx_b + c0 + 4);
    const float lw[8] = {lw0.x, lw0.y, lw0.z, lw0.w, lw1.x, lw1.y, lw1.z, lw1.w}, lb[8] = {lb0.x, lb0.y, lb0.z, lb0.w, lb1.x, lb1.y, lb1.z, lb1.w};
    const float4 mv0 = *(const float4*)(C.mu + 2 * RW + c0), mv1 = *(const float4*)(C.mu + 2 * RW + c0 + 4);
    const float mv[8] = {mv0.x, mv0.y, mv0.z, mv0.w, mv1.x, mv1.y, mv1.z, mv1.w};
    for (int t0 = gw * 4; t0 < T; t0 += ngw * 4) {
        float4 ya[4], yb[4]; u32x4_ vv[4], gg[4]; float bn[4];
        u32x4_ vprev = (t0 % SEQ) ? *(const u32x4_*)(rkv + (size_t)(t0 - 1) * 1536 + 1024 + c0) : (u32x4_){0u, 0u, 0u, 0u};
#pragma unroll
        for (int r = 0; r < 4; ++r) { const size_t t = t0 + r;
            { const u32x4_ yw = *(const u32x4_*)(y + t * RW + c0);
              ya[r] = make_float4(__uint_as_float(yw[0] << 16), __uint_as_float(yw[0] & 0xffff0000u), __uint_as_float(yw[1] << 16), __uint_as_float(yw[1] & 0xffff0000u));
              yb[r] = make_float4(__uint_as_float(yw[2] << 16), __uint_as_float(yw[2] & 0xffff0000u), __uint_as_float(yw[3] << 16), __uint_as_float(yw[3] & 0xffff0000u)); }
            vv[r] = *(const u32x4_*)(rkv + t * 1536 + 1024 + c0); gg[r] = *(const u32x4_*)(g + t * RW + c0); bn[r] = bonus[t * NH + h]; }
#pragma unroll
        for (int r = 0; r < 4; ++r) {
            const float yv[8] = {ya[r].x, ya[r].y, ya[r].z, ya[r].w, yb[r].x, yb[r].y, yb[r].z, yb[r].w};
            float sm = 0.f;
#pragma unroll
            for (int e = 0; e < 8; ++e) sm += yv[e];
            const float mean = sum8_dpp(sm) * (1.f / 64.f);
            float sq = 0.f;
#pragma unroll
            for (int e = 0; e < 8; ++e) { const float d = yv[e] - mean; sq += d * d; }
            const float rstd = rsqrtf(sum8_dpp(sq) * (1.f / 64.f) + GN_EPS);
            float o[8];
#pragma unroll
            for (int e = 0; e < 4; ++e) {
                const unsigned pw = r == 0 ? vprev[e] : vv[r - 1][e];
                const float z0 = __uint_as_float(vv[r][e] << 16), z1 = __uint_as_float(vv[r][e] & 0xffff0000u), p0 = __uint_as_float(pw << 16), p1 = __uint_as_float(pw & 0xffff0000u);
                const unsigned sw = cvtpk(z0 + (p0 - z0) * mv[2 * e], z1 + (p1 - z1) * mv[2 * e + 1]);
                const float v0 = __uint_as_float(sw << 16), v1 = __uint_as_float(sw & 0xffff0000u), g0 = __uint_as_float(gg[r][e] << 16), g1 = __uint_as_float(gg[r][e] & 0xffff0000u);
                o[2 * e] = ((yv[2 * e] - mean) * rstd * lw[2 * e] + lb[2 * e] + bn[r] * v0) * g0;
                o[2 * e + 1] = ((yv[2 * e + 1] - mean) * rstd * lw[2 * e + 1] + lb[2 * e + 1] + bn[r] * v1) * g1; }
            u32x4_ w; w.x = cvtpk(o[0], o[1]); w.y = cvtpk(o[2], o[3]); w.z = cvtpk(o[4], o[5]); w.w = cvtpk(o[6], o[7]);
            *(u32x4_*)(rwo + (size_t)(t0 + r) * RW + c0) = w;
        }
    }
}

#define LAS __attribute__((address_space(3)))
typedef short bf16x8 __attribute__((ext_vector_type(8)));
typedef float f32x4 __attribute__((ext_vector_type(4)));
typedef float f32x16 __attribute__((ext_vector_type(16)));
typedef unsigned u32x4 __attribute__((ext_vector_type(4)));

constexpr int NWAVES = 8, NTHR = NWAVES * 64;
constexpr int RING_BYTES = 131072;
constexpr int LDSCTL_OFF = RING_BYTES;
constexpr int LDS_BYTES = 163840;

namespace pg8 {
constexpr int BM = 256, BK = 64, HALF = 128, HTB = HALF * BK * 2, NXCD = 8, WGM = 8;
__host__ __device__ __forceinline__ int lds_byte(int r, int c) { const int st = (r >> 4) * 2 + (c >> 5), rr = r & 15, cc = c & 31, ob = rr * 64 + cc * 2; return st * 1024 + (ob ^ (((ob >> 9) & 1) << 5)); }
__host__ __device__ __forceinline__ void stage_rc(int b, int& R, int& C) { const int st = b / 1024, sb = b % 1024, swz = sb ^ (((sb >> 9) & 1) << 5); R = (st >> 1) * 16 + swz / 64; C = (st & 1) * 32 + (swz % 64) / 2; }
__host__ __device__ __forceinline__ int perm32(int rho) { const int n = rho >> 4, i = rho & 15; return 8 * (i >> 2) + 4 * n + (i & 3); }

struct Unit { int pm, pn, z; };

struct StaticOrder {
    int nM, nN, nwg, G, c, parts;
    __device__ void init(int M, int N, int G_, int c_, int parts_ = 1) { nM = M / BM; nN = N / BM; nwg = nM * nN; G = G_; c = c_; parts = parts_; }
    __device__ bool next(int i, Unit& u) const {
        const int it = i / parts; u.z = i - it * parts;
        const long L = (long)it * G + c; if (L >= nwg) return false;
        int wgid = (int)L; { const int q = nwg / NXCD, r = nwg % NXCD, xcd = wgid % NXCD, off = wgid / NXCD; wgid = (xcd < r ? xcd * (q + 1) : r * (q + 1) + (xcd - r) * q) + off; }
        const int nig = WGM * nN, gid = wgid / nig, fm = gid * WGM, gsz = (nM - fm) < WGM ? (nM - fm) : WGM;
        u.pm = fm + ((wgid % nig) % gsz); u.pn = (wgid % nig) / gsz; return true;
    }
};
struct Dense { static constexpr bool GATHER = false; const bf16_t* A; const bf16_t* Bt; int lda, ldb, K;
    __device__ __forceinline__ unsigned a_off(const Unit&, int R) const { return (unsigned)(R * lda) * 2u; }
    __device__ __forceinline__ const char* a_ptr(const Unit& u) const { return (const char*)(A + (size_t)u.pm * BM * lda); }
    __device__ __forceinline__ const char* b_ptr(const Unit& u) const { return (const char*)(Bt + (size_t)u.pn * BM * ldb); } };

template <class T, class = void> struct has_signal : std::false_type {};
template <class T> struct has_signal<T, std::void_t<decltype(T::SIGNAL)>> : std::true_type {};
template <class T, class = void> struct a_aux { static constexpr int value = 0; };
template <class T> struct a_aux<T, std::void_t<decltype(T::A_AUX)>> { static constexpr int value = T::A_AUX; };
template <bool ALIGN_EPI = true, class Epi, class Prob, class Sched>
__device__ __forceinline__ void gemm_phase(LAS unsigned char* lds, const Prob& P, const Sched& S, const Epi& E) {
    const int tid = threadIdx.x, wid = __builtin_amdgcn_readfirstlane(tid >> 6), lane = tid & 63, wr = wid >> 2, wc = wid & 3, fr = lane & 15, fq = lane >> 4;
    const int K = P.K, nt = K / BK;
    unsigned voffB[2]; int RA[2], CA[2];
#pragma unroll
    for (int i = 0; i < 2; ++i) { int R, C; stage_rc(tid * 16 + i * 8192, R, C); const int Rb = Epi::PERM ? ((R & ~31) + perm32(R & 31)) : R;
        RA[i] = R; CA[i] = C * 2; voffB[i] = (unsigned)(Rb * P.ldb + C) * 2u; }
    unsigned vAc[2][2], vAn[2][2];
#define PG8_FILLA(v, u) do { _Pragma("unroll") for (int h_ = 0; h_ < 2; ++h_) _Pragma("unroll") for (int i_ = 0; i_ < 2; ++i_) v[h_][i_] = P.a_off(u, RA[i_] + h_ * HALF) + (unsigned)CA[i_]; } while (0)
    const size_t kstep = (size_t)(BK * 2);
    const size_t hstepB = (size_t)HALF * P.ldb * 2;
    const unsigned ldsw = (unsigned)wid * 1024u;
    const int aoff = lds_byte(wr * 64 + fr, fq * 8), boff = lds_byte(wc * 32 + fr, fq * 8);
#define PG8_SA(b, h) (((b) * 2 + (h)) * HTB)
#define PG8_SB(b, h) ((4 + (b) * 2 + (h)) * HTB)
#define PG8_STAGE(bufoff, gbase, voff) do { _Pragma("unroll") for (int _i = 0; _i < 2; ++_i) \
        __builtin_amdgcn_global_load_lds((const unsigned*)((const char*)(gbase) + (voff)[_i]), (LAS unsigned*)(lds + (bufoff) + ldsw + _i * 8192), 16, 0, 0); } while (0)
#define PG8_STAGEA(bufoff, gbase, voff) do { _Pragma("unroll") for (int _i = 0; _i < 2; ++_i) \
        __builtin_amdgcn_global_load_lds((const unsigned*)((const char*)(gbase) + (voff)[_i]), (LAS unsigned*)(lds + (bufoff) + ldsw + _i * 8192), 16, 0, a_aux<Prob>::value); } while (0)
#define PG8_LDA(dst, b, h) do { _Pragma("unroll") for (int m = 0; m < 4; ++m) _Pragma("unroll") for (int k = 0; k < 2; ++k) dst[m][k] = *(const LAS bf16x8*)(lds + PG8_SA(b, h) + aoff + m * 2048 + k * 1024); } while (0)
#define PG8_LDB(dst, b, h) do { _Pragma("unroll") for (int n = 0; n < 2; ++n) _Pragma("unroll") for (int k = 0; k < 2; ++k) dst[n][k] = *(const LAS bf16x8*)(lds + PG8_SB(b, h) + boff + n * 2048 + k * 1024); } while (0)
#define PG8_MMA(ai, bj, At, Bt) do { __builtin_amdgcn_s_setprio(1); _Pragma("unroll") for (int m = 0; m < 4; ++m) _Pragma("unroll") for (int n = 0; n < 2; ++n) _Pragma("unroll") for (int k = 0; k < 2; ++k) \
        acc[ai][bj][m][n] = __builtin_amdgcn_mfma_f32_16x16x32_bf16(Bt[n][k], At[m][k], acc[ai][bj][m][n], 0, 0, 0); __builtin_amdgcn_s_setprio(0); } while (0)
#define PG8_WAIT_V(n) asm volatile("s_waitcnt vmcnt(" #n ")" ::: "memory")
#define PG8_WAIT_L(n) asm volatile("s_waitcnt lgkmcnt(" #n ")" ::: "memory")
#define PG8_BAR __builtin_amdgcn_s_barrier()
#define PG8_SCHED __builtin_amdgcn_sched_barrier(0)
    Unit cur, nxt; int ui = 0;
    if (!S.next(0, cur)) return;
    f32x4 acc[2][2][4][2];
#pragma unroll
    for (int a = 0; a < 2; ++a)
#pragma unroll
        for (int b = 0; b < 2; ++b)
#pragma unroll
            for (int m = 0; m < 4; ++m)
#pragma unroll
                for (int n = 0; n < 2; ++n) acc[a][b][m][n] = (f32x4){0.f, 0.f, 0.f, 0.f};
    bf16x8 At[4][2], B0[2][2], B1[2][2];
    const char* cA = P.a_ptr(cur); const char* cB = P.b_ptr(cur);
    PG8_FILLA(vAc, cur);
    PG8_STAGE(PG8_SB(0, 0), cB, voffB); PG8_STAGE(PG8_SB(0, 1), cB + hstepB, voffB); PG8_STAGEA(PG8_SA(0, 0), cA, vAc[0]); PG8_STAGEA(PG8_SA(0, 1), cA, vAc[1]);
    if (wr == 1) PG8_BAR;
    PG8_WAIT_V(2); PG8_BAR;
    PG8_STAGE(PG8_SB(1, 0), cB + kstep, voffB); PG8_STAGEA(PG8_SA(1, 0), cA + kstep, vAc[0]); PG8_STAGE(PG8_SB(1, 1), cB + hstepB + kstep, voffB);
    PG8_WAIT_V(6); PG8_BAR;
    for (;;) {
        const bool has_next = S.next(ui + 1, nxt);
        const char* nA = has_next ? P.a_ptr(nxt) : cA; const char* nB = has_next ? P.b_ptr(nxt) : cB;
        if (Prob::GATHER && has_next) { PG8_FILLA(vAn, nxt); }
        else {
#pragma unroll
            for (int h_ = 0; h_ < 2; ++h_)
#pragma unroll
                for (int i_ = 0; i_ < 2; ++i_) vAn[h_][i_] = vAc[h_][i_]; }
        for (int t = 0; t < nt; t += 2) {
            const bool last = (t == nt - 2);
            const char* a1 = cA + (size_t)(t + 1) * kstep;
            const char* a2 = last ? nA : cA + (size_t)(t + 2) * kstep; const char* b2 = last ? nB : cB + (size_t)(t + 2) * kstep;
            const char* a3 = a2 + kstep; const char* b3 = b2 + kstep;
            unsigned vA2[2][2];
#pragma unroll
            for (int h_ = 0; h_ < 2; ++h_)
#pragma unroll
                for (int i_ = 0; i_ < 2; ++i_) vA2[h_][i_] = (Prob::GATHER && last) ? vAn[h_][i_] : vAc[h_][i_];
            PG8_LDB(B0, 0, 0); PG8_LDB(B1, 0, 1); PG8_SCHED; PG8_LDA(At, 0, 0); PG8_STAGEA(PG8_SA(1, 1), a1, vAc[1]);
            PG8_WAIT_V(8); PG8_WAIT_L(0); PG8_BAR; PG8_MMA(0, 0, At, B0); PG8_MMA(0, 1, At, B1); PG8_BAR; PG8_SCHED;
            PG8_LDA(At, 0, 1); PG8_STAGE(PG8_SB(0, 0), b2, voffB); PG8_STAGE(PG8_SB(0, 1), b2 + hstepB, voffB); PG8_STAGEA(PG8_SA(0, 0), a2, vA2[0]);
            PG8_WAIT_V(8); PG8_WAIT_L(0); PG8_BAR; PG8_MMA(1, 0, At, B0); PG8_MMA(1, 1, At, B1); PG8_BAR; PG8_SCHED;
            PG8_LDB(B0, 1, 0); PG8_LDB(B1, 1, 1); PG8_SCHED; PG8_LDA(At, 1, 0); PG8_STAGEA(PG8_SA(0, 1), a2, vA2[1]);
            PG8_WAIT_V(8); PG8_WAIT_L(0); PG8_BAR; PG8_MMA(0, 0, At, B0); PG8_MMA(0, 1, At, B1); PG8_BAR; PG8_SCHED;
            PG8_LDA(At, 1, 1); PG8_STAGE(PG8_SB(1, 0), b3, voffB); PG8_STAGE(PG8_SB(1, 1), b3 + hstepB, voffB); PG8_STAGEA(PG8_SA(1, 0), a3, vA2[0]);
            PG8_WAIT_V(8); PG8_WAIT_L(0); PG8_BAR; PG8_MMA(1, 0, At, B0); PG8_MMA(1, 1, At, B1); PG8_BAR; PG8_SCHED;
        }
        if constexpr (ALIGN_EPI) { if (wr == 0) PG8_BAR; }
        E(acc, cur, wr, wc, fr, fq);
        if constexpr (has_signal<Epi>::value) { if (E.sig_now(cur)) { PG8_WAIT_V(0); PG8_BAR; if (tid == 0) E.signal(cur); } }
        if (!has_next) break;
        if (!E.keep(cur)) {
#pragma unroll
            for (int a = 0; a < 2; ++a)
#pragma unroll
                for (int b = 0; b < 2; ++b)
#pragma unroll
                    for (int m = 0; m < 4; ++m)
#pragma unroll
                        for (int n = 0; n < 2; ++n) acc[a][b][m][n] = (f32x4){0.f, 0.f, 0.f, 0.f};
        }
        cur = nxt; cA = nA; cB = nB; ++ui;
#pragma unroll
        for (int h_ = 0; h_ < 2; ++h_)
#pragma unroll
            for (int i_ = 0; i_ < 2; ++i_) vAc[h_][i_] = vAn[h_][i_];
        if constexpr (ALIGN_EPI) { if (wr == 1) PG8_BAR; }
    }
    PG8_WAIT_V(0);
    if constexpr (!ALIGN_EPI) { if (wr == 0) PG8_BAR; }
    PG8_BAR;
#undef PG8_FILLA
#undef PG8_SA
#undef PG8_SB
#undef PG8_STAGE
#undef PG8_STAGEA
#undef PG8_LDA
#undef PG8_LDB
#undef PG8_MMA
#undef PG8_WAIT_V
#undef PG8_WAIT_L
#undef PG8_BAR
#undef PG8_SCHED
}

struct EpiZ { static constexpr bool PERM = true; bf16_t *zm, *zrkv, *zl, *gates;
    __device__ __forceinline__ bool keep(const Unit&) const { return false; }
    __device__ __forceinline__ void operator()(f32x4 (&acc)[2][2][4][2], const Unit& u, int wr, int wc, int fr, int fq) const {
        bf16_t* base; int ldc, colt; bool sig = false;
        if (u.pn < 3) { base = zm; ldc = 768; colt = u.pn * 256; } else if (u.pn < 9) { base = zrkv; ldc = 3 * RW; colt = (u.pn - 3) * 256; } else if (u.pn == 9) { base = zl; ldc = 256; colt = 0; } else { base = gates; ldc = 2048; colt = (u.pn - 10) * 256; sig = true; }
        const int row0 = u.pm * BM + wr * 64 + fr, col0 = colt + wc * 32 + 8 * fq;
#pragma unroll
        for (int ai = 0; ai < 2; ++ai)
#pragma unroll
            for (int m = 0; m < 4; ++m) { bf16_t* rowp = base + (size_t)(row0 + ai * HALF + m * 16) * ldc + col0;
#pragma unroll
                for (int bj = 0; bj < 2; ++bj) { f32x4 v0 = acc[ai][bj][m][0], v1 = acc[ai][bj][m][1];
                    if (sig) {
#pragma unroll
                        for (int e = 0; e < 4; ++e) { v0[e] = fsigmoid(v0[e]); v1[e] = fsigmoid(v1[e]); } }
                    u32x4 w; w.x = cvtpk(v0[0], v0[1]); w.y = cvtpk(v0[2], v0[3]); w.z = cvtpk(v1[0], v1[1]); w.w = cvtpk(v1[2], v1[3]);
                    *(u32x4*)(rowp + bj * HALF) = w; } }
    } };

struct EpiQ { static constexpr bool PERM = true; bf16_t* qf; const float2* rope;
    __device__ __forceinline__ bool keep(const Unit&) const { return false; }
    __device__ __forceinline__ void operator()(f32x4 (&acc)[2][2][4][2], const Unit& u, int wr, int wc, int fr, int fq) const {
#pragma unroll
        for (int bj = 0; bj < 2; ++bj) {
            const int c0 = u.pn * BM + bj * HALF + wc * 32 + 8 * fq, h = c0 / QK, d0 = c0 - h * QK;
#pragma unroll
            for (int ai = 0; ai < 2; ++ai)
#pragma unroll
                for (int m = 0; m < 4; ++m) {
                    const int t = u.pm * BM + ai * HALF + wr * 64 + m * 16 + fr, b = t / SEQ, s_ = t - b * SEQ;
                    f32x4 v0 = acc[ai][bj][m][0], v1 = acc[ai][bj][m][1];
                    if (d0 >= NOPE) { const int i0 = (d0 - NOPE) >> 1; const float2* cs = rope + (size_t)t * 16 + i0;
                        const float2 c0_ = cs[0], c1_ = cs[1], c2_ = cs[2], c3_ = cs[3];
                        const f32x4 w0 = {v0[0] * c0_.x - v0[1] * c0_.y, v0[1] * c0_.x + v0[0] * c0_.y, v0[2] * c1_.x - v0[3] * c1_.y, v0[3] * c1_.x + v0[2] * c1_.y};
                        const f32x4 w1 = {v1[0] * c2_.x - v1[1] * c2_.y, v1[1] * c2_.x + v1[0] * c2_.y, v1[2] * c3_.x - v1[3] * c3_.y, v1[3] * c3_.x + v1[2] * c3_.y};
                        v0 = w0; v1 = w1; }
                    v0 = v0 * QSCALE; v1 = v1 * QSCALE;
                    u32x4 w; w.x = cvtpk(v0[0], v0[1]); w.y = cvtpk(v0[2], v0[3]); w.z = cvtpk(v1[0], v1[1]); w.w = cvtpk(v1[2], v1[3]);
                    *(u32x4*)(qf + (((size_t)b * NH + h) * SEQ + s_) * QK + d0) = w; } }
    } };
struct EpiKVp { static constexpr bool PERM = true; bf16_t *kf, *vf;
    __device__ __forceinline__ bool keep(const Unit&) const { return false; }
    __device__ __forceinline__ void operator()(f32x4 (&acc)[2][2][4][2], const Unit& u, int wr, int wc, int fr, int fq) const {
#pragma unroll
        for (int bj = 0; bj < 2; ++bj) {
            const int c0 = u.pn * BM + bj * HALF + wc * 32 + 8 * fq, h = c0 >> 7, c = c0 & 127;
#pragma unroll
            for (int ai = 0; ai < 2; ++ai)
#pragma unroll
                for (int m = 0; m < 4; ++m) {
                    const int t = u.pm * BM + ai * HALF + wr * 64 + m * 16 + fr, b = t / SEQ, s_ = t - b * SEQ;
                    const f32x4 v0 = acc[ai][bj][m][0], v1 = acc[ai][bj][m][1];
                    u32x4 w; w.x = cvtpk(v0[0], v0[1]); w.y = cvtpk(v0[2], v0[3]); w.z = cvtpk(v1[0], v1[1]); w.w = cvtpk(v1[2], v1[3]);
                    const size_t rowi = ((size_t)b * NH + h) * SEQ + s_;
                    if (c < 64) *(u32x4*)(kf + rowi * QK + c) = w; else *(u32x4*)(vf + rowi * VD + (c - 64)) = w; } }
    } };
struct EpiLora { static constexpr bool PERM = true; bf16_t *eb; const float *dbias, *abias;
    __device__ __forceinline__ bool keep(const Unit&) const { return false; }
    __device__ __forceinline__ void operator()(f32x4 (&acc)[2][2][4][2], const Unit& u, int wr, int wc, int fr, int fq) const {
        const int kind = u.pn >> 1; bf16_t* base = eb + (size_t)kind * ((size_t)T * RW);
        const float* bp = kind == 0 ? dbias : abias;
#pragma unroll
        for (int bj = 0; bj < 2; ++bj) {
            const int c0 = (u.pn & 1) * BM + bj * HALF + wc * 32 + 8 * fq;
            float bs[8];
#pragma unroll
            for (int e = 0; e < 8; ++e) bs[e] = kind < 2 ? bp[c0 + e] : 0.f;
#pragma unroll
            for (int ai = 0; ai < 2; ++ai)
#pragma unroll
                for (int m = 0; m < 4; ++m) {
                    const int t = u.pm * BM + ai * HALF + wr * 64 + m * 16 + fr;
                    float v[8];
#pragma unroll
                    for (int e = 0; e < 4; ++e) { v[e] = acc[ai][bj][m][0][e] + bs[e]; v[4 + e] = acc[ai][bj][m][1][e] + bs[4 + e]; }
                    if (kind == 0) {
#pragma unroll
                        for (int e = 0; e < 8; ++e) v[e] = 0.60653065971263342f * fsigmoid(v[e]); }
                    else if (kind == 1) {
#pragma unroll
                        for (int e = 0; e < 8; ++e) v[e] = fsigmoid(v[e]); }
                    u32x4 w; w.x = cvtpk(v[0], v[1]); w.y = cvtpk(v[2], v[3]); w.z = cvtpk(v[4], v[5]); w.w = cvtpk(v[6], v[7]);
                    *(u32x4*)(base + (size_t)t * RW + c0) = w; } }
    } };
struct DenseSC { static constexpr bool GATHER = false; static constexpr int A_AUX = 16; const bf16_t* A; const bf16_t* Bt; int lda, ldb, K;
    __device__ __forceinline__ unsigned a_off(const Unit&, int R) const { return (unsigned)(R * lda) * 2u; }
    __device__ __forceinline__ const char* a_ptr(const Unit& u) const { return (const char*)(A + (size_t)u.pm * BM * lda); }
    __device__ __forceinline__ const char* b_ptr(const Unit& u) const { return (const char*)(Bt + (size_t)u.pn * BM * ldb); } };
struct StaticOrderW { StaticOrder so; unsigned* flag; unsigned need;
    __device__ bool next(int i, Unit& u) const { if (!so.next(i, u)) return false;
        unsigned* f = flag + u.pm;
        for (unsigned sp = 0; __hip_atomic_load(f, __ATOMIC_RELAXED, __HIP_MEMORY_SCOPE_AGENT) < need && sp < (1u << 20); ++sp) __builtin_amdgcn_s_sleep(2);
        asm volatile("" ::: "memory");
        return true; } };
struct MixProb { static constexpr bool GATHER = false; const bf16_t *A0, *A1, *B0, *B1; int lda, ldb, K;
    __device__ __forceinline__ unsigned a_off(const Unit&, int R) const { return (unsigned)(R * lda) * 2u; }
    __device__ __forceinline__ const char* a_ptr(const Unit& u) const { return (const char*)((u.z ? A1 : A0) + (size_t)u.pm * BM * lda); }
    __device__ __forceinline__ const char* b_ptr(const Unit& u) const { return (const char*)((u.z ? B1 : B0) + (size_t)u.pn * BM * ldb); } };
struct EpiMix { static constexpr bool PERM = true; static constexpr bool SIGNAL = true; const bf16_t* gates; bf16_t* mixed; unsigned* flag;
    __device__ __forceinline__ bool keep(const Unit& u) const { return u.z == 0; }
    __device__ __forceinline__ bool sig_now(const Unit& u) const { return u.z != 0; }
    __device__ __forceinline__ void signal(const Unit& u) const { __hip_atomic_fetch_add(flag + u.pm, 1u, __ATOMIC_RELAXED, __HIP_MEMORY_SCOPE_AGENT); }
    __device__ __forceinline__ void operator()(f32x4 (&acc)[2][2][4][2], const Unit& u, int wr, int wc, int fr, int fq) const {
#pragma unroll
        for (int bj = 0; bj < 2; ++bj) {
            const int c0 = u.pn * BM + bj * HALF + wc * 32 + 8 * fq;
#pragma unroll
            for (int ai = 0; ai < 2; ++ai)
#pragma unroll
                for (int m = 0; m < 4; ++m) {
                    const int t = u.pm * BM + ai * HALF + wr * 64 + m * 16 + fr;
                    const u32x4 gbw = *(const u32x4*)(gates + (size_t)t * 2048 + DM + c0);
                    float gbv[8];
#pragma unroll
                    for (int e = 0; e < 4; ++e) { gbv[2 * e] = fmaxf(__uint_as_float(gbw[e] << 16), 1e-30f); gbv[2 * e + 1] = fmaxf(__uint_as_float(gbw[e] & 0xffff0000u), 1e-30f); }
                    if (u.z == 0) {
                        const u32x4 gaw = *(const u32x4*)(gates + (size_t)t * 2048 + c0);
#pragma unroll
                        for (int e = 0; e < 4; ++e) { const float ga0 = __uint_as_float(gaw[e] << 16), ga1 = __uint_as_float(gaw[e] & 0xffff0000u);
                            const float r0 = ga0 * __builtin_amdgcn_rcpf(gbv[2 * e]), r1 = ga1 * __builtin_amdgcn_rcpf(gbv[2 * e + 1]);
                            if (e < 2) { acc[ai][bj][m][0][2 * e] *= r0; acc[ai][bj][m][0][2 * e + 1] *= r1; } else { acc[ai][bj][m][1][2 * e - 4] *= r0; acc[ai][bj][m][1][2 * e - 3] *= r1; } }
                    } else {
                        float v[8];
#pragma unroll
                        for (int e = 0; e < 4; ++e) { v[e] = acc[ai][bj][m][0][e] * gbv[e]; v[4 + e] = acc[ai][bj][m][1][e] * gbv[4 + e]; }
                        u32x4 w; w.x = cvtpk(v[0], v[1]); w.y = cvtpk(v[2], v[3]); w.z = cvtpk(v[4], v[5]); w.w = cvtpk(v[6], v[7]);
                        asm volatile("global_store_dwordx4 %0, %1, off sc1\n\ts_nop 1" :: "v"(mixed + (size_t)t * DM + c0), "v"(w) : "memory"); } } }
    } };
struct EpiOutF { static constexpr bool PERM = true; bf16_t* y;
    __device__ __forceinline__ bool keep(const Unit&) const { return false; }
    __device__ __forceinline__ void operator()(f32x4 (&acc)[2][2][4][2], const Unit& u, int wr, int wc, int fr, int fq) const {
#pragma unroll
        for (int bj = 0; bj < 2; ++bj) {
            const int c0 = u.pn * BM + bj * HALF + wc * 32 + 8 * fq;
#pragma unroll
            for (int ai = 0; ai < 2; ++ai)
#pragma unroll
                for (int m = 0; m < 4; ++m) {
                    const int t = u.pm * BM + ai * HALF + wr * 64 + m * 16 + fr;
                    const f32x4 v0 = acc[ai][bj][m][0], v1 = acc[ai][bj][m][1];
                    u32x4 w; w.x = cvtpk(v0[0], v0[1]); w.y = cvtpk(v0[2], v0[3]); w.z = cvtpk(v1[0], v1[1]); w.w = cvtpk(v1[2], v1[3]);
                    *(u32x4*)(y + (size_t)t * DM + c0) = w; } }
    } };

constexpr int MOE_MAXU = 8;
struct MoeTab { const LAS int* desc; const LAS int* rowtab; };
struct MoeSched { MoeTab tb;
    __device__ __forceinline__ bool next(int i, Unit& u) const { if (i >= MOE_MAXU || tb.desc[i * 8 + 5] == 0) return false; u.pm = i; u.pn = tb.desc[i * 8 + 2]; u.z = tb.desc[i * 8 + 0]; return true; } };
struct MoeSched2 { MoeTab tb; unsigned* flag;
    __device__ __forceinline__ bool next(int i, Unit& u) const { if (i >= MOE_MAXU || tb.desc[i * 8 + 5] == 0) return false; u.pm = i; u.pn = tb.desc[i * 8 + 2]; u.z = tb.desc[i * 8 + 0];
        unsigned* f = flag + (tb.desc[i * 8 + 4] >> 8);
        for (unsigned sp = 0; __hip_atomic_load(f, __ATOMIC_RELAXED, __HIP_MEMORY_SCOPE_AGENT) < 2u && sp < (1u << 20); ++sp) __builtin_amdgcn_s_sleep(2);
        asm volatile("" ::: "memory");
        return true; } };
struct MoeProb1 { static constexpr bool GATHER = true; const bf16_t* h2; const bf16_t* wgu; MoeTab tb; int lda, ldb, K;
    __device__ __forceinline__ unsigned a_off(const Unit& u, int R) const { return (unsigned)((tb.rowtab[u.pm * 256 + R] >> 1) * lda) * 2u; }
    __device__ __forceinline__ const char* a_ptr(const Unit&) const { return (const char*)h2; }
    __device__ __forceinline__ const char* b_ptr(const Unit& u) const { return (const char*)(wgu + ((size_t)u.z * 512 + u.pn * BM) * ldb); } };
struct MoeProb2 { static constexpr bool GATHER = false; static constexpr int A_AUX = 16  ; const bf16_t* act; const bf16_t* wdn; MoeTab tb; int lda, ldb, K;
    __device__ __forceinline__ unsigned a_off(const Unit&, int R) const { return (unsigned)(R * lda) * 2u; }
    __device__ __forceinline__ const char* a_ptr(const Unit& u) const { return (const char*)(act + (size_t)tb.desc[u.pm * 8 + 4] * lda); }
    __device__ __forceinline__ const char* b_ptr(const Unit& u) const { return (const char*)(wdn + ((size_t)u.z * 1024 + u.pn * BM) * ldb); } };
struct EpiMoe1 { static constexpr bool PERM = true; static constexpr bool SIGNAL = true; bf16_t* act; const float* tokw; MoeTab tb; unsigned* flag;
    __device__ __forceinline__ bool keep(const Unit&) const { return false; }
    __device__ __forceinline__ bool sig_now(const Unit&) const { return true; }
    __device__ __forceinline__ void signal(const Unit& u) const {
        __hip_atomic_fetch_add(flag + (tb.desc[u.pm * 8 + 4] >> 8), 1u, __ATOMIC_RELAXED, __HIP_MEMORY_SCOPE_AGENT); }
    __device__ __forceinline__ void operator()(f32x4 (&acc)[2][2][4][2], const Unit& u, int wr, int wc, int fr, int fq) const {
        const int nvalid = tb.desc[u.pm * 8 + 3], arow0 = tb.desc[u.pm * 8 + 4];
        const int f0 = u.pn * HALF + wc * 32 + 8 * fq;
#pragma unroll
        for (int ai = 0; ai < 2; ++ai)
#pragma unroll
            for (int m = 0; m < 4; ++m) {
                const int r = ai * HALF + wr * 64 + m * 16 + fr;
                if (r < nvalid) {
                    const float w = tokw[tb.rowtab[u.pm * 256 + r]];
                    float v[8];
#pragma unroll
                    for (int e = 0; e < 4; ++e) { const float g0 = acc[ai][0][m][0][e], g1 = acc[ai][0][m][1][e];
                        v[e] = g0 * fsigmoid(g0) * acc[ai][1][m][0][e] * w; v[4 + e] = g1 * fsigmoid(g1) * acc[ai][1][m][1][e] * w; }
                    u32x4 o; o.x = cvtpk(v[0], v[1]); o.y = cvtpk(v[2], v[3]); o.z = cvtpk(v[4], v[5]); o.w = cvtpk(v[6], v[7]);
                    asm volatile("global_store_dwordx4 %0, %1, off sc1\n\ts_nop 1" :: "v"(act + (size_t)(arow0 + r) * FF + f0), "v"(o) : "memory"); } }
    } };
struct EpiMoe2 { static constexpr bool PERM = true; bf16_t* ys; MoeTab tb;
    __device__ __forceinline__ bool keep(const Unit&) const { return false; }
    __device__ __forceinline__ void operator()(f32x4 (&acc)[2][2][4][2], const Unit& u, int wr, int wc, int fr, int fq) const {
        const int nvalid = tb.desc[u.pm * 8 + 3];
#pragma unroll
        for (int ai = 0; ai < 2; ++ai)
#pragma unroll
            for (int m = 0; m < 4; ++m) {
                const int r = ai * HALF + wr * 64 + m * 16 + fr;
                if (r < nvalid) {
                    bf16_t* rowp = ys + (size_t)tb.rowtab[u.pm * 256 + r] * DM + u.pn * BM + wc * 32 + 8 * fq;
#pragma unroll
                    for (int bj = 0; bj < 2; ++bj) { const f32x4 v0 = acc[ai][bj][m][0], v1 = acc[ai][bj][m][1];
                        u32x4 o; o.x = cvtpk(v0[0], v0[1]); o.y = cvtpk(v0[2], v0[3]); o.z = cvtpk(v1[0], v1[1]); o.w = cvtpk(v1[2], v1[3]);
                        *(u32x4*)(rowp + bj * HALF) = o; } } }
    } };
}

struct TrItem { const float* W; bf16_t* WT; int ldw, ksrc0, ldt, kdst0, ndst0, kind, off, pad; };
__device__ __forceinline__ int tr_map(int kind, int off, int r) {
    if (kind == 0) return r - off;
    if (kind == 1) return r < MLA_IN ? r : (r < 768 ? -1 : r - 96);
    if (kind == 2) { const int h = r / QK, d = r % QK; if (d < NOPE) return r; const int i = (d - NOPE) >> 1, odd = (d - NOPE) & 1; return h * QK + NOPE + i + 16 * odd; }
    return ((r >> 8) << 7) + (r & 127);
}
__device__ __forceinline__ void tr_load(const TrItem& d, float (&v)[32], int lane) {
    const int n = lane & 31; const int sc = d.W ? tr_map(d.kind, d.off, d.ndst0 + n) : -1;
    const float* p = d.W + (size_t)(d.ksrc0 + (lane >> 5)) * d.ldw + (sc >= 0 ? sc : 0);
#pragma unroll
    for (int i = 0; i < 32; ++i) v[i] = (sc >= 0) ? p[(size_t)(2 * i) * d.ldw] : 0.f;
}
__device__ __forceinline__ void tr_store(const TrItem& d, const float (&v)[32], LAS float* scr, int lane) {
    const int n = lane & 31;
#pragma unroll
    for (int i = 0; i < 32; ++i) scr[(2 * i + (lane >> 5)) * 33 + n] = v[i];
    asm volatile("s_waitcnt lgkmcnt(0)" ::: "memory");
    const int c = lane & 7;
#pragma unroll
    for (int j = 0; j < 4; ++j) { const int nn = (lane >> 3) + 8 * j; const LAS float* s_ = scr + (8 * c) * 33 + nn;
        u32x4 o; o.x = cvtpk(s_[0 * 33], s_[1 * 33]); o.y = cvtpk(s_[2 * 33], s_[3 * 33]); o.z = cvtpk(s_[4 * 33], s_[5 * 33]); o.w = cvtpk(s_[6 * 33], s_[7 * 33]);
        *(u32x4*)(d.WT + (size_t)(d.ndst0 + nn) * d.ldt + d.kdst0 + 8 * c) = o; }
    asm volatile("s_waitcnt lgkmcnt(0)" ::: "memory");
}

constexpr size_t WO_IN = 0;
constexpr size_t WO_UQ = WO_IN + (size_t)4608 * 1024 * 2;
constexpr size_t WO_UKV = WO_UQ + (size_t)768 * 384 * 2;
constexpr size_t WO_LORA = WO_UKV + (size_t)1024 * 256 * 2;
constexpr size_t WO_OM = WO_LORA + (size_t)1536 * 256 * 2;
constexpr size_t WO_OR = WO_OM + (size_t)1024 * 512 * 2;
constexpr size_t WO_OUT = WO_OR + (size_t)1024 * 512 * 2;
constexpr size_t WO_GU = WO_OUT + (size_t)1024 * 1024 * 2;
constexpr size_t WO_DN = WO_GU + (size_t)32 * 512 * 1024 * 2;
constexpr size_t WO_END = WO_DN + (size_t)32 * 1024 * 256 * 2;
constexpr size_t WO_RH = WO_END;
constexpr size_t WO_RL = WO_RH + (size_t)48 * 1024 * 2;
static_assert(WO_RL + (size_t)48 * 1024 * 2 <= 64 * MiB, "weights region");
constexpr int TR_I_IN = 16 * 144, TR_I_UQ = 6 * 24, TR_I_UKV = 4 * 32, TR_I_LORA = 4 * 48, TR_I_OM = 8 * 32, TR_I_OR = 8 * 32, TR_I_OUT = 16 * 32, TR_I_GU = 32 * 16 * 16, TR_I_DN = 32 * 4 * 32;
constexpr int TR_NITEMS = TR_I_IN + TR_I_UQ + TR_I_UKV + TR_I_LORA + TR_I_OM + TR_I_OR + TR_I_OUT + TR_I_GU + TR_I_DN;
__device__ __forceinline__ TrItem tr_desc(const Ctx& C, int it) {
    bf16_t* wb = (bf16_t*)(C.ws + WS_W);
    TrItem d; d.kind = 0; d.off = 0; d.pad = 0;
    int r = it;
    if (r < TR_I_IN) { const int kb = r / 144, nb = r % 144; d.W = C.w_in; d.ldw = IN_W; d.ksrc0 = 64 * kb; d.WT = wb + WO_IN / 2; d.ldt = 1024; d.kdst0 = 64 * kb; d.ndst0 = 32 * nb; d.kind = 1; return d; } r -= TR_I_IN;
    if (r < TR_I_UQ) { const int kb = r / 24, nb = r % 24; d.W = C.w_uq; d.ldw = 768; d.ksrc0 = 64 * kb; d.WT = wb + WO_UQ / 2; d.ldt = QR; d.kdst0 = 64 * kb; d.ndst0 = 32 * nb; d.kind = 2; return d; } r -= TR_I_UQ;
    if (r < TR_I_UKV) { const int kb = r / 32, nb = r % 32; d.W = C.w_ukv; d.ldw = 1024; d.ksrc0 = 64 * kb; d.WT = wb + WO_UKV / 2; d.ldt = KVR; d.kdst0 = 64 * kb; d.ndst0 = 32 * nb; return d; } r -= TR_I_UKV;
    if (r < TR_I_LORA) { const int kb = r / 48, nb = r % 48;
        d.W = nullptr; d.ksrc0 = 0; d.ldw = RW;
        if (nb < 16) { if (kb == 0) d.W = C.w_dec; d.off = 0; }
        else if (nb < 32) { if (kb == 1) d.W = C.w_a; d.off = 512; }
        else { if (kb >= 2) { d.W = C.w_g; d.ksrc0 = 64 * (kb - 2); } d.off = 1024; }
        d.WT = wb + WO_LORA / 2; d.ldt = 256; d.kdst0 = 64 * kb; d.ndst0 = 32 * nb; return d; } r -= TR_I_LORA;
    if (r < TR_I_OM) { const int kb = r / 32, nb = r % 32; d.W = C.w_o_mla; d.ldw = DM; d.ksrc0 = 64 * kb; d.WT = wb + WO_OM / 2; d.ldt = RW; d.kdst0 = 64 * kb; d.ndst0 = 32 * nb; return d; } r -= TR_I_OM;
    if (r < TR_I_OR) { const int kb = r / 32, nb = r % 32; d.W = C.w_o_rwkv; d.ldw = DM; d.ksrc0 = 64 * kb; d.WT = wb + WO_OR / 2; d.ldt = RW; d.kdst0 = 64 * kb; d.ndst0 = 32 * nb; return d; } r -= TR_I_OR;
    if (r < TR_I_OUT) { const int kb = r / 32, nb = r % 32; d.W = C.w_out; d.ldw = DM; d.ksrc0 = 64 * kb; d.WT = wb + WO_OUT / 2; d.ldt = DM; d.kdst0 = 64 * kb; d.ndst0 = 32 * nb; return d; } r -= TR_I_OUT;
    if (r < TR_I_GU) { const int e = r / 256, q = r % 256, kb = q / 16, nb = q % 16;
        d.W = (((32 * nb) & 128) ? C.w_eu : C.w_eg) + (size_t)e * DM * FF; d.ldw = FF; d.ksrc0 = 64 * kb; d.WT = wb + WO_GU / 2 + (size_t)e * 512 * 1024; d.ldt = 1024; d.kdst0 = 64 * kb; d.ndst0 = 32 * nb; d.kind = 3; return d; } r -= TR_I_GU;
    { const int e = r / 128, q = r % 128, kb = q / 32, nb = q % 32;
      d.W = C.w_ed + (size_t)e * FF * DM; d.ldw = DM; d.ksrc0 = 64 * kb; d.WT = wb + WO_DN / 2 + (size_t)e * 1024 * 256; d.ldt = 256; d.kdst0 = 64 * kb; d.ndst0 = 32 * nb; return d; }
}


namespace att {
constexpr int KROW = 208, KBUF = 64 * KROW, VBUF = 8192, BUF = KBUF + VBUF;
typedef short v4i16_t __attribute__((ext_vector_type(4)));
__device__ __forceinline__ v4i16_t vtr(const LAS unsigned char* p) { return __builtin_amdgcn_ds_read_tr16_b64_v4i16((LAS v4i16_t*)p); }
__device__ __forceinline__ float hmax(float x) { auto rr = __builtin_amdgcn_permlane32_swap(__float_as_uint(x), __float_as_uint(x), false, false); return fmaxf(__uint_as_float(rr[0]), __uint_as_float(rr[1])); }
__device__ __forceinline__ float hsum(float x) { auto rr = __builtin_amdgcn_permlane32_swap(__float_as_uint(x), __float_as_uint(x), false, false); return __uint_as_float(rr[0]) + __uint_as_float(rr[1]); }

__device__ __forceinline__ void attn_unit(const Ctx& C, LAS unsigned char* lds, int bh, int qb, int tid, int lane, int wave) {
    const int r32 = lane & 31, hi = lane >> 5;
    const bf16_t* qf = (const bf16_t*)(C.ws + WS_QF) + ((size_t)bh * SEQ + qb * 256 + wave * 32 + r32) * QK;
    const unsigned char* kbase = (const unsigned char*)((const bf16_t*)(C.ws + WS_KF) + (size_t)bh * SEQ * QK);
    const unsigned char* vbase = (const unsigned char*)((const bf16_t*)(C.ws + WS_VF) + (size_t)bh * SEQ * VD);
    bf16x8 qr[6];
#pragma unroll
    for (int s = 0; s < 6; ++s) qr[s] = *(const bf16x8*)(qf + 16 * s + 8 * hi);
    const int kc1 = 512 + tid;
    const int koff0 = (tid / 12) * KROW + (tid % 12) * 16, koff1 = (kc1 / 12) * KROW + (kc1 % 12) * 16;
    const int vkey = tid >> 3, vj = tid & 7;
    const int voff = KBUF + (vj >> 2) * 4096 + (vkey >> 4) * 1024 + (vkey & 15) * 64 + (vj & 3) * 16;
    const int NT = 4 * qb + 4, cw = 4 * qb + (wave >> 1);
    const bool has_k1 = tid < 256;
    u32x4 k0r, k1r = {0u, 0u, 0u, 0u}, v0r;
    k0r = *(const u32x4*)(kbase + (size_t)tid * 16); if (has_k1) k1r = *(const u32x4*)(kbase + (size_t)kc1 * 16); v0r = *(const u32x4*)(vbase + (size_t)tid * 16);
    *(LAS u32x4*)(lds + koff0) = k0r; if (has_k1) *(LAS u32x4*)(lds + koff1) = k1r; *(LAS u32x4*)(lds + voff) = v0r;
    if (NT > 1) { k0r = *(const u32x4*)(kbase + 12288 + (size_t)tid * 16); if (has_k1) k1r = *(const u32x4*)(kbase + 12288 + (size_t)kc1 * 16); v0r = *(const u32x4*)(vbase + 8192 + (size_t)tid * 16); }
    __syncthreads();
    f32x16 o0, o1, negm;
#pragma unroll
    for (int r = 0; r < 16; ++r) { o0[r] = 0.f; o1[r] = 0.f; negm[r] = 0.f; }
    float m = 0.f, l = 0.f;
    const int kfrag = r32 * KROW + hi * 16;
    const int vfrag = KBUF + ((lane >> 4) & 1) * 32 + (lane & 3) * 8 + (4 * hi + ((lane & 15) >> 2)) * 64;
    for (int t = 0; t < NT; ++t) {
        const LAS unsigned char* cur = lds + (t & 1) * BUF;
        if (t + 1 < NT) { LAS unsigned char* nb = lds + ((t + 1) & 1) * BUF;
            *(LAS u32x4*)(nb + koff0) = k0r; if (has_k1) *(LAS u32x4*)(nb + koff1) = k1r; *(LAS u32x4*)(nb + voff) = v0r; }
        if (t + 2 < NT) { const unsigned char* kb = kbase + (size_t)(t + 2) * 12288; const unsigned char* vb = vbase + (size_t)(t + 2) * 8192;
            k0r = *(const u32x4*)(kb + (size_t)tid * 16); if (has_k1) k1r = *(const u32x4*)(kb + (size_t)kc1 * 16); v0r = *(const u32x4*)(vb + (size_t)tid * 16); }
        if (t <= cw) {
            f32x16 p0, p1;
            const LAS unsigned char* kp = cur + kfrag;
#pragma unroll
            for (int s = 0; s < 6; ++s) {
                const bf16x8 a0 = *(const LAS bf16x8*)(kp + s * 32), a1 = *(const LAS bf16x8*)(kp + 32 * KROW + s * 32);
                if (s == 0) { p0 = __builtin_amdgcn_mfma_f32_32x32x16_bf16(a0, qr[0], negm, 0, 0, 0); p1 = __builtin_amdgcn_mfma_f32_32x32x16_bf16(a1, qr[0], negm, 0, 0, 0); }
                else { p0 = __builtin_amdgcn_mfma_f32_32x32x16_bf16(a0, qr[s], p0, 0, 0, 0); p1 = __builtin_amdgcn_mfma_f32_32x32x16_bf16(a1, qr[s], p1, 0, 0, 0); }
            }
            float mx = fmaxf(fmaxf(p0[0], p1[0]), fmaxf(p0[1], p1[1]));
#pragma unroll
            for (int r = 2; r < 16; r += 2) mx = fmaxf(mx, fmaxf(fmaxf(p0[r], p1[r]), fmaxf(p0[r + 1], p1[r + 1])));
            mx = hmax(mx);
            if (t == 0) {
                m = mx;
#pragma unroll
                for (int r = 0; r < 16; ++r) { p0[r] -= mx; p1[r] -= mx; negm[r] = -mx; }
            } else if (__any(mx > 8.0f)) {
                const float dl = fmaxf(mx, 0.f), alpha = __builtin_amdgcn_exp2f(-dl);
                m += dl; l *= alpha;
#pragma unroll
                for (int r = 0; r < 16; ++r) { p0[r] -= dl; p1[r] -= dl; o0[r] *= alpha; o1[r] *= alpha; negm[r] = -m; }
            }
            float ps0 = 0.f, ps1 = 0.f;
#pragma unroll
            for (int r = 0; r < 16; ++r) { p0[r] = __builtin_amdgcn_exp2f(p0[r]); p1[r] = __builtin_amdgcn_exp2f(p1[r]); ps0 += p0[r]; ps1 += p1[r]; }
            l += ps0 + ps1;
            u32x4 pw0, pw1, pw2, pw3;
            pw0 = (u32x4){cvtpk(p0[0], p0[1]), cvtpk(p0[2], p0[3]), cvtpk(p0[4], p0[5]), cvtpk(p0[6], p0[7])};
            pw1 = (u32x4){cvtpk(p0[8], p0[9]), cvtpk(p0[10], p0[11]), cvtpk(p0[12], p0[13]), cvtpk(p0[14], p0[15])};
            pw2 = (u32x4){cvtpk(p1[0], p1[1]), cvtpk(p1[2], p1[3]), cvtpk(p1[4], p1[5]), cvtpk(p1[6], p1[7])};
            pw3 = (u32x4){cvtpk(p1[8], p1[9]), cvtpk(p1[10], p1[11]), cvtpk(p1[12], p1[13]), cvtpk(p1[14], p1[15])};
            const LAS unsigned char* vp = cur + vfrag;
#define ATT_PV(OD, D0, KS, PW) do { const v4i16_t lo_ = vtr(vp + (D0) * 4096 + (KS) * 1024), hi_ = vtr(vp + (D0) * 4096 + (KS) * 1024 + 512); \
                const bf16x8 vf_ = {lo_[0], lo_[1], lo_[2], lo_[3], hi_[0], hi_[1], hi_[2], hi_[3]}; \
                OD = __builtin_amdgcn_mfma_f32_32x32x16_bf16(vf_, __builtin_bit_cast(bf16x8, PW), OD, 0, 0, 0); } while (0)
            ATT_PV(o0, 0, 0, pw0); ATT_PV(o1, 1, 0, pw0); ATT_PV(o0, 0, 1, pw1); ATT_PV(o1, 1, 1, pw1);
            ATT_PV(o0, 0, 2, pw2); ATT_PV(o1, 1, 2, pw2); ATT_PV(o0, 0, 3, pw3); ATT_PV(o1, 1, 3, pw3);
#undef ATT_PV
        }
        asm volatile("s_waitcnt lgkmcnt(0)" ::: "memory"); __builtin_amdgcn_s_barrier(); asm volatile("" ::: "memory");
    }
    const float rl = 1.f / hsum(l);
    const int b = bh / NH, h = bh - b * NH;
    bf16_t* op = (bf16_t*)(C.ws + WS_ATT) + ((size_t)b * SEQ + qb * 256 + wave * 32 + r32) * RW + h * VD + 4 * hi;
#pragma unroll
    for (int g = 0; g < 4; ++g) {
        u32x2 w0, w1;
        w0.x = cvtpk(o0[4 * g] * rl, o0[4 * g + 1] * rl); w0.y = cvtpk(o0[4 * g + 2] * rl, o0[4 * g + 3] * rl);
        w1.x = cvtpk(o1[4 * g] * rl, o1[4 * g + 1] * rl); w1.y = cvtpk(o1[4 * g + 2] * rl, o1[4 * g + 3] * rl);
        *(u32x2*)(op + 8 * g) = w0; *(u32x2*)(op + 32 + 8 * g) = w1;
    }
}
__device__ __forceinline__ void attn_phase(const Ctx& C, LAS unsigned char* lds, int G, int bx, int tid, int lane, int wave) {
    const int v0 = (G % 8 == 0) ? (bx % 8) * (G / 8) + bx / 8 : bx;
    for (int v = v0; v < 256; v += G) {
        const int bh = v >> 1, odd = v & 1;
#pragma unroll 1
        for (int i = 0; i < 4; ++i) {
            const int qb = (i == 0) ? 7 - odd : (i == 1) ? odd : (i == 2) ? 4 + odd : 3 - odd;
            attn_unit(C, lds, bh, qb, tid, lane, wave);
        }
    }
}
}


namespace cscan {
constexpr int CH = 32, NCH = SEQ / CH;
constexpr int RS = 144;
constexpr int RS2 = 80;
constexpr int L_AT = 0, L_BT = 4608, L_RT = 9216, L_KT = 13824, L_BTV = 18432, L_VV = 22528, L_MAB = 26624, L_MAK = 30720, L_GC = 34816, L_MBRT = 35072, L_WAVE = 37632;
constexpr int L_P = L_AT, L_MAKT = L_MAK;
typedef short v4i16_t __attribute__((ext_vector_type(4)));
typedef float f32x2s __attribute__((ext_vector_type(2)));
#define CS_MF(a, b, c) __builtin_amdgcn_mfma_f32_32x32x16_bf16(a, b, c, 0, 0, 0)
template <int CTRL> __device__ __forceinline__ float dpp_add(float x) { return x + __builtin_bit_cast(float, __builtin_amdgcn_update_dpp(0, __builtin_bit_cast(int, x), CTRL, 0xf, 0xf, true)); }
__device__ __forceinline__ float wsum(float x) {
    x = dpp_add<0xB1>(x); x = dpp_add<0x4E>(x); x = dpp_add<0x141>(x); x = dpp_add<0x140>(x);
    x += __builtin_bit_cast(float, __builtin_amdgcn_update_dpp(0, __builtin_bit_cast(int, x), 0x142, 0xa, 0xf, false));
    x += __builtin_bit_cast(float, __builtin_amdgcn_update_dpp(0, __builtin_bit_cast(int, x), 0x143, 0xc, 0xf, false));
    return __builtin_bit_cast(float, __builtin_amdgcn_readlane(__builtin_bit_cast(int, x), 63));
}
__device__ __forceinline__ int crow(int r, int hi) { return (r & 3) + 8 * (r >> 2) + 4 * hi; }
__device__ __forceinline__ bf16x8 pack8(const f32x16& p, int s) {
    u32x4 w; w.x = cvtpk(p[8 * s], p[8 * s + 1]); w.y = cvtpk(p[8 * s + 2], p[8 * s + 3]); w.z = cvtpk(p[8 * s + 4], p[8 * s + 5]); w.w = cvtpk(p[8 * s + 6], p[8 * s + 7]);
    return __builtin_bit_cast(bf16x8, w); }
__device__ __forceinline__ bf16x8 rd_nat(const LAS unsigned char* p) { return *(const LAS bf16x8*)p; }
__device__ __forceinline__ bf16x8 rd_perm(const LAS unsigned char* p) { const u32x2 a = *(const LAS u32x2*)p, b = *(const LAS u32x2*)(p + 16);
    u32x4 w; w.x = a.x; w.y = a.y; w.z = b.x; w.w = b.y; return __builtin_bit_cast(bf16x8, w); }
__device__ __forceinline__ bf16x8 rd_tr(const LAS unsigned char* p) { const v4i16_t lo = __builtin_amdgcn_ds_read_tr16_b64_v4i16((LAS v4i16_t*)p), hi = __builtin_amdgcn_ds_read_tr16_b64_v4i16((LAS v4i16_t*)(p + 512));
    return (bf16x8){lo[0], lo[1], lo[2], lo[3], hi[0], hi[1], hi[2], hi[3]}; }
__device__ __forceinline__ float bfl(unsigned w) { return __uint_as_float(w << 16); }
__device__ __forceinline__ float bfh(unsigned w) { return __uint_as_float(w & 0xffff0000u); }

#define CS_BAR() do { asm volatile("s_waitcnt lgkmcnt(0)" ::: "memory"); __builtin_amdgcn_s_barrier(); asm volatile("" ::: "memory"); } while (0)
__device__ __forceinline__ void pair_bar(LAS unsigned* cnt, unsigned& ord, int lane) {
    asm volatile("s_waitcnt lgkmcnt(0)" ::: "memory");
    ord += 2u;
    if (lane == 0) __hip_atomic_fetch_add(cnt, 1u, __ATOMIC_RELAXED, __HIP_MEMORY_SCOPE_WORKGROUP);
    for (unsigned spins = 0; spins < (1u << 22); ++spins) {
        const unsigned v = __builtin_amdgcn_readfirstlane(__hip_atomic_load(cnt, __ATOMIC_RELAXED, __HIP_MEMORY_SCOPE_WORKGROUP));
        if ((int)(v - ord) >= 0) break;
        __builtin_amdgcn_s_sleep(1);
    }
    asm volatile("" ::: "memory");
}
struct RawRegs { u32x4 r[2], k[2], v[2], a[2], e[2], rp, kp, vp; };
__device__ __forceinline__ void rawLoad(const Ctx& C, RawRegs& R, int task, int lane, int role) {
    const int c = task & (NCH - 1), bh = task >> 6, b = bh / NH, h = bh - b * NH;
    const size_t trow0 = (size_t)b * SEQ + (size_t)c * CH + 16 * role + (lane >> 3);
    const bf16_t* rkv = (const bf16_t*)(C.ws + WS_RKV) + trow0 * 1536 + h * 64 + (lane & 7) * 8;
    const bf16_t* av = (const bf16_t*)(C.ws + WS_AV) + trow0 * RW + h * 64 + (lane & 7) * 8;
    const bf16_t* eb = (const bf16_t*)(C.ws + WS_EBUF) + trow0 * RW + h * 64 + (lane & 7) * 8;
#pragma unroll
    for (int q = 0; q < 2; ++q) { R.r[q] = *(const u32x4*)(rkv + (size_t)q * 8 * 1536); R.k[q] = *(const u32x4*)(rkv + (size_t)q * 8 * 1536 + 512); R.v[q] = *(const u32x4*)(rkv + (size_t)q * 8 * 1536 + 1024);
        R.a[q] = *(const u32x4*)(av + (size_t)q * 8 * RW); R.e[q] = *(const u32x4*)(eb + (size_t)q * 8 * RW); }
    if (c * CH + 16 * role > 0) { const bf16_t* pv = (const bf16_t*)(C.ws + WS_RKV) + ((size_t)b * SEQ + (size_t)c * CH + 16 * role - 1) * 1536 + h * 64 + (lane & 7) * 8;
        R.rp = *(const u32x4*)pv; R.kp = *(const u32x4*)(pv + 512); R.vp = *(const u32x4*)(pv + 1024); }
    else { R.rp = (u32x4){0u, 0u, 0u, 0u}; R.kp = R.rp; R.vp = R.rp; }
}
__device__ __forceinline__ void taskA(const Ctx& C, LAS unsigned char* L, int task, int lane, int role, bool valid, RawRegs& R, int next_task, bool next_valid, LAS unsigned* pcnt, unsigned& pord) {
    asm volatile("" : "+v"(lane));
    const int c = task & (NCH - 1), bh = task >> 6, b = bh / NH, h = bh - b * NH;
    const int r32 = lane & 31, hi = lane >> 5;
    const size_t trow0 = (size_t)b * SEQ + (size_t)c * CH;
    if (valid) {
        const int jg = lane & 7;
        const float4 kw0 = *(const float4*)(C.k_k + h * 64 + 8 * jg), kw1 = *(const float4*)(C.k_k + h * 64 + 8 * jg + 4), ka0 = *(const float4*)(C.k_a + h * 64 + 8 * jg), ka1 = *(const float4*)(C.k_a + h * 64 + 8 * jg + 4);
        const float4 rk0 = *(const float4*)(C.r_k + h * 64 + 8 * jg), rk1 = *(const float4*)(C.r_k + h * 64 + 8 * jg + 4);
        const float kkw[8] = {kw0.x, kw0.y, kw0.z, kw0.w, kw1.x, kw1.y, kw1.z, kw1.w}, kaw[8] = {ka0.x, ka0.y, ka0.z, ka0.w, ka1.x, ka1.y, ka1.z, ka1.w};
        const float rkw[8] = {rk0.x, rk0.y, rk0.z, rk0.w, rk1.x, rk1.y, rk1.z, rk1.w};
        float* bonus = (float*)(C.ws + WS_BONUS) + trow0 * NH + h;
        {
            const int src = ((lane - 8) & 63) * 4; const bool top = lane >= 56;
#define CS_SHIFT(X_, P_, MU_) do { const float4 ma_ = *(const float4*)(C.mu + (MU_) + h * 64 + 8 * jg), mb_ = *(const float4*)(C.mu + (MU_) + h * 64 + 8 * jg + 4); \
            const float mm_[8] = {ma_.x, ma_.y, ma_.z, ma_.w, mb_.x, mb_.y, mb_.z, mb_.w}; \
            _Pragma("unroll") for (int q = 1; q >= 0; --q) _Pragma("unroll") for (int e = 0; e < 4; ++e) { \
                const unsigned y_ = top ? (q ? X_[0][e] : P_[e]) : X_[q][e]; \
                const unsigned p_ = (unsigned)__builtin_amdgcn_ds_bpermute(src, (int)y_); \
                const float z0_ = bfl(X_[q][e]), z1_ = bfh(X_[q][e]), p0_ = bfl(p_), p1_ = bfh(p_); \
                X_[q][e] = cvtpk(z0_ + (p0_ - z0_) * mm_[2 * e], z1_ + (p1_ - z1_) * mm_[2 * e + 1]); } } while (0)
            CS_SHIFT(R.r, R.rp, 0); CS_SHIFT(R.k, R.kp, RW); CS_SHIFT(R.v, R.vp, 2 * RW);
#undef CS_SHIFT
        }
#pragma unroll
        for (int q = 0; q < 2; ++q) { const int t = 16 * role + 8 * q + (lane >> 3);
            float kf[8], rf[8], af[8], kk0[8], kp[8];
#pragma unroll
            for (int e = 0; e < 4; ++e) { kf[2 * e] = bfl(R.k[q][e]); kf[2 * e + 1] = bfh(R.k[q][e]); rf[2 * e] = bfl(R.r[q][e]); rf[2 * e + 1] = bfh(R.r[q][e]); af[2 * e] = bfl(R.a[q][e]); af[2 * e + 1] = bfh(R.a[q][e]); }
            float n2 = 0.f, bn = 0.f;
#pragma unroll
            for (int e = 0; e < 8; ++e) { kk0[e] = kf[e] * kkw[e]; n2 += kk0[e] * kk0[e]; kp[e] = kf[e] * (1.f + (af[e] - 1.f) * kaw[e]); bn += rf[e] * kp[e] * rkw[e]; }
            n2 = sum8_dpp(n2); bn = sum8_dpp(bn);
            const float rn = __builtin_amdgcn_rsqf(fmaxf(n2, 1e-24f));
            u32x4 wkk, wkp;
            wkk.x = cvtpk(kk0[0] * rn, kk0[1] * rn); wkk.y = cvtpk(kk0[2] * rn, kk0[3] * rn); wkk.z = cvtpk(kk0[4] * rn, kk0[5] * rn); wkk.w = cvtpk(kk0[6] * rn, kk0[7] * rn);
            wkp.x = cvtpk(kp[0], kp[1]); wkp.y = cvtpk(kp[2], kp[3]); wkp.z = cvtpk(kp[4], kp[5]); wkp.w = cvtpk(kp[6], kp[7]);
            if (jg == 0) bonus[(size_t)t * NH] = bn;
            *(LAS u32x4*)(L + L_RT + t * RS + jg * 16) = R.r[q]; *(LAS u32x4*)(L + L_KT + t * RS + jg * 16) = wkp; *(LAS u32x4*)(L + L_AT + t * RS + jg * 16) = wkk;
            *(LAS u32x4*)(L + L_MAK + t * 128 + jg * 16) = R.a[q]; *(LAS u32x4*)(L + L_MAB + t * 128 + jg * 16) = R.e[q];
            *(LAS u32x4*)(L + L_VV + (jg >> 2) * 2048 + (t >> 4) * 1024 + (t & 15) * 64 + (jg & 3) * 16) = R.v[q]; }
    }
    if (next_valid) rawLoad(C, R, next_task, lane, role);
    pair_bar(pcnt, pord, lane);
    if (valid) {
        float Lc = 0.f;
        if (role == 1) {
#pragma unroll
            for (int t = 0; t < 16; ++t) Lc -= bf2f(*(const LAS bf16_t*)(L + L_MAB + t * 128 + lane * 2)); }
        float gprev = __expf(Lc);
        const int vbase = (lane >> 5) * 2048 + (lane & 31) * 2;
#pragma unroll 4
        for (int tt = 0; tt < 16; ++tt) {
            const int t = 16 * role + tt; const int ro = t * RS + lane * 2;
            const float r = bf2f(*(const LAS bf16_t*)(L + L_RT + ro)), kp = bf2f(*(const LAS bf16_t*)(L + L_KT + ro)), kk = bf2f(*(const LAS bf16_t*)(L + L_AT + ro));
            const float a = bf2f(*(const LAS bf16_t*)(L + L_MAK + t * 128 + lane * 2)), e = bf2f(*(const LAS bf16_t*)(L + L_MAB + t * 128 + lane * 2));
            Lc -= e; const float gam = __expf(Lc), ginv = __expf(-Lc);
            const unsigned w1 = cvtpk(-kk * gprev, r * gam), w2 = cvtpk(kp * ginv, kk * a * ginv);
            *(LAS bf16_t*)(L + L_AT + ro) = (bf16_t)w1; *(LAS bf16_t*)(L + L_RT + ro) = (bf16_t)(w1 >> 16); *(LAS bf16_t*)(L + L_KT + ro) = (bf16_t)w2;
            *(LAS bf16_t*)(L + L_BT + ro) = (bf16_t)(w2 >> 16); *(LAS bf16_t*)(L + L_BTV + vbase + (t >> 4) * 1024 + (t & 15) * 64) = (bf16_t)(w2 >> 16);
            gprev = gam;
        }
        if (role == 1) *(LAS float*)(L + L_GC + lane * 4) = gprev;
    }
    pair_bar(pcnt, pord, lane);
    f32x16 mkr;
#pragma unroll
    for (int q = 0; q < 16; ++q) mkr[q] = 0.f;
    if (valid) {
        f32x16 m0;
#pragma unroll
        for (int q = 0; q < 16; ++q) m0[q] = 0.f;
        const int bt_ = role == 0 ? L_AT : L_RT;
#pragma unroll
        for (int s_ = 0; s_ < 4; ++s_) {
            const int ko = r32 * RS + (16 * s_ + 8 * hi) * 2;
            const bf16x8 aB = rd_nat(L + L_BT + ko), aK = rd_nat(L + L_KT + ko), bX = rd_nat(L + bt_ + ko);
            m0 = CS_MF(aB, bX, m0); mkr = CS_MF(aK, bX, mkr);
        }
        const float base_ = (float)(r32 - 4 * hi) + (role == 0 ? 0.f : 1.f);
#pragma unroll
        for (int q = 0; q < 16; ++q) { const float mk_ = __builtin_amdgcn_fmed3f(base_ - (float)((q & 3) + 8 * (q >> 2)), 0.f, 1.f); m0[q] *= mk_; mkr[q] *= mk_; }
        if (role == 0) {
#pragma unroll
            for (int g = 0; g < 4; ++g) {
                *(LAS f32x4*)(L + L_MAB + r32 * 128 + (8 * g + 4 * hi) * 4) = (f32x4){m0[4 * g], m0[4 * g + 1], m0[4 * g + 2], m0[4 * g + 3]};
                *(LAS f32x4*)(L + L_MAK + r32 * 128 + (8 * g + 4 * hi) * 4) = (f32x4){mkr[4 * g], mkr[4 * g + 1], mkr[4 * g + 2], mkr[4 * g + 3]}; }
        } else {
#pragma unroll
            for (int g = 0; g < 4; ++g) { u32x2 w; w.x = cvtpk(m0[4 * g], m0[4 * g + 1]); w.y = cvtpk(m0[4 * g + 2], m0[4 * g + 3]);
                *(LAS u32x2*)(L + L_MBRT + r32 * RS2 + (8 * g + 4 * hi) * 2) = w; }
        }
    }
    pair_bar(pcnt, pord, lane);
    if (valid) {
        float xa[16], xb[16];
#pragma unroll
        for (int t = 0; t < 16; ++t) { xa[t] = 0.f; xb[t] = 0.f; }
#pragma unroll
        for (int t = 0; t < 16; ++t) {
            float ap = role == 0 ? bf2f(*(const LAS bf16_t*)(L + L_AT + t * RS + lane * 2)) : *(const LAS float*)(L + L_MAK + t * 128 + r32 * 4);
            float aq = 0.f;
#pragma unroll
            for (int i4 = 0; i4 < (t + 3) / 4; ++i4) { const f32x4 m4 = *(const LAS f32x4*)(L + L_MAB + t * 128 + i4 * 16);
                ap += xa[4 * i4] * m4[0]; aq += xa[4 * i4 + 1] * m4[1]; ap += xa[4 * i4 + 2] * m4[2]; aq += xa[4 * i4 + 3] * m4[3]; }
            xa[t] = ap + aq;
            asm volatile("" : "+v"(xa[t]) :: "memory");
        }
#pragma unroll
        for (int t = 0; t < 16; ++t) {
            float ap = role == 0 ? bf2f(*(const LAS bf16_t*)(L + L_AT + (16 + t) * RS + lane * 2)) : *(const LAS float*)(L + L_MAK + (16 + t) * 128 + r32 * 4);
            float aq = 0.f;
#pragma unroll
            for (int i4 = 0; i4 < 4; ++i4) { const f32x4 m4 = *(const LAS f32x4*)(L + L_MAB + (16 + t) * 128 + i4 * 16);
                ap += xa[4 * i4] * m4[0]; aq += xa[4 * i4 + 1] * m4[1]; ap += xa[4 * i4 + 2] * m4[2]; aq += xa[4 * i4 + 3] * m4[3]; }
#pragma unroll
            for (int i4 = 0; i4 < (t + 3) / 4; ++i4) { const f32x4 m4 = *(const LAS f32x4*)(L + L_MAB + (16 + t) * 128 + 64 + i4 * 16);
                ap += xb[4 * i4] * m4[0]; aq += xb[4 * i4 + 1] * m4[1]; ap += xb[4 * i4 + 2] * m4[2]; aq += xb[4 * i4 + 3] * m4[3]; }
            xb[t] = ap + aq;
            asm volatile("" : "+v"(xb[t]) :: "memory");
        }
        u32x4 w0, w1, w2, w3;
        w0.x = cvtpk(xa[0], xa[1]); w0.y = cvtpk(xa[2], xa[3]); w0.z = cvtpk(xa[4], xa[5]); w0.w = cvtpk(xa[6], xa[7]);
        w1.x = cvtpk(xa[8], xa[9]); w1.y = cvtpk(xa[10], xa[11]); w1.z = cvtpk(xa[12], xa[13]); w1.w = cvtpk(xa[14], xa[15]);
        w2.x = cvtpk(xb[0], xb[1]); w2.y = cvtpk(xb[2], xb[3]); w2.z = cvtpk(xb[4], xb[5]); w2.w = cvtpk(xb[6], xb[7]);
        w3.x = cvtpk(xb[8], xb[9]); w3.y = cvtpk(xb[10], xb[11]); w3.z = cvtpk(xb[12], xb[13]); w3.w = cvtpk(xb[14], xb[15]);
        if (role == 0) { LAS u32x4* d = (LAS u32x4*)(L + L_P + lane * RS2); d[0] = w0; d[1] = w1; d[2] = w2; d[3] = w3; }
        else if (hi == 0) { LAS u32x4* d = (LAS u32x4*)(L + L_MAKT + r32 * RS2); d[0] = w0; d[1] = w1; d[2] = w2; d[3] = w3; }
    }
    pair_bar(pcnt, pord, lane);
    if (valid) {
        const int trf = ((lane >> 4) & 1) * 32 + (lane & 3) * 8 + (4 * hi + ((lane & 15) >> 2)) * 64;
        if (role == 0) {
            bf16_t* gQT = (bf16_t*)(C.ws + WS_CQT) + (size_t)task * (CH * 64);
            bf16_t* gGT = (bf16_t*)(C.ws + WS_CGT) + (size_t)task * (64 * 64);
            {
                f32x16 q0, q1;
#pragma unroll
                for (int q = 0; q < 16; ++q) { q0[q] = 0.f; q1[q] = 0.f; }
#pragma unroll
                for (int s_ = 0; s_ < 2; ++s_) { const int ko = (16 * s_ + 8 * hi) * 2; const bf16x8 bM = rd_nat(L + L_MBRT + r32 * RS2 + ko);
                    q0 = CS_MF(rd_nat(L + L_P + r32 * RS2 + ko), bM, q0); q1 = CS_MF(rd_nat(L + L_P + (32 + r32) * RS2 + ko), bM, q1); }
#pragma unroll
                for (int g = 0; g < 4; ++g) {
                    const u32x2 ra = *(const LAS u32x2*)(L + L_RT + r32 * RS + (8 * g + 4 * hi) * 2), rb = *(const LAS u32x2*)(L + L_RT + r32 * RS + (32 + 8 * g + 4 * hi) * 2);
                    u32x2 w0, w1;
                    w0.x = cvtpk(q0[4 * g] + bfl(ra.x), q0[4 * g + 1] + bfh(ra.x)); w0.y = cvtpk(q0[4 * g + 2] + bfl(ra.y), q0[4 * g + 3] + bfh(ra.y));
                    w1.x = cvtpk(q1[4 * g] + bfl(rb.x), q1[4 * g + 1] + bfh(rb.x)); w1.y = cvtpk(q1[4 * g + 2] + bfl(rb.y), q1[4 * g + 3] + bfh(rb.y));
                    *(u32x2*)(gQT + r32 * 64 + 8 * g + 4 * hi) = w0; *(u32x2*)(gQT + r32 * 64 + 32 + 8 * g + 4 * hi) = w1; }
            }
            __builtin_amdgcn_sched_barrier(0);
#define CS_G(N_) do { const float gc_ = *(const LAS float*)(L + L_GC + ((N_) * 32 + r32) * 4); \
                f32x16 ga_, gb_; _Pragma("unroll") for (int q = 0; q < 16; ++q) { ga_[q] = 0.f; gb_[q] = 0.f; } \
                _Pragma("unroll") for (int s_ = 0; s_ < 2; ++s_) { const int ko = (16 * s_ + 4 * hi) * 2; const bf16x8 bb_ = rd_tr(L + L_BTV + trf + (N_) * 2048 + s_ * 1024); \
                    ga_ = CS_MF(rd_perm(L + L_P + r32 * RS2 + ko), bb_, ga_); gb_ = CS_MF(rd_perm(L + L_P + (32 + r32) * RS2 + ko), bb_, gb_); } \
                { const float base_ = (float)(r32 - 4 * hi); \
                _Pragma("unroll") for (int q = 0; q < 16; ++q) { const float dl_ = __builtin_amdgcn_fmed3f(1.f - __builtin_fabsf(base_ - (float)((q & 3) + 8 * (q >> 2))), 0.f, 1.f); \
                    ga_[q] = (ga_[q] + ((N_) == 0 ? dl_ : 0.f)) * gc_; gb_[q] = (gb_[q] + ((N_) == 1 ? dl_ : 0.f)) * gc_; } } \
                _Pragma("unroll") for (int g = 0; g < 4; ++g) { u32x2 w; \
                    w.x = cvtpk(ga_[4 * g], ga_[4 * g + 1]); w.y = cvtpk(ga_[4 * g + 2], ga_[4 * g + 3]); *(u32x2*)(gGT + ((N_) * 32 + r32) * 64 + 8 * g + 4 * hi) = w; \
                    w.x = cvtpk(gb_[4 * g], gb_[4 * g + 1]); w.y = cvtpk(gb_[4 * g + 2], gb_[4 * g + 3]); *(u32x2*)(gGT + ((N_) * 32 + r32) * 64 + 32 + 8 * g + 4 * hi) = w; } \
                __builtin_amdgcn_sched_barrier(0); } while (0)
            CS_G(0); CS_G(1);
#undef CS_G
        } else {
            bf16_t* gHT = (bf16_t*)(C.ws + WS_CHT) + (size_t)task * (64 * 64);
            bf16_t* gYL = (bf16_t*)(C.ws + WS_CYL) + (size_t)task * (64 * CH);
            f32x16 z = mkr, x0, x1;
#pragma unroll
            for (int s_ = 0; s_ < 2; ++s_) { const int ko = (16 * s_ + 8 * hi) * 2;
                z = CS_MF(rd_nat(L + L_MAKT + r32 * RS2 + ko), rd_nat(L + L_MBRT + r32 * RS2 + ko), z); }
#define CS_X(N_, XN_) do { const float gc_ = *(const LAS float*)(L + L_GC + ((N_) * 32 + r32) * 4); \
                _Pragma("unroll") for (int q = 0; q < 16; ++q) XN_[q] = 0.f; \
                _Pragma("unroll") for (int s_ = 0; s_ < 2; ++s_) { const int ko = (16 * s_ + 4 * hi) * 2; \
                    XN_ = CS_MF(rd_perm(L + L_MAKT + r32 * RS2 + ko), rd_tr(L + L_BTV + trf + (N_) * 2048 + s_ * 1024), XN_); } \
                { const LAS unsigned char* kb_ = L + L_KT + 4 * hi * RS + ((N_) * 32 + r32) * 2; \
                _Pragma("unroll") for (int q = 0; q < 16; ++q) XN_[q] = (XN_[q] + bf2f(*(const LAS bf16_t*)(kb_ + ((q & 3) + 8 * (q >> 2)) * RS))) * gc_; } } while (0)
            CS_X(0, x0); CS_X(1, x1);
#undef CS_X
            const bf16x8 ax00 = pack8(x0, 0), ax01 = pack8(x0, 1), ax10 = pack8(x1, 0), ax11 = pack8(x1, 1), az0 = pack8(z, 0), az1 = pack8(z, 1);
#define CS_HY(N_) do { \
                f32x16 ha_, hb_, yy_; _Pragma("unroll") for (int q = 0; q < 16; ++q) { ha_[q] = 0.f; hb_[q] = 0.f; yy_[q] = 0.f; } \
                const bf16x8 va_ = rd_tr(L + L_VV + trf + (N_) * 2048), vb_ = rd_tr(L + L_VV + trf + (N_) * 2048 + 1024); \
                ha_ = CS_MF(ax00, va_, ha_); ha_ = CS_MF(ax01, vb_, ha_); hb_ = CS_MF(ax10, va_, hb_); hb_ = CS_MF(ax11, vb_, hb_); yy_ = CS_MF(az0, va_, yy_); yy_ = CS_MF(az1, vb_, yy_); \
                _Pragma("unroll") for (int g = 0; g < 4; ++g) { u32x2 w; \
                    w.x = cvtpk(ha_[4 * g], ha_[4 * g + 1]); w.y = cvtpk(ha_[4 * g + 2], ha_[4 * g + 3]); *(u32x2*)(gHT + ((N_) * 32 + r32) * 64 + 8 * g + 4 * hi) = w; \
                    w.x = cvtpk(hb_[4 * g], hb_[4 * g + 1]); w.y = cvtpk(hb_[4 * g + 2], hb_[4 * g + 3]); *(u32x2*)(gHT + ((N_) * 32 + r32) * 64 + 32 + 8 * g + 4 * hi) = w; \
                    w.x = cvtpk(yy_[4 * g], yy_[4 * g + 1]); w.y = cvtpk(yy_[4 * g + 2], yy_[4 * g + 3]); *(u32x2*)(gYL + ((N_) * 32 + r32) * CH + 8 * g + 4 * hi) = w; } \
                __builtin_amdgcn_sched_barrier(0); } while (0)
            CS_HY(0); CS_HY(1);
#undef CS_HY
        }
    }
    pair_bar(pcnt, pord, lane);
}
__device__ __forceinline__ void phaseA(const Ctx& C, LAS unsigned char* lds, int G, int bx, int lane, int wave) {
    LAS unsigned char* L = lds + (wave >> 1) * L_WAVE; const int role = wave & 1;
    LAS unsigned* pcnt = (LAS unsigned*)(lds + 4 * L_WAVE) + (wave >> 1) * 32;
    if (role == 0 && lane == 0) *pcnt = 0u;
    __syncthreads();
    unsigned pord = 0u;
    constexpr int NTASK = NB * NH * NCH;
    const int rounds = (NTASK + 4 * G - 1) / (4 * G);
    RawRegs R;
    int task = bx * 4 + (wave >> 1);
    if (task < NTASK) rawLoad(C, R, task, lane, role);
#pragma unroll 1
    for (int k = 0; k < rounds; ++k) { const int nt = task + 4 * G; taskA(C, L, task, lane, role, task < NTASK, R, nt, (k + 1 < rounds) && nt < NTASK, pcnt, pord); task = nt; }
    __syncthreads();
}
constexpr int K_QT = 0, K_GT = 4608, K_YL = 13824, K_HT = 16384, K_BUF = 20992;
constexpr int K_FR = 2 * K_BUF;
__device__ __forceinline__ void chain_unit(const Ctx& C, LAS unsigned char* lds, int unit, int tid, int lane, int wave) {
    const int bh = unit >> 1, half = unit & 1, b = bh / NH, h = bh - b * NH;
    const int r32 = lane & 31, hi = lane >> 5;
    const unsigned char* gQT = (const unsigned char*)((const bf16_t*)(C.ws + WS_CQT) + (size_t)bh * NCH * (CH * 64));
    const unsigned char* gGT = (const unsigned char*)((const bf16_t*)(C.ws + WS_CGT) + (size_t)bh * NCH * (64 * 64));
    const unsigned char* gHT = (const unsigned char*)((const bf16_t*)(C.ws + WS_CHT) + (size_t)bh * NCH * (64 * 64) + half * 32 * 64);
    const unsigned char* gYL = (const unsigned char*)((const bf16_t*)(C.ws + WS_CYL) + (size_t)bh * NCH * (64 * CH) + half * 32 * CH);
    bf16_t* yout = (bf16_t*)(C.ws + WS_Y2) + (size_t)b * SEQ * RW + h * 64 + half * 32 + r32;
    const int lt = tid - 192;
    const unsigned char* src[4]; int dst[4]; size_t cstep[4];
#pragma unroll
    for (int q_ = 0; q_ < 4; ++q_) { const int p0_ = (lt < 0 ? 0 : lt) + 320 * q_; const int p_ = p0_ < 1152 ? p0_ : 1151;
        if (p_ < 256) { src[q_] = gQT + p_ * 16; dst[q_] = K_QT + (p_ >> 3) * 144 + (p_ & 7) * 16; cstep[q_] = 4096; }
        else if (p_ < 768) { const int r_ = p_ - 256; src[q_] = gGT + r_ * 16; dst[q_] = K_GT + (r_ >> 3) * 144 + (r_ & 7) * 16; cstep[q_] = 8192; }
        else if (p_ < 896) { const int r_ = p_ - 768; src[q_] = gYL + r_ * 16; dst[q_] = K_YL + (r_ >> 2) * 80 + (r_ & 3) * 16; cstep[q_] = 4096; }
        else { const int r_ = p_ - 896; src[q_] = gHT + r_ * 16; dst[q_] = K_HT + (r_ >> 3) * 144 + (r_ & 7) * 16; cstep[q_] = 8192; } }
    const bool ldr = lt >= 0;
    u32x4 sA[4], sB[4], sC[4];
#define CH_LD1(dst_, p_) asm volatile("global_load_dwordx4 %0, %1, off" : "=v"(dst_) : "v"(p_) : "memory")
#define CH_LD(S_, cc) do { if (ldr) { const size_t cc_ = (cc) < NCH ? (cc) : NCH - 1; CH_LD1(S_[0], src[0] + cc_ * cstep[0]); CH_LD1(S_[1], src[1] + cc_ * cstep[1]); \
        CH_LD1(S_[2], src[2] + cc_ * cstep[2]); CH_LD1(S_[3], src[3] + cc_ * cstep[3]); } } while (0)
#define CH_WR(S_, cc) do { if (ldr) { asm volatile("s_waitcnt vmcnt(8)" : "+v"(S_[0]), "+v"(S_[1]), "+v"(S_[2]), "+v"(S_[3]) :: "memory"); __builtin_amdgcn_sched_barrier(0); \
        const int bo_ = ((cc) & 1) * K_BUF; *(LAS u32x4*)(lds + bo_ + dst[0]) = S_[0]; *(LAS u32x4*)(lds + bo_ + dst[1]) = S_[1]; *(LAS u32x4*)(lds + bo_ + dst[2]) = S_[2]; \
        *(LAS u32x4*)(lds + bo_ + dst[3]) = S_[3]; } } while (0)
    if (tid < 256) *(LAS u32x4*)(lds + K_FR + tid * 16) = (u32x4){0u, 0u, 0u, 0u};
#define CH_STEP(c, SW_) do { \
        CH_WR(SW_, (c) + 1); CH_LD(SW_, (c) + 4); \
        if (wave < 3 && (c) < NCH) { \
            const LAS unsigned char* B_ = lds + ((c) & 1) * K_BUF; const LAS unsigned char* F_ = lds + K_FR + ((c) & 1) * 4096 + lane * 16; \
            const bf16x8 sb0 = *(const LAS bf16x8*)(F_), sb1 = *(const LAS bf16x8*)(F_ + 1024), sb2 = *(const LAS bf16x8*)(F_ + 2048), sb3 = *(const LAS bf16x8*)(F_ + 3072); \
            f32x16 acc_; \
            if (wave < 2) {         \
                _Pragma("unroll") for (int g = 0; g < 4; ++g) { const u32x2 i0 = *(const LAS u32x2*)(B_ + K_HT + r32 * 144 + (wave * 32 + 8 * g + 4 * hi) * 2); \
                    acc_[4 * g] = bfl(i0.x); acc_[4 * g + 1] = bfh(i0.x); acc_[4 * g + 2] = bfl(i0.y); acc_[4 * g + 3] = bfh(i0.y); } \
                const LAS unsigned char* ag_ = B_ + K_GT + (wave * 32 + r32) * 144 + 8 * hi; \
                acc_ = __builtin_amdgcn_mfma_f32_32x32x16_bf16(rd_perm(ag_), sb0, acc_, 0, 0, 0); acc_ = __builtin_amdgcn_mfma_f32_32x32x16_bf16(rd_perm(ag_ + 32), sb1, acc_, 0, 0, 0); \
                acc_ = __builtin_amdgcn_mfma_f32_32x32x16_bf16(rd_perm(ag_ + 64), sb2, acc_, 0, 0, 0); acc_ = __builtin_amdgcn_mfma_f32_32x32x16_bf16(rd_perm(ag_ + 96), sb3, acc_, 0, 0, 0); \
                LAS unsigned char* FN_ = lds + K_FR + (((c) + 1) & 1) * 4096 + wave * 2048 + lane * 16; \
                *(LAS bf16x8*)(FN_) = pack8(acc_, 0); *(LAS bf16x8*)(FN_ + 1024) = pack8(acc_, 1); \
            } else {                \
                _Pragma("unroll") for (int g = 0; g < 4; ++g) { const u32x2 iy = *(const LAS u32x2*)(B_ + K_YL + r32 * 80 + (8 * g + 4 * hi) * 2); \
                    acc_[4 * g] = bfl(iy.x); acc_[4 * g + 1] = bfh(iy.x); acc_[4 * g + 2] = bfl(iy.y); acc_[4 * g + 3] = bfh(iy.y); } \
                const LAS unsigned char* aq_ = B_ + K_QT + r32 * 144 + 8 * hi; \
                acc_ = __builtin_amdgcn_mfma_f32_32x32x16_bf16(rd_perm(aq_), sb0, acc_, 0, 0, 0); acc_ = __builtin_amdgcn_mfma_f32_32x32x16_bf16(rd_perm(aq_ + 32), sb1, acc_, 0, 0, 0); \
                acc_ = __builtin_amdgcn_mfma_f32_32x32x16_bf16(rd_perm(aq_ + 64), sb2, acc_, 0, 0, 0); acc_ = __builtin_amdgcn_mfma_f32_32x32x16_bf16(rd_perm(aq_ + 96), sb3, acc_, 0, 0, 0); \
                bf16_t* yp = yout + (size_t)(c) * CH * RW; \
                _Pragma("unroll") for (int q = 0; q < 16; ++q) yp[(size_t)crow(q, hi) * RW] = (bf16_t)cvtpk(acc_[q], acc_[q]); \
            } \
        } \
        CS_BAR(); } while (0)
    CH_LD(sA, 0); CH_LD(sB, 1); CH_LD(sC, 2);
    CH_WR(sA, 0); CH_LD(sA, 3);
    CS_BAR();
#pragma unroll 1
    for (int c3 = 0; c3 < NCH + 2; c3 += 3) { CH_STEP(c3, sB); CH_STEP(c3 + 1, sC); CH_STEP(c3 + 2, sA); }
#undef CH_STEP
#undef CH_LD
#undef CH_LD1
#undef CH_WR
}
__device__ __forceinline__ void chain_phase(const Ctx& C, LAS unsigned char* lds, int G, int bx, int tid, int lane, int wave) {
    const int v0 = (G % 8 == 0) ? (bx % 8) * (G / 8) + bx / 8 : bx;
    for (int v = v0; v < 256; v += G) chain_unit(C, lds, v, tid, lane, wave);
}
#undef CS_BAR
#undef CS_MF
}

struct Frame { LAS unsigned char* lds; int tid, lane, wave, G, bx; };

__device__ __forceinline__ void p0_prologue(const Ctx& C, const Frame& F) {
    {
        LAS float* sc = (LAS float*)F.lds;
        LAS float* red = (LAS float*)(F.lds + 65536);
        for (int i = F.tid; i < NB * DM; i += NTHR) { const float cv = C.c[i]; sc[i] = cv / (1.f + __expf(-cv)); }
        __syncthreads();
        float* mod = (float*)(C.ws + WS_MOD);
        for (int cb = F.bx; cb < 6 * DM / 24; cb += F.G) {
            const int n0 = cb * 24;
            if (F.tid < 384) {
                const int kg = F.tid / 24, j = F.tid % 24;
                float acc[NB];
#pragma unroll
                for (int b = 0; b < NB; ++b) acc[b] = 0.f;
                for (int k = kg; k < DM; k += 16) { const float w = C.w_ada[(size_t)k * 6 * DM + n0 + j];
#pragma unroll
                    for (int b = 0; b < NB; ++b) acc[b] += sc[b * DM + k] * w; }
#pragma unroll
                for (int b = 0; b < NB; ++b) red[(kg * NB + b) * 24 + j] = acc[b];
            }
            __syncthreads();
            if (F.tid < 384) { const int b = F.tid / 24, j = F.tid % 24; float s = C.b_ada[n0 + j];
#pragma unroll
                for (int kg = 0; kg < 16; ++kg) s += red[(kg * NB + b) * 24 + j];
                mod[b * 6 * DM + n0 + j] = s; }
            __syncthreads();
        }
    }
    for (int o = F.bx * NTHR + F.tid; o < T * 16; o += F.G * NTHR) {
        const int t = o >> 4, i = o & 15;
        const float inv = powf(10000.0f, -(float)(2 * i) / 32.0f);
        float s, c; sincosf((float)C.pos[t] * inv, &s, &c);
        ((float2*)(C.ws + WS_ROPE))[o] = make_float2(c, s);
    }
    for (int o = F.bx * NTHR + F.tid; o < 48 * DM; o += F.G * NTHR) {
        const int j = o & 7, ln = (o >> 3) & 63, pc = o >> 9, nb = pc % 3, ks = pc / 3;
        const int n = 16 * nb + (ln & 15), k = 32 * ks + 8 * (ln >> 4) + j;
        const float w = n < NG ? C.w_rg[k * NG + n] : (n < NG + NE ? C.w_re[k * NE + (n - NG)] : 0.f);
        const bf16_t hi = f2bf(w);
        ((bf16_t*)(C.ws + WS_W + WO_RH))[o] = hi; ((bf16_t*)(C.ws + WS_W + WO_RL))[o] = f2bf(w - bf2f(hi));
    }
    __syncthreads();
    {
        LAS float* scr = (LAS float*)(F.lds + F.wave * 16384);
        const int gw = F.bx * NWAVES + F.wave, NGW = F.G * NWAVES;
        float va[32], vb[32];
        TrItem da, db;
        int it = gw;
        if (it < TR_NITEMS) { da = tr_desc(C, it); tr_load(da, va, F.lane); }
        for (; it < TR_NITEMS; it += 2 * NGW) {
            const bool hb = it + NGW < TR_NITEMS;
            if (hb) { db = tr_desc(C, it + NGW); tr_load(db, vb, F.lane); }
            tr_store(da, va, scr, F.lane);
            if (hb) {
                if (it + 2 * NGW < TR_NITEMS) { da = tr_desc(C, it + 2 * NGW); tr_load(da, va, F.lane); }
                tr_store(db, vb, scr, F.lane);
            }
        }
    }
}

__device__ __forceinline__ void p1_modulate(const Ctx& C, const Frame& F) {
    const float* mod = (const float*)(C.ws + WS_MOD);
    bf16_t* h1 = (bf16_t*)(C.ws + WS_H);
    const int lane = F.lane;
    for (int row0 = (F.bx * NWAVES + F.wave) * 4; row0 < T; row0 += F.G * NWAVES * 4) {
        const int b = row0 / SEQ;
        float4 v[4][4]; float ss[4];
#pragma unroll
        for (int r = 0; r < 4; ++r) { const float4* xr = (const float4*)(C.x + (size_t)(row0 + r) * DM);
#pragma unroll
            for (int j = 0; j < 4; ++j) v[r][j] = xr[lane + 64 * j]; }
#pragma unroll
        for (int r = 0; r < 4; ++r) { float a = 0.f;
#pragma unroll
            for (int j = 0; j < 4; ++j) a += v[r][j].x * v[r][j].x + v[r][j].y * v[r][j].y + v[r][j].z * v[r][j].z + v[r][j].w * v[r][j].w;
            ss[r] = a; }
#pragma unroll
        for (int r = 0; r < 4; ++r) ss[r] = rsqrtf(wsum_dpp(ss[r]) * (1.f / DM) + RMS_EPS);
#pragma unroll
        for (int j = 0; j < 4; ++j) {
            const int col = 4 * (lane + 64 * j);
            const float4 g = *(const float4*)(C.g_pre_mix + col);
            const float4 sh = *(const float4*)(mod + b * 6 * DM + col), sc = *(const float4*)(mod + b * 6 * DM + DM + col);
            const float m0 = g.x * (1.f + sc.x), m1 = g.y * (1.f + sc.y), m2 = g.z * (1.f + sc.z), m3 = g.w * (1.f + sc.w);
#pragma unroll
            for (int r = 0; r < 4; ++r) { const float rs = ss[r];
                u32x2 w; w.x = cvtpk(v[r][j].x * rs * m0 + sh.x, v[r][j].y * rs * m1 + sh.y); w.y = cvtpk(v[r][j].z * rs * m2 + sh.z, v[r][j].w * rs * m3 + sh.w);
                *(u32x2*)(h1 + (size_t)(row0 + r) * DM + col) = w; }
        }
    }
}

__device__ __forceinline__ void d_post_mix(const Ctx& C, int G, int bx, int tid, int lane, int wave, LAS unsigned char* lds, bool dry) {
    const float* mod = (const float*)(C.ws + WS_MOD); const bf16_t* ym = (const bf16_t*)(C.ws + WS_YMIX);
    bf16_t* h2 = (bf16_t*)(C.ws + WS_H); bf16_t* x1b = (bf16_t*)(C.ws + WS_X1B);
    const bf16_t* wrh = (const bf16_t*)(C.ws + WS_W + WO_RH); const bf16_t* wrl = (const bf16_t*)(C.ws + WS_W + WO_RL);
    float* tokw = (float*)(C.ws + WS_ROUTE);
    unsigned* gcnt = (unsigned*)(C.ws + WS_CTL) + CW_GCNT;
    int* list = (int*)(C.ws + WS_LIST);
    LAS int* le = (LAS int*)lds; LAS float* lg = (LAS float*)(lds + 1024) + wave * 16 * 48;
    LAS unsigned char* lw = lds + 25600;
    for (int q = 0; q < 16; ++q) { const int idx = wave * 16 + q, hl = idx & 1, nb = (idx >> 1) & 1, ks = idx >> 2;
        __builtin_amdgcn_global_load_lds((const unsigned*)((hl ? wrl : wrh) + (ks * 3 + nb) * 512 + lane * 8), (LAS unsigned*)(lw + idx * 1024), 16, 0, 0); }
    for (int grp = bx; grp < T / 128; grp += G) {
      const int r0 = grp * 128 + wave * 16;
      for (int rr = 0; rr < 16; rr += 4) {
        const int row = r0 + rr;
        const int b = row / SEQ; const float* mb = mod + b * 6 * DM;
        float4 yq[4][4], xq[4][4]; float rs[4], rs2[4];
#pragma unroll
        for (int u = 0; u < 4; ++u)
#pragma unroll
            for (int j = 0; j < 4; ++j) { const u32x2 yw = *(const u32x2*)(ym + (size_t)(row + u) * DM + 4 * (lane + 64 * j));
                yq[u][j] = make_float4(__uint_as_float(yw.x << 16), __uint_as_float(yw.x & 0xffff0000u), __uint_as_float(yw.y << 16), __uint_as_float(yw.y & 0xffff0000u)); xq[u][j] = *(const float4*)(C.x + (size_t)(row + u) * DM + 4 * (lane + 64 * j)); }
#pragma unroll
        for (int u = 0; u < 4; ++u) { float a = 0.f;
#pragma unroll
            for (int j = 0; j < 4; ++j) a += yq[u][j].x * yq[u][j].x + yq[u][j].y * yq[u][j].y + yq[u][j].z * yq[u][j].z + yq[u][j].w * yq[u][j].w;
            rs[u] = a; }
#pragma unroll
        for (int u = 0; u < 4; ++u) rs[u] = rsqrtf(wsum_dpp(rs[u]) * (1.f / DM) + RMS_EPS);
#pragma unroll
        for (int u = 0; u < 4; ++u) rs2[u] = 0.f;
#pragma unroll
        for (int j = 0; j < 4; ++j) { const int col = 4 * (lane + 64 * j);
            const float4 g1 = *(const float4*)(mb + 2 * DM + col), gp = *(const float4*)(C.g_post_mix + col);
            const float m0 = g1.x * gp.x, m1 = g1.y * gp.y, m2 = g1.z * gp.z, m3 = g1.w * gp.w;
#pragma unroll
            for (int u = 0; u < 4; ++u) { float4 x1 = xq[u][j];
                x1.x += m0 * (yq[u][j].x * rs[u]); x1.y += m1 * (yq[u][j].y * rs[u]); x1.z += m2 * (yq[u][j].z * rs[u]); x1.w += m3 * (yq[u][j].w * rs[u]);
                xq[u][j] = x1; rs2[u] += x1.x * x1.x + x1.y * x1.y + x1.z * x1.z + x1.w * x1.w;
                u32x2 xw; xw.x = cvtpk(x1.x, x1.y); xw.y = cvtpk(x1.z, x1.w); *(u32x2*)(x1b + (size_t)(row + u) * DM + col) = xw; } }
#pragma unroll
        for (int u = 0; u < 4; ++u) rs2[u] = rsqrtf(wsum_dpp(rs2[u]) * (1.f / DM) + RMS_EPS);
#pragma unroll
        for (int j = 0; j < 4; ++j) { const int col = 4 * (lane + 64 * j);
            const float4 gf = *(const float4*)(C.g_pre_ffn + col), sc = *(const float4*)(mb + 4 * DM + col), sh = *(const float4*)(mb + 3 * DM + col);
            const float m0 = gf.x * (1.f + sc.x), m1 = gf.y * (1.f + sc.y), m2 = gf.z * (1.f + sc.z), m3 = gf.w * (1.f + sc.w);
#pragma unroll
            for (int u = 0; u < 4; ++u) {
                const float h0 = xq[u][j].x * rs2[u] * m0 + sh.x, h1 = xq[u][j].y * rs2[u] * m1 + sh.y, h2_ = xq[u][j].z * rs2[u] * m2 + sh.z, h3 = xq[u][j].w * rs2[u] * m3 + sh.w;
                u32x2 wh; wh.x = cvtpk(h0, h1); wh.y = cvtpk(h2_, h3);
                *(u32x2*)(h2 + (size_t)(row + u) * DM + col) = wh; } }
      }
      asm volatile("s_waitcnt vmcnt(0)" ::: "memory");
      __syncthreads();
      {
        f32x4 acc0 = {0.f, 0.f, 0.f, 0.f}, acc1 = acc0, acc2 = acc0;
        const int fr = lane & 15, fq = lane >> 4;
        const bf16_t* ah = h2 + (size_t)(r0 + fr) * DM + 8 * fq;
        const bf16_t* bh = wrh + lane * 8; const bf16_t* bl = wrl + lane * 8;
#pragma unroll 8
        for (int ks = 0; ks < 32; ++ks) {
            const bf16x8 a_h = *(const bf16x8*)(ah + 32 * ks);
            const LAS unsigned char* lp = lw + ks * 4096 + lane * 16;
            const bf16x8 b0h = *(const LAS bf16x8*)(lp), b0l = *(const LAS bf16x8*)(lp + 1024), b1h = *(const LAS bf16x8*)(lp + 2048), b1l = *(const LAS bf16x8*)(lp + 3072);
            const bf16x8 b2h = *(const bf16x8*)(bh + ks * 1536 + 1024), b2l = *(const bf16x8*)(bl + ks * 1536 + 1024);
            acc0 = __builtin_amdgcn_mfma_f32_16x16x32_bf16(a_h, b0h, acc0, 0, 0, 0); acc0 = __builtin_amdgcn_mfma_f32_16x16x32_bf16(a_h, b0l, acc0, 0, 0, 0);
            acc1 = __builtin_amdgcn_mfma_f32_16x16x32_bf16(a_h, b1h, acc1, 0, 0, 0); acc1 = __builtin_amdgcn_mfma_f32_16x16x32_bf16(a_h, b1l, acc1, 0, 0, 0);
            acc2 = __builtin_amdgcn_mfma_f32_16x16x32_bf16(a_h, b2h, acc2, 0, 0, 0); acc2 = __builtin_amdgcn_mfma_f32_16x16x32_bf16(a_h, b2l, acc2, 0, 0, 0);
        }
#pragma unroll
        for (int e = 0; e < 4; ++e) { lg[(4 * fq + e) * 48 + fr] = acc0[e]; lg[(4 * fq + e) * 48 + 16 + fr] = acc1[e]; lg[(4 * fq + e) * 48 + 32 + fr] = acc2[e]; }
      }
      asm volatile("s_waitcnt lgkmcnt(0)" ::: "memory");
      if (lane < 16) {
            float gl[NG], el[NE];
#pragma unroll
            for (int c = 0; c < NG; ++c) gl[c] = lg[lane * 48 + c] + C.b_rg[c];
#pragma unroll
            for (int c = 0; c < NE; ++c) el[c] = lg[lane * 48 + NG + c] + C.b_re[c];
            int gs = 0; float gm = gl[0];
#pragma unroll
            for (int c = 1; c < NG; ++c) if (gl[c] > gm) { gm = gl[c]; gs = c; }
            float den = 0.f;
#pragma unroll
            for (int c = 0; c < NG; ++c) den += __expf(gl[c] - gm);
            const float psel = 1.f / den;
            float eg[EPG];
#pragma unroll
            for (int c = 0; c < EPG; ++c) eg[c] = gs == 0 ? el[c] : (gs == 1 ? el[EPG + c] : (gs == 2 ? el[2 * EPG + c] : el[3 * EPG + c]));
            int i0 = 0; float v0 = eg[0];
#pragma unroll
            for (int c = 1; c < EPG; ++c) if (eg[c] > v0) { v0 = eg[c]; i0 = c; }
            int i1 = -1; float v1 = -INFINITY;
#pragma unroll
            for (int c = 0; c < EPG; ++c) if (c != i0 && eg[c] > v1) { v1 = eg[c]; i1 = c; }
            const float e1 = __expf(v1 - v0), w0 = 1.f / (1.f + e1), w1 = e1 / (1.f + e1);
            le[(wave * 16 + lane) * 2] = gs * EPG + i0; le[(wave * 16 + lane) * 2 + 1] = gs * EPG + i1;
            *(float2*)(tokw + (size_t)(r0 + lane) * 2) = make_float2(psel * w0, psel * w1);
      }
      __syncthreads();
      if (tid < NE && !dry) {
          int cnt = 0;
          for (int k = 0; k < 256; ++k) cnt += (le[k] == tid) ? 1 : 0;
          if (cnt) { const unsigned base = __hip_atomic_fetch_add(gcnt + tid, (unsigned)cnt, __ATOMIC_RELAXED, __HIP_MEMORY_SCOPE_AGENT);
              int j = 0;
              for (int k = 0; k < 256; ++k) if (le[k] == tid) { list[(size_t)tid * T + base + j] = grp * 256 + k; ++j; } }
      }
      __syncthreads();
    }
}
template <int NPN, bool BAL = false>
__device__ __forceinline__ pg8::MoeTab moe_setup(const Ctx& C, int G, int bx, int tid, __attribute__((address_space(3))) int* ctl) {
    const unsigned* gcnt = (const unsigned*)(C.ws + WS_CTL) + CW_GCNT;
    const int* list = (const int*)(C.ws + WS_LIST);
    __syncthreads();
    if (tid == 0) { int acc = 0; for (int e = 0; e < NE; ++e) { const int c = (int)__hip_atomic_load(gcnt + e, __ATOMIC_RELAXED, __HIP_MEMORY_SCOPE_AGENT); ctl[64 + e] = c; ctl[e] = acc; acc += (c + 255) >> 8; } ctl[NE] = acc; }
    __syncthreads();
    if (tid < pg8::MOE_MAXU) {
        const int total = ctl[NE] * NPN; long L = (long)tid * G + bx;
        if constexpr (BAL) { const int s_ = (ctl[NE] * 2) % G;
            constexpr int SK = MOE_SKIP;
            if (s_ > 0) { if (bx >= s_) L = tid < SK ? (long)tid * (G - s_) + (bx - s_) : (long)SK * (G - s_) + (long)(tid - SK) * G + (bx - s_);
                          else L = (long)SK * (G - s_) + (long)tid * G + (G - s_ + bx); } }
        int* d = nullptr; (void)d;
        if (L < total) { const int pn = (int)(L % NPN), rt = (int)(L / NPN); int e = 0;
            for (int q = 1; q < NE; ++q) if (ctl[q] <= rt) e = q;
            const int m = rt - ctl[e]; int nv = ctl[64 + e] - m * 256; nv = nv > 256 ? 256 : nv;
            ctl[128 + tid * 8 + 0] = e; ctl[128 + tid * 8 + 1] = m; ctl[128 + tid * 8 + 2] = pn; ctl[128 + tid * 8 + 3] = nv; ctl[128 + tid * 8 + 4] = rt * 256; ctl[128 + tid * 8 + 5] = 1; }
        else ctl[128 + tid * 8 + 5] = 0;
    }
    __syncthreads();
    for (int i = 0; i < pg8::MOE_MAXU; ++i) {
        if (ctl[128 + i * 8 + 5] && tid < 256) { const int e = ctl[128 + i * 8 + 0], m = ctl[128 + i * 8 + 1], nv = ctl[128 + i * 8 + 3];
            const int r = tid < nv ? tid : nv - 1;
            ctl[256 + i * 256 + tid] = list[(size_t)e * T + m * 256 + r]; }
    }
    __syncthreads();
    pg8::MoeTab tb; tb.desc = ctl + 128; tb.rowtab = ctl + 256; return tb;
}
__device__ __forceinline__ void d_final(const Ctx& C, int gw, int ngw, int lane) {
    const float* mod = (const float*)(C.ws + WS_MOD); const bf16_t* ys = (const bf16_t*)(C.ws + WS_YSLOT); const bf16_t* x1b = (const bf16_t*)(C.ws + WS_X1B);
    for (int row0 = gw * 4; row0 < T; row0 += ngw * 4) {
        const int b = row0 / SEQ; const float* mb = mod + b * 6 * DM;
        u32x2 ya[4][4], yb[4][4]; float4 x1[4][4]; float rs[4];
#pragma unroll
        for (int r = 0; r < 4; ++r)
#pragma unroll
            for (int j = 0; j < 4; ++j) { const int col = 4 * (lane + 64 * j);
                ya[r][j] = *(const u32x2*)(ys + (size_t)(row0 + r) * 2 * DM + col); yb[r][j] = *(const u32x2*)(ys + (size_t)(row0 + r) * 2 * DM + DM + col);
                { const u32x2 xw = *(const u32x2*)(x1b + (size_t)(row0 + r) * DM + col); x1[r][j] = make_float4(__uint_as_float(xw.x << 16), __uint_as_float(xw.x & 0xffff0000u), __uint_as_float(xw.y << 16), __uint_as_float(xw.y & 0xffff0000u)); } }
        float yv[4][16];
#pragma unroll
        for (int r = 0; r < 4; ++r) { float a = 0.f;
#pragma unroll
            for (int j = 0; j < 4; ++j) {
                yv[r][4 * j] = __uint_as_float(ya[r][j].x << 16) + __uint_as_float(yb[r][j].x << 16); yv[r][4 * j + 1] = __uint_as_float(ya[r][j].x & 0xffff0000u) + __uint_as_float(yb[r][j].x & 0xffff0000u);
                yv[r][4 * j + 2] = __uint_as_float(ya[r][j].y << 16) + __uint_as_float(yb[r][j].y << 16); yv[r][4 * j + 3] = __uint_as_float(ya[r][j].y & 0xffff0000u) + __uint_as_float(yb[r][j].y & 0xffff0000u);
                a += yv[r][4 * j] * yv[r][4 * j] + yv[r][4 * j + 1] * yv[r][4 * j + 1] + yv[r][4 * j + 2] * yv[r][4 * j + 2] + yv[r][4 * j + 3] * yv[r][4 * j + 3]; }
            rs[r] = a; }
#pragma unroll
        for (int r = 0; r < 4; ++r) rs[r] = rsqrtf(wsum_dpp(rs[r]) * (1.f / DM) + RMS_EPS);
#pragma unroll
        for (int j = 0; j < 4; ++j) { const int col = 4 * (lane + 64 * j);
            const float4 g = *(const float4*)(C.g_post_ffn + col), g2 = *(const float4*)(mb + 5 * DM + col);
            const float m0 = g.x * g2.x, m1 = g.y * g2.y, m2 = g.z * g2.z, m3 = g.w * g2.w;
#pragma unroll
            for (int r = 0; r < 4; ++r) { float4 o = x1[r][j];
                o.x += m0 * (yv[r][4 * j] * rs[r]); o.y += m1 * (yv[r][4 * j + 1] * rs[r]); o.z += m2 * (yv[r][4 * j + 2] * rs[r]); o.w += m3 * (yv[r][4 * j + 3] * rs[r]);
                *(float4*)(C.out + (size_t)(row0 + r) * DM + col) = o; } }
    }
}

#define XB_TMO      128
#define XB_XCNT(j)  (256  + 64 * (j))
#define XB_XSUB(j)  (1280 + 64 * (j))
#define XB_XGEN(j)  (2304 + 64 * (j))
#define XB_TOP      3328
#define XB_TOPGEN   3392
#define XCD_BAR_WORDS 3456
#define XB_SPIN_CAP (1u << 18)
__device__ __forceinline__ unsigned xb_ld(unsigned* p)              { return __hip_atomic_load(p, __ATOMIC_RELAXED, __HIP_MEMORY_SCOPE_AGENT); }
__device__ __forceinline__ unsigned xb_add(unsigned* p, unsigned v) { return __hip_atomic_fetch_add(p, v, __ATOMIC_RELAXED, __HIP_MEMORY_SCOPE_AGENT); }
__device__ __forceinline__ unsigned xb_xcc_id() { return (unsigned)__builtin_amdgcn_s_getreg((3 << 11) | 20) & 0xFu; }
#define XB_SPIN(cond, bar) do { unsigned _sp = 0; while (cond) { __builtin_amdgcn_s_sleep(1); \
    if ((++_sp & 255u) == 0u) { if (xb_ld(&(bar)[XB_TMO])) break; if (_sp > XB_SPIN_CAP) { atomicAdd(&(bar)[XB_TMO], 1u); break; } } } } while (0)
struct XcdBarrier { unsigned* bar; unsigned x; volatile LAS unsigned* st; };
__device__ __forceinline__ XcdBarrier xcd_barrier_post(unsigned* bar, volatile LAS unsigned* st) {
    XcdBarrier b; b.bar = bar; b.x = xb_xcc_id(); b.st = st;
    if (threadIdx.x == 0) (void)xb_add(&bar[XB_XCNT(b.x)], 1u);
    return b;
}
__device__ __forceinline__ void xcd_barrier_complete(unsigned* bar, unsigned x, unsigned& nloc, unsigned& nx) {
    const unsigned G = gridDim.x * gridDim.y * gridDim.z;
    unsigned sum, cnt, mine, sp = 0u;
    for (;;) {
        sum = 0u; cnt = 0u; mine = 0u;
#pragma unroll
        for (unsigned j = 0; j < 16; ++j) { const unsigned c = xb_ld(&bar[XB_XCNT(j)]); sum += c; cnt += (c > 0u) ? 1u : 0u; mine = (j == x) ? c : mine; }
        if (sum == G) break;
        __builtin_amdgcn_s_sleep(1);
        if ((++sp & 255u) == 0u) { if (xb_ld(&bar[XB_TMO])) break; if (sp > XB_SPIN_CAP) { atomicAdd(&bar[XB_TMO], 1u); break; } }
    }
    nloc = mine > 0u ? mine : 1u; nx = cnt > 0u ? cnt : 1u;
}
__device__ __forceinline__ void xcd_barrier(const XcdBarrier& b) {
    asm volatile("s_waitcnt vmcnt(0)" ::: "memory");
    __syncthreads();
    if (threadIdx.x == 0) {
        unsigned* bar = b.bar;
        __builtin_amdgcn_s_waitcnt(0);
        unsigned nloc = b.st[0], nx = b.st[1];
        if (nloc == 0u) { xcd_barrier_complete(bar, b.x, nloc, nx); b.st[0] = nloc; b.st[1] = nx; }
        const unsigned old = xb_add(&bar[XB_XSUB(b.x)], 1u);
        const unsigned gen = old / nloc;
        if (old + 1u == (gen + 1u) * nloc) {
            __builtin_amdgcn_fence(__ATOMIC_RELEASE, "agent");
            asm volatile("s_waitcnt vmcnt(0)" ::: "memory");
            const unsigned og = xb_add(&bar[XB_TOP], 1u);
            const unsigned tg = og / nx;
            if (og + 1u == (tg + 1u) * nx) xb_add(&bar[XB_TOPGEN], 1u);
            else XB_SPIN(xb_ld(&bar[XB_TOPGEN]) == tg, bar);
            __builtin_amdgcn_fence(__ATOMIC_ACQUIRE, "agent");
            xb_add(&bar[XB_XGEN(b.x)], 1u);
            asm volatile("s_waitcnt vmcnt(0)" ::: "memory");
        } else {
            XB_SPIN(xb_ld(&bar[XB_XGEN(b.x)]) == gen, bar);
            __builtin_amdgcn_fence(__ATOMIC_ACQUIRE, "agent");
            asm volatile("s_waitcnt vmcnt(0)" ::: "memory");
        }
    }
    __syncthreads();
}

struct Args { Ctx C; int ph_lo, ph_hi, sub, breg; };
__global__ void __launch_bounds__(NTHR, 2) mk(Args args) {
    extern __shared__ __attribute__((aligned(16))) unsigned char lds_raw[];
    const Ctx& C = args.C;
    Frame F; F.lds = (LAS unsigned char*)lds_raw; F.tid = threadIdx.x; F.lane = F.tid & 63; F.wave = __builtin_amdgcn_readfirstlane(F.tid >> 6); F.G = gridDim.x; F.bx = blockIdx.x;
    const int lo = args.ph_lo, hi = args.ph_hi;
    volatile LAS unsigned* xbw = (volatile LAS unsigned*)(F.lds + LDS_BYTES - 16);
    if (F.tid < 4) xbw[F.tid] = 0u;
    __syncthreads();
    unsigned* barw = (unsigned*)(C.ws + WS_CTL) + args.breg * XCD_BAR_WORDS;
    XcdBarrier bar; bar.bar = barw; bar.x = 0; bar.st = xbw;
    if (hi - lo > 1) bar = xcd_barrier_post(barw, xbw);
#define IN(k) (lo <= (k) && (k) < hi)
#define SEAM(k) do { if (IN(k) && IN((k) + 1)) xcd_barrier(bar); } while (0)
    if (IN(0)) { p0_prologue(C, F); }
    SEAM(0);
    if (IN(1)) { p1_modulate(C, F); }
    SEAM(1);
    if (IN(2)) {
        pg8::Dense P{(const bf16_t*)(C.ws + WS_H), (const bf16_t*)(C.ws + WS_W + WO_IN), DM, DM, DM};
        pg8::StaticOrder S; S.init(T, 4608, F.G, F.bx);
        pg8::EpiZ E{(bf16_t*)(C.ws + WS_ZM), (bf16_t*)(C.ws + WS_RKV), (bf16_t*)(C.ws + WS_ZL), (bf16_t*)C.out};
        pg8::gemm_phase(F.lds, P, S, E);
    }
    SEAM(2);
    if (IN(3)) { d_prep(C, F.bx * NWAVES + F.wave, F.G * NWAVES, F.lane); }
    SEAM(3);
    if (IN(4)) {
        const bf16_t* wb = (const bf16_t*)(C.ws + WS_W);
        {   pg8::Dense P{(const bf16_t*)(C.ws + WS_CQN), wb + WO_UQ / 2, QR, QR, QR};
            pg8::StaticOrder S; S.init(T, 768, F.G, F.bx);
            pg8::EpiQ E{(bf16_t*)(C.ws + WS_QF), (const float2*)(C.ws + WS_ROPE)};
            pg8::gemm_phase(F.lds, P, S, E); }
        {   pg8::Dense P{(const bf16_t*)(C.ws + WS_CKVN), wb + WO_UKV / 2, KVR, KVR, KVR};
            pg8::StaticOrder S; S.init(T, 1024, F.G, F.bx);
            pg8::EpiKVp E{(bf16_t*)(C.ws + WS_KF), (bf16_t*)(C.ws + WS_VF)};
            pg8::gemm_phase(F.lds, P, S, E); }
        {   pg8::Dense P{(const bf16_t*)(C.ws + WS_LORA), wb + WO_LORA / 2, 256, 256, 256};
            pg8::StaticOrder S; S.init(T, 1536, F.G, F.bx);
            static_assert(WS_AV == WS_EBUF + (size_t)T * RW * 2 && WS_G == WS_AV + (size_t)T * RW * 2, "ebuf|av|g contiguous");
            pg8::EpiLora E{(bf16_t*)(C.ws + WS_EBUF), C.dec_bias, C.a_bias};
            pg8::gemm_phase(F.lds, P, S, E); }
    }
    SEAM(4);
    if (IN(5)) { att::attn_phase(C, F.lds, F.G, F.bx, F.tid, F.lane, F.wave); }
    SEAM(5);
    if (IN(6)) { cscan::phaseA(C, F.lds, F.G, F.bx, F.lane, F.wave); }
    SEAM(6);
    if (IN(7)) { cscan::chain_phase(C, F.lds, F.G, F.bx, F.tid, F.lane, F.wave); }
    SEAM(7);
    if (IN(8)) { d_rwkv_post(C, F.bx * NWAVES + F.wave, F.G * NWAVES, F.lane); }
    SEAM(8);
    if (IN(9)) {
        const bf16_t* wb = (const bf16_t*)(C.ws + WS_W);
        pg8::MixProb P{(const bf16_t*)(C.ws + WS_ATT), (const bf16_t*)(C.ws + WS_RWO), wb + WO_OM / 2, wb + WO_OR / 2, RW, RW, RW};
        pg8::StaticOrder S; S.init(T, DM, F.G, F.bx, 2);
        pg8::EpiMix E{(const bf16_t*)C.out, (bf16_t*)(C.ws + WS_MIXED), (unsigned*)(C.ws + WS_CTL) + CW_PFLAG};
        pg8::gemm_phase(F.lds, P, S, E);
    }
    if (IN(10)) {
        const bf16_t* wb = (const bf16_t*)(C.ws + WS_W);
        pg8::DenseSC P{(const bf16_t*)(C.ws + WS_MIXED), wb + WO_OUT / 2, DM, DM, DM};
        pg8::StaticOrderW S; S.so.init(T, DM, F.G, F.bx); S.flag = (unsigned*)(C.ws + WS_CTL) + CW_PFLAG; S.need = 4u;
        pg8::EpiOutF E{(bf16_t*)(C.ws + WS_YMIX)};
        pg8::gemm_phase(F.lds, P, S, E);
    }
    SEAM(10);
    if (IN(11)) { d_post_mix(C, F.G, F.bx, F.tid, F.lane, F.wave, F.lds, (args.sub & 4) != 0); }
    SEAM(11);
    if (IN(12)) {
        const pg8::MoeTab tb = moe_setup<2>(C, F.G, F.bx, F.tid, (LAS int*)(F.lds + LDSCTL_OFF));
        pg8::MoeProb1 P{(const bf16_t*)(C.ws + WS_H), (const bf16_t*)(C.ws + WS_W + WO_GU), tb, DM, DM, DM};
        pg8::MoeSched S{tb};
        pg8::EpiMoe1 E{(bf16_t*)(C.ws + WS_ACT), (const float*)(C.ws + WS_ROUTE), tb, (unsigned*)(C.ws + WS_CTL) + CW_RTFLAG};
        pg8::gemm_phase(F.lds, P, S, E);
    }
    if (IN(13)) {
        const pg8::MoeTab tb = moe_setup<4, true>(C, F.G, F.bx, F.tid, (LAS int*)(F.lds + LDSCTL_OFF));
        pg8::MoeProb2 P{(const bf16_t*)(C.ws + WS_ACT), (const bf16_t*)(C.ws + WS_W + WO_DN), tb, FF, FF, FF};
        pg8::MoeSched2 S{tb, (unsigned*)(C.ws + WS_CTL) + CW_RTFLAG};
        pg8::EpiMoe2 E{(bf16_t*)(C.ws + WS_YSLOT), tb};
        pg8::gemm_phase(F.lds, P, S, E);
    }
    SEAM(13);
    if (IN(14)) { d_final(C, F.bx * NWAVES + F.wave, F.G * NWAVES, F.lane); }
#undef IN
#undef SEAM
}

static int g_grid = 0;
static int g_breg = 0;
static void launch_mk(const Ctx& C, int lo, int hi, hipStream_t stream, int sub = 3) {
    Args a{}; a.C = C; a.ph_lo = lo; a.ph_hi = hi; a.sub = sub; a.breg = g_breg++;
    hipLaunchKernelGGL(mk, dim3(g_grid), dim3(NTHR), LDS_BYTES, stream, a);
}
extern "C" void kernel_launch(void* const* d_in, const int* in_sizes, int n_in, void* d_out, int out_size, void* d_ws, size_t ws_size, hipStream_t stream) {
    if (g_grid == 0) {
        int dev = 0, cus = 0; hipGetDevice(&dev); hipDeviceGetAttribute(&cus, hipDeviceAttributeMultiprocessorCount, dev);
        hipFuncSetAttribute((const void*)mk, hipFuncAttributeMaxDynamicSharedMemorySize, LDS_BYTES);
        g_grid = cus > 0 ? cus : 256;
    }
    Ctx C{};
    const float* const* f = (const float* const*)d_in;
    C.x = f[0]; C.c = f[1]; C.pos = (const int*)d_in[2];
    C.w_ada = f[3]; C.b_ada = f[4]; C.g_pre_mix = f[5]; C.g_post_mix = f[6]; C.g_pre_ffn = f[7]; C.g_post_ffn = f[8];
    C.w_in = f[9]; C.g_cq = f[10]; C.w_uq = f[11]; C.g_ckv = f[12]; C.w_ukv = f[13]; C.w_o_mla = f[14];
    C.mu = f[15]; C.w_dec = f[16]; C.dec_bias = f[17]; C.w_a = f[18]; C.a_bias = f[19]; C.w_g = f[20];
    C.k_k = f[21]; C.k_a = f[22]; C.r_k = f[23]; C.lnx_w = f[24]; C.lnx_b = f[25]; C.w_o_rwkv = f[26]; C.w_out = f[27];
    C.w_rg = f[28]; C.b_rg = f[29]; C.w_re = f[30]; C.b_re = f[31]; C.w_eg = f[32]; C.w_eu = f[33]; C.w_ed = f[34];
    C.out = (float*)d_out; C.ws = (unsigned char*)d_ws;

    g_breg = 0;
    hipMemsetAsync((char*)d_ws + WS_CTL, 0, CTL_ZERO_BYTES, stream);
    launch_mk(C, 0, 15, stream);
}
```

```cpp
#include <hip/hip_runtime.h>
#include <stdint.h>
#include <math.h>
#include <type_traits>

constexpr int NB = 16, SEQ = 2048, DM = 1024, T = NB * SEQ;
constexpr int NH = 8;
constexpr int QR = 384, KVR = 256, ROPE = 32, NOPE = 64, VD = 64, QK = NOPE + ROPE;
constexpr int RW = 512, DR = 64, AR = 64, GR = 128;
constexpr int MLA_IN = QR + KVR + ROPE;
constexpr int RWKV_IN = 3 * RW + DR + AR + GR;
constexpr int IN_W = MLA_IN + RWKV_IN + 2 * DM;
constexpr int NE = 32, EPG = 8, NG = 4, FF = 256;
constexpr float RMS_EPS = 1e-6f, GN_EPS = 64e-5f;
constexpr float QSCALE = 0.10206207261596577f * 1.4426950408889634f;

typedef unsigned short bf16_t;
__device__ __forceinline__ float bf2f(bf16_t h) { return __uint_as_float(((unsigned)h) << 16); }
__device__ __forceinline__ bf16_t f2bf(float f) { unsigned u = __float_as_uint(f); return (bf16_t)((u + 0x7fffu + ((u >> 16) & 1u)) >> 16); }
__device__ __forceinline__ float sigmoidf_(float x) { return 1.f / (1.f + __expf(-x)); }
typedef unsigned u32x2 __attribute__((ext_vector_type(2)));
typedef float f32x2_t __attribute__((ext_vector_type(2)));
typedef __bf16 bf16x2_t __attribute__((ext_vector_type(2)));
__device__ __forceinline__ unsigned cvtpk(float lo, float hi) { f32x2_t v = {lo, hi}; bf16x2_t b = __builtin_convertvector(v, bf16x2_t); return __builtin_bit_cast(unsigned, b); }
__device__ __forceinline__ float fsigmoid(float x) { return __builtin_amdgcn_rcpf(1.f + __expf(-x)); }
template <int CTRL> __device__ __forceinline__ float dpp_add_(float x) { return x + __builtin_bit_cast(float, __builtin_amdgcn_update_dpp(0, __builtin_bit_cast(int, x), CTRL, 0xf, 0xf, true)); }
__device__ __forceinline__ float wsum_dpp(float x) {
    x = dpp_add_<0xB1>(x); x = dpp_add_<0x4E>(x); x = dpp_add_<0x141>(x); x = dpp_add_<0x140>(x);
    x += __builtin_bit_cast(float, __builtin_amdgcn_update_dpp(0, __builtin_bit_cast(int, x), 0x142, 0xa, 0xf, false));
    x += __builtin_bit_cast(float, __builtin_amdgcn_update_dpp(0, __builtin_bit_cast(int, x), 0x143, 0xc, 0xf, false));
    return __builtin_bit_cast(float, __builtin_amdgcn_readlane(__builtin_bit_cast(int, x), 63));
}
__device__ __forceinline__ float sum8_dpp(float x) { x = dpp_add_<0xB1>(x); x = dpp_add_<0x4E>(x); x = dpp_add_<0x141>(x); return x; }
__device__ __forceinline__ float wave_sum(float v) {
#pragma unroll
    for (int o = 1; o < 64; o <<= 1) v += __shfl_xor(v, o);
    return v;
}

constexpr size_t MiB = 1u << 20;
constexpr size_t WS_MOD = 5 * MiB;
constexpr size_t WS_ROPE = 1 * MiB;
constexpr size_t WS_CTL = 0;
constexpr size_t CTL_ZERO_BYTES = 65536;
constexpr int MOE_SKIP = 1;
constexpr int CW_PFLAG = 15744;
constexpr int CW_RTFLAG = 15424;
constexpr int CW_GCNT = 15360;
constexpr size_t WS_H = 8 * MiB;
constexpr size_t WS_QF = 8 * MiB;
constexpr size_t WS_RWO = 8 * MiB;
constexpr size_t WS_ZM = 72 * MiB;
constexpr size_t WS_VF = 72 * MiB;
constexpr size_t WS_EBUF = 104 * MiB;
constexpr size_t WS_MIXED = 72 * MiB;
constexpr size_t WS_ACT = 72 * MiB;
constexpr size_t WS_ZL = 120 * MiB;
constexpr size_t WS_AV = 136 * MiB;
constexpr size_t WS_G = 168 * MiB;
constexpr size_t WS_Y = 200 * MiB;
constexpr size_t WS_YMIX = 136 * MiB;
constexpr size_t WS_CQN = 232 * MiB;
constexpr size_t WS_CKVN = 256 * MiB;
constexpr size_t WS_LORA = 272 * MiB;
constexpr size_t WS_ATT = 264 * MiB;
constexpr size_t WS_YSLOT = 264 * MiB;
constexpr size_t WS_H2LO = 264 * MiB;
constexpr size_t WS_X1B = 200 * MiB;
constexpr size_t WS_CGT = 8 * MiB, WS_CQT = 72 * MiB, WS_CHT = 200 * MiB, WS_CYL = 392 * MiB, WS_Y2 = 104 * MiB;
constexpr size_t WS_RKV = 296 * MiB;
constexpr size_t WS_KF = 392 * MiB;
constexpr size_t WS_MIX1 = 296 * MiB;
constexpr size_t WS_BONUS = 440 * MiB;
constexpr size_t WS_ROUTE = 442 * MiB;
constexpr size_t WS_LIST = 444 * MiB;
constexpr size_t WS_W = 448 * MiB;
constexpr size_t WS_QRAW = 448 * MiB;

struct Ctx {
    const float *x, *c; const int* pos;
    const float *w_ada, *b_ada, *g_pre_mix, *g_post_mix, *g_pre_ffn, *g_post_ffn;
    const float *w_in, *g_cq, *w_uq, *g_ckv, *w_ukv, *w_o_mla;
    const float *mu, *w_dec, *dec_bias, *w_a, *a_bias, *w_g, *k_k, *k_a, *r_k, *lnx_w, *lnx_b, *w_o_rwkv, *w_out;
    const float *w_rg, *b_rg, *w_re, *b_re, *w_eg, *w_eu, *w_ed;
    float* out; unsigned char* ws;
};

__device__ __forceinline__ void d_prep(const Ctx& C, int gw, int ngw, int lane) {
    typedef unsigned u32x4_ __attribute__((ext_vector_type(4)));
    const bf16_t* zm = (const bf16_t*)(C.ws + WS_ZM); const bf16_t* zl = (const bf16_t*)(C.ws + WS_ZL);
    bf16_t* cqn = (bf16_t*)(C.ws + WS_CQN); bf16_t* ckvn = (bf16_t*)(C.ws + WS_CKVN); bf16_t* lora = (bf16_t*)(C.ws + WS_LORA);
    bf16_t* kf = (bf16_t*)(C.ws + WS_KF);
    const float2* rope = (const float2*)(C.ws + WS_ROPE);
#define UNPK8(W_, F_) do { F_[0] = __uint_as_float(W_[0] << 16); F_[1] = __uint_as_float(W_[0] & 0xffff0000u); F_[2] = __uint_as_float(W_[1] << 16); F_[3] = __uint_as_float(W_[1] & 0xffff0000u); \
        F_[4] = __uint_as_float(W_[2] << 16); F_[5] = __uint_as_float(W_[2] & 0xffff0000u); F_[6] = __uint_as_float(W_[3] << 16); F_[7] = __uint_as_float(W_[3] & 0xffff0000u); } while (0)
    for (int t0 = gw * 4; t0 < T; t0 += ngw * 4) {
        const int b = t0 / SEQ, s0 = t0 % SEQ;
        u32x4_ wq[4], wk[4], wz[5];
        const u32x4_ zero4 = {0u, 0u, 0u, 0u};
#pragma unroll
        for (int r = 0; r < 4; ++r) { const bf16_t* zrow = zm + (size_t)(t0 + r) * 768;
            wq[r] = lane < 48 ? *(const u32x4_*)(zrow + 8 * lane) : zero4; wk[r] = lane < 32 ? *(const u32x4_*)(zrow + QR + 8 * lane) : zero4; }
#pragma unroll
        for (int r = 0; r < 5; ++r) { const bool ok = (lane < 32) && (r > 0 || s0 > 0);
            wz[r] = ok ? *(const u32x4_*)(zl + (size_t)(t0 + r - 1) * 256 + 8 * lane) : zero4; }
        float rs1[4], rs2[4];
#pragma unroll
        for (int r = 0; r < 4; ++r) { float v[8], u[8]; UNPK8(wq[r], v); UNPK8(wk[r], u); float ss = 0.f, su = 0.f;
#pragma unroll
            for (int e = 0; e < 8; ++e) { ss += v[e] * v[e]; su += u[e] * u[e]; }
            rs1[r] = ss; rs2[r] = su; }
#pragma unroll
        for (int r = 0; r < 4; ++r) { rs1[r] = rsqrtf(wsum_dpp(rs1[r]) * (1.f / QR) + RMS_EPS); rs2[r] = rsqrtf(wsum_dpp(rs2[r]) * (1.f / KVR) + RMS_EPS); }
        if (lane < 48) { const float4 g0 = *(const float4*)(C.g_cq + 8 * lane), g1 = *(const float4*)(C.g_cq + 8 * lane + 4);
#pragma unroll
            for (int r = 0; r < 4; ++r) { float v[8]; UNPK8(wq[r], v); const float q = rs1[r];
                u32x4_ o; o.x = cvtpk(v[0] * q * g0.x, v[1] * q * g0.y); o.y = cvtpk(v[2] * q * g0.z, v[3] * q * g0.w); o.z = cvtpk(v[4] * q * g1.x, v[5] * q * g1.y); o.w = cvtpk(v[6] * q * g1.z, v[7] * q * g1.w);
                *(u32x4_*)(cqn + (size_t)(t0 + r) * QR + 8 * lane) = o; } }
        if (lane < 32) { const float4 g0 = *(const float4*)(C.g_ckv + 8 * lane), g1 = *(const float4*)(C.g_ckv + 8 * lane + 4);
#pragma unroll
            for (int r = 0; r < 4; ++r) { float u[8]; UNPK8(wk[r], u); const float q = rs2[r];
                u32x4_ o; o.x = cvtpk(u[0] * q * g0.x, u[1] * q * g0.y); o.y = cvtpk(u[2] * q * g0.z, u[3] * q * g0.w); o.z = cvtpk(u[4] * q * g1.x, u[5] * q * g1.y); o.w = cvtpk(u[6] * q * g1.z, u[7] * q * g1.w);
                *(u32x4_*)(ckvn + (size_t)(t0 + r) * KVR + 8 * lane) = o; } }
        {   const int h = lane >> 3, i2 = (lane & 7) * 2;
#pragma unroll
            for (int r = 0; r < 4; ++r) { const int t = t0 + r; const bf16_t* zrow = zm + (size_t)t * 768 + QR + KVR;
                const unsigned pa = *(const unsigned*)(zrow + i2), pb = *(const unsigned*)(zrow + 16 + i2);
                const float x1a = __uint_as_float(pa << 16), x1b = __uint_as_float(pa & 0xffff0000u), x2a = __uint_as_float(pb << 16), x2b = __uint_as_float(pb & 0xffff0000u);
                const float4 cc = *(const float4*)(rope + (size_t)t * 16 + i2);
                u32x2 o; o.x = cvtpk(x1a * cc.x - x2a * cc.y, x2a * cc.x + x1a * cc.y); o.y = cvtpk(x1b * cc.z - x2b * cc.w, x2b * cc.z + x1b * cc.w);
                *(u32x2*)(kf + (((size_t)b * NH + h) * SEQ + (s0 + r)) * QK + NOPE + 2 * i2) = o; } }
        if (lane < 32) {
            const int c = 3 * RW / 8 + lane;
            const float4 m0 = *(const float4*)(C.mu + 8 * c), m1 = *(const float4*)(C.mu + 8 * c + 4);
            const float mm[8] = {m0.x, m0.y, m0.z, m0.w, m1.x, m1.y, m1.z, m1.w};
            float p[8]; UNPK8(wz[0], p);
#pragma unroll
            for (int r = 0; r < 4; ++r) {
                float z[8]; UNPK8(wz[r + 1], z);
                float zs[8];
#pragma unroll
                for (int e = 0; e < 8; ++e) { zs[e] = z[e] + (p[e] - z[e]) * mm[e]; p[e] = z[e]; }
                if (c < (3 * RW + DR) / 8) {
#pragma unroll
                    for (int e = 0; e < 8; ++e) { const float ex = __expf(2.f * zs[e]); zs[e] = 1.f - 2.f * __builtin_amdgcn_rcpf(ex + 1.f); } }
                else if (c >= (3 * RW + DR + AR) / 8) {
#pragma unroll
                    for (int e = 0; e < 8; ++e) zs[e] = fsigmoid(zs[e]); }
                u32x4_ o; o.x = cvtpk(zs[0], zs[1]); o.y = cvtpk(zs[2], zs[3]); o.z = cvtpk(zs[4], zs[5]); o.w = cvtpk(zs[6], zs[7]);
                *(u32x4_*)(lora + (size_t)(t0 + r) * 256 + 8 * lane) = o;
            }
        }
    }
#undef UNPK8
}

__device__ __forceinline__ void d_rwkv_post(const Ctx& C, int gw, int ngw, int lane) {
    typedef unsigned u32x4_ __attribute__((ext_vector_type(4)));
    const bf16_t* y = (const bf16_t*)(C.ws + WS_Y2); const float* bonus = (const float*)(C.ws + WS_BONUS);
    const bf16_t* rkv = (const bf16_t*)(C.ws + WS_RKV); const bf16_t* g = (const bf16_t*)(C.ws + WS_G);
    bf16_t* rwo = (bf16_t*)(C.ws + WS_RWO);
    const int c0 = 8 * lane, h = lane >> 3;
    const float4 lw0 = *(const float4*)(C.lnx_w + c0), lw1 = *(const float4*)(C.lnx_w + c0 + 4), lb0 = *(const float4*)(C.lnx_b + c0), lb1 = *(const float4*)(C.lnx_b + c0 + 4);
    const float lw[8] = {lw0.x, lw0.y, lw0.z, lw0.w, lw1.x, lw1.y, lw1.z, lw1.w}, lb[8] = {lb0.x, lb0.y, lb0.z, lb0.w, lb1.x, lb1.y, lb1.z, lb1.w};
    const float4 mv0 = *(const float4*)(C.mu + 2 * RW + c0), mv1 = *(const float4*)(C.mu + 2 * RW + c0 + 4);
    const float mv[8] = {mv0.x, mv0.y, mv0.z, mv0.w, mv1.x, mv1.y, mv1.z, mv1.w};
    for (int t0 = gw * 4; t0 < T; t0 += ngw * 4) {
        float4 ya[4], yb[4]; u32x4_ vv[4], gg[4]; float bn[4];
        u32x4_ vprev = (t0 % SEQ) ? *(const u32x4_*)(rkv + (size_t)(t0 - 1) * 1536 + 1024 + c0) : (u32x4_){0u, 0u, 0u, 0u};
#pragma unroll
        for (int r = 0; r < 4; ++r) { const size_t t = t0 + r;
            { const u32x4_ yw = *(const u32x4_*)(y + t * RW + c0);
              ya[r] = make_float4(__uint_as_float(yw[0] << 16), __uint_as_float(yw[0] & 0xffff0000u), __uint_as_float(yw[1] << 16), __uint_as_float(yw[1] & 0xffff0000u));
              yb[r] = make_float4(__uint_as_float(yw[2] << 16), __uint_as_float(yw[2] & 0xffff0000u), __uint_as_float(yw[3] << 16), __uint_as_float(yw[3] & 0xffff0000u)); }
            vv[r] = *(const u32x4_*)(rkv + t * 1536 + 1024 + c0); gg[r] = *(const u32x4_*)(g + t * RW + c0); bn[r] = bonus[t * NH + h]; }
#pragma unroll
        for (int r = 0; r < 4; ++r) {
            const float yv[8] = {ya[r].x, ya[r].y, ya[r].z, ya[r].w, yb[r].x, yb[r].y, yb[r].z, yb[r].w};
            float sm = 0.f;
#pragma unroll
            for (int e = 0; e < 8; ++e) sm += yv[e];
            const float mean = sum8_dpp(sm) * (1.f / 64.f);
            float sq = 0.f;
#pragma unroll
            for (int e = 0; e < 8; ++e) { const float d = yv[e] - mean; sq += d * d; }
            const float rstd = rsqrtf(sum8_dpp(sq) * (1.f / 64.f) + GN_EPS);
            float o[8];
#pragma unroll
            for (int e = 0; e < 4; ++e) {
                const unsigned pw = r == 0 ? vprev[e] : vv[r - 1][e];
                const float z0 = __uint_as_float(vv[r][e] << 16), z1 = __uint_as_float(vv[r][e] & 0xffff0000u), p0 = __uint_as_float(pw << 16), p1 = __uint_as_float(pw & 0xffff0000u);
                const unsigned sw = cvtpk(z0 + (p0 - z0) * mv[2 * e], z1 + (p1 - z1) * mv[2 * e + 1]);
                const float v0 = __uint_as_float(sw << 16), v1 = __uint_as_float(sw & 0xffff0000u), g0 = __uint_as_float(gg[r][e] << 16), g1 = __uint_as_float(gg[r][e] & 0xffff0000u);
                o[2 * e] = ((yv[2 * e] - mean) * rstd * lw[2 * e] + lb[2 * e] + bn[r] * v0) * g0;
                o[2 * e + 1] = ((yv[2 * e + 1] - mean) * rstd * lw[2 * e + 1] + lb[2 * e + 1] + bn[r] * v1) * g1; }
            u32x4_ w; w.x = cvtpk(o[0], o[1]); w.y = cvtpk(o[2], o[3]); w.z = cvtpk(o[4], o[5]); w.w = cvtpk(o[6], o[7]);
            *(u32x4_*)(rwo + (size_t)(t0 + r) * RW + c0) = w;
        }
    }
}

#define LAS __attribute__((address_space(3)))
typedef short bf16x8 __attribute__((ext_vector_type(8)));
typedef float f32x4 __attribute__((ext_vector_type(4)));
typedef float f32x16 __attribute__((ext_vector_type(16)));
typedef unsigned u32x4 __attribute__((ext_vector_type(4)));

constexpr int NWAVES = 8, NTHR = NWAVES * 64;
constexpr int RING_BYTES = 131072;
constexpr int LDSCTL_OFF = RING_BYTES;
constexpr int LDS_BYTES = 163840;

namespace pg8 {
constexpr int BM = 256, BK = 64, HALF = 128, HTB = HALF * BK * 2, NXCD = 8, WGM = 8;
__host__ __device__ __forceinline__ int lds_byte(int r, int c) { const int st = (r >> 4) * 2 + (c >> 5), rr = r & 15, cc = c & 31, ob = rr * 64 + cc * 2; return st * 1024 + (ob ^ (((ob >> 9) & 1) << 5)); }
__host__ __device__ __forceinline__ void stage_rc(int b, int& R, int& C) { const int st = b / 1024, sb = b % 1024, swz = sb ^ (((sb >> 9) & 1) << 5); R = (st >> 1) * 16 + swz / 64; C = (st & 1) * 32 + (swz % 64) / 2; }
__host__ __device__ __forceinline__ int perm32(int rho) { const int n = rho >> 4, i = rho & 15; return 8 * (i >> 2) + 4 * n + (i & 3); }

struct Unit { int pm, pn, z; };

struct StaticOrder {
    int nM, nN, nwg, G, c, parts;
    __device__ void init(int M, int N, int G_, int c_, int parts_ = 1) { nM = M / BM; nN = N / BM; nwg = nM * nN; G = G_; c = c_; parts = parts_; }
    __device__ bool next(int i, Unit& u) const {
        const int it = i / parts; u.z = i - it * parts;
        const long L = (long)it * G + c; if (L >= nwg) return false;
        int wgid = (int)L; { const int q = nwg / NXCD, r = nwg % NXCD, xcd = wgid % NXCD, off = wgid / NXCD; wgid = (xcd < r ? xcd * (q + 1) : r * (q + 1) + (xcd - r) * q) + off; }
        const int nig = WGM * nN, gid = wgid / nig, fm = gid * WGM, gsz = (nM - fm) < WGM ? (nM - fm) : WGM;
        u.pm = fm + ((wgid % nig) % gsz); u.pn = (wgid % nig) / gsz; return true;
    }
};
struct Dense { static constexpr bool GATHER = false; const bf16_t* A; const bf16_t* Bt; int lda, ldb, K;
    __device__ __forceinline__ unsigned a_off(const Unit&, int R) const { return (unsigned)(R * lda) * 2u; }
    __device__ __forceinline__ const char* a_ptr(const Unit& u) const { return (const char*)(A + (size_t)u.pm * BM * lda); }
    __device__ __forceinline__ const char* b_ptr(const Unit& u) const { return (const char*)(Bt + (size_t)u.pn * BM * ldb); } };

template <class T, class = void> struct has_signal : std::false_type {};
template <class T> struct has_signal<T, std::void_t<decltype(T::SIGNAL)>> : std::true_type {};
template <class T, class = void> struct a_aux { static constexpr int value = 0; };
template <class T> struct a_aux<T, std::void_t<decltype(T::A_AUX)>> { static constexpr int value = T::A_AUX; };
template <bool ALIGN_EPI = true, class Epi, class Prob, class Sched>
__device__ __forceinline__ void gemm_phase(LAS unsigned char* lds, const Prob& P, const Sched& S, const Epi& E) {
    const int tid = threadIdx.x, wid = __builtin_amdgcn_readfirstlane(tid >> 6), lane = tid & 63, wr = wid >> 2, wc = wid & 3, fr = lane & 15, fq = lane >> 4;
    const int K = P.K, nt = K / BK;
    unsigned voffB[2]; int RA[2], CA[2];
#pragma unroll
    for (int i = 0; i < 2; ++i) { int R, C; stage_rc(tid * 16 + i * 8192, R, C); const int Rb = Epi::PERM ? ((R & ~31) + perm32(R & 31)) : R;
        RA[i] = R; CA[i] = C * 2; voffB[i] = (unsigned)(Rb * P.ldb + C) * 2u; }
    unsigned vAc[2][2], vAn[2][2];
#define PG8_FILLA(v, u) do { _Pragma("unroll") for (int h_ = 0; h_ < 2; ++h_) _Pragma("unroll") for (int i_ = 0; i_ < 2; ++i_) v[h_][i_] = P.a_off(u, RA[i_] + h_ * HALF) + (unsigned)CA[i_]; } while (0)
    const size_t kstep = (size_t)(BK * 2);
    const size_t hstepB = (size_t)HALF * P.ldb * 2;
    const unsigned ldsw = (unsigned)wid * 1024u;
    const int aoff = lds_byte(wr * 64 + fr, fq * 8), boff = lds_byte(wc * 32 + fr, fq * 8);
#define PG8_SA(b, h) (((b) * 2 + (h)) * HTB)
#define PG8_SB(b, h) ((4 + (b) * 2 + (h)) * HTB)
#define PG8_STAGE(bufoff, gbase, voff) do { _Pragma("unroll") for (int _i = 0; _i < 2; ++_i) \
        __builtin_amdgcn_global_load_lds((const unsigned*)((const char*)(gbase) + (voff)[_i]), (LAS unsigned*)(lds + (bufoff) + ldsw + _i * 8192), 16, 0, 0); } while (0)
#define PG8_STAGEA(bufoff, gbase, voff) do { _Pragma("unroll") for (int _i = 0; _i < 2; ++_i) \
        __builtin_amdgcn_global_load_lds((const unsigned*)((const char*)(gbase) + (voff)[_i]), (LAS unsigned*)(lds + (bufoff) + ldsw + _i * 8192), 16, 0, a_aux<Prob>::value); } while (0)
#define PG8_LDA(dst, b, h) do { _Pragma("unroll") for (int m = 0; m < 4; ++m) _Pragma("unroll") for (int k = 0; k < 2; ++k) dst[m][k] = *(const LAS bf16x8*)(lds + PG8_SA(b, h) + aoff + m * 2048 + k * 1024); } while (0)
#define PG8_LDB(dst, b, h) do { _Pragma("unroll") for (int n = 0; n < 2; ++n) _Pragma("unroll") for (int k = 0; k < 2; ++k) dst[n][k] = *(const LAS bf16x8*)(lds + PG8_SB(b, h) + boff + n * 2048 + k * 1024); } while (0)
#define PG8_MMA(ai, bj, At, Bt) do { __builtin_amdgcn_s_setprio(1); _Pragma("unroll") for (int m = 0; m < 4; ++m) _Pragma("unroll") for (int n = 0; n < 2; ++n) _Pragma("unroll") for (int k = 0; k < 2; ++k) \
        acc[ai][bj][m][n] = __builtin_amdgcn_mfma_f32_16x16x32_bf16(Bt[n][k], At[m][k], acc[ai][bj][m][n], 0, 0, 0); __builtin_amdgcn_s_setprio(0); } while (0)
#define PG8_WAIT_V(n) asm volatile("s_waitcnt vmcnt(" #n ")" ::: "memory")
#define PG8_WAIT_L(n) asm volatile("s_waitcnt lgkmcnt(" #n ")" ::: "memory")
#define PG8_BAR __builtin_amdgcn_s_barrier()
#define PG8_SCHED __builtin_amdgcn_sched_barrier(0)
    Unit cur, nxt; int ui = 0;
    if (!S.next(0, cur)) return;
    f32x4 acc[2][2][4][2];
#pragma unroll
    for (int a = 0; a < 2; ++a)
#pragma unroll
        for (int b = 0; b < 2; ++b)
#pragma unroll
            for (int m = 0; m < 4; ++m)
#pragma unroll
                for (int n = 0; n < 2; ++n) acc[a][b][m][n] = (f32x4){0.f, 0.f, 0.f, 0.f};
    bf16x8 At[4][2], B0[2][2], B1[2][2];
    const char* cA = P.a_ptr(cur); const char* cB = P.b_ptr(cur);
    PG8_FILLA(vAc, cur);
    PG8_STAGE(PG8_SB(0, 0), cB, voffB); PG8_STAGE(PG8_SB(0, 1), cB + hstepB, voffB); PG8_STAGEA(PG8_SA(0, 0), cA, vAc[0]); PG8_STAGEA(PG8_SA(0, 1), cA, vAc[1]);
    if (wr == 1) PG8_BAR;
    PG8_WAIT_V(2); PG8_BAR;
    PG8_STAGE(PG8_SB(1, 0), cB + kstep, voffB); PG8_STAGEA(PG8_SA(1, 0), cA + kstep, vAc[0]); PG8_STAGE(PG8_SB(1, 1), cB + hstepB + kstep, voffB);
    PG8_WAIT_V(6); PG8_BAR;
    for (;;) {
        const bool has_next = S.next(ui + 1, nxt);
        const char* nA = has_next ? P.a_ptr(nxt) : cA; const char* nB = has_next ? P.b_ptr(nxt) : cB;
        if (Prob::GATHER && has_next) { PG8_FILLA(vAn, nxt); }
        else {
#pragma unroll
            for (int h_ = 0; h_ < 2; ++h_)
#pragma unroll
                for (int i_ = 0; i_ < 2; ++i_) vAn[h_][i_] = vAc[h_][i_]; }
        for (int t = 0; t < nt; t += 2) {
            const bool last = (t == nt - 2);
            const char* a1 = cA + (size_t)(t + 1) * kstep;
            const char* a2 = last ? nA : cA + (size_t)(t + 2) * kstep; const char* b2 = last ? nB : cB + (size_t)(t + 2) * kstep;
            const char* a3 = a2 + kstep; const char* b3 = b2 + kstep;
            unsigned vA2[2][2];
#pragma unroll
            for (int h_ = 0; h_ < 2; ++h_)
#pragma unroll
                for (int i_ = 0; i_ < 2; ++i_) vA2[h_][i_] = (Prob::GATHER && last) ? vAn[h_][i_] : vAc[h_][i_];
            PG8_LDB(B0, 0, 0); PG8_LDB(B1, 0, 1); PG8_SCHED; PG8_LDA(At, 0, 0); PG8_STAGEA(PG8_SA(1, 1), a1, vAc[1]);
            PG8_WAIT_V(8); PG8_WAIT_L(0); PG8_BAR; PG8_MMA(0, 0, At, B0); PG8_MMA(0, 1, At, B1); PG8_BAR; PG8_SCHED;
            PG8_LDA(At, 0, 1); PG8_STAGE(PG8_SB(0, 0), b2, voffB); PG8_STAGE(PG8_SB(0, 1), b2 + hstepB, voffB); PG8_STAGEA(PG8_SA(0, 0), a2, vA2[0]);
            PG8_WAIT_V(8); PG8_WAIT_L(0); PG8_BAR; PG8_MMA(1, 0, At, B0); PG8_MMA(1, 1, At, B1); PG8_BAR; PG8_SCHED;
            PG8_LDB(B0, 1, 0); PG8_LDB(B1, 1, 1); PG8_SCHED; PG8_LDA(At, 1, 0); PG8_STAGEA(PG8_SA(0, 1), a2, vA2[1]);
            PG8_WAIT_V(8); PG8_WAIT_L(0); PG8_BAR; PG8_MMA(0, 0, At, B0); PG8_MMA(0, 1, At, B1); PG8_BAR; PG8_SCHED;
            PG8_LDA(At, 1, 1); PG8_STAGE(PG8_SB(1, 0), b3, voffB); PG8_STAGE(PG8_SB(1, 1), b3 + hstepB, voffB); PG8_STAGEA(PG8_SA(1, 0), a3, vA2[0]);
            PG8_WAIT_V(8); PG8_WAIT_L(0); PG8_BAR; PG8_MMA(1, 0, At, B0); PG8_MMA(1, 1, At, B1); PG8_BAR; PG8_SCHED;
        }
        if constexpr (ALIGN_EPI) { if (wr == 0) PG8_BAR; }
        E(acc, cur, wr, wc, fr, fq);
        if constexpr (has_signal<Epi>::value) { if (E.sig_now(cur)) { PG8_WAIT_V(0); PG8_BAR; if (tid == 0) E.signal(cur); } }
        if (!has_next) break;
        if (!E.keep(cur)) {
#pragma unroll
            for (int a = 0; a < 2; ++a)
#pragma unroll
                for (int b = 0; b < 2; ++b)
#pragma unroll
                    for (int m = 0; m < 4; ++m)
#pragma unroll
                        for (int n = 0; n < 2; ++n) acc[a][b][m][n] = (f32x4){0.f, 0.f, 0.f, 0.f};
        }
        cur = nxt; cA = nA; cB = nB; ++ui;
#pragma unroll
        for (int h_ = 0; h_ < 2; ++h_)
#pragma unroll
            for (int i_ = 0; i_ < 2; ++i_) vAc[h_][i_] = vAn[h_][i_];
        if constexpr (ALIGN_EPI) { if (wr == 1) PG8_BAR; }
    }
    PG8_WAIT_V(0);
    if constexpr (!ALIGN_EPI) { if (wr == 0) PG8_BAR; }
    PG8_BAR;
#undef PG8_FILLA
#undef PG8_SA
#undef PG8_SB
#undef PG8_STAGE
#undef PG8_STAGEA
#undef PG8_LDA
#undef PG8_LDB
#undef PG8_MMA
#undef PG8_WAIT_V
#undef PG8_WAIT_L
#undef PG8_BAR
#undef PG8_SCHED
}

struct EpiZ { static constexpr bool PERM = true; bf16_t *zm, *zrkv, *zl, *gates;
    __device__ __forceinline__ bool keep(const Unit&) const { return false; }
    __device__ __forceinline__ void operator()(f32x4 (&acc)[2][2][4][2], const Unit& u, int wr, int wc, int fr, int fq) const {
        bf16_t* base; int ldc, colt; bool sig = false;
        if (u.pn < 3) { base = zm; ldc = 768; colt = u.pn * 256; } else if (u.pn < 9) { base = zrkv; ldc = 3 * RW; colt = (u.pn - 3) * 256; } else if (u.pn == 9) { base = zl; ldc = 256; colt = 0; } else { base = gates; ldc = 2048; colt = (u.pn - 10) * 256; sig = true; }
        const int row0 = u.pm * BM + wr * 64 + fr, col0 = colt + wc * 32 + 8 * fq;
#pragma unroll
        for (int ai = 0; ai < 2; ++ai)
#pragma unroll
            for (int m = 0; m < 4; ++m) { bf16_t* rowp = base + (size_t)(row0 + ai * HALF + m * 16) * ldc + col0;
#pragma unroll
                for (int bj = 0; bj < 2; ++bj) { f32x4 v0 = acc[ai][bj][m][0], v1 = acc[ai][bj][m][1];
                    if (sig) {
#pragma unroll
                        for (int e = 0; e < 4; ++e) { v0[e] = fsigmoid(v0[e]); v1[e] = fsigmoid(v1[e]); } }
                    u32x4 w; w.x = cvtpk(v0[0], v0[1]); w.y = cvtpk(v0[2], v0[3]); w.z = cvtpk(v1[0], v1[1]); w.w = cvtpk(v1[2], v1[3]);
                    *(u32x4*)(rowp + bj * HALF) = w; } }
    } };

struct EpiQ { static constexpr bool PERM = true; bf16_t* qf; const float2* rope;
    __device__ __forceinline__ bool keep(const Unit&) const { return false; }
    __device__ __forceinline__ void operator()(f32x4 (&acc)[2][2][4][2], const Unit& u, int wr, int wc, int fr, int fq) const {
#pragma unroll
        for (int bj = 0; bj < 2; ++bj) {
            const int c0 = u.pn * BM + bj * HALF + wc * 32 + 8 * fq, h = c0 / QK, d0 = c0 - h * QK;
#pragma unroll
            for (int ai = 0; ai < 2; ++ai)
#pragma unroll
                for (int m = 0; m < 4; ++m) {
                    const int t = u.pm * BM + ai * HALF + wr * 64 + m * 16 + fr, b = t / SEQ, s_ = t - b * SEQ;
                    f32x4 v0 = acc[ai][bj][m][0], v1 = acc[ai][bj][m][1];
                    if (d0 >= NOPE) { const int i0 = (d0 - NOPE) >> 1; const float2* cs = rope + (size_t)t * 16 + i0;
                        const float2 c0_ = cs[0], c1_ = cs[1], c2_ = cs[2], c3_ = cs[3];
                        const f32x4 w0 = {v0[0] * c0_.x - v0[1] * c0_.y, v0[1] * c0_.x + v0[0] * c0_.y, v0[2] * c1_.x - v0[3] * c1_.y, v0[3] * c1_.x + v0[2] * c1_.y};
                        const f32x4 w1 = {v1[0] * c2_.x - v1[1] * c2_.y, v1[1] * c2_.x + v1[0] * c2_.y, v1[2] * c3_.x - v1[3] * c3_.y, v1[3] * c3_.x + v1[2] * c3_.y};
                        v0 = w0; v1 = w1; }
                    v0 = v0 * QSCALE; v1 = v1 * QSCALE;
                    u32x4 w; w.x = cvtpk(v0[0], v0[1]); w.y = cvtpk(v0[2], v0[3]); w.z = cvtpk(v1[0], v1[1]); w.w = cvtpk(v1[2], v1[3]);
                    *(u32x4*)(qf + (((size_t)b * NH + h) * SEQ + s_) * QK + d0) = w; } }
    } };
struct EpiKVp { static constexpr bool PERM = true; bf16_t *kf, *vf;
    __device__ __forceinline__ bool keep(const Unit&) const { return false; }
    __device__ __forceinline__ void operator()(f32x4 (&acc)[2][2][4][2], const Unit& u, int wr, int wc, int fr, int fq) const {
#pragma unroll
        for (int bj = 0; bj < 2; ++bj) {
            const int c0 = u.pn * BM + bj * HALF + wc * 32 + 8 * fq, h = c0 >> 7, c = c0 & 127;
#pragma unroll
            for (int ai = 0; ai < 2; ++ai)
#pragma unroll
                for (int m = 0; m < 4; ++m) {
                    const int t = u.pm * BM + ai * HALF + wr * 64 + m * 16 + fr, b = t / SEQ, s_ = t - b * SEQ;
                    const f32x4 v0 = acc[ai][bj][m][0], v1 = acc[ai][bj][m][1];
                    u32x4 w; w.x = cvtpk(v0[0], v0[1]); w.y = cvtpk(v0[2], v0[3]); w.z = cvtpk(v1[0], v1[1]); w.w = cvtpk(v1[2], v1[3]);
                    const size_t rowi = ((size_t)b * NH + h) * SEQ + s_;
                    if (c < 64) *(u32x4*)(kf + rowi * QK + c) = w; else *(u32x4*)(vf + rowi * VD + (c - 64)) = w; } }
    } };
struct EpiLora { static constexpr bool PERM = true; bf16_t *eb; const float *dbias, *abias;
    __device__ __forceinline__ bool keep(const Unit&) const { return false; }
    __device__ __forceinline__ void operator()(f32x4 (&acc)[2][2][4][2], const Unit& u, int wr, int wc, int fr, int fq) const {
        const int kind = u.pn >> 1; bf16_t* base = eb + (size_t)kind * ((size_t)T * RW);
        const float* bp = kind == 0 ? dbias : abias;
#pragma unroll
        for (int bj = 0; bj < 2; ++bj) {
            const int c0 = (u.pn & 1) * BM + bj * HALF + wc * 32 + 8 * fq;
            float bs[8];
#pragma unroll
            for (int e = 0; e < 8; ++e) bs[e] = kind < 2 ? bp[c0 + e] : 0.f;
#pragma unroll
            for (int ai = 0; ai < 2; ++ai)
#pragma unroll
                for (int m = 0; m < 4; ++m) {
                    const int t = u.pm * BM + ai * HALF + wr * 64 + m * 16 + fr;
                    float v[8];
#pragma unroll
                    for (int e = 0; e < 4; ++e) { v[e] = acc[ai][bj][m][0][e] + bs[e]; v[4 + e] = acc[ai][bj][m][1][e] + bs[4 + e]; }
                    if (kind == 0) {
#pragma unroll
                        for (int e = 0; e < 8; ++e) v[e] = 0.60653065971263342f * fsigmoid(v[e]); }
                    else if (kind == 1) {
#pragma unroll
                        for (int e = 0; e < 8; ++e) v[e] = fsigmoid(v[e]); }
                    u32x4 w; w.x = cvtpk(v[0], v[1]); w.y = cvtpk(v[2], v[3]); w.z = cvtpk(v[4], v[5]); w.w = cvtpk(v[6], v[7]);
                    *(u32x4*)(base + (size_t)t * RW + c0) = w; } }
    } };
struct DenseSC { static constexpr bool GATHER = false; static constexpr int A_AUX = 16; const bf16_t* A; const bf16_t* Bt; int lda, ldb, K;
    __device__ __forceinline__ unsigned a_off(const Unit&, int R) const { return (unsigned)(R * lda) * 2u; }
    __device__ __forceinline__ const char* a_ptr(const Unit& u) const { return (const char*)(A + (size_t)u.pm * BM * lda); }
    __device__ __forceinline__ const char* b_ptr(const Unit& u) const { return (const char*)(Bt + (size_t)u.pn * BM * ldb); } };
struct StaticOrderW { StaticOrder so; unsigned* flag; unsigned need;
    __device__ bool next(int i, Unit& u) const { if (!so.next(i, u)) return false;
        unsigned* f = flag + u.pm;
        for (unsigned sp = 0; __hip_atomic_load(f, __ATOMIC_RELAXED, __HIP_MEMORY_SCOPE_AGENT) < need && sp < (1u << 20); ++sp) __builtin_amdgcn_s_sleep(2);
        asm volatile("" ::: "memory");
        return true; } };
struct MixProb { static constexpr bool GATHER = false; const bf16_t *A0, *A1, *B0, *B1; int lda, ldb, K;
    __device__ __forceinline__ unsigned a_off(const Unit&, int R) const { return (unsigned)(R * lda) * 2u; }
    __device__ __forceinline__ const char* a_ptr(const Unit& u) const { return (const char*)((u.z ? A1 : A0) + (size_t)u.pm * BM * lda); }
    __device__ __forceinline__ const char* b_ptr(const Unit& u) const { return (const char*)((u.z ? B1 : B0) + (size_t)u.pn * BM * ldb); } };
struct EpiMix { static constexpr bool PERM = true; static constexpr bool SIGNAL = true; const bf16_t* gates; bf16_t* mixed; unsigned* flag;
    __device__ __forceinline__ bool keep(const Unit& u) const { return u.z == 0; }
    __device__ __forceinline__ bool sig_now(const Unit& u) const { return u.z != 0; }
    __device__ __forceinline__ void signal(const Unit& u) const { __hip_atomic_fetch_add(flag + u.pm, 1u, __ATOMIC_RELAXED, __HIP_MEMORY_SCOPE_AGENT); }
    __device__ __forceinline__ void operator()(f32x4 (&acc)[2][2][4][2], const Unit& u, int wr, int wc, int fr, int fq) const {
#pragma unroll
        for (int bj = 0; bj < 2; ++bj) {
            const int c0 = u.pn * BM + bj * HALF + wc * 32 + 8 * fq;
#pragma unroll
            for (int ai = 0; ai < 2; ++ai)
#pragma unroll
                for (int m = 0; m < 4; ++m) {
                    const int t = u.pm * BM + ai * HALF + wr * 64 + m * 16 + fr;
                    const u32x4 gbw = *(const u32x4*)(gates + (size_t)t * 2048 + DM + c0);
                    float gbv[8];
#pragma unroll
                    for (int e = 0; e < 4; ++e) { gbv[2 * e] = fmaxf(__uint_as_float(gbw[e] << 16), 1e-30f); gbv[2 * e + 1] = fmaxf(__uint_as_float(gbw[e] & 0xffff0000u), 1e-30f); }
                    if (u.z == 0) {
                        const u32x4 gaw = *(const u32x4*)(gates + (size_t)t * 2048 + c0);
#pragma unroll
                        for (int e = 0; e < 4; ++e) { const float ga0 = __uint_as_float(gaw[e] << 16), ga1 = __uint_as_float(gaw[e] & 0xffff0000u);
                            const float r0 = ga0 * __builtin_amdgcn_rcpf(gbv[2 * e]), r1 = ga1 * __builtin_amdgcn_rcpf(gbv[2 * e + 1]);
                            if (e < 2) { acc[ai][bj][m][0][2 * e] *= r0; acc[ai][bj][m][0][2 * e + 1] *= r1; } else { acc[ai][bj][m][1][2 * e - 4] *= r0; acc[ai][bj][m][1][2 * e - 3] *= r1; } }
                    } else {
                        float v[8];
#pragma unroll
                        for (int e = 0; e < 4; ++e) { v[e] = acc[ai][bj][m][0][e] * gbv[e]; v[4 + e] = acc[ai][bj][m][1][e] * gbv[4 + e]; }
                        u32x4 w; w.x = cvtpk(v[0], v[1]); w.y = cvtpk(v[2], v[3]); w.z = cvtpk(v[4], v[5]); w.w = cvtpk(v[6], v[7]);
                        asm volatile("global_store_dwordx4 %0, %1, off sc1\n\ts_nop 1" :: "v"(mixed + (size_t)t * DM + c0), "v"(w) : "memory"); } } }
    } };
struct EpiOutF { static constexpr bool PERM = true; bf16_t* y;
    __device__ __forceinline__ bool keep(const Unit&) const { return false; }
    __device__ __forceinline__ void operator()(f32x4 (&acc)[2][2][4][2], const Unit& u, int wr, int wc, int fr, int fq) const {
#pragma unroll
        for (int bj = 0; bj < 2; ++bj) {
            const int c0 = u.pn * BM + bj * HALF + wc * 32 + 8 * fq;
#pragma unroll
            for (int ai = 0; ai < 2; ++ai)
#pragma unroll
                for (int m = 0; m < 4; ++m) {
                    const int t = u.pm * BM + ai * HALF + wr * 64 + m * 16 + fr;
                    const f32x4 v0 = acc[ai][bj][m][0], v1 = acc[ai][bj][m][1];
                    u32x4 w; w.x = cvtpk(v0[0], v0[1]); w.y = cvtpk(v0[2], v0[3]); w.z = cvtpk(v1[0], v1[1]); w.w = cvtpk(v1[2], v1[3]);
                    *(u32x4*)(y + (size_t)t * DM + c0) = w; } }
    } };

constexpr int MOE_MAXU = 8;
struct MoeTab { const LAS int* desc; const LAS int* rowtab; };
struct MoeSched { MoeTab tb;
    __device__ __forceinline__ bool next(int i, Unit& u) const { if (i >= MOE_MAXU || tb.desc[i * 8 + 5] == 0) return false; u.pm = i; u.pn = tb.desc[i * 8 + 2]; u.z = tb.desc[i * 8 + 0]; return true; } };
struct MoeSched2 { MoeTab tb; unsigned* flag;
    __device__ __forceinline__ bool next(int i, Unit& u) const { if (i >= MOE_MAXU || tb.desc[i * 8 + 5] == 0) return false; u.pm = i; u.pn = tb.desc[i * 8 + 2]; u.z = tb.desc[i * 8 + 0];
        unsigned* f = flag + (tb.desc[i * 8 + 4] >> 8);
        for (unsigned sp = 0; __hip_atomic_load(f, __ATOMIC_RELAXED, __HIP_MEMORY_SCOPE_AGENT) < 2u && sp < (1u << 20); ++sp) __builtin_amdgcn_s_sleep(2);
        asm volatile("" ::: "memory");
        return true; } };
struct MoeProb1 { static constexpr bool GATHER = true; const bf16_t* h2; const bf16_t* wgu; MoeTab tb; int lda, ldb, K;
    __device__ __forceinline__ unsigned a_off(const Unit& u, int R) const { return (unsigned)((tb.rowtab[u.pm * 256 + R] >> 1) * lda) * 2u; }
    __device__ __forceinline__ const char* a_ptr(const Unit&) const { return (const char*)h2; }
    __device__ __forceinline__ const char* b_ptr(const Unit& u) const { return (const char*)(wgu + ((size_t)u.z * 512 + u.pn * BM) * ldb); } };
struct MoeProb2 { static constexpr bool GATHER = false; static constexpr int A_AUX = 16  ; const bf16_t* act; const bf16_t* wdn; MoeTab tb; int lda, ldb, K;
    __device__ __forceinline__ unsigned a_off(const Unit&, int R) const { return (unsigned)(R * lda) * 2u; }
    __device__ __forceinline__ const char* a_ptr(const Unit& u) const { return (const char*)(act + (size_t)tb.desc[u.pm * 8 + 4] * lda); }
    __device__ __forceinline__ const char* b_ptr(const Unit& u) const { return (const char*)(wdn + ((size_t)u.z * 1024 + u.pn * BM) * ldb); } };
struct EpiMoe1 { static constexpr bool PERM = true; static constexpr bool SIGNAL = true; bf16_t* act; const float* tokw; MoeTab tb; unsigned* flag;
    __device__ __forceinline__ bool keep(const Unit&) const { return false; }
    __device__ __forceinline__ bool sig_now(const Unit&) const { return true; }
    __device__ __forceinline__ void signal(const Unit& u) const {
        __hip_atomic_fetch_add(flag + (tb.desc[u.pm * 8 + 4] >> 8), 1u, __ATOMIC_RELAXED, __HIP_MEMORY_SCOPE_AGENT); }
    __device__ __forceinline__ void operator()(f32x4 (&acc)[2][2][4][2], const Unit& u, int wr, int wc, int fr, int fq) const {
        const int nvalid = tb.desc[u.pm * 8 + 3], arow0 = tb.desc[u.pm * 8 + 4];
        const int f0 = u.pn * HALF + wc * 32 + 8 * fq;
#pragma unroll
        for (int ai = 0; ai < 2; ++ai)
#pragma unroll
            for (int m = 0; m < 4; ++m) {
                const int r = ai * HALF + wr * 64 + m * 16 + fr;
                if (r < nvalid) {
                    const float w = tokw[tb.rowtab[u.pm * 256 + r]];
                    float v[8];
#pragma unroll
                    for (int e = 0; e < 4; ++e) { const float g0 = acc[ai][0][m][0][e], g1 = acc[ai][0][m][1][e];
                        v[e] = g0 * fsigmoid(g0) * acc[ai][1][m][0][e] * w; v[4 + e] = g1 * fsigmoid(g1) * acc[ai][1][m][1][e] * w; }
                    u32x4 o; o.x = cvtpk(v[0], v[1]); o.y = cvtpk(v[2], v[3]); o.z = cvtpk(v[4], v[5]); o.w = cvtpk(v[6], v[7]);
                    asm volatile("global_store_dwordx4 %0, %1, off sc1\n\ts_nop 1" :: "v"(act + (size_t)(arow0 + r) * FF + f0), "v"(o) : "memory"); } }
    } };
struct EpiMoe2 { static constexpr bool PERM = true; bf16_t* ys; MoeTab tb;
    __device__ __forceinline__ bool keep(const Unit&) const { return false; }
    __device__ __forceinline__ void operator()(f32x4 (&acc)[2][2][4][2], const Unit& u, int wr, int wc, int fr, int fq) const {
        const int nvalid = tb.desc[u.pm * 8 + 3];
#pragma unroll
        for (int ai = 0; ai < 2; ++ai)
#pragma unroll
            for (int m = 0; m < 4; ++m) {
                const int r = ai * HALF + wr * 64 + m * 16 + fr;
                if (r < nvalid) {
                    bf16_t* rowp = ys + (size_t)tb.rowtab[u.pm * 256 + r] * DM + u.pn * BM + wc * 32 + 8 * fq;
#pragma unroll
                    for (int bj = 0; bj < 2; ++bj) { const f32x4 v0 = acc[ai][bj][m][0], v1 = acc[ai][bj][m][1];
                        u32x4 o; o.x = cvtpk(v0[0], v0[1]); o.y = cvtpk(v0[2], v0[3]); o.z = cvtpk(v1[0], v1[1]); o.w = cvtpk(v1[2], v1[3]);
                        *(u32x4*)(rowp + bj * HALF) = o; } } }
    } };
}


namespace rsg {
#define RS_LD1(dst_, p_) asm volatile("global_load_dwordx4 %0, %1, off" : "=v"(dst_) : "v"(p_) : "memory")
template <int N> struct WaitVm;
#define RS_DEFWAIT(N_) template <> struct WaitVm<N_> { template <int P> static __device__ __forceinline__ void w(u32x4 (&r)[P]) { \
    if constexpr (P == 1) asm volatile("s_waitcnt vmcnt(" #N_ ")" : "+v"(r[0]) :: "memory"); \
    else if constexpr (P == 2) asm volatile("s_waitcnt vmcnt(" #N_ ")" : "+v"(r[0]), "+v"(r[1]) :: "memory"); \
    else if constexpr (P == 4) asm volatile("s_waitcnt vmcnt(" #N_ ")" : "+v"(r[0]), "+v"(r[1]), "+v"(r[2]), "+v"(r[3]) :: "memory"); \
    else asm volatile("s_waitcnt vmcnt(" #N_ ")" : "+v"(r[0]), "+v"(r[1]), "+v"(r[2]), "+v"(r[3]), "+v"(r[4]), "+v"(r[5]) :: "memory"); } };
RS_DEFWAIT(0) RS_DEFWAIT(1) RS_DEFWAIT(2) RS_DEFWAIT(3) RS_DEFWAIT(4) RS_DEFWAIT(5) RS_DEFWAIT(6) RS_DEFWAIT(7) RS_DEFWAIT(8) RS_DEFWAIT(9) RS_DEFWAIT(10) RS_DEFWAIT(11) RS_DEFWAIT(12)
RS_DEFWAIT(13) RS_DEFWAIT(14) RS_DEFWAIT(15) RS_DEFWAIT(16)
template <int KT, class Prob, class Epi>
__device__ __forceinline__ void rs_gemm_phase(LAS unsigned char* lds, const Prob& P, const Epi& E, int tid, int lane, int wave) {
    constexpr int K = KT * 16, ROWB = 2 * K + 16, SLAB = 64 * ROWB, CPR = K / 8, NPC = 64 * CPR, PPT = NPC / NTHR, NST = Epi::NST;
    constexpr int TROW = 144, TBUF = 32 * TROW;
    static_assert(NPC % NTHR == 0 && 2 * SLAB + 8 * TBUF <= LDS_BYTES - 64, "slab ring");
    LAS unsigned char* tbuf = lds + 2 * SLAB + wave * TBUF;
    const int r32 = lane & 31, hi = lane >> 5;
    int goff[PPT], loff[PPT];
    const int ldb = P.ldb;
#pragma unroll
    for (int q = 0; q < PPT; ++q) { const int p = tid + NTHR * q; goff[q] = (p / CPR) * ldb + 8 * (p % CPR); loff[q] = (p / CPR) * ROWB + (p % CPR) * 16; }
    for (int ui = 0; P.valid(ui); ++ui) {
        const int NT = P.ntiles(ui);
        const bf16_t* bt = P.b_ptr(ui);
        typename Epi::St st = E.prep(ui, wave, lane);
        u32x4 afr[KT];
        {   const bf16_t* rowp = P.a_row(ui, 32 * wave + r32) + 8 * hi;
#pragma unroll
            for (int s_ = 0; s_ < KT; ++s_) RS_LD1(afr[s_], rowp + 16 * s_); }
        u32x4 sr0[PPT], sr1[PPT];
#define RS_LOAD(S_, j_) do { const int jj_ = (j_) < NT ? (j_) : NT - 1; const bf16_t* bp_ = bt + (size_t)jj_ * 64 * ldb; \
        _Pragma("unroll") for (int q = 0; q < PPT; ++q) RS_LD1(S_[q], bp_ + goff[q]); } while (0)
#define RS_WRITE(S_, j_) do { LAS unsigned char* sb_ = lds + ((j_) & 1) * SLAB; _Pragma("unroll") for (int q = 0; q < PPT; ++q) *(LAS u32x4*)(sb_ + loff[q]) = S_[q]; } while (0)
#define RS_BODY(j_, S_, WN_) do { \
        WaitVm<WN_>::w(S_); \
        asm volatile("s_waitcnt lgkmcnt(0)" ::: "memory"); __builtin_amdgcn_s_barrier(); asm volatile("" ::: "memory"); \
        RS_WRITE(S_, (j_) + 1); RS_LOAD(S_, (j_) + 3); \
        f32x16 acc0, acc1; \
        _Pragma("unroll") for (int q = 0; q < 16; ++q) { acc0[q] = 0.f; acc1[q] = 0.f; } \
        const LAS unsigned char* sp_ = lds + ((j_) & 1) * SLAB + r32 * ROWB + hi * 16; \
        _Pragma("unroll") for (int s_ = 0; s_ < KT; ++s_) { \
            acc0 = __builtin_amdgcn_mfma_f32_32x32x16_bf16(*(const LAS bf16x8*)(sp_ + s_ * 32), __builtin_bit_cast(bf16x8, afr[s_]), acc0, 0, 0, 0); \
            acc1 = __builtin_amdgcn_mfma_f32_32x32x16_bf16(*(const LAS bf16x8*)(sp_ + 32 * ROWB + s_ * 32), __builtin_bit_cast(bf16x8, afr[s_]), acc1, 0, 0, 0); } \
        E.xf(st, acc0, (j_), 0, r32, hi); E.xf(st, acc1, (j_), 1, r32, hi); \
        { LAS unsigned char* tw_ = tbuf + r32 * TROW + hi * 8; \
          _Pragma("unroll") for (int g = 0; g < 4; ++g) { \
              u32x2 w0_, w1_; w0_.x = cvtpk(acc0[4 * g], acc0[4 * g + 1]); w0_.y = cvtpk(acc0[4 * g + 2], acc0[4 * g + 3]); w1_.x = cvtpk(acc1[4 * g], acc1[4 * g + 1]); w1_.y = cvtpk(acc1[4 * g + 2], acc1[4 * g + 3]); \
              *(LAS u32x2*)(tw_ + 16 * g) = w0_; *(LAS u32x2*)(tw_ + 64 + 16 * g) = w1_; } \
          u32x4 o_[4]; \
          _Pragma("unroll") for (int i = 0; i < 4; ++i) o_[i] = *(const LAS u32x4*)(tbuf + (8 * i + (lane >> 3)) * TROW + (lane & 7) * 16); \
          E.store(st, (j_), o_, lane); } } while (0)
        RS_LOAD(sr0, 0); RS_LOAD(sr1, 1);
        WaitVm<PPT>::w(sr0); RS_WRITE(sr0, 0); RS_LOAD(sr0, 2);
        RS_BODY(0, sr1, PPT);
        RS_BODY(1, sr0, PPT + NST);
        for (int j = 2; j < NT; j += 2) { RS_BODY(j, sr1, PPT + 2 * NST); RS_BODY(j + 1, sr0, PPT + 2 * NST); }
        WaitVm<0>::w(sr0); WaitVm<0>::w(sr1);
        asm volatile("s_waitcnt lgkmcnt(0)" ::: "memory"); __builtin_amdgcn_s_barrier(); asm volatile("" ::: "memory");
#undef RS_LOAD
#undef RS_WRITE
#undef RS_BODY
    }
}
struct DenseRS { const bf16_t* A; const bf16_t* Bt; int lda, ldb, ncols, G, bx;
    __device__ __forceinline__ bool valid(int ui) const { return bx + ui * G < 2 * (T / 256); }
    __device__ __forceinline__ int ntiles(int) const { return ncols / 64; }
    __device__ __forceinline__ const bf16_t* a_row(int ui, int row) const { return A + ((size_t)((bx + ui * G) >> 1) * 256 + row) * lda; }
    __device__ __forceinline__ const bf16_t* b_ptr(int ui) const { return Bt + (size_t)((bx + ui * G) & 1) * ncols * ldb; } };
struct EpiKVrs { bf16_t *kf, *vf; int G, bx;
    static constexpr int NST = 4;
    struct St { int half; size_t rowi[4]; };
    __device__ __forceinline__ St prep(int ui, int wave, int lane) const { St s_; const int L = bx + ui * G; s_.half = L & 1;
#pragma unroll
        for (int i = 0; i < 4; ++i) { const int t = (L >> 1) * 256 + 32 * wave + 8 * i + (lane >> 3), b = t / SEQ; s_.rowi[i] = (size_t)b * NH * SEQ + (t - b * SEQ); }
        return s_; }
    __device__ __forceinline__ void xf(const St&, f32x16&, int, int, int, int) const {}
    __device__ __forceinline__ void store(const St& s_, int j, const u32x4 (&o)[4], int lane) const {
        const int c = s_.half * 512 + 64 * j + 8 * (lane & 7), h = c >> 7, cc = c & 127;
#pragma unroll
        for (int i = 0; i < 4; ++i) { const size_t rowi = s_.rowi[i] + (size_t)h * SEQ;
            bf16_t* dp = cc < 64 ? kf + rowi * QK + cc : vf + rowi * VD + (cc - 64);
            *(u32x4*)dp = o[i]; }
    } };
template <int KIND>
struct EpiLoraRS { bf16_t* base; const float* bias; int G, bx;
    static constexpr int NST = 4;
    struct St { int half; bf16_t* dp[4]; };
    __device__ __forceinline__ St prep(int ui, int wave, int lane) const { St s_; const int L = bx + ui * G; s_.half = L & 1;
#pragma unroll
        for (int i = 0; i < 4; ++i) { const int t = (L >> 1) * 256 + 32 * wave + 8 * i + (lane >> 3); s_.dp[i] = base + (size_t)t * RW + s_.half * 256 + 8 * (lane & 7); }
        return s_; }
    __device__ __forceinline__ void xf(const St& s_, f32x16& acc, int j, int tile, int, int hi) const {
        if constexpr (KIND < 2) {
#pragma unroll
            for (int g = 0; g < 4; ++g) { const float4 bs = *(const float4*)(bias + s_.half * 256 + 64 * j + 32 * tile + 8 * g + 4 * hi);
                const float bv[4] = {bs.x, bs.y, bs.z, bs.w};
#pragma unroll
                for (int e = 0; e < 4; ++e) { const float v = fsigmoid(acc[4 * g + e] + bv[e]); acc[4 * g + e] = KIND == 0 ? 0.60653065971263342f * v : v; } }
        }
    }
    __device__ __forceinline__ void store(const St& s_, int j, const u32x4 (&o)[4], int) const {
#pragma unroll
        for (int i = 0; i < 4; ++i) *(u32x4*)(s_.dp[i] + 64 * j) = o[i];
    } };
}

struct TrItem { const float* W; bf16_t* WT; int ldw, ksrc0, ldt, kdst0, ndst0, kind, off, pad; };
__device__ __forceinline__ int tr_map(int kind, int off, int r) {
    if (kind == 0) return r - off;
    if (kind == 1) return r < MLA_IN ? r : (r < 768 ? -1 : r - 96);
    if (kind == 2) { const int h = r / QK, d = r % QK; if (d < NOPE) return r; const int i = (d - NOPE) >> 1, odd = (d - NOPE) & 1; return h * QK + NOPE + i + 16 * odd; }
    return ((r >> 8) << 7) + (r & 127);
}
__device__ __forceinline__ void tr_load(const TrItem& d, float (&v)[32], int lane) {
    const int n = lane & 31; const int sc = d.W ? tr_map(d.kind, d.off, d.ndst0 + n) : -1;
    const float* p = d.W + (size_t)(d.ksrc0 + (lane >> 5)) * d.ldw + (sc >= 0 ? sc : 0);
#pragma unroll
    for (int i = 0; i < 32; ++i) v[i] = (sc >= 0) ? p[(size_t)(2 * i) * d.ldw] : 0.f;
}
__device__ __forceinline__ void tr_store(const TrItem& d, const float (&v)[32], LAS float* scr, int lane) {
    const int n = lane & 31;
#pragma unroll
    for (int i = 0; i < 32; ++i) scr[(2 * i + (lane >> 5)) * 33 + n] = v[i];
    asm volatile("s_waitcnt lgkmcnt(0)" ::: "memory");
    const int c = lane & 7;
#pragma unroll
    for (int j = 0; j < 4; ++j) { const int nn = (lane >> 3) + 8 * j; const LAS float* s_ = scr + (8 * c) * 33 + nn;
        u32x4 o; o.x = cvtpk(s_[0 * 33], s_[1 * 33]); o.y = cvtpk(s_[2 * 33], s_[3 * 33]); o.z = cvtpk(s_[4 * 33], s_[5 * 33]); o.w = cvtpk(s_[6 * 33], s_[7 * 33]);
        *(u32x4*)(d.WT + (size_t)(d.ndst0 + nn) * d.ldt + d.kdst0 + 8 * c) = o; }
    asm volatile("s_waitcnt lgkmcnt(0)" ::: "memory");
}

constexpr size_t WO_IN = 0;
constexpr size_t WO_UQ = WO_IN + (size_t)4608 * 1024 * 2;
constexpr size_t WO_UKV = WO_UQ + (size_t)768 * 384 * 2;
constexpr size_t WO_LORA = WO_UKV + (size_t)1024 * 256 * 2;
constexpr size_t WO_OM = WO_LORA + (size_t)1536 * 256 * 2;
constexpr size_t WO_OR = WO_OM + (size_t)1024 * 512 * 2;
constexpr size_t WO_OUT = WO_OR + (size_t)1024 * 512 * 2;
constexpr size_t WO_GU = WO_OUT + (size_t)1024 * 1024 * 2;
constexpr size_t WO_DN = WO_GU + (size_t)32 * 512 * 1024 * 2;
constexpr size_t WO_END = WO_DN + (size_t)32 * 1024 * 256 * 2;
constexpr size_t WO_RH = WO_END;
constexpr size_t WO_RL = WO_RH + (size_t)48 * 1024 * 2;
static_assert(WO_RL + (size_t)48 * 1024 * 2 <= 64 * MiB, "weights region");
constexpr int TR_I_IN = 16 * 144, TR_I_UQ = 6 * 24, TR_I_UKV = 4 * 32, TR_I_LORA = 4 * 48, TR_I_OM = 8 * 32, TR_I_OR = 8 * 32, TR_I_OUT = 16 * 32, TR_I_GU = 32 * 16 * 16, TR_I_DN = 32 * 4 * 32;
constexpr int TR_NITEMS = TR_I_IN + TR_I_UQ + TR_I_UKV + TR_I_LORA + TR_I_OM + TR_I_OR + TR_I_OUT + TR_I_GU + TR_I_DN;
__device__ __forceinline__ TrItem tr_desc(const Ctx& C, int it) {
    bf16_t* wb = (bf16_t*)(C.ws + WS_W);
    TrItem d; d.kind = 0; d.off = 0; d.pad = 0;
    int r = it;
    if (r < TR_I_IN) { const int kb = r / 144, nb = r % 144; d.W = C.w_in; d.ldw = IN_W; d.ksrc0 = 64 * kb; d.WT = wb + WO_IN / 2; d.ldt = 1024; d.kdst0 = 64 * kb; d.ndst0 = 32 * nb; d.kind = 1; return d; } r -= TR_I_IN;
    if (r < TR_I_UQ) { const int kb = r / 24, nb = r % 24; d.W = C.w_uq; d.ldw = 768; d.ksrc0 = 64 * kb; d.WT = wb + WO_UQ / 2; d.ldt = QR; d.kdst0 = 64 * kb; d.ndst0 = 32 * nb; d.kind = 2; return d; } r -= TR_I_UQ;
    if (r < TR_I_UKV) { const int kb = r / 32, nb = r % 32; d.W = C.w_ukv; d.ldw = 1024; d.ksrc0 = 64 * kb; d.WT = wb + WO_UKV / 2; d.ldt = KVR; d.kdst0 = 64 * kb; d.ndst0 = 32 * nb; return d; } r -= TR_I_UKV;
    if (r < TR_I_LORA) { const int kb = r / 48, nb = r % 48;
        d.W = nullptr; d.ksrc0 = 0; d.ldw = RW;
        if (nb < 16) { if (kb == 0) d.W = C.w_dec; d.off = 0; }
        else if (nb < 32) { if (kb == 1) d.W = C.w_a; d.off = 512; }
        else { if (kb >= 2) { d.W = C.w_g; d.ksrc0 = 64 * (kb - 2); } d.off = 1024; }
        d.WT = wb + WO_LORA / 2; d.ldt = 256; d.kdst0 = 64 * kb; d.ndst0 = 32 * nb; return d; } r -= TR_I_LORA;
    if (r < TR_I_OM) { const int kb = r / 32, nb = r % 32; d.W = C.w_o_mla; d.ldw = DM; d.ksrc0 = 64 * kb; d.WT = wb + WO_OM / 2; d.ldt = RW; d.kdst0 = 64 * kb; d.ndst0 = 32 * nb; return d; } r -= TR_I_OM;
    if (r < TR_I_OR) { const int kb = r / 32, nb = r % 32; d.W = C.w_o_rwkv; d.ldw = DM; d.ksrc0 = 64 * kb; d.WT = wb + WO_OR / 2; d.ldt = RW; d.kdst0 = 64 * kb; d.ndst0 = 32 * nb; return d; } r -= TR_I_OR;
    if (r < TR_I_OUT) { const int kb = r / 32, nb = r % 32; d.W = C.w_out; d.ldw = DM; d.ksrc0 = 64 * kb; d.WT = wb + WO_OUT / 2; d.ldt = DM; d.kdst0 = 64 * kb; d.ndst0 = 32 * nb; return d; } r -= TR_I_OUT;
    if (r < TR_I_GU) { const int e = r / 256, q = r % 256, kb = q / 16, nb = q % 16;
        d.W = (((32 * nb) & 128) ? C.w_eu : C.w_eg) + (size_t)e * DM * FF; d.ldw = FF; d.ksrc0 = 64 * kb; d.WT = wb + WO_GU / 2 + (size_t)e * 512 * 1024; d.ldt = 1024; d.kdst0 = 64 * kb; d.ndst0 = 32 * nb; d.kind = 3; return d; } r -= TR_I_GU;
    { const int e = r / 128, q = r % 128, kb = q / 32, nb = q % 32;
      d.W = C.w_ed + (size_t)e * FF * DM; d.ldw = DM; d.ksrc0 = 64 * kb; d.WT = wb + WO_DN / 2 + (size_t)e * 1024 * 256; d.ldt = 256; d.kdst0 = 64 * kb; d.ndst0 = 32 * nb; return d; }
}


namespace att {
constexpr int KROW = 208, KBUF = 64 * KROW, VBUF = 8192, BUF = KBUF + VBUF;
typedef short v4i16_t __attribute__((ext_vector_type(4)));
__device__ __forceinline__ v4i16_t vtr(const LAS unsigned char* p) { return __builtin_amdgcn_ds_read_tr16_b64_v4i16((LAS v4i16_t*)p); }
__device__ __forceinline__ float hmax(float x) { auto rr = __builtin_amdgcn_permlane32_swap(__float_as_uint(x), __float_as_uint(x), false, false); return fmaxf(__uint_as_float(rr[0]), __uint_as_float(rr[1])); }
__device__ __forceinline__ float hsum(float x) { auto rr = __builtin_amdgcn_permlane32_swap(__float_as_uint(x), __float_as_uint(x), false, false); return __uint_as_float(rr[0]) + __uint_as_float(rr[1]); }

__device__ __forceinline__ void attn_unit(const Ctx& C, LAS unsigned char* lds, int bh, int qb, int tid, int lane, int wave) {
    const int r32 = lane & 31, hi = lane >> 5;
    const bf16_t* qf = (const bf16_t*)(C.ws + WS_QF) + ((size_t)bh * SEQ + qb * 256 + wave * 32 + r32) * QK;
    const unsigned char* kbase = (const unsigned char*)((const bf16_t*)(C.ws + WS_KF) + (size_t)bh * SEQ * QK);
    const unsigned char* vbase = (const unsigned char*)((const bf16_t*)(C.ws + WS_VF) + (size_t)bh * SEQ * VD);
    bf16x8 qr[6];
#pragma unroll
    for (int s = 0; s < 6; ++s) qr[s] = *(const bf16x8*)(qf + 16 * s + 8 * hi);
    const int kc1 = 512 + tid;
    const int koff0 = (tid / 12) * KROW + (tid % 12) * 16, koff1 = (kc1 / 12) * KROW + (kc1 % 12) * 16;
    const int vkey = tid >> 3, vj = tid & 7;
    const int voff = KBUF + (vj >> 2) * 4096 + (vkey >> 4) * 1024 + (vkey & 15) * 64 + (vj & 3) * 16;
    const int NT = 4 * qb + 4, cw = 4 * qb + (wave >> 1);
    const bool has_k1 = tid < 256;
    u32x4 k0r, k1r = {0u, 0u, 0u, 0u}, v0r;
    k0r = *(const u32x4*)(kbase + (size_t)tid * 16); if (has_k1) k1r = *(const u32x4*)(kbase + (size_t)kc1 * 16); v0r = *(const u32x4*)(vbase + (size_t)tid * 16);
    *(LAS u32x4*)(lds + koff0) = k0r; if (has_k1) *(LAS u32x4*)(lds + koff1) = k1r; *(LAS u32x4*)(lds + voff) = v0r;
    if (NT > 1) { k0r = *(const u32x4*)(kbase + 12288 + (size_t)tid * 16); if (has_k1) k1r = *(const u32x4*)(kbase + 12288 + (size_t)kc1 * 16); v0r = *(const u32x4*)(vbase + 8192 + (size_t)tid * 16); }
    __syncthreads();
    f32x16 o0, o1, negm;
#pragma unroll
    for (int r = 0; r < 16; ++r) { o0[r] = 0.f; o1[r] = 0.f; negm[r] = 0.f; }
    float m = 0.f, l = 0.f;
    const int kfrag = r32 * KROW + hi * 16;
    const int vfrag = KBUF + ((lane >> 4) & 1) * 32 + (lane & 3) * 8 + (4 * hi + ((lane & 15) >> 2)) * 64;
    for (int t = 0; t < NT; ++t) {
        const LAS unsigned char* cur = lds + (t & 1) * BUF;
        if (t + 1 < NT) { LAS unsigned char* nb = lds + ((t + 1) & 1) * BUF;
            *(LAS u32x4*)(nb + koff0) = k0r; if (has_k1) *(LAS u32x4*)(nb + koff1) = k1r; *(LAS u32x4*)(nb + voff) = v0r; }
        if (t + 2 < NT) { const unsigned char* kb = kbase + (size_t)(t + 2) * 12288; const unsigned char* vb = vbase + (size_t)(t + 2) * 8192;
            k0r = *(const u32x4*)(kb + (size_t)tid * 16); if (has_k1) k1r = *(const u32x4*)(kb + (size_t)kc1 * 16); v0r = *(const u32x4*)(vb + (size_t)tid * 16); }
        if (t <= cw) {
            f32x16 p0, p1;
            const LAS unsigned char* kp = cur + kfrag;
#pragma unroll
            for (int s = 0; s < 6; ++s) {
                const bf16x8 a0 = *(const LAS bf16x8*)(kp + s * 32), a1 = *(const LAS bf16x8*)(kp + 32 * KROW + s * 32);
                if (s == 0) { p0 = __builtin_amdgcn_mfma_f32_32x32x16_bf16(a0, qr[0], negm, 0, 0, 0); p1 = __builtin_amdgcn_mfma_f32_32x32x16_bf16(a1, qr[0], negm, 0, 0, 0); }
                else { p0 = __builtin_amdgcn_mfma_f32_32x32x16_bf16(a0, qr[s], p0, 0, 0, 0); p1 = __builtin_amdgcn_mfma_f32_32x32x16_bf16(a1, qr[s], p1, 0, 0, 0); }
            }
            float mx = fmaxf(fmaxf(p0[0], p1[0]), fmaxf(p0[1], p1[1]));
#pragma unroll
            for (int r = 2; r < 16; r += 2) mx = fmaxf(mx, fmaxf(fmaxf(p0[r], p1[r]), fmaxf(p0[r + 1], p1[r + 1])));
            mx = hmax(mx);
            if (t == 0) {
                m = mx;
#pragma unroll
                for (int r = 0; r < 16; ++r) { p0[r] -= mx; p1[r] -= mx; negm[r] = -mx; }
            } else if (__any(mx > 8.0f)) {
                const float dl = fmaxf(mx, 0.f), alpha = __builtin_amdgcn_exp2f(-dl);
                m += dl; l *= alpha;
#pragma unroll
                for (int r = 0; r < 16; ++r) { p0[r] -= dl; p1[r] -= dl; o0[r] *= alpha; o1[r] *= alpha; negm[r] = -m; }
            }
            float ps0 = 0.f, ps1 = 0.f;
#pragma unroll
            for (int r = 0; r < 16; ++r) { p0[r] = __builtin_amdgcn_exp2f(p0[r]); p1[r] = __builtin_amdgcn_exp2f(p1[r]); ps0 += p0[r]; ps1 += p1[r]; }
            l += ps0 + ps1;
            u32x4 pw0, pw1, pw2, pw3;
            pw0 = (u32x4){cvtpk(p0[0], p0[1]), cvtpk(p0[2], p0[3]), cvtpk(p0[4], p0[5]), cvtpk(p0[6], p0[7])};
            pw1 = (u32x4){cvtpk(p0[8], p0[9]), cvtpk(p0[10], p0[11]), cvtpk(p0[12], p0[13]), cvtpk(p0[14], p0[15])};
            pw2 = (u32x4){cvtpk(p1[0], p1[1]), cvtpk(p1[2], p1[3]), cvtpk(p1[4], p1[5]), cvtpk(p1[6], p1[7])};
            pw3 = (u32x4){cvtpk(p1[8], p1[9]), cvtpk(p1[10], p1[11]), cvtpk(p1[12], p1[13]), cvtpk(p1[14], p1[15])};
            const LAS unsigned char* vp = cur + vfrag;
#define ATT_PV(OD, D0, KS, PW) do { const v4i16_t lo_ = vtr(vp + (D0) * 4096 + (KS) * 1024), hi_ = vtr(vp + (D0) * 4096 + (KS) * 1024 + 512); \
                const bf16x8 vf_ = {lo_[0], lo_[1], lo_[2], lo_[3], hi_[0], hi_[1], hi_[2], hi_[3]}; \
                OD = __builtin_amdgcn_mfma_f32_32x32x16_bf16(vf_, __builtin_bit_cast(bf16x8, PW), OD, 0, 0, 0); } while (0)
            ATT_PV(o0, 0, 0, pw0); ATT_PV(o1, 1, 0, pw0); ATT_PV(o0, 0, 1, pw1); ATT_PV(o1, 1, 1, pw1);
            ATT_PV(o0, 0, 2, pw2); ATT_PV(o1, 1, 2, pw2); ATT_PV(o0, 0, 3, pw3); ATT_PV(o1, 1, 3, pw3);
#undef ATT_PV
        }
        asm volatile("s_waitcnt lgkmcnt(0)" ::: "memory"); __builtin_amdgcn_s_barrier(); asm volatile("" ::: "memory");
    }
    const float rl = 1.f / hsum(l);
    const int b = bh / NH, h = bh - b * NH;
    bf16_t* op = (bf16_t*)(C.ws + WS_ATT) + ((size_t)b * SEQ + qb * 256 + wave * 32 + r32) * RW + h * VD + 4 * hi;
#pragma unroll
    for (int g = 0; g < 4; ++g) {
        u32x2 w0, w1;
        w0.x = cvtpk(o0[4 * g] * rl, o0[4 * g + 1] * rl); w0.y = cvtpk(o0[4 * g + 2] * rl, o0[4 * g + 3] * rl);
        w1.x = cvtpk(o1[4 * g] * rl, o1[4 * g + 1] * rl); w1.y = cvtpk(o1[4 * g + 2] * rl, o1[4 * g + 3] * rl);
        *(u32x2*)(op + 8 * g) = w0; *(u32x2*)(op + 32 + 8 * g) = w1;
    }
}
__device__ __forceinline__ void attn_phase(const Ctx& C, LAS unsigned char* lds, int G, int bx, int tid, int lane, int wave) {
    const int v0 = (G % 8 == 0) ? (bx % 8) * (G / 8) + bx / 8 : bx;
    for (int v = v0; v < 256; v += G) {
        const int bh = v >> 1, odd = v & 1;
#pragma unroll 1
        for (int i = 0; i < 4; ++i) {
            const int qb = (i == 0) ? 7 - odd : (i == 1) ? odd : (i == 2) ? 4 + odd : 3 - odd;
            attn_unit(C, lds, bh, qb, tid, lane, wave);
        }
    }
}
}


namespace cscan {
constexpr int CH = 32, NCH = SEQ / CH;
constexpr int RS = 144;
constexpr int RS2 = 80;
constexpr int L_AT = 0, L_BT = 4608, L_RT = 9216, L_KT = 13824, L_BTV = 18432, L_VV = 22528, L_MAB = 26624, L_MAK = 30720, L_GC = 34816, L_MBRT = 35072, L_WAVE = 37632;
constexpr int L_P = L_AT, L_MAKT = L_MAK;
typedef short v4i16_t __attribute__((ext_vector_type(4)));
typedef float f32x2s __attribute__((ext_vector_type(2)));
#define CS_MF(a, b, c) __builtin_amdgcn_mfma_f32_32x32x16_bf16(a, b, c, 0, 0, 0)
template <int CTRL> __device__ __forceinline__ float dpp_add(float x) { return x + __builtin_bit_cast(float, __builtin_amdgcn_update_dpp(0, __builtin_bit_cast(int, x), CTRL, 0xf, 0xf, true)); }
__device__ __forceinline__ float wsum(float x) {
    x = dpp_add<0xB1>(x); x = dpp_add<0x4E>(x); x = dpp_add<0x141>(x); x = dpp_add<0x140>(x);
    x += __builtin_bit_cast(float, __builtin_amdgcn_update_dpp(0, __builtin_bit_cast(int, x), 0x142, 0xa, 0xf, false));
    x += __builtin_bit_cast(float, __builtin_amdgcn_update_dpp(0, __builtin_bit_cast(int, x), 0x143, 0xc, 0xf, false));
    return __builtin_bit_cast(float, __builtin_amdgcn_readlane(__builtin_bit_cast(int, x), 63));
}
__device__ __forceinline__ int crow(int r, int hi) { return (r & 3) + 8 * (r >> 2) + 4 * hi; }
__device__ __forceinline__ bf16x8 pack8(const f32x16& p, int s) {
    u32x4 w; w.x = cvtpk(p[8 * s], p[8 * s + 1]); w.y = cvtpk(p[8 * s + 2], p[8 * s + 3]); w.z = cvtpk(p[8 * s + 4], p[8 * s + 5]); w.w = cvtpk(p[8 * s + 6], p[8 * s + 7]);
    return __builtin_bit_cast(bf16x8, w); }
__device__ __forceinline__ bf16x8 rd_nat(const LAS unsigned char* p) { return *(const LAS bf16x8*)p; }
__device__ __forceinline__ bf16x8 rd_perm(const LAS unsigned char* p) { const u32x2 a = *(const LAS u32x2*)p, b = *(const LAS u32x2*)(p + 16);
    u32x4 w; w.x = a.x; w.y = a.y; w.z = b.x; w.w = b.y; return __builtin_bit_cast(bf16x8, w); }
__device__ __forceinline__ bf16x8 rd_tr(const LAS unsigned char* p) { const v4i16_t lo = __builtin_amdgcn_ds_read_tr16_b64_v4i16((LAS v4i16_t*)p), hi = __builtin_amdgcn_ds_read_tr16_b64_v4i16((LAS v4i16_t*)(p + 512));
    return (bf16x8){lo[0], lo[1], lo[2], lo[3], hi[0], hi[1], hi[2], hi[3]}; }
__device__ __forceinline__ float bfl(unsigned w) { return __uint_as_float(w << 16); }
__device__ __forceinline__ float bfh(unsigned w) { return __uint_as_float(w & 0xffff0000u); }

#define CS_BAR() do { asm volatile("s_waitcnt lgkmcnt(0)" ::: "memory"); __builtin_amdgcn_s_barrier(); asm volatile("" ::: "memory"); } while (0)
__device__ __forceinline__ void pair_bar(LAS unsigned* cnt, unsigned& ord, int lane) {
    asm volatile("s_waitcnt lgkmcnt(0)" ::: "memory");
    ord += 2u;
    if (lane == 0) __hip_atomic_fetch_add(cnt, 1u, __ATOMIC_RELAXED, __HIP_MEMORY_SCOPE_WORKGROUP);
    for (unsigned spins = 0; spins < (1u << 22); ++spins) {
        const unsigned v = __builtin_amdgcn_readfirstlane(__hip_atomic_load(cnt, __ATOMIC_RELAXED, __HIP_MEMORY_SCOPE_WORKGROUP));
        if ((int)(v - ord) >= 0) break;
        __builtin_amdgcn_s_sleep(1);
    }
    asm volatile("" ::: "memory");
}
struct RawRegs { u32x4 r[2], k[2], v[2], a[2], e[2], rp, kp, vp; };
__device__ __forceinline__ void rawLoad(const Ctx& C, RawRegs& R, int task, int lane, int role) {
    const int c = task & (NCH - 1), bh = task >> 6, b = bh / NH, h = bh - b * NH;
    const size_t trow0 = (size_t)b * SEQ + (size_t)c * CH + 16 * role + (lane >> 3);
    const bf16_t* rkv = (const bf16_t*)(C.ws + WS_RKV) + trow0 * 1536 + h * 64 + (lane & 7) * 8;
    const bf16_t* av = (const bf16_t*)(C.ws + WS_AV) + trow0 * RW + h * 64 + (lane & 7) * 8;
    const bf16_t* eb = (const bf16_t*)(C.ws + WS_EBUF) + trow0 * RW + h * 64 + (lane & 7) * 8;
#pragma unroll
    for (int q = 0; q < 2; ++q) { R.r[q] = *(const u32x4*)(rkv + (size_t)q * 8 * 1536); R.k[q] = *(const u32x4*)(rkv + (size_t)q * 8 * 1536 + 512); R.v[q] = *(const u32x4*)(rkv + (size_t)q * 8 * 1536 + 1024);
        R.a[q] = *(const u32x4*)(av + (size_t)q * 8 * RW); R.e[q] = *(const u32x4*)(eb + (size_t)q * 8 * RW); }
    if (c * CH + 16 * role > 0) { const bf16_t* pv = (const bf16_t*)(C.ws + WS_RKV) + ((size_t)b * SEQ + (size_t)c * CH + 16 * role - 1) * 1536 + h * 64 + (lane & 7) * 8;
        R.rp = *(const u32x4*)pv; R.kp = *(const u32x4*)(pv + 512); R.vp = *(const u32x4*)(pv + 1024); }
    else { R.rp = (u32x4){0u, 0u, 0u, 0u}; R.kp = R.rp; R.vp = R.rp; }
}
__device__ __forceinline__ void taskA(const Ctx& C, LAS unsigned char* L, int task, int lane, int role, bool valid, RawRegs& R, int next_task, bool next_valid, LAS unsigned* pcnt, unsigned& pord) {
    asm volatile("" : "+v"(lane));
    const int c = task & (NCH - 1), bh = task >> 6, b = bh / NH, h = bh - b * NH;
    const int r32 = lane & 31, hi = lane >> 5;
    const size_t trow0 = (size_t)b * SEQ + (size_t)c * CH;
    if (valid) {
        const int jg = lane & 7;
        const float4 kw0 = *(const float4*)(C.k_k + h * 64 + 8 * jg), kw1 = *(const float4*)(C.k_k + h * 64 + 8 * jg + 4), ka0 = *(const float4*)(C.k_a + h * 64 + 8 * jg), ka1 = *(const float4*)(C.k_a + h * 64 + 8 * jg + 4);
        const float4 rk0 = *(const float4*)(C.r_k + h * 64 + 8 * jg), rk1 = *(const float4*)(C.r_k + h * 64 + 8 * jg + 4);
        const float kkw[8] = {kw0.x, kw0.y, kw0.z, kw0.w, kw1.x, kw1.y, kw1.z, kw1.w}, kaw[8] = {ka0.x, ka0.y, ka0.z, ka0.w, ka1.x, ka1.y, ka1.z, ka1.w};
        const float rkw[8] = {rk0.x, rk0.y, rk0.z, rk0.w, rk1.x, rk1.y, rk1.z, rk1.w};
        float* bonus = (float*)(C.ws + WS_BONUS) + trow0 * NH + h;
        {
            const int src = ((lane - 8) & 63) * 4; const bool top = lane >= 56;
#define CS_SHIFT(X_, P_, MU_) do { const float4 ma_ = *(const float4*)(C.mu + (MU_) + h * 64 + 8 * jg), mb_ = *(const float4*)(C.mu + (MU_) + h * 64 + 8 * jg + 4); \
            const float mm_[8] = {ma_.x, ma_.y, ma_.z, ma_.w, mb_.x, mb_.y, mb_.z, mb_.w}; \
            _Pragma("unroll") for (int q = 1; q >= 0; --q) _Pragma("unroll") for (int e = 0; e < 4; ++e) { \
                const unsigned y_ = top ? (q ? X_[0][e] : P_[e]) : X_[q][e]; \
                const unsigned p_ = (unsigned)__builtin_amdgcn_ds_bpermute(src, (int)y_); \
                const float z0_ = bfl(X_[q][e]), z1_ = bfh(X_[q][e]), p0_ = bfl(p_), p1_ = bfh(p_); \
                X_[q][e] = cvtpk(z0_ + (p0_ - z0_) * mm_[2 * e], z1_ + (p1_ - z1_) * mm_[2 * e + 1]); } } while (0)
            CS_SHIFT(R.r, R.rp, 0); CS_SHIFT(R.k, R.kp, RW); CS_SHIFT(R.v, R.vp, 2 * RW);
#undef CS_SHIFT
        }
#pragma unroll
        for (int q = 0; q < 2; ++q) { const int t = 16 * role + 8 * q + (lane >> 3);
            float kf[8], rf[8], af[8], kk0[8], kp[8];
#pragma unroll
            for (int e = 0; e < 4; ++e) { kf[2 * e] = bfl(R.k[q][e]); kf[2 * e + 1] = bfh(R.k[q][e]); rf[2 * e] = bfl(R.r[q][e]); rf[2 * e + 1] = bfh(R.r[q][e]); af[2 * e] = bfl(R.a[q][e]); af[2 * e + 1] = bfh(R.a[q][e]); }
            float n2 = 0.f, bn = 0.f;
#pragma unroll
            for (int e = 0; e < 8; ++e) { kk0[e] = kf[e] * kkw[e]; n2 += kk0[e] * kk0[e]; kp[e] = kf[e] * (1.f + (af[e] - 1.f) * kaw[e]); bn += rf[e] * kp[e] * rkw[e]; }
            n2 = sum8_dpp(n2); bn = sum8_dpp(bn);
            const float rn = __builtin_amdgcn_rsqf(fmaxf(n2, 1e-24f));
            u32x4 wkk, wkp;
            wkk.x = cvtpk(kk0[0] * rn, kk0[1] * rn); wkk.y = cvtpk(kk0[2] * rn, kk0[3] * rn); wkk.z = cvtpk(kk0[4] * rn, kk0[5] * rn); wkk.w = cvtpk(kk0[6] * rn, kk0[7] * rn);
            wkp.x = cvtpk(kp[0], kp[1]); wkp.y = cvtpk(kp[2], kp[3]); wkp.z = cvtpk(kp[4], kp[5]); wkp.w = cvtpk(kp[6], kp[7]);
            if (jg == 0) bonus[(size_t)t * NH] = bn;
            *(LAS u32x4*)(L + L_RT + t * RS + jg * 16) = R.r[q]; *(LAS u32x4*)(L + L_KT + t * RS + jg * 16) = wkp; *(LAS u32x4*)(L + L_AT + t * RS + jg * 16) = wkk;
            *(LAS u32x4*)(L + L_MAK + t * 128 + jg * 16) = R.a[q]; *(LAS u32x4*)(L + L_MAB + t * 128 + jg * 16) = R.e[q];
            *(LAS u32x4*)(L + L_VV + (jg >> 2) * 2048 + (t >> 4) * 1024 + (t & 15) * 64 + (jg & 3) * 16) = R.v[q]; }
    }
    if (next_valid) rawLoad(C, R, next_task, lane, role);
    pair_bar(pcnt, pord, lane);
    if (valid) {
        float Lc = 0.f;
        if (role == 1) {
#pragma unroll
            for (int t = 0; t < 16; ++t) Lc -= bf2f(*(const LAS bf16_t*)(L + L_MAB + t * 128 + lane * 2)); }
        float gprev = __expf(Lc);
        const int vbase = (lane >> 5) * 2048 + (lane & 31) * 2;
#pragma unroll 4
        for (int tt = 0; tt < 16; ++tt) {
            const int t = 16 * role + tt; const int ro = t * RS + lane * 2;
            const float r = bf2f(*(const LAS bf16_t*)(L + L_RT + ro)), kp = bf2f(*(const LAS bf16_t*)(L + L_KT + ro)), kk = bf2f(*(const LAS bf16_t*)(L + L_AT + ro));
            const float a = bf2f(*(const LAS bf16_t*)(L + L_MAK + t * 128 + lane * 2)), e = bf2f(*(const LAS bf16_t*)(L + L_MAB + t * 128 + lane * 2));
            Lc -= e; const float gam = __expf(Lc), ginv = __expf(-Lc);
            const unsigned w1 = cvtpk(-kk * gprev, r * gam), w2 = cvtpk(kp * ginv, kk * a * ginv);
            *(LAS bf16_t*)(L + L_AT + ro) = (bf16_t)w1; *(LAS bf16_t*)(L + L_RT + ro) = (bf16_t)(w1 >> 16); *(LAS bf16_t*)(L + L_KT + ro) = (bf16_t)w2;
            *(LAS bf16_t*)(L + L_BT + ro) = (bf16_t)(w2 >> 16); *(LAS bf16_t*)(L + L_BTV + vbase + (t >> 4) * 1024 + (t & 15) * 64) = (bf16_t)(w2 >> 16);
            gprev = gam;
        }
        if (role == 1) *(LAS float*)(L + L_GC + lane * 4) = gprev;
    }
    pair_bar(pcnt, pord, lane);
    f32x16 mkr;
#pragma unroll
    for (int q = 0; q < 16; ++q) mkr[q] = 0.f;
    if (valid) {
        f32x16 m0;
#pragma unroll
        for (int q = 0; q < 16; ++q) m0[q] = 0.f;
        const int bt_ = role == 0 ? L_AT : L_RT;
#pragma unroll
        for (int s_ = 0; s_ < 4; ++s_) {
            const int ko = r32 * RS + (16 * s_ + 8 * hi) * 2;
            const bf16x8 aB = rd_nat(L + L_BT + ko), aK = rd_nat(L + L_KT + ko), bX = rd_nat(L + bt_ + ko);
            m0 = CS_MF(aB, bX, m0); mkr = CS_MF(aK, bX, mkr);
        }
        const float base_ = (float)(r32 - 4 * hi) + (role == 0 ? 0.f : 1.f);
#pragma unroll
        for (int q = 0; q < 16; ++q) { const float mk_ = __builtin_amdgcn_fmed3f(base_ - (float)((q & 3) + 8 * (q >> 2)), 0.f, 1.f); m0[q] *= mk_; mkr[q] *= mk_; }
        if (role == 0) {
#pragma unroll
            for (int g = 0; g < 4; ++g) {
                *(LAS f32x4*)(L + L_MAB + r32 * 128 + (8 * g + 4 * hi) * 4) = (f32x4){m0[4 * g], m0[4 * g + 1], m0[4 * g + 2], m0[4 * g + 3]};
                *(LAS f32x4*)(L + L_MAK + r32 * 128 + (8 * g + 4 * hi) * 4) = (f32x4){mkr[4 * g], mkr[4 * g + 1], mkr[4 * g + 2], mkr[4 * g + 3]}; }
        } else {
#pragma unroll
            for (int g = 0; g < 4; ++g) { u32x2 w; w.x = cvtpk(m0[4 * g], m0[4 * g + 1]); w.y = cvtpk(m0[4 * g + 2], m0[4 * g + 3]);
                *(LAS u32x2*)(L + L_MBRT + r32 * RS2 + (8 * g + 4 * hi) * 2) = w; }
        }
    }
    pair_bar(pcnt, pord, lane);
    if (valid) {
        float xa[16], xb[16];
#pragma unroll
        for (int t = 0; t < 16; ++t) { xa[t] = 0.f; xb[t] = 0.f; }
#pragma unroll
        for (int t = 0; t < 16; ++t) {
            float ap = role == 0 ? bf2f(*(const LAS bf16_t*)(L + L_AT + t * RS + lane * 2)) : *(const LAS float*)(L + L_MAK + t * 128 + r32 * 4);
            float aq = 0.f;
#pragma unroll
            for (int i4 = 0; i4 < (t + 3) / 4; ++i4) { const f32x4 m4 = *(const LAS f32x4*)(L + L_MAB + t * 128 + i4 * 16);
                ap += xa[4 * i4] * m4[0]; aq += xa[4 * i4 + 1] * m4[1]; ap += xa[4 * i4 + 2] * m4[2]; aq += xa[4 * i4 + 3] * m4[3]; }
            xa[t] = ap + aq;
            asm volatile("" : "+v"(xa[t]) :: "memory");
        }
#pragma unroll
        for (int t = 0; t < 16; ++t) {
            float ap = role == 0 ? bf2f(*(const LAS bf16_t*)(L + L_AT + (16 + t) * RS + lane * 2)) : *(const LAS float*)(L + L_MAK + (16 + t) * 128 + r32 * 4);
            float aq = 0.f;
#pragma unroll
            for (int i4 = 0; i4 < 4; ++i4) { const f32x4 m4 = *(const LAS f32x4*)(L + L_MAB + (16 + t) * 128 + i4 * 16);
                ap += xa[4 * i4] * m4[0]; aq += xa[4 * i4 + 1] * m4[1]; ap += xa[4 * i4 + 2] * m4[2]; aq += xa[4 * i4 + 3] * m4[3]; }
#pragma unroll
            for (int i4 = 0; i4 < (t + 3) / 4; ++i4) { const f32x4 m4 = *(const LAS f32x4*)(L + L_MAB + (16 + t) * 128 + 64 + i4 * 16);
                ap += xb[4 * i4] * m4[0]; aq += xb[4 * i4 + 1] * m4[1]; ap += xb[4 * i4 + 2] * m4[2]; aq += xb[4 * i4 + 3] * m4[3]; }
            xb[t] = ap + aq;
            asm volatile("" : "+v"(xb[t]) :: "memory");
        }
        u32x4 w0, w1, w2, w3;
        w0.x = cvtpk(xa[0], xa[1]); w0.y = cvtpk(xa[2], xa[3]); w0.z = cvtpk(xa[4], xa[5]); w0.w = cvtpk(xa[6], xa[7]);
        w1.x = cvtpk(xa[8], xa[9]); w1.y = cvtpk(xa[10], xa[11]); w1.z = cvtpk(xa[12], xa[13]); w1.w = cvtpk(xa[14], xa[15]);
        w2.x = cvtpk(xb[0], xb[1]); w2.y = cvtpk(xb[2], xb[3]); w2.z = cvtpk(xb[4], xb[5]); w2.w = cvtpk(xb[6], xb[7]);
        w3.x = cvtpk(xb[8], xb[9]); w3.y = cvtpk(xb[10], xb[11]); w3.z = cvtpk(xb[12], xb[13]); w3.w = cvtpk(xb[14], xb[15]);
        if (role == 0) { LAS u32x4* d = (LAS u32x4*)(L + L_P + lane * RS2); d[0] = w0; d[1] = w1; d[2] = w2; d[3] = w3; }
        else if (hi == 0) { LAS u32x4* d = (LAS u32x4*)(L + L_MAKT + r32 * RS2); d[0] = w0; d[1] = w1; d[2] = w2; d[3] = w3; }
    }
    pair_bar(pcnt, pord, lane);
    if (valid) {
        const int trf = ((lane >> 4) & 1) * 32 + (lane & 3) * 8 + (4 * hi + ((lane & 15) >> 2)) * 64;
        if (role == 0) {
            bf16_t* gQT = (bf16_t*)(C.ws + WS_CQT) + (size_t)task * (CH * 64);
            bf16_t* gGT = (bf16_t*)(C.ws + WS_CGT) + (size_t)task * (64 * 64);
            {
                f32x16 q0, q1;
#pragma unroll
                for (int q = 0; q < 16; ++q) { q0[q] = 0.f; q1[q] = 0.f; }
#pragma unroll
                for (int s_ = 0; s_ < 2; ++s_) { const int ko = (16 * s_ + 8 * hi) * 2; const bf16x8 bM = rd_nat(L + L_MBRT + r32 * RS2 + ko);
                    q0 = CS_MF(rd_nat(L + L_P + r32 * RS2 + ko), bM, q0); q1 = CS_MF(rd_nat(L + L_P + (32 + r32) * RS2 + ko), bM, q1); }
#pragma unroll
                for (int g = 0; g < 4; ++g) {
                    const u32x2 ra = *(const LAS u32x2*)(L + L_RT + r32 * RS + (8 * g + 4 * hi) * 2), rb = *(const LAS u32x2*)(L + L_RT + r32 * RS + (32 + 8 * g + 4 * hi) * 2);
                    u32x2 w0, w1;
                    w0.x = cvtpk(q0[4 * g] + bfl(ra.x), q0[4 * g + 1] + bfh(ra.x)); w0.y = cvtpk(q0[4 * g + 2] + bfl(ra.y), q0[4 * g + 3] + bfh(ra.y));
                    w1.x = cvtpk(q1[4 * g] + bfl(rb.x), q1[4 * g + 1] + bfh(rb.x)); w1.y = cvtpk(q1[4 * g + 2] + bfl(rb.y), q1[4 * g + 3] + bfh(rb.y));
                    *(u32x2*)(gQT + r32 * 64 + 8 * g + 4 * hi) = w0; *(u32x2*)(gQT + r32 * 64 + 32 + 8 * g + 4 * hi) = w1; }
            }
            __builtin_amdgcn_sched_barrier(0);
#define CS_G(N_) do { const float gc_ = *(const LAS float*)(L + L_GC + ((N_) * 32 + r32) * 4); \
                f32x16 ga_, gb_; _Pragma("unroll") for (int q = 0; q < 16; ++q) { ga_[q] = 0.f; gb_[q] = 0.f; } \
                _Pragma("unroll") for (int s_ = 0; s_ < 2; ++s_) { const int ko = (16 * s_ + 4 * hi) * 2; const bf16x8 bb_ = rd_tr(L + L_BTV + trf + (N_) * 2048 + s_ * 1024); \
                    ga_ = CS_MF(rd_perm(L + L_P + r32 * RS2 + ko), bb_, ga_); gb_ = CS_MF(rd_perm(L + L_P + (32 + r32) * RS2 + ko), bb_, gb_); } \
                { const float base_ = (float)(r32 - 4 * hi); \
                _Pragma("unroll") for (int q = 0; q < 16; ++q) { const float dl_ = __builtin_amdgcn_fmed3f(1.f - __builtin_fabsf(base_ - (float)((q & 3) + 8 * (q >> 2))), 0.f, 1.f); \
                    ga_[q] = (ga_[q] + ((N_) == 0 ? dl_ : 0.f)) * gc_; gb_[q] = (gb_[q] + ((N_) == 1 ? dl_ : 0.f)) * gc_; } } \
                _Pragma("unroll") for (int g = 0; g < 4; ++g) { u32x2 w; \
                    w.x = cvtpk(ga_[4 * g], ga_[4 * g + 1]); w.y = cvtpk(ga_[4 * g + 2], ga_[4 * g + 3]); *(u32x2*)(gGT + ((N_) * 32 + r32) * 64 + 8 * g + 4 * hi) = w; \
                    w.x = cvtpk(gb_[4 * g], gb_[4 * g + 1]); w.y = cvtpk(gb_[4 * g + 2], gb_[4 * g + 3]); *(u32x2*)(gGT + ((N_) * 32 + r32) * 64 + 32 + 8 * g + 4 * hi) = w; } \
                __builtin_amdgcn_sched_barrier(0); } while (0)
            CS_G(0); CS_G(1);
#undef CS_G
        } else {
            bf16_t* gHT = (bf16_t*)(C.ws + WS_CHT) + (size_t)task * (64 * 64);
            bf16_t* gYL = (bf16_t*)(C.ws + WS_CYL) + (size_t)task * (64 * CH);
            f32x16 z = mkr, x0, x1;
#pragma unroll
            for (int s_ = 0; s_ < 2; ++s_) { const int ko = (16 * s_ + 8 * hi) * 2;
                z = CS_MF(rd_nat(L + L_MAKT + r32 * RS2 + ko), rd_nat(L + L_MBRT + r32 * RS2 + ko), z); }
#define CS_X(N_, XN_) do { const float gc_ = *(const LAS float*)(L + L_GC + ((N_) * 32 + r32) * 4); \
                _Pragma("unroll") for (int q = 0; q < 16; ++q) XN_[q] = 0.f; \
                _Pragma("unroll") for (int s_ = 0; s_ < 2; ++s_) { const int ko = (16 * s_ + 4 * hi) * 2; \
                    XN_ = CS_MF(rd_perm(L + L_MAKT + r32 * RS2 + ko), rd_tr(L + L_BTV + trf + (N_) * 2048 + s_ * 1024), XN_); } \
                { const LAS unsigned char* kb_ = L + L_KT + 4 * hi * RS + ((N_) * 32 + r32) * 2; \
                _Pragma("unroll") for (int q = 0; q < 16; ++q) XN_[q] = (XN_[q] + bf2f(*(const LAS bf16_t*)(kb_ + ((q & 3) + 8 * (q >> 2)) * RS))) * gc_; } } while (0)
            CS_X(0, x0); CS_X(1, x1);
#undef CS_X
            const bf16x8 ax00 = pack8(x0, 0), ax01 = pack8(x0, 1), ax10 = pack8(x1, 0), ax11 = pack8(x1, 1), az0 = pack8(z, 0), az1 = pack8(z, 1);
#define CS_HY(N_) do { \
                f32x16 ha_, hb_, yy_; _Pragma("unroll") for (int q = 0; q < 16; ++q) { ha_[q] = 0.f; hb_[q] = 0.f; yy_[q] = 0.f; } \
                const bf16x8 va_ = rd_tr(L + L_VV + trf + (N_) * 2048), vb_ = rd_tr(L + L_VV + trf + (N_) * 2048 + 1024); \
                ha_ = CS_MF(ax00, va_, ha_); ha_ = CS_MF(ax01, vb_, ha_); hb_ = CS_MF(ax10, va_, hb_); hb_ = CS_MF(ax11, vb_, hb_); yy_ = CS_MF(az0, va_, yy_); yy_ = CS_MF(az1, vb_, yy_); \
                _Pragma("unroll") for (int g = 0; g < 4; ++g) { u32x2 w; \
                    w.x = cvtpk(ha_[4 * g], ha_[4 * g + 1]); w.y = cvtpk(ha_[4 * g + 2], ha_[4 * g + 3]); *(u32x2*)(gHT + ((N_) * 32 + r32) * 64 + 8 * g + 4 * hi) = w; \
                    w.x = cvtpk(hb_[4 * g], hb_[4 * g + 1]); w.y = cvtpk(hb_[4 * g + 2], hb_[4 * g + 3]); *(u32x2*)(gHT + ((N_) * 32 + r32) * 64 + 32 + 8 * g + 4 * hi) = w; \
                    w.x = cvtpk(yy_[4 * g], yy_[4 * g + 1]); w.y = cvtpk(yy_[4 * g + 2], yy_[4 * g + 3]); *(u32x2*)(gYL + ((N_) * 32 + r32) * CH + 8 * g + 4 * hi) = w; } \
                __builtin_amdgcn_sched_barrier(0); } while (0)
            CS_HY(0); CS_HY(1);
#undef CS_HY
        }
    }
    pair_bar(pcnt, pord, lane);
}
__device__ __forceinline__ void phaseA(const Ctx& C, LAS unsigned char* lds, int G, int bx, int lane, int wave) {
    LAS unsigned char* L = lds + (wave >> 1) * L_WAVE; const int role = wave & 1;
    LAS unsigned* pcnt = (LAS unsigned*)(lds + 4 * L_WAVE) + (wave >> 1) * 32;
    if (role == 0 && lane == 0) *pcnt = 0u;
    __syncthreads();
    unsigned pord = 0u;
    constexpr int NTASK = NB * NH * NCH;
    const int rounds = (NTASK + 4 * G - 1) / (4 * G);
    RawRegs R;
    int task = bx * 4 + (wave >> 1);
    if (task < NTASK) rawLoad(C, R, task, lane, role);
#pragma unroll 1
    for (int k = 0; k < rounds; ++k) { const int nt = task + 4 * G; taskA(C, L, task, lane, role, task < NTASK, R, nt, (k + 1 < rounds) && nt < NTASK, pcnt, pord); task = nt; }
    __syncthreads();
}
constexpr int K_QT = 0, K_GT = 4608, K_YL = 13824, K_HT = 16384, K_BUF = 20992;
constexpr int K_FR = 2 * K_BUF;
__device__ __forceinline__ void chain_unit(const Ctx& C, LAS unsigned char* lds, int unit, int tid, int lane, int wave) {
    const int bh = unit >> 1, half = unit & 1, b = bh / NH, h = bh - b * NH;
    const int r32 = lane & 31, hi = lane >> 5;
    const unsigned char* gQT = (const unsigned char*)((const bf16_t*)(C.ws + WS_CQT) + (size_t)bh * NCH * (CH * 64));
    const unsigned char* gGT = (const unsigned char*)((const bf16_t*)(C.ws + WS_CGT) + (size_t)bh * NCH * (64 * 64));
    const unsigned char* gHT = (const unsigned char*)((const bf16_t*)(C.ws + WS_CHT) + (size_t)bh * NCH * (64 * 64) + half * 32 * 64);
    const unsigned char* gYL = (const unsigned char*)((const bf16_t*)(C.ws + WS_CYL) + (size_t)bh * NCH * (64 * CH) + half * 32 * CH);
    bf16_t* yout = (bf16_t*)(C.ws + WS_Y2) + (size_t)b * SEQ * RW + h * 64 + half * 32 + r32;
    const int lt = tid - 192;
    const unsigned char* src[4]; int dst[4]; size_t cstep[4];
#pragma unroll
    for (int q_ = 0; q_ < 4; ++q_) { const int p0_ = (lt < 0 ? 0 : lt) + 320 * q_; const int p_ = p0_ < 1152 ? p0_ : 1151;
        if (p_ < 256) { src[q_] = gQT + p_ * 16; dst[q_] = K_QT + (p_ >> 3) * 144 + (p_ & 7) * 16; cstep[q_] = 4096; }
        else if (p_ < 768) { const int r_ = p_ - 256; src[q_] = gGT + r_ * 16; dst[q_] = K_GT + (r_ >> 3) * 144 + (r_ & 7) * 16; cstep[q_] = 8192; }
        else if (p_ < 896) { const int r_ = p_ - 768; src[q_] = gYL + r_ * 16; dst[q_] = K_YL + (r_ >> 2) * 80 + (r_ & 3) * 16; cstep[q_] = 4096; }
        else { const int r_ = p_ - 896; src[q_] = gHT + r_ * 16; dst[q_] = K_HT + (r_ >> 3) * 144 + (r_ & 7) * 16; cstep[q_] = 8192; } }
    const bool ldr = lt >= 0;
    u32x4 sA[4], sB[4], sC[4];
#define CH_LD1(dst_, p_) asm volatile("global_load_dwordx4 %0, %1, off" : "=v"(dst_) : "v"(p_) : "memory")
#define CH_LD(S_, cc) do { if (ldr) { const size_t cc_ = (cc) < NCH ? (cc) : NCH - 1; CH_LD1(S_[0], src[0] + cc_ * cstep[0]); CH_LD1(S_[1], src[1] + cc_ * cstep[1]); \
        CH_LD1(S_[2], src[2] + cc_ * cstep[2]); CH_LD1(S_[3], src[3] + cc_ * cstep[3]); } } while (0)
#define CH_WR(S_, cc) do { if (ldr) { asm volatile("s_waitcnt vmcnt(8)" : "+v"(S_[0]), "+v"(S_[1]), "+v"(S_[2]), "+v"(S_[3]) :: "memory"); __builtin_amdgcn_sched_barrier(0); \
        const int bo_ = ((cc) & 1) * K_BUF; *(LAS u32x4*)(lds + bo_ + dst[0]) = S_[0]; *(LAS u32x4*)(lds + bo_ + dst[1]) = S_[1]; *(LAS u32x4*)(lds + bo_ + dst[2]) = S_[2]; \
        *(LAS u32x4*)(lds + bo_ + dst[3]) = S_[3]; } } while (0)
    if (tid < 256) *(LAS u32x4*)(lds + K_FR + tid * 16) = (u32x4){0u, 0u, 0u, 0u};
#define CH_STEP(c, SW_) do { \
        CH_WR(SW_, (c) + 1); CH_LD(SW_, (c) + 4); \
        if (wave < 3 && (c) < NCH) { \
            const LAS unsigned char* B_ = lds + ((c) & 1) * K_BUF; const LAS unsigned char* F_ = lds + K_FR + ((c) & 1) * 4096 + lane * 16; \
            const bf16x8 sb0 = *(const LAS bf16x8*)(F_), sb1 = *(const LAS bf16x8*)(F_ + 1024), sb2 = *(const LAS bf16x8*)(F_ + 2048), sb3 = *(const LAS bf16x8*)(F_ + 3072); \
            f32x16 acc_; \
            if (wave < 2) {         \
                _Pragma("unroll") for (int g = 0; g < 4; ++g) { const u32x2 i0 = *(const LAS u32x2*)(B_ + K_HT + r32 * 144 + (wave * 32 + 8 * g + 4 * hi) * 2); \
                    acc_[4 * g] = bfl(i0.x); acc_[4 * g + 1] = bfh(i0.x); acc_[4 * g + 2] = bfl(i0.y); acc_[4 * g + 3] = bfh(i0.y); } \
                const LAS unsigned char* ag_ = B_ + K_GT + (wave * 32 + r32) * 144 + 8 * hi; \
                acc_ = __builtin_amdgcn_mfma_f32_32x32x16_bf16(rd_perm(ag_), sb0, acc_, 0, 0, 0); acc_ = __builtin_amdgcn_mfma_f32_32x32x16_bf16(rd_perm(ag_ + 32), sb1, acc_, 0, 0, 0); \
                acc_ = __builtin_amdgcn_mfma_f32_32x32x16_bf16(rd_perm(ag_ + 64), sb2, acc_, 0, 0, 0); acc_ = __builtin_amdgcn_mfma_f32_32x32x16_bf16(rd_perm(ag_ + 96), sb3, acc_, 0, 0, 0); \
                LAS unsigned char* FN_ = lds + K_FR + (((c) + 1) & 1) * 4096 + wave * 2048 + lane * 16; \
                *(LAS bf16x8*)(FN_) = pack8(acc_, 0); *(LAS bf16x8*)(FN_ + 1024) = pack8(acc_, 1); \
            } else {                \
                _Pragma("unroll") for (int g = 0; g < 4; ++g) { const u32x2 iy = *(const LAS u32x2*)(B_ + K_YL + r32 * 80 + (8 * g + 4 * hi) * 2); \
                    acc_[4 * g] = bfl(iy.x); acc_[4 * g + 1] = bfh(iy.x); acc_[4 * g + 2] = bfl(iy.y); acc_[4 * g + 3] = bfh(iy.y); } \
                const LAS unsigned char* aq_ = B_ + K_QT + r32 * 144 + 8 * hi; \
                acc_ = __builtin_amdgcn_mfma_f32_32x32x16_bf16(rd_perm(aq_), sb0, acc_, 0, 0, 0); acc_ = __builtin_amdgcn_mfma_f32_32x32x16_bf16(rd_perm(aq_ + 32), sb1, acc_, 0, 0, 0); \
                acc_ = __builtin_amdgcn_mfma_f32_32x32x16_bf16(rd_perm(aq_ + 64), sb2, acc_, 0, 0, 0); acc_ = __builtin_amdgcn_mfma_f32_32x32x16_bf16(rd_perm(aq_ + 96), sb3, acc_, 0, 0, 0); \
                bf16_t* yp = yout + (size_t)(c) * CH * RW; \
                _Pragma("unroll") for (int q = 0; q < 16; ++q) yp[(size_t)crow(q, hi) * RW] = (bf16_t)cvtpk(acc_[q], acc_[q]); \
            } \
        } \
        CS_BAR(); } while (0)
    CH_LD(sA, 0); CH_LD(sB, 1); CH_LD(sC, 2);
    CH_WR(sA, 0); CH_LD(sA, 3);
    CS_BAR();
#pragma unroll 1
    for (int c3 = 0; c3 < NCH + 2; c3 += 3) { CH_STEP(c3, sB); CH_STEP(c3 + 1, sC); CH_STEP(c3 + 2, sA); }
#undef CH_STEP
#undef CH_LD
#undef CH_LD1
#undef CH_WR
}
__device__ __forceinline__ void chain_phase(const Ctx& C, LAS unsigned char* lds, int G, int bx, int tid, int lane, int wave) {
    const int v0 = (G % 8 == 0) ? (bx % 8) * (G / 8) + bx / 8 : bx;
    for (int v = v0; v < 256; v += G) chain_unit(C, lds, v, tid, lane, wave);
}
#undef CS_BAR
#undef CS_MF
}

struct Frame { LAS unsigned char* lds; int tid, lane, wave, G, bx; };

__device__ __forceinline__ void p0_prologue(const Ctx& C, const Frame& F) {
    {
        LAS float* sc = (LAS float*)F.lds;
        LAS float* red = (LAS float*)(F.lds + 65536);
        for (int i = F.tid; i < NB * DM; i += NTHR) { const float cv = C.c[i]; sc[i] = cv / (1.f + __expf(-cv)); }
        __syncthreads();
        float* mod = (float*)(C.ws + WS_MOD);
        for (int cb = F.bx; cb < 6 * DM / 24; cb += F.G) {
            const int n0 = cb * 24;
            if (F.tid < 384) {
                const int kg = F.tid / 24, j = F.tid % 24;
                float acc[NB];
#pragma unroll
                for (int b = 0; b < NB; ++b) acc[b] = 0.f;
                for (int k = kg; k < DM; k += 16) { const float w = C.w_ada[(size_t)k * 6 * DM + n0 + j];
#pragma unroll
                    for (int b = 0; b < NB; ++b) acc[b] += sc[b * DM + k] * w; }
#pragma unroll
                for (int b = 0; b < NB; ++b) red[(kg * NB + b) * 24 + j] = acc[b];
            }
            __syncthreads();
            if (F.tid < 384) { const int b = F.tid / 24, j = F.tid % 24; float s = C.b_ada[n0 + j];
#pragma unroll
                for (int kg = 0; kg < 16; ++kg) s += red[(kg * NB + b) * 24 + j];
                mod[b * 6 * DM + n0 + j] = s; }
            __syncthreads();
        }
    }
    for (int o = F.bx * NTHR + F.tid; o < T * 16; o += F.G * NTHR) {
        const int t = o >> 4, i = o & 15;
        const float inv = powf(10000.0f, -(float)(2 * i) / 32.0f);
        float s, c; sincosf((float)C.pos[t] * inv, &s, &c);
        ((float2*)(C.ws + WS_ROPE))[o] = make_float2(c, s);
    }
    for (int o = F.bx * NTHR + F.tid; o < 48 * DM; o += F.G * NTHR) {
        const int j = o & 7, ln = (o >> 3) & 63, pc = o >> 9, nb = pc % 3, ks = pc / 3;
        const int n = 16 * nb + (ln & 15), k = 32 * ks + 8 * (ln >> 4) + j;
        const float w = n < NG ? C.w_rg[k * NG + n] : (n < NG + NE ? C.w_re[k * NE + (n - NG)] : 0.f);
        const bf16_t hi = f2bf(w);
        ((bf16_t*)(C.ws + WS_W + WO_RH))[o] = hi; ((bf16_t*)(C.ws + WS_W + WO_RL))[o] = f2bf(w - bf2f(hi));
    }
    __syncthreads();
    {
        LAS float* scr = (LAS float*)(F.lds + F.wave * 16384);
        const int gw = F.bx * NWAVES + F.wave, NGW = F.G * NWAVES;
        float va[32], vb[32];
        TrItem da, db;
        int it = gw;
        if (it < TR_NITEMS) { da = tr_desc(C, it); tr_load(da, va, F.lane); }
        for (; it < TR_NITEMS; it += 2 * NGW) {
            const bool hb = it + NGW < TR_NITEMS;
            if (hb) { db = tr_desc(C, it + NGW); tr_load(db, vb, F.lane); }
            tr_store(da, va, scr, F.lane);
            if (hb) {
                if (it + 2 * NGW < TR_NITEMS) { da = tr_desc(C, it + 2 * NGW); tr_load(da, va, F.lane); }
                tr_store(db, vb, scr, F.lane);
            }
        }
    }
}

__device__ __forceinline__ void p1_modulate(const Ctx& C, const Frame& F) {
    const float* mod = (const float*)(C.ws + WS_MOD);
    bf16_t* h1 = (bf16_t*)(C.ws + WS_H);
    const int lane = F.lane;
    for (int row0 = (F.bx * NWAVES + F.wave) * 4; row0 < T; row0 += F.G * NWAVES * 4) {
        const int b = row0 / SEQ;
        float4 v[4][4]; float ss[4];
#pragma unroll
        for (int r = 0; r < 4; ++r) { const float4* xr = (const float4*)(C.x + (size_t)(row0 + r) * DM);
#pragma unroll
            for (int j = 0; j < 4; ++j) v[r][j] = xr[lane + 64 * j]; }
#pragma unroll
        for (int r = 0; r < 4; ++r) { float a = 0.f;
#pragma unroll
            for (int j = 0; j < 4; ++j) a += v[r][j].x * v[r][j].x + v[r][j].y * v[r][j].y + v[r][j].z * v[r][j].z + v[r][j].w * v[r][j].w;
            ss[r] = a; }
#pragma unroll
        for (int r = 0; r < 4; ++r) ss[r] = rsqrtf(wsum_dpp(ss[r]) * (1.f / DM) + RMS_EPS);
#pragma unroll
        for (int j = 0; j < 4; ++j) {
            const int col = 4 * (lane + 64 * j);
            const float4 g = *(const float4*)(C.g_pre_mix + col);
            const float4 sh = *(const float4*)(mod + b * 6 * DM + col), sc = *(const float4*)(mod + b * 6 * DM + DM + col);
            const float m0 = g.x * (1.f + sc.x), m1 = g.y * (1.f + sc.y), m2 = g.z * (1.f + sc.z), m3 = g.w * (1.f + sc.w);
#pragma unroll
            for (int r = 0; r < 4; ++r) { const float rs = ss[r];
                u32x2 w; w.x = cvtpk(v[r][j].x * rs * m0 + sh.x, v[r][j].y * rs * m1 + sh.y); w.y = cvtpk(v[r][j].z * rs * m2 + sh.z, v[r][j].w * rs * m3 + sh.w);
                *(u32x2*)(h1 + (size_t)(row0 + r) * DM + col) = w; }
        }
    }
}

__device__ __forceinline__ void d_post_mix(const Ctx& C, int G, int bx, int tid, int lane, int wave, LAS unsigned char* lds, bool dry) {
    const float* mod = (const float*)(C.ws + WS_MOD); const bf16_t* ym = (const bf16_t*)(C.ws + WS_YMIX);
    bf16_t* h2 = (bf16_t*)(C.ws + WS_H); bf16_t* x1b = (bf16_t*)(C.ws + WS_X1B);
    const bf16_t* wrh = (const bf16_t*)(C.ws + WS_W + WO_RH); const bf16_t* wrl = (const bf16_t*)(C.ws + WS_W + WO_RL);
    float* tokw = (float*)(C.ws + WS_ROUTE);
    unsigned* gcnt = (unsigned*)(C.ws + WS_CTL) + CW_GCNT;
    int* list = (int*)(C.ws + WS_LIST);
    LAS int* le = (LAS int*)lds; LAS float* lg = (LAS float*)(lds + 1024) + wave * 16 * 48;
    LAS unsigned char* lw = lds + 25600;
    for (int q = 0; q < 16; ++q) { const int idx = wave * 16 + q, hl = idx & 1, nb = (idx >> 1) & 1, ks = idx >> 2;
        __builtin_amdgcn_global_load_lds((const unsigned*)((hl ? wrl : wrh) + (ks * 3 + nb) * 512 + lane * 8), (LAS unsigned*)(lw + idx * 1024), 16, 0, 0); }
    for (int grp = bx; grp < T / 128; grp += G) {
      const int r0 = grp * 128 + wave * 16;
      for (int rr = 0; rr < 16; rr += 4) {
        const int row = r0 + rr;
        const int b = row / SEQ; const float* mb = mod + b * 6 * DM;
        float4 yq[4][4], xq[4][4]; float rs[4], rs2[4];
#pragma unroll
        for (int u = 0; u < 4; ++u)
#pragma unroll
            for (int j = 0; j < 4; ++j) { const u32x2 yw = *(const u32x2*)(ym + (size_t)(row + u) * DM + 4 * (lane + 64 * j));
                yq[u][j] = make_float4(__uint_as_float(yw.x << 16), __uint_as_float(yw.x & 0xffff0000u), __uint_as_float(yw.y << 16), __uint_as_float(yw.y & 0xffff0000u)); xq[u][j] = *(const float4*)(C.x + (size_t)(row + u) * DM + 4 * (lane + 64 * j)); }
#pragma unroll
        for (int u = 0; u < 4; ++u) { float a = 0.f;
#pragma unroll
            for (int j = 0; j < 4; ++j) a += yq[u][j].x * yq[u][j].x + yq[u][j].y * yq[u][j].y + yq[u][j].z * yq[u][j].z + yq[u][j].w * yq[u][j].w;
            rs[u] = a; }
#pragma unroll
        for (int u = 0; u < 4; ++u) rs[u] = rsqrtf(wsum_dpp(rs[u]) * (1.f / DM) + RMS_EPS);
#pragma unroll
        for (int u = 0; u < 4; ++u) rs2[u] = 0.f;
#pragma unroll
        for (int j = 0; j < 4; ++j) { const int col = 4 * (lane + 64 * j);
            const float4 g1 = *(const float4*)(mb + 2 * DM + col), gp = *(const float4*)(C.g_post_mix + col);
            const float m0 = g1.x * gp.x, m1 = g1.y * gp.y, m2 = g1.z * gp.z, m3 = g1.w * gp.w;
#pragma unroll
            for (int u = 0; u < 4; ++u) { float4 x1 = xq[u][j];
                x1.x += m0 * (yq[u][j].x * rs[u]); x1.y += m1 * (yq[u][j].y * rs[u]); x1.z += m2 * (yq[u][j].z * rs[u]); x1.w += m3 * (yq[u][j].w * rs[u]);
                xq[u][j] = x1; rs2[u] += x1.x * x1.x + x1.y * x1.y + x1.z * x1.z + x1.w * x1.w;
                u32x2 xw; xw.x = cvtpk(x1.x, x1.y); xw.y = cvtpk(x1.z, x1.w); *(u32x2*)(x1b + (size_t)(row + u) * DM + col) = xw; } }
#pragma unroll
        for (int u = 0; u < 4; ++u) rs2[u] = rsqrtf(wsum_dpp(rs2[u]) * (1.f / DM) + RMS_EPS);
#pragma unroll
        for (int j = 0; j < 4; ++j) { const int col = 4 * (lane + 64 * j);
            const float4 gf = *(const float4*)(C.g_pre_ffn + col), sc = *(const float4*)(mb + 4 * DM + col), sh = *(const float4*)(mb + 3 * DM + col);
            const float m0 = gf.x * (1.f + sc.x), m1 = gf.y * (1.f + sc.y), m2 = gf.z * (1.f + sc.z), m3 = gf.w * (1.f + sc.w);
#pragma unroll
            for (int u = 0; u < 4; ++u) {
                const float h0 = xq[u][j].x * rs2[u] * m0 + sh.x, h1 = xq[u][j].y * rs2[u] * m1 + sh.y, h2_ = xq[u][j].z * rs2[u] * m2 + sh.z, h3 = xq[u][j].w * rs2[u] * m3 + sh.w;
                u32x2 wh; wh.x = cvtpk(h0, h1); wh.y = cvtpk(h2_, h3);
                *(u32x2*)(h2 + (size_t)(row + u) * DM + col) = wh; } }
      }
      asm volatile("s_waitcnt vmcnt(0)" ::: "memory");
      __syncthreads();
      {
        f32x4 acc0 = {0.f, 0.f, 0.f, 0.f}, acc1 = acc0, acc2 = acc0;
        const int fr = lane & 15, fq = lane >> 4;
        const bf16_t* ah = h2 + (size_t)(r0 + fr) * DM + 8 * fq;
        const bf16_t* bh = wrh + lane * 8; const bf16_t* bl = wrl + lane * 8;
#pragma unroll 8
        for (int ks = 0; ks < 32; ++ks) {
            const bf16x8 a_h = *(const bf16x8*)(ah + 32 * ks);
            const LAS unsigned char* lp = lw + ks * 4096 + lane * 16;
            const bf16x8 b0h = *(const LAS bf16x8*)(lp), b0l = *(const LAS bf16x8*)(lp + 1024), b1h = *(const LAS bf16x8*)(lp + 2048), b1l = *(const LAS bf16x8*)(lp + 3072);
            const bf16x8 b2h = *(const bf16x8*)(bh + ks * 1536 + 1024), b2l = *(const bf16x8*)(bl + ks * 1536 + 1024);
            acc0 = __builtin_amdgcn_mfma_f32_16x16x32_bf16(a_h, b0h, acc0, 0, 0, 0); acc0 = __builtin_amdgcn_mfma_f32_16x16x32_bf16(a_h, b0l, acc0, 0, 0, 0);
            acc1 = __builtin_amdgcn_mfma_f32_16x16x32_bf16(a_h, b1h, acc1, 0, 0, 0); acc1 = __builtin_amdgcn_mfma_f32_16x16x32_bf16(a_h, b1l, acc1, 0, 0, 0);
            acc2 = __builtin_amdgcn_mfma_f32_16x16x32_bf16(a_h, b2h, acc2, 0, 0, 0); acc2 = __builtin_amdgcn_mfma_f32_16x16x32_bf16(a_h, b2l, acc2, 0, 0, 0);
        }
#pragma unroll
        for (int e = 0; e < 4; ++e) { lg[(4 * fq + e) * 48 + fr] = acc0[e]; lg[(4 * fq + e) * 48 + 16 + fr] = acc1[e]; lg[(4 * fq + e) * 48 + 32 + fr] = acc2[e]; }
      }
      asm volatile("s_waitcnt lgkmcnt(0)" ::: "memory");
      if (lane < 16) {
            float gl[NG], el[NE];
#pragma unroll
            for (int c = 0; c < NG; ++c) gl[c] = lg[lane * 48 + c] + C.b_rg[c];
#pragma unroll
            for (int c = 0; c < NE; ++c) el[c] = lg[lane * 48 + NG + c] + C.b_re[c];
            int gs = 0; float gm = gl[0];
#pragma unroll
            for (int c = 1; c < NG; ++c) if (gl[c] > gm) { gm = gl[c]; gs = c; }
            float den = 0.f;
#pragma unroll
            for (int c = 0; c < NG; ++c) den += __expf(gl[c] - gm);
            const float psel = 1.f / den;
            float eg[EPG];
#pragma unroll
            for (int c = 0; c < EPG; ++c) eg[c] = gs == 0 ? el[c] : (gs == 1 ? el[EPG + c] : (gs == 2 ? el[2 * EPG + c] : el[3 * EPG + c]));
            int i0 = 0; float v0 = eg[0];
#pragma unroll
            for (int c = 1; c < EPG; ++c) if (eg[c] > v0) { v0 = eg[c]; i0 = c; }
            int i1 = -1; float v1 = -INFINITY;
#pragma unroll
            for (int c = 0; c < EPG; ++c) if (c != i0 && eg[c] > v1) { v1 = eg[c]; i1 = c; }
            const float e1 = __expf(v1 - v0), w0 = 1.f / (1.f + e1), w1 = e1 / (1.f + e1);
            le[(wave * 16 + lane) * 2] = gs * EPG + i0; le[(wave * 16 + lane) * 2 + 1] = gs * EPG + i1;
            *(float2*)(tokw + (size_t)(r0 + lane) * 2) = make_float2(psel * w0, psel * w1);
      }
      __syncthreads();
      if (tid < NE && !dry) {
          int cnt = 0;
          for (int k = 0; k < 256; ++k) cnt += (le[k] == tid) ? 1 : 0;
          if (cnt) { const unsigned base = __hip_atomic_fetch_add(gcnt + tid, (unsigned)cnt, __ATOMIC_RELAXED, __HIP_MEMORY_SCOPE_AGENT);
              int j = 0;
              for (int k = 0; k < 256; ++k) if (le[k] == tid) { list[(size_t)tid * T + base + j] = grp * 256 + k; ++j; } }
      }
      __syncthreads();
    }
}
template <int NPN, bool BAL = false>
__device__ __forceinline__ pg8::MoeTab moe_setup(const Ctx& C, int G, int bx, int tid, __attribute__((address_space(3))) int* ctl) {
    const unsigned* gcnt = (const unsigned*)(C.ws + WS_CTL) + CW_GCNT;
    const int* list = (const int*)(C.ws + WS_LIST);
    __syncthreads();
    if (tid == 0) { int acc = 0; for (int e = 0; e < NE; ++e) { const int c = (int)__hip_atomic_load(gcnt + e, __ATOMIC_RELAXED, __HIP_MEMORY_SCOPE_AGENT); ctl[64 + e] = c; ctl[e] = acc; acc += (c + 255) >> 8; } ctl[NE] = acc; }
    __syncthreads();
    if (tid < pg8::MOE_MAXU) {
        const int total = ctl[NE] * NPN; long L = (long)tid * G + bx;
        if constexpr (BAL) { const int s_ = (ctl[NE] * 2) % G;
            constexpr int SK = MOE_SKIP;
            if (s_ > 0) { if (bx >= s_) L = tid < SK ? (long)tid * (G - s_) + (bx - s_) : (long)SK * (G - s_) + (long)(tid - SK) * G + (bx - s_);
                          else L = (long)SK * (G - s_) + (long)tid * G + (G - s_ + bx); } }
        int* d = nullptr; (void)d;
        if (L < total) { const int pn = (int)(L % NPN), rt = (int)(L / NPN); int e = 0;
            for (int q = 1; q < NE; ++q) if (ctl[q] <= rt) e = q;
            const int m = rt - ctl[e]; int nv = ctl[64 + e] - m * 256; nv = nv > 256 ? 256 : nv;
            ctl[128 + tid * 8 + 0] = e; ctl[128 + tid * 8 + 1] = m; ctl[128 + tid * 8 + 2] = pn; ctl[128 + tid * 8 + 3] = nv; ctl[128 + tid * 8 + 4] = rt * 256; ctl[128 + tid * 8 + 5] = 1; }
        else ctl[128 + tid * 8 + 5] = 0;
    }
    __syncthreads();
    for (int i = 0; i < pg8::MOE_MAXU; ++i) {
        if (ctl[128 + i * 8 + 5] && tid < 256) { const int e = ctl[128 + i * 8 + 0], m = ctl[128 + i * 8 + 1], nv = ctl[128 + i * 8 + 3];
            const int r = tid < nv ? tid : nv - 1;
            ctl[256 + i * 256 + tid] = list[(size_t)e * T + m * 256 + r]; }
    }
    __syncthreads();
    pg8::MoeTab tb; tb.desc = ctl + 128; tb.rowtab = ctl + 256; return tb;
}
__device__ __forceinline__ void d_final(const Ctx& C, int gw, int ngw, int lane) {
    const float* mod = (const float*)(C.ws + WS_MOD); const bf16_t* ys = (const bf16_t*)(C.ws + WS_YSLOT); const bf16_t* x1b = (const bf16_t*)(C.ws + WS_X1B);
    for (int row0 = gw * 4; row0 < T; row0 += ngw * 4) {
        const int b = row0 / SEQ; const float* mb = mod + b * 6 * DM;
        u32x2 ya[4][4], yb[4][4]; float4 x1[4][4]; float rs[4];
#pragma unroll
        for (int r = 0; r < 4; ++r)
#pragma unroll
            for (int j = 0; j < 4; ++j) { const int col = 4 * (lane + 64 * j);
                ya[r][j] = *(const u32x2*)(ys + (size_t)(row0 + r) * 2 * DM + col); yb[r][j] = *(const u32x2*)(ys + (size_t)(row0 + r) * 2 * DM + DM + col);
                { const u32x2 xw = *(const u32x2*)(x1b + (size_t)(row0 + r) * DM + col); x1[r][j] = make_float4(__uint_as_float(xw.x << 16), __uint_as_float(xw.x & 0xffff0000u), __uint_as_float(xw.y << 16), __uint_as_float(xw.y & 0xffff0000u)); } }
        float yv[4][16];
#pragma unroll
        for (int r = 0; r < 4; ++r) { float a = 0.f;
#pragma unroll
            for (int j = 0; j < 4; ++j) {
                yv[r][4 * j] = __uint_as_float(ya[r][j].x << 16) + __uint_as_float(yb[r][j].x << 16); yv[r][4 * j + 1] = __uint_as_float(ya[r][j].x & 0xffff0000u) + __uint_as_float(yb[r][j].x & 0xffff0000u);
                yv[r][4 * j + 2] = __uint_as_float(ya[r][j].y << 16) + __uint_as_float(yb[r][j].y << 16); yv[r][4 * j + 3] = __uint_as_float(ya[r][j].y & 0xffff0000u) + __uint_as_float(yb[r][j].y & 0xffff0000u);
                a += yv[r][4 * j] * yv[r][4 * j] + yv[r][4 * j + 1] * yv[r][4 * j + 1] + yv[r][4 * j + 2] * yv[r][4 * j + 2] + yv[r][4 * j + 3] * yv[r][4 * j + 3]; }
            rs[r] = a; }
#pragma unroll
        for (int r = 0; r < 4; ++r) rs[r] = rsqrtf(wsum_dpp(rs[r]) * (1.f / DM) + RMS_EPS);
#pragma unroll
        for (int j = 0; j < 4; ++j) { const int col = 4 * (lane + 64 * j);
            const float4 g = *(const float4*)(C.g_post_ffn + col), g2 = *(const float4*)(mb + 5 * DM + col);
            const float m0 = g.x * g2.x, m1 = g.y * g2.y, m2 = g.z * g2.z, m3 = g.w * g2.w;
#pragma unroll
            for (int r = 0; r < 4; ++r) { float4 o = x1[r][j];
                o.x += m0 * (yv[r][4 * j] * rs[r]); o.y += m1 * (yv[r][4 * j + 1] * rs[r]); o.z += m2 * (yv[r][4 * j + 2] * rs[r]); o.w += m3 * (yv[r][4 * j + 3] * rs[r]);
                *(float4*)(C.out + (size_t)(row0 + r) * DM + col) = o; } }
    }
}

#define XB_TMO      128
#define XB_XCNT(j)  (256  + 64 * (j))
#define XB_XSUB(j)  (1280 + 64 * (j))
#define XB_XGEN(j)  (2304 + 64 * (j))
#define XB_TOP      3328
#define XB_TOPGEN   3392
#define XCD_BAR_WORDS 3456
#define XB_SPIN_CAP (1u << 18)
__device__ __forceinline__ unsigned xb_ld(unsigned* p)              { return __hip_atomic_load(p, __ATOMIC_RELAXED, __HIP_MEMORY_SCOPE_AGENT); }
__device__ __forceinline__ unsigned xb_add(unsigned* p, unsigned v) { return __hip_atomic_fetch_add(p, v, __ATOMIC_RELAXED, __HIP_MEMORY_SCOPE_AGENT); }
__device__ __forceinline__ unsigned xb_xcc_id() { return (unsigned)__builtin_amdgcn_s_getreg((3 << 11) | 20) & 0xFu; }
#define XB_SPIN(cond, bar) do { unsigned _sp = 0; while (cond) { __builtin_amdgcn_s_sleep(1); \
    if ((++_sp & 255u) == 0u) { if (xb_ld(&(bar)[XB_TMO])) break; if (_sp > XB_SPIN_CAP) { atomicAdd(&(bar)[XB_TMO], 1u); break; } } } } while (0)
struct XcdBarrier { unsigned* bar; unsigned x; volatile LAS unsigned* st; };
__device__ __forceinline__ XcdBarrier xcd_barrier_post(unsigned* bar, volatile LAS unsigned* st) {
    XcdBarrier b; b.bar = bar; b.x = xb_xcc_id(); b.st = st;
    if (threadIdx.x == 0) (void)xb_add(&bar[XB_XCNT(b.x)], 1u);
    return b;
}
__device__ __forceinline__ void xcd_barrier_complete(unsigned* bar, unsigned x, unsigned& nloc, unsigned& nx) {
    const unsigned G = gridDim.x * gridDim.y * gridDim.z;
    unsigned sum, cnt, mine, sp = 0u;
    for (;;) {
        sum = 0u; cnt = 0u; mine = 0u;
#pragma unroll
        for (unsigned j = 0; j < 16; ++j) { const unsigned c = xb_ld(&bar[XB_XCNT(j)]); sum += c; cnt += (c > 0u) ? 1u : 0u; mine = (j == x) ? c : mine; }
        if (sum == G) break;
        __builtin_amdgcn_s_sleep(1);
        if ((++sp & 255u) == 0u) { if (xb_ld(&bar[XB_TMO])) break; if (sp > XB_SPIN_CAP) { atomicAdd(&bar[XB_TMO], 1u); break; } }
    }
    nloc = mine > 0u ? mine : 1u; nx = cnt > 0u ? cnt : 1u;
}
__device__ __forceinline__ void xcd_barrier(const XcdBarrier& b) {
    asm volatile("s_waitcnt vmcnt(0)" ::: "memory");
    __syncthreads();
    if (threadIdx.x == 0) {
        unsigned* bar = b.bar;
        __builtin_amdgcn_s_waitcnt(0);
        unsigned nloc = b.st[0], nx = b.st[1];
        if (nloc == 0u) { xcd_barrier_complete(bar, b.x, nloc, nx); b.st[0] = nloc; b.st[1] = nx; }
        const unsigned old = xb_add(&bar[XB_XSUB(b.x)], 1u);
        const unsigned gen = old / nloc;
        if (old + 1u == (gen + 1u) * nloc) {
            __builtin_amdgcn_fence(__ATOMIC_RELEASE, "agent");
            asm volatile("s_waitcnt vmcnt(0)" ::: "memory");
            const unsigned og = xb_add(&bar[XB_TOP], 1u);
            const unsigned tg = og / nx;
            if (og + 1u == (tg + 1u) * nx) xb_add(&bar[XB_TOPGEN], 1u);
            else XB_SPIN(xb_ld(&bar[XB_TOPGEN]) == tg, bar);
            __builtin_amdgcn_fence(__ATOMIC_ACQUIRE, "agent");
            xb_add(&bar[XB_XGEN(b.x)], 1u);
            asm volatile("s_waitcnt vmcnt(0)" ::: "memory");
        } else {
            XB_SPIN(xb_ld(&bar[XB_XGEN(b.x)]) == gen, bar);
            __builtin_amdgcn_fence(__ATOMIC_ACQUIRE, "agent");
            asm volatile("s_waitcnt vmcnt(0)" ::: "memory");
        }
    }
    __syncthreads();
}

struct Args { Ctx C; int ph_lo, ph_hi, sub, breg; };
__global__ void __launch_bounds__(NTHR, 2) mk(Args args) {
    extern __shared__ __attribute__((aligned(16))) unsigned char lds_raw[];
    const Ctx& C = args.C;
    Frame F; F.lds = (LAS unsigned char*)lds_raw; F.tid = threadIdx.x; F.lane = F.tid & 63; F.wave = __builtin_amdgcn_readfirstlane(F.tid >> 6); F.G = gridDim.x; F.bx = blockIdx.x;
    const int lo = args.ph_lo, hi = args.ph_hi;
    volatile LAS unsigned* xbw = (volatile LAS unsigned*)(F.lds + LDS_BYTES - 16);
    if (F.tid < 4) xbw[F.tid] = 0u;
    __syncthreads();
    unsigned* barw = (unsigned*)(C.ws + WS_CTL) + args.breg * XCD_BAR_WORDS;
    XcdBarrier bar; bar.bar = barw; bar.x = 0; bar.st = xbw;
    if (hi - lo > 1) bar = xcd_barrier_post(barw, xbw);
#define IN(k) (lo <= (k) && (k) < hi)
#define SEAM(k) do { if (IN(k) && IN((k) + 1)) xcd_barrier(bar); } while (0)
    if (IN(0)) { p0_prologue(C, F); }
    SEAM(0);
    if (IN(1)) { p1_modulate(C, F); }
    SEAM(1);
    if (IN(2)) {
        pg8::Dense P{(const bf16_t*)(C.ws + WS_H), (const bf16_t*)(C.ws + WS_W + WO_IN), DM, DM, DM};
        pg8::StaticOrder S; S.init(T, 4608, F.G, F.bx);
        pg8::EpiZ E{(bf16_t*)(C.ws + WS_ZM), (bf16_t*)(C.ws + WS_RKV), (bf16_t*)(C.ws + WS_ZL), (bf16_t*)C.out};
        pg8::gemm_phase(F.lds, P, S, E);
    }
    SEAM(2);
    if (IN(3)) { d_prep(C, F.bx * NWAVES + F.wave, F.G * NWAVES, F.lane); }
    SEAM(3);
    if (IN(4)) {
        const bf16_t* wb = (const bf16_t*)(C.ws + WS_W);
        {   pg8::Dense P{(const bf16_t*)(C.ws + WS_CQN), wb + WO_UQ / 2, QR, QR, QR};
            pg8::StaticOrder S; S.init(T, 768, F.G, F.bx);
            pg8::EpiQ E{(bf16_t*)(C.ws + WS_QF), (const float2*)(C.ws + WS_ROPE)};
            pg8::gemm_phase(F.lds, P, S, E); }
        {   rsg::DenseRS P{(const bf16_t*)(C.ws + WS_CKVN), wb + WO_UKV / 2, KVR, KVR, 512, F.G, F.bx};
            rsg::EpiKVrs E{(bf16_t*)(C.ws + WS_KF), (bf16_t*)(C.ws + WS_VF), F.G, F.bx};
            rsg::rs_gemm_phase<KVR / 16>(F.lds, P, E, F.tid, F.lane, F.wave); }
        {   const bf16_t* la = (const bf16_t*)(C.ws + WS_LORA); const bf16_t* lw = wb + WO_LORA / 2;
            {   rsg::DenseRS P{la, lw, 256, 256, 256, F.G, F.bx};
                rsg::EpiLoraRS<0> E{(bf16_t*)(C.ws + WS_EBUF), C.dec_bias, F.G, F.bx};
                rsg::rs_gemm_phase<DR / 16>(F.lds, P, E, F.tid, F.lane, F.wave); }
            {   rsg::DenseRS P{la + DR, lw + (size_t)512 * 256 + DR, 256, 256, 256, F.G, F.bx};
                rsg::EpiLoraRS<1> E{(bf16_t*)(C.ws + WS_AV), C.a_bias, F.G, F.bx};
                rsg::rs_gemm_phase<AR / 16>(F.lds, P, E, F.tid, F.lane, F.wave); }
            {   rsg::DenseRS P{la + DR + AR, lw + (size_t)1024 * 256 + DR + AR, 256, 256, 256, F.G, F.bx};
                rsg::EpiLoraRS<2> E{(bf16_t*)(C.ws + WS_G), nullptr, F.G, F.bx};
                rsg::rs_gemm_phase<GR / 16>(F.lds, P, E, F.tid, F.lane, F.wave); } }
    }
    SEAM(4);
    if (IN(5)) { att::attn_phase(C, F.lds, F.G, F.bx, F.tid, F.lane, F.wave); }
    SEAM(5);
    if (IN(6)) { cscan::phaseA(C, F.lds, F.G, F.bx, F.lane, F.wave); }
    SEAM(6);
    if (IN(7)) { cscan::chain_phase(C, F.lds, F.G, F.bx, F.tid, F.lane, F.wave); }
    SEAM(7);
    if (IN(8)) { d_rwkv_post(C, F.bx * NWAVES + F.wave, F.G * NWAVES, F.lane); }
    SEAM(8);
    if (IN(9)) {
        const bf16_t* wb = (const bf16_t*)(C.ws + WS_W);
        pg8::MixProb P{(const bf16_t*)(C.ws + WS_ATT), (const bf16_t*)(C.ws + WS_RWO), wb + WO_OM / 2, wb + WO_OR / 2, RW, RW, RW};
        pg8::StaticOrder S; S.init(T, DM, F.G, F.bx, 2);
        pg8::EpiMix E{(const bf16_t*)C.out, (bf16_t*)(C.ws + WS_MIXED), (unsigned*)(C.ws + WS_CTL) + CW_PFLAG};
        pg8::gemm_phase(F.lds, P, S, E);
    }
    if (IN(10)) {
        const bf16_t* wb = (const bf16_t*)(C.ws + WS_W);
        pg8::DenseSC P{(const bf16_t*)(C.ws + WS_MIXED), wb + WO_OUT / 2, DM, DM, DM};
        pg8::StaticOrderW S; S.so.init(T, DM, F.G, F.bx); S.flag = (unsigned*)(C.ws + WS_CTL) + CW_PFLAG; S.need = 4u;
        pg8::EpiOutF E{(bf16_t*)(C.ws + WS_YMIX)};
        pg8::gemm_phase(F.lds, P, S, E);
    }
    SEAM(10);
    if (IN(11)) { d_post_mix(C, F.G, F.bx, F.tid, F.lane, F.wave, F.lds, (args.sub & 4) != 0); }
    SEAM(11);
    if (IN(12)) {
        const pg8::MoeTab tb = moe_setup<2>(C, F.G, F.bx, F.tid, (LAS int*)(F.lds + LDSCTL_OFF));
        pg8::MoeProb1 P{(const bf16_t*)(C.ws + WS_H), (const bf16_t*)(C.ws + WS_W + WO_GU), tb, DM, DM, DM};
        pg8::MoeSched S{tb};
        pg8::EpiMoe1 E{(bf16_t*)(C.ws + WS_ACT), (const float*)(C.ws + WS_ROUTE), tb, (unsigned*)(C.ws + WS_CTL) + CW_RTFLAG};
        pg8::gemm_phase(F.lds, P, S, E);
    }
    if (IN(13)) {
        const pg8::MoeTab tb = moe_setup<4, true>(C, F.G, F.bx, F.tid, (LAS int*)(F.lds + LDSCTL_OFF));
        pg8::MoeProb2 P{(const bf16_t*)(C.ws + WS_ACT), (const bf16_t*)(C.ws + WS_W + WO_DN), tb, FF, FF, FF};
        pg8::MoeSched2 S{tb, (unsigned*)(C.ws + WS_CTL) + CW_RTFLAG};
        pg8::EpiMoe2 E{(bf16_t*)(C.ws + WS_YSLOT), tb};
        pg8::gemm_phase(F.lds, P, S, E);
    }
    SEAM(13);
    if (IN(14)) { d_final(C, F.bx * NWAVES + F.wave, F.G * NWAVES, F.lane); }
#undef IN
#undef SEAM
}

static int g_grid = 0;
static int g_breg = 0;
static void launch_mk(const Ctx& C, int lo, int hi, hipStream_t stream, int sub = 3) {
    Args a{}; a.C = C; a.ph_lo = lo; a.ph_hi = hi; a.sub = sub; a.breg = g_breg++;
    hipLaunchKernelGGL(mk, dim3(g_grid), dim3(NTHR), LDS_BYTES, stream, a);
}
extern "C" void kernel_launch(void* const* d_in, const int* in_sizes, int n_in, void* d_out, int out_size, void* d_ws, size_t ws_size, hipStream_t stream) {
    if (g_grid == 0) {
        int dev = 0, cus = 0; hipGetDevice(&dev); hipDeviceGetAttribute(&cus, hipDeviceAttributeMultiprocessorCount, dev);
        hipFuncSetAttribute((const void*)mk, hipFuncAttributeMaxDynamicSharedMemorySize, LDS_BYTES);
        g_grid = cus > 0 ? cus : 256;
    }
    Ctx C{};
    const float* const* f = (const float* const*)d_in;
    C.x = f[0]; C.c = f[1]; C.pos = (const int*)d_in[2];
    C.w_ada = f[3]; C.b_ada = f[4]; C.g_pre_mix = f[5]; C.g_post_mix = f[6]; C.g_pre_ffn = f[7]; C.g_post_ffn = f[8];
    C.w_in = f[9]; C.g_cq = f[10]; C.w_uq = f[11]; C.g_ckv = f[12]; C.w_ukv = f[13]; C.w_o_mla = f[14];
    C.mu = f[15]; C.w_dec = f[16]; C.dec_bias = f[17]; C.w_a = f[18]; C.a_bias = f[19]; C.w_g = f[20];
    C.k_k = f[21]; C.k_a = f[22]; C.r_k = f[23]; C.lnx_w = f[24]; C.lnx_b = f[25]; C.w_o_rwkv = f[26]; C.w_out = f[27];
    C.w_rg = f[28]; C.b_rg = f[29]; C.w_re = f[30]; C.b_re = f[31]; C.w_eg = f[32]; C.w_eu = f[33]; C.w_ed = f[34];
    C.out = (float*)d_out; C.ws = (unsigned char*)d_ws;

    g_breg = 0;
    hipMemsetAsync((char*)d_ws + WS_CTL, 0, CTL_ZERO_BYTES, stream);
    launch_mk(C, 0, 15, stream);
}
```

```cpp
#include <hip/hip_runtime.h>
#include <stdint.h>
#include <math.h>
#include <type_traits>

constexpr int NB = 16, SEQ = 2048, DM = 1024, T = NB * SEQ;
constexpr int NH = 8;
constexpr int QR = 384, KVR = 256, ROPE = 32, NOPE = 64, VD = 64, QK = NOPE + ROPE;
constexpr int RW = 512, DR = 64, AR = 64, GR = 128;
constexpr int MLA_IN = QR + KVR + ROPE;
constexpr int RWKV_IN = 3 * RW + DR + AR + GR;
constexpr int IN_W = MLA_IN + RWKV_IN + 2 * DM;
constexpr int NE = 32, EPG = 8, NG = 4, FF = 256;
constexpr float RMS_EPS = 1e-6f, GN_EPS = 64e-5f;
constexpr float QSCALE = 0.10206207261596577f * 1.4426950408889634f;

typedef unsigned short bf16_t;
__device__ __forceinline__ float bf2f(bf16_t h) { return __uint_as_float(((unsigned)h) << 16); }
__device__ __forceinline__ bf16_t f2bf(float f) { unsigned u = __float_as_uint(f); return (bf16_t)((u + 0x7fffu + ((u >> 16) & 1u)) >> 16); }
__device__ __forceinline__ float sigmoidf_(float x) { return 1.f / (1.f + __expf(-x)); }
typedef unsigned u32x2 __attribute__((ext_vector_type(2)));
typedef float f32x2_t __attribute__((ext_vector_type(2)));
typedef __bf16 bf16x2_t __attribute__((ext_vector_type(2)));
__device__ __forceinline__ unsigned cvtpk(float lo, float hi) { f32x2_t v = {lo, hi}; bf16x2_t b = __builtin_convertvector(v, bf16x2_t); return __builtin_bit_cast(unsigned, b); }
__device__ __forceinline__ float fsigmoid(float x) { return __builtin_amdgcn_rcpf(1.f + __expf(-x)); }
template <int CTRL> __device__ __forceinline__ float dpp_add_(float x) { return x + __builtin_bit_cast(float, __builtin_amdgcn_update_dpp(0, __builtin_bit_cast(int, x), CTRL, 0xf, 0xf, true)); }
template <int CTRL> __device__ __forceinline__ float dpp_max_(float x) { return fmaxf(x, __builtin_bit_cast(float, __builtin_amdgcn_update_dpp(0, __builtin_bit_cast(int, x), CTRL, 0xf, 0xf, true))); }
__device__ __forceinline__ float wmax_dpp(float x) {
    x = dpp_max_<0xB1>(x); x = dpp_max_<0x4E>(x); x = dpp_max_<0x141>(x); x = dpp_max_<0x140>(x);
    x = fmaxf(x, __builtin_bit_cast(float, __builtin_amdgcn_update_dpp(0, __builtin_bit_cast(int, x), 0x142, 0xa, 0xf, false)));
    x = fmaxf(x, __builtin_bit_cast(float, __builtin_amdgcn_update_dpp(0, __builtin_bit_cast(int, x), 0x143, 0xc, 0xf, false)));
    return __builtin_bit_cast(float, __builtin_amdgcn_readlane(__builtin_bit_cast(int, x), 63));
}
__device__ __forceinline__ unsigned q8pack(float a, float b, float c, float d) {
    const int i0 = (int)__builtin_rintf(a), i1 = (int)__builtin_rintf(b), i2 = (int)__builtin_rintf(c), i3 = (int)__builtin_rintf(d);
    return (unsigned)(i0 & 255) | ((unsigned)(i1 & 255) << 8) | ((unsigned)(i2 & 255) << 16) | ((unsigned)i3 << 24); }
__device__ __forceinline__ float wsum_dpp(float x) {
    x = dpp_add_<0xB1>(x); x = dpp_add_<0x4E>(x); x = dpp_add_<0x141>(x); x = dpp_add_<0x140>(x);
    x += __builtin_bit_cast(float, __builtin_amdgcn_update_dpp(0, __builtin_bit_cast(int, x), 0x142, 0xa, 0xf, false));
    x += __builtin_bit_cast(float, __builtin_amdgcn_update_dpp(0, __builtin_bit_cast(int, x), 0x143, 0xc, 0xf, false));
    return __builtin_bit_cast(float, __builtin_amdgcn_readlane(__builtin_bit_cast(int, x), 63));
}
__device__ __forceinline__ float sum8_dpp(float x) { x = dpp_add_<0xB1>(x); x = dpp_add_<0x4E>(x); x = dpp_add_<0x141>(x); return x; }
__device__ __forceinline__ float wave_sum(float v) {
#pragma unroll
    for (int o = 1; o < 64; o <<= 1) v += __shfl_xor(v, o);
    return v;
}

constexpr size_t MiB = 1u << 20;
constexpr size_t WS_MOD = 5 * MiB;
constexpr size_t WS_ROPE = 1 * MiB;
constexpr size_t WS_CTL = 0;
constexpr size_t CTL_ZERO_BYTES = 65536 + 32768;
constexpr size_t CTL_SBMAX = 65536;
constexpr size_t CTL_SA = 131072;
constexpr int MOE_SKIP = 1;
constexpr int CW_PFLAG = 15744;
constexpr int CW_RTFLAG = 15424;
constexpr int CW_GCNT = 15360;
constexpr size_t WS_H = 8 * MiB;
constexpr size_t WS_QF = 8 * MiB;
constexpr size_t WS_RWO = 8 * MiB;
constexpr size_t WS_ZM = 72 * MiB;
constexpr size_t WS_VF = 72 * MiB;
constexpr size_t WS_EBUF = 104 * MiB;
constexpr size_t WS_MIXED = 72 * MiB;
constexpr size_t WS_ACT = 72 * MiB;
constexpr size_t WS_ZL = 120 * MiB;
constexpr size_t WS_AV = 136 * MiB;
constexpr size_t WS_G = 168 * MiB;
constexpr size_t WS_Y = 200 * MiB;
constexpr size_t WS_YMIX = 136 * MiB;
constexpr size_t WS_CQN = 232 * MiB;
constexpr size_t WS_CKVN = 256 * MiB;
constexpr size_t WS_LORA = 272 * MiB;
constexpr size_t WS_ATT = 264 * MiB;
constexpr size_t WS_YSLOT = 264 * MiB;
constexpr size_t WS_H2LO = 264 * MiB;
constexpr size_t WS_X1B = 200 * MiB;
constexpr size_t WS_CGT = 8 * MiB, WS_CQT = 72 * MiB, WS_CHT = 200 * MiB, WS_CYL = 392 * MiB, WS_Y2 = 104 * MiB;
constexpr size_t WS_RKV = 296 * MiB;
constexpr size_t WS_KF = 392 * MiB;
constexpr size_t WS_MIX1 = 296 * MiB;
constexpr size_t WS_BONUS = 440 * MiB;
constexpr size_t WS_ROUTE = 442 * MiB;
constexpr size_t WS_LIST = 444 * MiB;
constexpr size_t WS_W = 448 * MiB;
constexpr size_t WS_QRAW = 448 * MiB;

struct Ctx {
    const float *x, *c; const int* pos;
    const float *w_ada, *b_ada, *g_pre_mix, *g_post_mix, *g_pre_ffn, *g_post_ffn;
    const float *w_in, *g_cq, *w_uq, *g_ckv, *w_ukv, *w_o_mla;
    const float *mu, *w_dec, *dec_bias, *w_a, *a_bias, *w_g, *k_k, *k_a, *r_k, *lnx_w, *lnx_b, *w_o_rwkv, *w_out;
    const float *w_rg, *b_rg, *w_re, *b_re, *w_eg, *w_eu, *w_ed;
    float* out; unsigned char* ws;
};

__device__ __forceinline__ void d_prep(const Ctx& C, int gw, int ngw, int lane) {
    typedef unsigned u32x4_ __attribute__((ext_vector_type(4)));
    const bf16_t* zm = (const bf16_t*)(C.ws + WS_ZM); const bf16_t* zl = (const bf16_t*)(C.ws + WS_ZL);
    bf16_t* cqn = (bf16_t*)(C.ws + WS_CQN); bf16_t* ckvn = (bf16_t*)(C.ws + WS_CKVN); bf16_t* lora = (bf16_t*)(C.ws + WS_LORA);
    bf16_t* kf = (bf16_t*)(C.ws + WS_KF);
    const float2* rope = (const float2*)(C.ws + WS_ROPE);
#define UNPK8(W_, F_) do { F_[0] = __uint_as_float(W_[0] << 16); F_[1] = __uint_as_float(W_[0] & 0xffff0000u); F_[2] = __uint_as_float(W_[1] << 16); F_[3] = __uint_as_float(W_[1] & 0xffff0000u); \
        F_[4] = __uint_as_float(W_[2] << 16); F_[5] = __uint_as_float(W_[2] & 0xffff0000u); F_[6] = __uint_as_float(W_[3] << 16); F_[7] = __uint_as_float(W_[3] & 0xffff0000u); } while (0)
    for (int t0 = gw * 4; t0 < T; t0 += ngw * 4) {
        const int b = t0 / SEQ, s0 = t0 % SEQ;
        u32x4_ wq[4], wk[4], wz[5];
        const u32x4_ zero4 = {0u, 0u, 0u, 0u};
#pragma unroll
        for (int r = 0; r < 4; ++r) { const bf16_t* zrow = zm + (size_t)(t0 + r) * 768;
            wq[r] = lane < 48 ? *(const u32x4_*)(zrow + 8 * lane) : zero4; wk[r] = lane < 32 ? *(const u32x4_*)(zrow + QR + 8 * lane) : zero4; }
#pragma unroll
        for (int r = 0; r < 5; ++r) { const bool ok = (lane < 32) && (r > 0 || s0 > 0);
            wz[r] = ok ? *(const u32x4_*)(zl + (size_t)(t0 + r - 1) * 256 + 8 * lane) : zero4; }
        float rs1[4], rs2[4];
#pragma unroll
        for (int r = 0; r < 4; ++r) { float v[8], u[8]; UNPK8(wq[r], v); UNPK8(wk[r], u); float ss = 0.f, su = 0.f;
#pragma unroll
            for (int e = 0; e < 8; ++e) { ss += v[e] * v[e]; su += u[e] * u[e]; }
            rs1[r] = ss; rs2[r] = su; }
#pragma unroll
        for (int r = 0; r < 4; ++r) { rs1[r] = rsqrtf(wsum_dpp(rs1[r]) * (1.f / QR) + RMS_EPS); rs2[r] = rsqrtf(wsum_dpp(rs2[r]) * (1.f / KVR) + RMS_EPS); }
        if (lane < 48) { const float4 g0 = *(const float4*)(C.g_cq + 8 * lane), g1 = *(const float4*)(C.g_cq + 8 * lane + 4);
#pragma unroll
            for (int r = 0; r < 4; ++r) { float v[8]; UNPK8(wq[r], v); const float q = rs1[r];
                u32x4_ o; o.x = cvtpk(v[0] * q * g0.x, v[1] * q * g0.y); o.y = cvtpk(v[2] * q * g0.z, v[3] * q * g0.w); o.z = cvtpk(v[4] * q * g1.x, v[5] * q * g1.y); o.w = cvtpk(v[6] * q * g1.z, v[7] * q * g1.w);
                *(u32x4_*)(cqn + (size_t)(t0 + r) * QR + 8 * lane) = o; } }
        if (lane < 32) { const float4 g0 = *(const float4*)(C.g_ckv + 8 * lane), g1 = *(const float4*)(C.g_ckv + 8 * lane + 4);
#pragma unroll
            for (int r = 0; r < 4; ++r) { float u[8]; UNPK8(wk[r], u); const float q = rs2[r];
                u32x4_ o; o.x = cvtpk(u[0] * q * g0.x, u[1] * q * g0.y); o.y = cvtpk(u[2] * q * g0.z, u[3] * q * g0.w); o.z = cvtpk(u[4] * q * g1.x, u[5] * q * g1.y); o.w = cvtpk(u[6] * q * g1.z, u[7] * q * g1.w);
                *(u32x4_*)(ckvn + (size_t)(t0 + r) * KVR + 8 * lane) = o; } }
        {   const int h = lane >> 3, i2 = (lane & 7) * 2;
#pragma unroll
            for (int r = 0; r < 4; ++r) { const int t = t0 + r; const bf16_t* zrow = zm + (size_t)t * 768 + QR + KVR;
                const unsigned pa = *(const unsigned*)(zrow + i2), pb = *(const unsigned*)(zrow + 16 + i2);
                const float x1a = __uint_as_float(pa << 16), x1b = __uint_as_float(pa & 0xffff0000u), x2a = __uint_as_float(pb << 16), x2b = __uint_as_float(pb & 0xffff0000u);
                const float4 cc = *(const float4*)(rope + (size_t)t * 16 + i2);
                u32x2 o; o.x = cvtpk(x1a * cc.x - x2a * cc.y, x2a * cc.x + x1a * cc.y); o.y = cvtpk(x1b * cc.z - x2b * cc.w, x2b * cc.z + x1b * cc.w);
                *(u32x2*)(kf + (((size_t)b * NH + h) * SEQ + (s0 + r)) * QK + NOPE + 2 * i2) = o; } }
        if (lane < 32) {
            const int c = 3 * RW / 8 + lane;
            const float4 m0 = *(const float4*)(C.mu + 8 * c), m1 = *(const float4*)(C.mu + 8 * c + 4);
            const float mm[8] = {m0.x, m0.y, m0.z, m0.w, m1.x, m1.y, m1.z, m1.w};
            float p[8]; UNPK8(wz[0], p);
#pragma unroll
            for (int r = 0; r < 4; ++r) {
                float z[8]; UNPK8(wz[r + 1], z);
                float zs[8];
#pragma unroll
                for (int e = 0; e < 8; ++e) { zs[e] = z[e] + (p[e] - z[e]) * mm[e]; p[e] = z[e]; }
                if (c < (3 * RW + DR) / 8) {
#pragma unroll
                    for (int e = 0; e < 8; ++e) { const float ex = __expf(2.f * zs[e]); zs[e] = 1.f - 2.f * __builtin_amdgcn_rcpf(ex + 1.f); } }
                else if (c >= (3 * RW + DR + AR) / 8) {
#pragma unroll
                    for (int e = 0; e < 8; ++e) zs[e] = fsigmoid(zs[e]); }
                u32x4_ o; o.x = cvtpk(zs[0], zs[1]); o.y = cvtpk(zs[2], zs[3]); o.z = cvtpk(zs[4], zs[5]); o.w = cvtpk(zs[6], zs[7]);
                *(u32x4_*)(lora + (size_t)(t0 + r) * 256 + 8 * lane) = o;
            }
        }
    }
#undef UNPK8
}

__device__ __forceinline__ void d_rwkv_post(const Ctx& C, int gw, int ngw, int lane) {
    typedef unsigned u32x4_ __attribute__((ext_vector_type(4)));
    const bf16_t* y = (const bf16_t*)(C.ws + WS_Y2); const float* bonus = (const float*)(C.ws + WS_BONUS);
    const bf16_t* rkv = (const bf16_t*)(C.ws + WS_RKV); const bf16_t* g = (const bf16_t*)(C.ws + WS_G);
    bf16_t* rwo = (bf16_t*)(C.ws + WS_RWO);
    const int c0 = 8 * lane, h = lane >> 3;
    const float4 lw0 = *(const float4*)(C.lnx_w + c0), lw1 = *(const float4*)(C.lnx_w + c0 + 4), lb0 = *(const float4*)(C.lnx_b + c0), lb1 = *(const float4*)(C.lnx_b + c0 + 4);
    const float lw[8] = {lw0.x, lw0.y, lw0.z, lw0.w, lw1.x, lw1.y, lw1.z, lw1.w}, lb[8] = {lb0.x, lb0.y, lb0.z, lb0.w, lb1.x, lb1.y, lb1.z, lb1.w};
    const float4 mv0 = *(const float4*)(C.mu + 2 * RW + c0), mv1 = *(const float4*)(C.mu + 2 * RW + c0 + 4);
    const float mv[8] = {mv0.x, mv0.y, mv0.z, mv0.w, mv1.x, mv1.y, mv1.z, mv1.w};
    for (int t0 = gw * 4; t0 < T; t0 += ngw * 4) {
        float4 ya[4], yb[4]; u32x4_ vv[4], gg[4]; float bn[4];
        u32x4_ vprev = (t0 % SEQ) ? *(const u32x4_*)(rkv + (size_t)(t0 - 1) * 1536 + 1024 + c0) : (u32x4_){0u, 0u, 0u, 0u};
#pragma unroll
        for (int r = 0; r < 4; ++r) { const size_t t = t0 + r;
            { const u32x4_ yw = *(const u32x4_*)(y + t * RW + c0);
              ya[r] = make_float4(__uint_as_float(yw[0] << 16), __uint_as_float(yw[0] & 0xffff0000u), __uint_as_float(yw[1] << 16), __uint_as_float(yw[1] & 0xffff0000u));
              yb[r] = make_float4(__uint_as_float(yw[2] << 16), __uint_as_float(yw[2] & 0xffff0000u), __uint_as_float(yw[3] << 16), __uint_as_float(yw[3] & 0xffff0000u)); }
            vv[r] = *(const u32x4_*)(rkv + t * 1536 + 1024 + c0); gg[r] = *(const u32x4_*)(g + t * RW + c0); bn[r] = bonus[t * NH + h]; }
#pragma unroll
        for (int r = 0; r < 4; ++r) {
            const float yv[8] = {ya[r].x, ya[r].y, ya[r].z, ya[r].w, yb[r].x, yb[r].y, yb[r].z, yb[r].w};
            float sm = 0.f;
#pragma unroll
            for (int e = 0; e < 8; ++e) sm += yv[e];
            const float mean = sum8_dpp(sm) * (1.f / 64.f);
            float sq = 0.f;
#pragma unroll
            for (int e = 0; e < 8; ++e) { const float d = yv[e] - mean; sq += d * d; }
            const float rstd = rsqrtf(sum8_dpp(sq) * (1.f / 64.f) + GN_EPS);
            float o[8];
#pragma unroll
            for (int e = 0; e < 4; ++e) {
                const unsigned pw = r == 0 ? vprev[e] : vv[r - 1][e];
                const float z0 = __uint_as_float(vv[r][e] << 16), z1 = __uint_as_float(vv[r][e] & 0xffff0000u), p0 = __uint_as_float(pw << 16), p1 = __uint_as_float(pw & 0xffff0000u);
                const unsigned sw = cvtpk(z0 + (p0 - z0) * mv[2 * e], z1 + (p1 - z1) * mv[2 * e + 1]);
                const float v0 = __uint_as_float(sw << 16), v1 = __uint_as_float(sw & 0xffff0000u), g0 = __uint_as_float(gg[r][e] << 16), g1 = __uint_as_float(gg[r][e] & 0xffff0000u);
                o[2 * e] = ((yv[2 * e] - mean) * rstd * lw[2 * e] + lb[2 * e] + bn[r] * v0) * g0;
                o[2 * e + 1] = ((yv[2 * e + 1] - mean) * rstd * lw[2 * e + 1] + lb[2 * e + 1] + bn[r] * v1) * g1; }
            u32x4_ w; w.x = cvtpk(o[0], o[1]); w.y = cvtpk(o[2], o[3]); w.z = cvtpk(o[4], o[5]); w.w = cvtpk(o[6], o[7]);
            *(u32x4_*)(rwo + (size_t)(t0 + r) * RW + c0) = w;
        }
    }
}

#define LAS __attribute__((address_space(3)))
typedef short bf16x8 __attribute__((ext_vector_type(8)));
typedef float f32x4 __attribute__((ext_vector_type(4)));
typedef int i32x4 __attribute__((ext_vector_type(4)));
typedef float f32x16 __attribute__((ext_vector_type(16)));
typedef unsigned u32x4 __attribute__((ext_vector_type(4)));

constexpr int NWAVES = 8, NTHR = NWAVES * 64;
constexpr int RING_BYTES = 131072;
constexpr int LDSCTL_OFF = RING_BYTES;
constexpr int LDS_BYTES = 163840;

namespace pg8 {
constexpr int BM = 256, BK = 64, HALF = 128, HTB = HALF * BK * 2, NXCD = 8, WGM = 8;
__host__ __device__ __forceinline__ int lds_byte(int r, int c) { const int st = (r >> 4) * 2 + (c >> 5), rr = r & 15, cc = c & 31, ob = rr * 64 + cc * 2; return st * 1024 + (ob ^ (((ob >> 9) & 1) << 5)); }
__host__ __device__ __forceinline__ void stage_rc(int b, int& R, int& C) { const int st = b / 1024, sb = b % 1024, swz = sb ^ (((sb >> 9) & 1) << 5); R = (st >> 1) * 16 + swz / 64; C = (st & 1) * 32 + (swz % 64) / 2; }
__host__ __device__ __forceinline__ int perm32(int rho) { const int n = rho >> 4, i = rho & 15; return 8 * (i >> 2) + 4 * n + (i & 3); }

struct Unit { int pm, pn, z; };

struct StaticOrder {
    int nM, nN, nwg, G, c, parts;
    __device__ void init(int M, int N, int G_, int c_, int parts_ = 1) { nM = M / BM; nN = N / BM; nwg = nM * nN; G = G_; c = c_; parts = parts_; }
    __device__ bool next(int i, Unit& u) const {
        const int it = i / parts; u.z = i - it * parts;
        const long L = (long)it * G + c; if (L >= nwg) return false;
        int wgid = (int)L; { const int q = nwg / NXCD, r = nwg % NXCD, xcd = wgid % NXCD, off = wgid / NXCD; wgid = (xcd < r ? xcd * (q + 1) : r * (q + 1) + (xcd - r) * q) + off; }
        const int nig = WGM * nN, gid = wgid / nig, fm = gid * WGM, gsz = (nM - fm) < WGM ? (nM - fm) : WGM;
        u.pm = fm + ((wgid % nig) % gsz); u.pn = (wgid % nig) / gsz; return true;
    }
};
struct Dense { static constexpr bool GATHER = false; const bf16_t* A; const bf16_t* Bt; int lda, ldb, K;
    __device__ __forceinline__ unsigned a_off(const Unit&, int R) const { return (unsigned)(R * lda) * 2u; }
    __device__ __forceinline__ const char* a_ptr(const Unit& u) const { return (const char*)(A + (size_t)u.pm * BM * lda); }
    __device__ __forceinline__ const char* b_ptr(const Unit& u) const { return (const char*)(Bt + (size_t)u.pn * BM * ldb); } };

template <class T, class = void> struct has_signal : std::false_type {};
template <class T> struct has_signal<T, std::void_t<decltype(T::SIGNAL)>> : std::true_type {};
template <class T, class = void> struct a_aux { static constexpr int value = 0; };
template <class T> struct a_aux<T, std::void_t<decltype(T::A_AUX)>> { static constexpr int value = T::A_AUX; };
template <bool ALIGN_EPI = true, bool I8 = false, class Epi, class Prob, class Sched>
__device__ __forceinline__ void gemm_phase(LAS unsigned char* lds, const Prob& P, const Sched& S, const Epi& E) {
    const int tid = threadIdx.x, wid = __builtin_amdgcn_readfirstlane(tid >> 6), lane = tid & 63, wr = wid >> 2, wc = wid & 3, fr = lane & 15, fq = lane >> 4;
    const int K = P.K, nt = K / BK;
    unsigned voffB[2]; int RA[2], CA[2];
#pragma unroll
    for (int i = 0; i < 2; ++i) { int R, C; stage_rc(tid * 16 + i * 8192, R, C); const int Rb = Epi::PERM ? ((R & ~31) + perm32(R & 31)) : R;
        RA[i] = R; CA[i] = C * 2; voffB[i] = (unsigned)(Rb * P.ldb + C) * 2u; }
    unsigned vAc[2][2], vAn[2][2];
#define PG8_FILLA(v, u) do { _Pragma("unroll") for (int h_ = 0; h_ < 2; ++h_) _Pragma("unroll") for (int i_ = 0; i_ < 2; ++i_) v[h_][i_] = P.a_off(u, RA[i_] + h_ * HALF) + (unsigned)CA[i_]; } while (0)
    const size_t kstep = (size_t)(BK * 2);
    const size_t hstepB = (size_t)HALF * P.ldb * 2;
    const unsigned ldsw = (unsigned)wid * 1024u;
    const int aoff = lds_byte(wr * 64 + fr, fq * 8), boff = lds_byte(wc * 32 + fr, fq * 8);
#define PG8_SA(b, h) (((b) * 2 + (h)) * HTB)
#define PG8_SB(b, h) ((4 + (b) * 2 + (h)) * HTB)
#define PG8_STAGE(bufoff, gbase, voff) do { _Pragma("unroll") for (int _i = 0; _i < 2; ++_i) \
        __builtin_amdgcn_global_load_lds((const unsigned*)((const char*)(gbase) + (voff)[_i]), (LAS unsigned*)(lds + (bufoff) + ldsw + _i * 8192), 16, 0, 0); } while (0)
#define PG8_STAGEA(bufoff, gbase, voff) do { _Pragma("unroll") for (int _i = 0; _i < 2; ++_i) \
        __builtin_amdgcn_global_load_lds((const unsigned*)((const char*)(gbase) + (voff)[_i]), (LAS unsigned*)(lds + (bufoff) + ldsw + _i * 8192), 16, 0, a_aux<Prob>::value); } while (0)
#define PG8_LDA(dst, b, h) do { _Pragma("unroll") for (int m = 0; m < 4; ++m) _Pragma("unroll") for (int k = 0; k < 2; ++k) dst[m][k] = *(const LAS bf16x8*)(lds + PG8_SA(b, h) + aoff + m * 2048 + k * 1024); } while (0)
#define PG8_LDB(dst, b, h) do { _Pragma("unroll") for (int n = 0; n < 2; ++n) _Pragma("unroll") for (int k = 0; k < 2; ++k) dst[n][k] = *(const LAS bf16x8*)(lds + PG8_SB(b, h) + boff + n * 2048 + k * 1024); } while (0)
#define PG8_MMA(ai, bj, At, Bt) do { __builtin_amdgcn_s_setprio(1); _Pragma("unroll") for (int m = 0; m < 4; ++m) _Pragma("unroll") for (int n = 0; n < 2; ++n) _Pragma("unroll") for (int k = 0; k < 2; ++k) \
        { if constexpr (I8) acc[ai][bj][m][n] = __builtin_bit_cast(f32x4, __builtin_amdgcn_mfma_i32_16x16x64_i8(__builtin_bit_cast(i32x4, Bt[n][k]), __builtin_bit_cast(i32x4, At[m][k]), __builtin_bit_cast(i32x4, acc[ai][bj][m][n]), 0, 0, 0)); \
          else acc[ai][bj][m][n] = __builtin_amdgcn_mfma_f32_16x16x32_bf16(Bt[n][k], At[m][k], acc[ai][bj][m][n], 0, 0, 0); } __builtin_amdgcn_s_setprio(0); } while (0)
#define PG8_WAIT_V(n) asm volatile("s_waitcnt vmcnt(" #n ")" ::: "memory")
#define PG8_WAIT_L(n) asm volatile("s_waitcnt lgkmcnt(" #n ")" ::: "memory")
#define PG8_BAR __builtin_amdgcn_s_barrier()
#define PG8_SCHED __builtin_amdgcn_sched_barrier(0)
    Unit cur, nxt; int ui = 0;
    if (!S.next(0, cur)) return;
    f32x4 acc[2][2][4][2];
#pragma unroll
    for (int a = 0; a < 2; ++a)
#pragma unroll
        for (int b = 0; b < 2; ++b)
#pragma unroll
            for (int m = 0; m < 4; ++m)
#pragma unroll
                for (int n = 0; n < 2; ++n) acc[a][b][m][n] = (f32x4){0.f, 0.f, 0.f, 0.f};
    bf16x8 At[4][2], B0[2][2], B1[2][2];
    const char* cA = P.a_ptr(cur); const char* cB = P.b_ptr(cur);
    PG8_FILLA(vAc, cur);
    PG8_STAGE(PG8_SB(0, 0), cB, voffB); PG8_STAGE(PG8_SB(0, 1), cB + hstepB, voffB); PG8_STAGEA(PG8_SA(0, 0), cA, vAc[0]); PG8_STAGEA(PG8_SA(0, 1), cA, vAc[1]);
    if (wr == 1) PG8_BAR;
    PG8_WAIT_V(2); PG8_BAR;
    PG8_STAGE(PG8_SB(1, 0), cB + kstep, voffB); PG8_STAGEA(PG8_SA(1, 0), cA + kstep, vAc[0]); PG8_STAGE(PG8_SB(1, 1), cB + hstepB + kstep, voffB);
    PG8_WAIT_V(6); PG8_BAR;
    for (;;) {
        const bool has_next = S.next(ui + 1, nxt);
        const char* nA = has_next ? P.a_ptr(nxt) : cA; const char* nB = has_next ? P.b_ptr(nxt) : cB;
        if (Prob::GATHER && has_next) { PG8_FILLA(vAn, nxt); }
        else {
#pragma unroll
            for (int h_ = 0; h_ < 2; ++h_)
#pragma unroll
                for (int i_ = 0; i_ < 2; ++i_) vAn[h_][i_] = vAc[h_][i_]; }
        for (int t = 0; t < nt; t += 2) {
            const bool last = (t == nt - 2);
            const char* a1 = cA + (size_t)(t + 1) * kstep;
            const char* a2 = last ? nA : cA + (size_t)(t + 2) * kstep; const char* b2 = last ? nB : cB + (size_t)(t + 2) * kstep;
            const char* a3 = a2 + kstep; const char* b3 = b2 + kstep;
            unsigned vA2[2][2];
#pragma unroll
            for (int h_ = 0; h_ < 2; ++h_)
#pragma unroll
                for (int i_ = 0; i_ < 2; ++i_) vA2[h_][i_] = (Prob::GATHER && last) ? vAn[h_][i_] : vAc[h_][i_];
            PG8_LDB(B0, 0, 0); PG8_LDB(B1, 0, 1); PG8_SCHED; PG8_LDA(At, 0, 0); PG8_STAGEA(PG8_SA(1, 1), a1, vAc[1]);
            PG8_WAIT_V(8); PG8_WAIT_L(0); PG8_BAR; PG8_MMA(0, 0, At, B0); PG8_MMA(0, 1, At, B1); PG8_BAR; PG8_SCHED;
            PG8_LDA(At, 0, 1); PG8_STAGE(PG8_SB(0, 0), b2, voffB); PG8_STAGE(PG8_SB(0, 1), b2 + hstepB, voffB); PG8_STAGEA(PG8_SA(0, 0), a2, vA2[0]);
            PG8_WAIT_V(8); PG8_WAIT_L(0); PG8_BAR; PG8_MMA(1, 0, At, B0); PG8_MMA(1, 1, At, B1); PG8_BAR; PG8_SCHED;
            PG8_LDB(B0, 1, 0); PG8_LDB(B1, 1, 1); PG8_SCHED; PG8_LDA(At, 1, 0); PG8_STAGEA(PG8_SA(0, 1), a2, vA2[1]);
            PG8_WAIT_V(8); PG8_WAIT_L(0); PG8_BAR; PG8_MMA(0, 0, At, B0); PG8_MMA(0, 1, At, B1); PG8_BAR; PG8_SCHED;
            PG8_LDA(At, 1, 1); PG8_STAGE(PG8_SB(1, 0), b3, voffB); PG8_STAGE(PG8_SB(1, 1), b3 + hstepB, voffB); PG8_STAGEA(PG8_SA(1, 0), a3, vA2[0]);
            PG8_WAIT_V(8); PG8_WAIT_L(0); PG8_BAR; PG8_MMA(1, 0, At, B0); PG8_MMA(1, 1, At, B1); PG8_BAR; PG8_SCHED;
        }
        if constexpr (ALIGN_EPI) { if (wr == 0) PG8_BAR; }
        if constexpr (I8) {
#pragma unroll
            for (int a = 0; a < 2; ++a)
#pragma unroll
                for (int b = 0; b < 2; ++b)
#pragma unroll
                    for (int m = 0; m < 4; ++m)
#pragma unroll
                        for (int n = 0; n < 2; ++n) acc[a][b][m][n] = __builtin_convertvector(__builtin_bit_cast(i32x4, acc[a][b][m][n]), f32x4); }
        E(acc, cur, wr, wc, fr, fq);
        if constexpr (has_signal<Epi>::value) { if (E.sig_now(cur)) { PG8_WAIT_V(0); PG8_BAR; if (tid == 0) E.signal(cur); } }
        if (!has_next) break;
        if (!E.keep(cur)) {
#pragma unroll
            for (int a = 0; a < 2; ++a)
#pragma unroll
                for (int b = 0; b < 2; ++b)
#pragma unroll
                    for (int m = 0; m < 4; ++m)
#pragma unroll
                        for (int n = 0; n < 2; ++n) acc[a][b][m][n] = (f32x4){0.f, 0.f, 0.f, 0.f};
        }
        cur = nxt; cA = nA; cB = nB; ++ui;
#pragma unroll
        for (int h_ = 0; h_ < 2; ++h_)
#pragma unroll
            for (int i_ = 0; i_ < 2; ++i_) vAc[h_][i_] = vAn[h_][i_];
        if constexpr (ALIGN_EPI) { if (wr == 1) PG8_BAR; }
    }
    PG8_WAIT_V(0);
    if constexpr (!ALIGN_EPI) { if (wr == 0) PG8_BAR; }
    PG8_BAR;
#undef PG8_FILLA
#undef PG8_SA
#undef PG8_SB
#undef PG8_STAGE
#undef PG8_STAGEA
#undef PG8_LDA
#undef PG8_LDB
#undef PG8_MMA
#undef PG8_WAIT_V
#undef PG8_WAIT_L
#undef PG8_BAR
#undef PG8_SCHED
}

struct EpiZ { static constexpr bool PERM = true; bf16_t *zm, *zrkv, *zl, *gates; const float* sa; const unsigned* sbmax;
    __device__ __forceinline__ bool keep(const Unit&) const { return false; }
    __device__ __forceinline__ void operator()(f32x4 (&acc)[2][2][4][2], const Unit& u, int wr, int wc, int fr, int fq) const {
        bf16_t* base; int ldc, colt; bool sig = false;
        if (u.pn < 3) { base = zm; ldc = 768; colt = u.pn * 256; } else if (u.pn < 9) { base = zrkv; ldc = 3 * RW; colt = (u.pn - 3) * 256; } else if (u.pn == 9) { base = zl; ldc = 256; colt = 0; } else { base = gates; ldc = 2048; colt = (u.pn - 10) * 256; sig = true; }
        const int row0 = u.pm * BM + wr * 64 + fr, col0 = colt + wc * 32 + 8 * fq;
        float sb[2][8];
#pragma unroll
        for (int bj = 0; bj < 2; ++bj) { const u32x4 q0 = *(const u32x4*)(sbmax + u.pn * BM + bj * HALF + wc * 32 + 8 * fq), q1 = *(const u32x4*)(sbmax + u.pn * BM + bj * HALF + wc * 32 + 8 * fq + 4);
#pragma unroll
            for (int e = 0; e < 4; ++e) { sb[bj][e] = __uint_as_float(q0[e]) * (1.f / 127.f); sb[bj][4 + e] = __uint_as_float(q1[e]) * (1.f / 127.f); } }
#pragma unroll
        for (int ai = 0; ai < 2; ++ai)
#pragma unroll
            for (int m = 0; m < 4; ++m) { bf16_t* rowp = base + (size_t)(row0 + ai * HALF + m * 16) * ldc + col0;
                const float sr_ = sa[row0 + ai * HALF + m * 16];
#pragma unroll
                for (int bj = 0; bj < 2; ++bj) { f32x4 v0 = acc[ai][bj][m][0], v1 = acc[ai][bj][m][1];
#pragma unroll
                    for (int e = 0; e < 4; ++e) { v0[e] *= sr_ * sb[bj][e]; v1[e] *= sr_ * sb[bj][4 + e]; }
                    if (sig) {
#pragma unroll
                        for (int e = 0; e < 4; ++e) { v0[e] = fsigmoid(v0[e]); v1[e] = fsigmoid(v1[e]); } }
                    u32x4 w; w.x = cvtpk(v0[0], v0[1]); w.y = cvtpk(v0[2], v0[3]); w.z = cvtpk(v1[0], v1[1]); w.w = cvtpk(v1[2], v1[3]);
                    *(u32x4*)(rowp + bj * HALF) = w; } }
    } };

struct EpiQ { static constexpr bool PERM = true; bf16_t* qf; const float2* rope;
    __device__ __forceinline__ bool keep(const Unit&) const { return false; }
    __device__ __forceinline__ void operator()(f32x4 (&acc)[2][2][4][2], const Unit& u, int wr, int wc, int fr, int fq) const {
#pragma unroll
        for (int bj = 0; bj < 2; ++bj) {
            const int c0 = u.pn * BM + bj * HALF + wc * 32 + 8 * fq, h = c0 / QK, d0 = c0 - h * QK;
#pragma unroll
            for (int ai = 0; ai < 2; ++ai)
#pragma unroll
                for (int m = 0; m < 4; ++m) {
                    const int t = u.pm * BM + ai * HALF + wr * 64 + m * 16 + fr, b = t / SEQ, s_ = t - b * SEQ;
                    f32x4 v0 = acc[ai][bj][m][0], v1 = acc[ai][bj][m][1];
                    if (d0 >= NOPE) { const int i0 = (d0 - NOPE) >> 1; const float2* cs = rope + (size_t)t * 16 + i0;
                        const float2 c0_ = cs[0], c1_ = cs[1], c2_ = cs[2], c3_ = cs[3];
                        const f32x4 w0 = {v0[0] * c0_.x - v0[1] * c0_.y, v0[1] * c0_.x + v0[0] * c0_.y, v0[2] * c1_.x - v0[3] * c1_.y, v0[3] * c1_.x + v0[2] * c1_.y};
                        const f32x4 w1 = {v1[0] * c2_.x - v1[1] * c2_.y, v1[1] * c2_.x + v1[0] * c2_.y, v1[2] * c3_.x - v1[3] * c3_.y, v1[3] * c3_.x + v1[2] * c3_.y};
                        v0 = w0; v1 = w1; }
                    v0 = v0 * QSCALE; v1 = v1 * QSCALE;
                    u32x4 w; w.x = cvtpk(v0[0], v0[1]); w.y = cvtpk(v0[2], v0[3]); w.z = cvtpk(v1[0], v1[1]); w.w = cvtpk(v1[2], v1[3]);
                    *(u32x4*)(qf + (((size_t)b * NH + h) * SEQ + s_) * QK + d0) = w; } }
    } };
struct EpiKVp { static constexpr bool PERM = true; bf16_t *kf, *vf;
    __device__ __forceinline__ bool keep(const Unit&) const { return false; }
    __device__ __forceinline__ void operator()(f32x4 (&acc)[2][2][4][2], const Unit& u, int wr, int wc, int fr, int fq) const {
#pragma unroll
        for (int bj = 0; bj < 2; ++bj) {
            const int c0 = u.pn * BM + bj * HALF + wc * 32 + 8 * fq, h = c0 >> 7, c = c0 & 127;
#pragma unroll
            for (int ai = 0; ai < 2; ++ai)
#pragma unroll
                for (int m = 0; m < 4; ++m) {
                    const int t = u.pm * BM + ai * HALF + wr * 64 + m * 16 + fr, b = t / SEQ, s_ = t - b * SEQ;
                    const f32x4 v0 = acc[ai][bj][m][0], v1 = acc[ai][bj][m][1];
                    u32x4 w; w.x = cvtpk(v0[0], v0[1]); w.y = cvtpk(v0[2], v0[3]); w.z = cvtpk(v1[0], v1[1]); w.w = cvtpk(v1[2], v1[3]);
                    const size_t rowi = ((size_t)b * NH + h) * SEQ + s_;
                    if (c < 64) *(u32x4*)(kf + rowi * QK + c) = w; else *(u32x4*)(vf + rowi * VD + (c - 64)) = w; } }
    } };
struct EpiLora { static constexpr bool PERM = true; bf16_t *eb; const float *dbias, *abias;
    __device__ __forceinline__ bool keep(const Unit&) const { return false; }
    __device__ __forceinline__ void operator()(f32x4 (&acc)[2][2][4][2], const Unit& u, int wr, int wc, int fr, int fq) const {
        const int kind = u.pn >> 1; bf16_t* base = eb + (size_t)kind * ((size_t)T * RW);
        const float* bp = kind == 0 ? dbias : abias;
#pragma unroll
        for (int bj = 0; bj < 2; ++bj) {
            const int c0 = (u.pn & 1) * BM + bj * HALF + wc * 32 + 8 * fq;
            float bs[8];
#pragma unroll
            for (int e = 0; e < 8; ++e) bs[e] = kind < 2 ? bp[c0 + e] : 0.f;
#pragma unroll
            for (int ai = 0; ai < 2; ++ai)
#pragma unroll
                for (int m = 0; m < 4; ++m) {
                    const int t = u.pm * BM + ai * HALF + wr * 64 + m * 16 + fr;
                    float v[8];
#pragma unroll
                    for (int e = 0; e < 4; ++e) { v[e] = acc[ai][bj][m][0][e] + bs[e]; v[4 + e] = acc[ai][bj][m][1][e] + bs[4 + e]; }
                    if (kind == 0) {
#pragma unroll
                        for (int e = 0; e < 8; ++e) v[e] = 0.60653065971263342f * fsigmoid(v[e]); }
                    else if (kind == 1) {
#pragma unroll
                        for (int e = 0; e < 8; ++e) v[e] = fsigmoid(v[e]); }
                    u32x4 w; w.x = cvtpk(v[0], v[1]); w.y = cvtpk(v[2], v[3]); w.z = cvtpk(v[4], v[5]); w.w = cvtpk(v[6], v[7]);
                    *(u32x4*)(base + (size_t)t * RW + c0) = w; } }
    } };
struct DenseSC { static constexpr bool GATHER = false; static constexpr int A_AUX = 16; const bf16_t* A; const bf16_t* Bt; int lda, ldb, K;
    __device__ __forceinline__ unsigned a_off(const Unit&, int R) const { return (unsigned)(R * lda) * 2u; }
    __device__ __forceinline__ const char* a_ptr(const Unit& u) const { return (const char*)(A + (size_t)u.pm * BM * lda); }
    __device__ __forceinline__ const char* b_ptr(const Unit& u) const { return (const char*)(Bt + (size_t)u.pn * BM * ldb); } };
struct StaticOrderW { StaticOrder so; unsigned* flag; unsigned need;
    __device__ bool next(int i, Unit& u) const { if (!so.next(i, u)) return false;
        unsigned* f = flag + u.pm;
        for (unsigned sp = 0; __hip_atomic_load(f, __ATOMIC_RELAXED, __HIP_MEMORY_SCOPE_AGENT) < need && sp < (1u << 20); ++sp) __builtin_amdgcn_s_sleep(2);
        asm volatile("" ::: "memory");
        return true; } };
struct MixProb { static constexpr bool GATHER = false; const bf16_t *A0, *A1, *B0, *B1; int lda, ldb, K;
    __device__ __forceinline__ unsigned a_off(const Unit&, int R) const { return (unsigned)(R * lda) * 2u; }
    __device__ __forceinline__ const char* a_ptr(const Unit& u) const { return (const char*)((u.z ? A1 : A0) + (size_t)u.pm * BM * lda); }
    __device__ __forceinline__ const char* b_ptr(const Unit& u) const { return (const char*)((u.z ? B1 : B0) + (size_t)u.pn * BM * ldb); } };
struct EpiMix { static constexpr bool PERM = true; static constexpr bool SIGNAL = true; const bf16_t* gates; bf16_t* mixed; unsigned* flag;
    __device__ __forceinline__ bool keep(const Unit& u) const { return u.z == 0; }
    __device__ __forceinline__ bool sig_now(const Unit& u) const { return u.z != 0; }
    __device__ __forceinline__ void signal(const Unit& u) const { __hip_atomic_fetch_add(flag + u.pm, 1u, __ATOMIC_RELAXED, __HIP_MEMORY_SCOPE_AGENT); }
    __device__ __forceinline__ void operator()(f32x4 (&acc)[2][2][4][2], const Unit& u, int wr, int wc, int fr, int fq) const {
#pragma unroll
        for (int bj = 0; bj < 2; ++bj) {
            const int c0 = u.pn * BM + bj * HALF + wc * 32 + 8 * fq;
#pragma unroll
            for (int ai = 0; ai < 2; ++ai)
#pragma unroll
                for (int m = 0; m < 4; ++m) {
                    const int t = u.pm * BM + ai * HALF + wr * 64 + m * 16 + fr;
                    const u32x4 gbw = *(const u32x4*)(gates + (size_t)t * 2048 + DM + c0);
                    float gbv[8];
#pragma unroll
                    for (int e = 0; e < 4; ++e) { gbv[2 * e] = fmaxf(__uint_as_float(gbw[e] << 16), 1e-30f); gbv[2 * e + 1] = fmaxf(__uint_as_float(gbw[e] & 0xffff0000u), 1e-30f); }
                    if (u.z == 0) {
                        const u32x4 gaw = *(const u32x4*)(gates + (size_t)t * 2048 + c0);
#pragma unroll
                        for (int e = 0; e < 4; ++e) { const float ga0 = __uint_as_float(gaw[e] << 16), ga1 = __uint_as_float(gaw[e] & 0xffff0000u);
                            const float r0 = ga0 * __builtin_amdgcn_rcpf(gbv[2 * e]), r1 = ga1 * __builtin_amdgcn_rcpf(gbv[2 * e + 1]);
                            if (e < 2) { acc[ai][bj][m][0][2 * e] *= r0; acc[ai][bj][m][0][2 * e + 1] *= r1; } else { acc[ai][bj][m][1][2 * e - 4] *= r0; acc[ai][bj][m][1][2 * e - 3] *= r1; } }
                    } else {
                        float v[8];
#pragma unroll
                        for (int e = 0; e < 4; ++e) { v[e] = acc[ai][bj][m][0][e] * gbv[e]; v[4 + e] = acc[ai][bj][m][1][e] * gbv[4 + e]; }
                        u32x4 w; w.x = cvtpk(v[0], v[1]); w.y = cvtpk(v[2], v[3]); w.z = cvtpk(v[4], v[5]); w.w = cvtpk(v[6], v[7]);
                        asm volatile("global_store_dwordx4 %0, %1, off sc1\n\ts_nop 1" :: "v"(mixed + (size_t)t * DM + c0), "v"(w) : "memory"); } } }
    } };
struct EpiOutF { static constexpr bool PERM = true; bf16_t* y;
    __device__ __forceinline__ bool keep(const Unit&) const { return false; }
    __device__ __forceinline__ void operator()(f32x4 (&acc)[2][2][4][2], const Unit& u, int wr, int wc, int fr, int fq) const {
#pragma unroll
        for (int bj = 0; bj < 2; ++bj) {
            const int c0 = u.pn * BM + bj * HALF + wc * 32 + 8 * fq;
#pragma unroll
            for (int ai = 0; ai < 2; ++ai)
#pragma unroll
                for (int m = 0; m < 4; ++m) {
                    const int t = u.pm * BM + ai * HALF + wr * 64 + m * 16 + fr;
                    const f32x4 v0 = acc[ai][bj][m][0], v1 = acc[ai][bj][m][1];
                    u32x4 w; w.x = cvtpk(v0[0], v0[1]); w.y = cvtpk(v0[2], v0[3]); w.z = cvtpk(v1[0], v1[1]); w.w = cvtpk(v1[2], v1[3]);
                    *(u32x4*)(y + (size_t)t * DM + c0) = w; } }
    } };

constexpr int MOE_MAXU = 8;
struct MoeTab { const LAS int* desc; const LAS int* rowtab; };
struct MoeSched { MoeTab tb;
    __device__ __forceinline__ bool next(int i, Unit& u) const { if (i >= MOE_MAXU || tb.desc[i * 8 + 5] == 0) return false; u.pm = i; u.pn = tb.desc[i * 8 + 2]; u.z = tb.desc[i * 8 + 0]; return true; } };
struct MoeSched2 { MoeTab tb; unsigned* flag;
    __device__ __forceinline__ bool next(int i, Unit& u) const { if (i >= MOE_MAXU || tb.desc[i * 8 + 5] == 0) return false; u.pm = i; u.pn = tb.desc[i * 8 + 2]; u.z = tb.desc[i * 8 + 0];
        unsigned* f = flag + (tb.desc[i * 8 + 4] >> 8);
        for (unsigned sp = 0; __hip_atomic_load(f, __ATOMIC_RELAXED, __HIP_MEMORY_SCOPE_AGENT) < 2u && sp < (1u << 20); ++sp) __builtin_amdgcn_s_sleep(2);
        asm volatile("" ::: "memory");
        return true; } };
struct MoeProb1 { static constexpr bool GATHER = true; const bf16_t* h2; const bf16_t* wgu; MoeTab tb; int lda, ldb, K;
    __device__ __forceinline__ unsigned a_off(const Unit& u, int R) const { return (unsigned)((tb.rowtab[u.pm * 256 + R] >> 1) * lda) * 2u; }
    __device__ __forceinline__ const char* a_ptr(const Unit&) const { return (const char*)h2; }
    __device__ __forceinline__ const char* b_ptr(const Unit& u) const { return (const char*)(wgu + ((size_t)u.z * 512 + u.pn * BM) * ldb); } };
struct MoeProb2 { static constexpr bool GATHER = false; static constexpr int A_AUX = 16  ; const bf16_t* act; const bf16_t* wdn; MoeTab tb; int lda, ldb, K;
    __device__ __forceinline__ unsigned a_off(const Unit&, int R) const { return (unsigned)(R * lda) * 2u; }
    __device__ __forceinline__ const char* a_ptr(const Unit& u) const { return (const char*)(act + (size_t)tb.desc[u.pm * 8 + 4] * lda); }
    __device__ __forceinline__ const char* b_ptr(const Unit& u) const { return (const char*)(wdn + ((size_t)u.z * 1024 + u.pn * BM) * ldb); } };
struct EpiMoe1 { static constexpr bool PERM = true; static constexpr bool SIGNAL = true; bf16_t* act; const float* tokw; MoeTab tb; unsigned* flag;
    __device__ __forceinline__ bool keep(const Unit&) const { return false; }
    __device__ __forceinline__ bool sig_now(const Unit&) const { return true; }
    __device__ __forceinline__ void signal(const Unit& u) const {
        __hip_atomic_fetch_add(flag + (tb.desc[u.pm * 8 + 4] >> 8), 1u, __ATOMIC_RELAXED, __HIP_MEMORY_SCOPE_AGENT); }
    __device__ __forceinline__ void operator()(f32x4 (&acc)[2][2][4][2], const Unit& u, int wr, int wc, int fr, int fq) const {
        const int nvalid = tb.desc[u.pm * 8 + 3], arow0 = tb.desc[u.pm * 8 + 4];
        const int f0 = u.pn * HALF + wc * 32 + 8 * fq;
#pragma unroll
        for (int ai = 0; ai < 2; ++ai)
#pragma unroll
            for (int m = 0; m < 4; ++m) {
                const int r = ai * HALF + wr * 64 + m * 16 + fr;
                if (r < nvalid) {
                    const float w = tokw[tb.rowtab[u.pm * 256 + r]];
                    float v[8];
#pragma unroll
                    for (int e = 0; e < 4; ++e) { const float g0 = acc[ai][0][m][0][e], g1 = acc[ai][0][m][1][e];
                        v[e] = g0 * fsigmoid(g0) * acc[ai][1][m][0][e] * w; v[4 + e] = g1 * fsigmoid(g1) * acc[ai][1][m][1][e] * w; }
                    u32x4 o; o.x = cvtpk(v[0], v[1]); o.y = cvtpk(v[2], v[3]); o.z = cvtpk(v[4], v[5]); o.w = cvtpk(v[6], v[7]);
                    asm volatile("global_store_dwordx4 %0, %1, off sc1\n\ts_nop 1" :: "v"(act + (size_t)(arow0 + r) * FF + f0), "v"(o) : "memory"); } }
    } };
struct EpiMoe2 { static constexpr bool PERM = true; bf16_t* ys; MoeTab tb;
    __device__ __forceinline__ bool keep(const Unit&) const { return false; }
    __device__ __forceinline__ void operator()(f32x4 (&acc)[2][2][4][2], const Unit& u, int wr, int wc, int fr, int fq) const {
        const int nvalid = tb.desc[u.pm * 8 + 3];
#pragma unroll
        for (int ai = 0; ai < 2; ++ai)
#pragma unroll
            for (int m = 0; m < 4; ++m) {
                const int r = ai * HALF + wr * 64 + m * 16 + fr;
                if (r < nvalid) {
                    bf16_t* rowp = ys + (size_t)tb.rowtab[u.pm * 256 + r] * DM + u.pn * BM + wc * 32 + 8 * fq;
#pragma unroll
                    for (int bj = 0; bj < 2; ++bj) { const f32x4 v0 = acc[ai][bj][m][0], v1 = acc[ai][bj][m][1];
                        u32x4 o; o.x = cvtpk(v0[0], v0[1]); o.y = cvtpk(v0[2], v0[3]); o.z = cvtpk(v1[0], v1[1]); o.w = cvtpk(v1[2], v1[3]);
                        *(u32x4*)(rowp + bj * HALF) = o; } } }
    } };
}


namespace rsg {
#define RS_LD1(dst_, p_) asm volatile("global_load_dwordx4 %0, %1, off" : "=v"(dst_) : "v"(p_) : "memory")
template <int N> struct WaitVm;
#define RS_DEFWAIT(N_) template <> struct WaitVm<N_> { template <int P> static __device__ __forceinline__ void w(u32x4 (&r)[P]) { \
    if constexpr (P == 1) asm volatile("s_waitcnt vmcnt(" #N_ ")" : "+v"(r[0]) :: "memory"); \
    else if constexpr (P == 2) asm volatile("s_waitcnt vmcnt(" #N_ ")" : "+v"(r[0]), "+v"(r[1]) :: "memory"); \
    else if constexpr (P == 4) asm volatile("s_waitcnt vmcnt(" #N_ ")" : "+v"(r[0]), "+v"(r[1]), "+v"(r[2]), "+v"(r[3]) :: "memory"); \
    else asm volatile("s_waitcnt vmcnt(" #N_ ")" : "+v"(r[0]), "+v"(r[1]), "+v"(r[2]), "+v"(r[3]), "+v"(r[4]), "+v"(r[5]) :: "memory"); } };
RS_DEFWAIT(0) RS_DEFWAIT(1) RS_DEFWAIT(2) RS_DEFWAIT(3) RS_DEFWAIT(4) RS_DEFWAIT(5) RS_DEFWAIT(6) RS_DEFWAIT(7) RS_DEFWAIT(8) RS_DEFWAIT(9) RS_DEFWAIT(10) RS_DEFWAIT(11) RS_DEFWAIT(12)
RS_DEFWAIT(13) RS_DEFWAIT(14) RS_DEFWAIT(15) RS_DEFWAIT(16)
template <int KT, class Prob, class Epi>
__device__ __forceinline__ void rs_gemm_phase(LAS unsigned char* lds, const Prob& P, const Epi& E, int tid, int lane, int wave) {
    constexpr int K = KT * 16, ROWB = 2 * K + 16, SLAB = 64 * ROWB, CPR = K / 8, NPC = 64 * CPR, PPT = NPC / NTHR, NST = Epi::NST;
    constexpr int TROW = 144, TBUF = 32 * TROW;
    static_assert(NPC % NTHR == 0 && 2 * SLAB + 8 * TBUF <= LDS_BYTES - 64, "slab ring");
    LAS unsigned char* tbuf = lds + 2 * SLAB + wave * TBUF;
    const int r32 = lane & 31, hi = lane >> 5;
    int goff[PPT], loff[PPT];
    const int ldb = P.ldb;
#pragma unroll
    for (int q = 0; q < PPT; ++q) { const int p = tid + NTHR * q; goff[q] = (p / CPR) * ldb + 8 * (p % CPR); loff[q] = (p / CPR) * ROWB + (p % CPR) * 16; }
    for (int ui = 0; P.valid(ui); ++ui) {
        const int NT = P.ntiles(ui);
        const bf16_t* bt = P.b_ptr(ui);
        typename Epi::St st = E.prep(ui, wave, lane);
        u32x4 afr[KT];
        {   const bf16_t* rowp = P.a_row(ui, 32 * wave + r32) + 8 * hi;
#pragma unroll
            for (int s_ = 0; s_ < KT; ++s_) RS_LD1(afr[s_], rowp + 16 * s_); }
        u32x4 sr0[PPT], sr1[PPT];
#define RS_LOAD(S_, j_) do { const int jj_ = (j_) < NT ? (j_) : NT - 1; const bf16_t* bp_ = bt + (size_t)jj_ * 64 * ldb; \
        _Pragma("unroll") for (int q = 0; q < PPT; ++q) RS_LD1(S_[q], bp_ + goff[q]); } while (0)
#define RS_WRITE(S_, j_) do { LAS unsigned char* sb_ = lds + ((j_) & 1) * SLAB; _Pragma("unroll") for (int q = 0; q < PPT; ++q) *(LAS u32x4*)(sb_ + loff[q]) = S_[q]; } while (0)
#define RS_BODY(j_, S_, WN_) do { \
        WaitVm<WN_>::w(S_); \
        asm volatile("s_waitcnt lgkmcnt(0)" ::: "memory"); __builtin_amdgcn_s_barrier(); asm volatile("" ::: "memory"); \
        RS_WRITE(S_, (j_) + 1); RS_LOAD(S_, (j_) + 3); \
        f32x16 acc0, acc1; \
        _Pragma("unroll") for (int q = 0; q < 16; ++q) { acc0[q] = 0.f; acc1[q] = 0.f; } \
        const LAS unsigned char* sp_ = lds + ((j_) & 1) * SLAB + r32 * ROWB + hi * 16; \
        _Pragma("unroll") for (int s_ = 0; s_ < KT; ++s_) { \
            acc0 = __builtin_amdgcn_mfma_f32_32x32x16_bf16(*(const LAS bf16x8*)(sp_ + s_ * 32), __builtin_bit_cast(bf16x8, afr[s_]), acc0, 0, 0, 0); \
            acc1 = __builtin_amdgcn_mfma_f32_32x32x16_bf16(*(const LAS bf16x8*)(sp_ + 32 * ROWB + s_ * 32), __builtin_bit_cast(bf16x8, afr[s_]), acc1, 0, 0, 0); } \
        E.xf(st, acc0, (j_), 0, r32, hi); E.xf(st, acc1, (j_), 1, r32, hi); \
        { LAS unsigned char* tw_ = tbuf + r32 * TROW + hi * 8; \
          _Pragma("unroll") for (int g = 0; g < 4; ++g) { \
              u32x2 w0_, w1_; w0_.x = cvtpk(acc0[4 * g], acc0[4 * g + 1]); w0_.y = cvtpk(acc0[4 * g + 2], acc0[4 * g + 3]); w1_.x = cvtpk(acc1[4 * g], acc1[4 * g + 1]); w1_.y = cvtpk(acc1[4 * g + 2], acc1[4 * g + 3]); \
              *(LAS u32x2*)(tw_ + 16 * g) = w0_; *(LAS u32x2*)(tw_ + 64 + 16 * g) = w1_; } \
          u32x4 o_[4]; \
          _Pragma("unroll") for (int i = 0; i < 4; ++i) o_[i] = *(const LAS u32x4*)(tbuf + (8 * i + (lane >> 3)) * TROW + (lane & 7) * 16); \
          E.store(st, (j_), o_, lane); } } while (0)
        RS_LOAD(sr0, 0); RS_LOAD(sr1, 1);
        WaitVm<PPT>::w(sr0); RS_WRITE(sr0, 0); RS_LOAD(sr0, 2);
        RS_BODY(0, sr1, PPT);
        RS_BODY(1, sr0, PPT + NST);
        for (int j = 2; j < NT; j += 2) { RS_BODY(j, sr1, PPT + 2 * NST); RS_BODY(j + 1, sr0, PPT + 2 * NST); }
        WaitVm<0>::w(sr0); WaitVm<0>::w(sr1);
        asm volatile("s_waitcnt lgkmcnt(0)" ::: "memory"); __builtin_amdgcn_s_barrier(); asm volatile("" ::: "memory");
#undef RS_LOAD
#undef RS_WRITE
#undef RS_BODY
    }
}
struct DenseRS { const bf16_t* A; const bf16_t* Bt; int lda, ldb, ncols, G, bx;
    __device__ __forceinline__ bool valid(int ui) const { return bx + ui * G < 2 * (T / 256); }
    __device__ __forceinline__ int ntiles(int) const { return ncols / 64; }
    __device__ __forceinline__ const bf16_t* a_row(int ui, int row) const { return A + ((size_t)((bx + ui * G) >> 1) * 256 + row) * lda; }
    __device__ __forceinline__ const bf16_t* b_ptr(int ui) const { return Bt + (size_t)((bx + ui * G) & 1) * ncols * ldb; } };
struct EpiKVrs { bf16_t *kf, *vf; int G, bx;
    static constexpr int NST = 4;
    struct St { int half; size_t rowi[4]; };
    __device__ __forceinline__ St prep(int ui, int wave, int lane) const { St s_; const int L = bx + ui * G; s_.half = L & 1;
#pragma unroll
        for (int i = 0; i < 4; ++i) { const int t = (L >> 1) * 256 + 32 * wave + 8 * i + (lane >> 3), b = t / SEQ; s_.rowi[i] = (size_t)b * NH * SEQ + (t - b * SEQ); }
        return s_; }
    __device__ __forceinline__ void xf(const St&, f32x16&, int, int, int, int) const {}
    __device__ __forceinline__ void store(const St& s_, int j, const u32x4 (&o)[4], int lane) const {
        const int c = s_.half * 512 + 64 * j + 8 * (lane & 7), h = c >> 7, cc = c & 127;
#pragma unroll
        for (int i = 0; i < 4; ++i) { const size_t rowi = s_.rowi[i] + (size_t)h * SEQ;
            bf16_t* dp = cc < 64 ? kf + rowi * QK + cc : vf + rowi * VD + (cc - 64);
            *(u32x4*)dp = o[i]; }
    } };
template <int KIND>
struct EpiLoraRS { bf16_t* base; const float* bias; int G, bx;
    static constexpr int NST = 4;
    struct St { int half; bf16_t* dp[4]; };
    __device__ __forceinline__ St prep(int ui, int wave, int lane) const { St s_; const int L = bx + ui * G; s_.half = L & 1;
#pragma unroll
        for (int i = 0; i < 4; ++i) { const int t = (L >> 1) * 256 + 32 * wave + 8 * i + (lane >> 3); s_.dp[i] = base + (size_t)t * RW + s_.half * 256 + 8 * (lane & 7); }
        return s_; }
    __device__ __forceinline__ void xf(const St& s_, f32x16& acc, int j, int tile, int, int hi) const {
        if constexpr (KIND < 2) {
#pragma unroll
            for (int g = 0; g < 4; ++g) { const float4 bs = *(const float4*)(bias + s_.half * 256 + 64 * j + 32 * tile + 8 * g + 4 * hi);
                const float bv[4] = {bs.x, bs.y, bs.z, bs.w};
#pragma unroll
                for (int e = 0; e < 4; ++e) { const float v = fsigmoid(acc[4 * g + e] + bv[e]); acc[4 * g + e] = KIND == 0 ? 0.60653065971263342f * v : v; } }
        }
    }
    __device__ __forceinline__ void store(const St& s_, int j, const u32x4 (&o)[4], int) const {
#pragma unroll
        for (int i = 0; i < 4; ++i) *(u32x4*)(s_.dp[i] + 64 * j) = o[i];
    } };
}

struct TrItem { const float* W; bf16_t* WT; int ldw, ksrc0, ldt, kdst0, ndst0, kind, off, pad; };
__device__ __forceinline__ int tr_map(int kind, int off, int r) {
    if (kind == 0) return r - off;
    if (kind == 1) return r < MLA_IN ? r : (r < 768 ? -1 : r - 96);
    if (kind == 2) { const int h = r / QK, d = r % QK; if (d < NOPE) return r; const int i = (d - NOPE) >> 1, odd = (d - NOPE) & 1; return h * QK + NOPE + i + 16 * odd; }
    return ((r >> 8) << 7) + (r & 127);
}
__device__ __forceinline__ void tr_load(const TrItem& d, float (&v)[32], int lane) {
    const int n = lane & 31; const int sc = d.W ? tr_map(d.kind, d.off, d.ndst0 + n) : -1;
    const float* p = d.W + (size_t)(d.ksrc0 + (lane >> 5)) * d.ldw + (sc >= 0 ? sc : 0);
#pragma unroll
    for (int i = 0; i < 32; ++i) v[i] = (sc >= 0) ? p[(size_t)(2 * i) * d.ldw] : 0.f;
}
__device__ __forceinline__ void tr_absmax(const TrItem& d, const float (&v)[32], unsigned* sbmax, int lane) {
    float m = 0.f;
#pragma unroll
    for (int i = 0; i < 32; ++i) m = fmaxf(m, fabsf(v[i]));
    auto rr = __builtin_amdgcn_permlane32_swap(__float_as_uint(m), __float_as_uint(m), false, false);
    m = fmaxf(__uint_as_float(rr[0]), __uint_as_float(rr[1]));
    if (lane < 32) atomicMax(sbmax + d.ndst0 + lane, __float_as_uint(m));
}
__device__ __forceinline__ void tr_store_q8(const TrItem& d, const float (&v)[32], const unsigned* sbmax, LAS float* scr, int lane) {
    const int n = lane & 31;
#pragma unroll
    for (int i = 0; i < 32; ++i) scr[(2 * i + (lane >> 5)) * 33 + n] = v[i];
    asm volatile("s_waitcnt lgkmcnt(0)" ::: "memory");
    const int c = lane & 3;
#pragma unroll
    for (int j = 0; j < 2; ++j) { const int nn = (lane >> 2) + 16 * j; const LAS float* s_ = scr + (16 * c) * 33 + nn;
        const float am = __uint_as_float(sbmax[d.ndst0 + nn]), inv = am > 0.f ? 127.f / am : 0.f;
        u32x4 o;
        o.x = q8pack(s_[0 * 33] * inv, s_[1 * 33] * inv, s_[2 * 33] * inv, s_[3 * 33] * inv); o.y = q8pack(s_[4 * 33] * inv, s_[5 * 33] * inv, s_[6 * 33] * inv, s_[7 * 33] * inv);
        o.z = q8pack(s_[8 * 33] * inv, s_[9 * 33] * inv, s_[10 * 33] * inv, s_[11 * 33] * inv); o.w = q8pack(s_[12 * 33] * inv, s_[13 * 33] * inv, s_[14 * 33] * inv, s_[15 * 33] * inv);
        *(u32x4*)((unsigned char*)d.WT + (size_t)(d.ndst0 + nn) * 1024 + d.kdst0 + 16 * c) = o; }
    asm volatile("s_waitcnt lgkmcnt(0)" ::: "memory");
}
__device__ __forceinline__ void tr_store(const TrItem& d, const float (&v)[32], LAS float* scr, int lane) {
    const int n = lane & 31;
#pragma unroll
    for (int i = 0; i < 32; ++i) scr[(2 * i + (lane >> 5)) * 33 + n] = v[i];
    asm volatile("s_waitcnt lgkmcnt(0)" ::: "memory");
    const int c = lane & 7;
#pragma unroll
    for (int j = 0; j < 4; ++j) { const int nn = (lane >> 3) + 8 * j; const LAS float* s_ = scr + (8 * c) * 33 + nn;
        u32x4 o; o.x = cvtpk(s_[0 * 33], s_[1 * 33]); o.y = cvtpk(s_[2 * 33], s_[3 * 33]); o.z = cvtpk(s_[4 * 33], s_[5 * 33]); o.w = cvtpk(s_[6 * 33], s_[7 * 33]);
        *(u32x4*)(d.WT + (size_t)(d.ndst0 + nn) * d.ldt + d.kdst0 + 8 * c) = o; }
    asm volatile("s_waitcnt lgkmcnt(0)" ::: "memory");
}

constexpr size_t WO_IN = 0;
constexpr size_t WO_UQ = WO_IN + (size_t)4608 * 1024 * 2;
constexpr size_t WO_UKV = WO_UQ + (size_t)768 * 384 * 2;
constexpr size_t WO_LORA = WO_UKV + (size_t)1024 * 256 * 2;
constexpr size_t WO_OM = WO_LORA + (size_t)1536 * 256 * 2;
constexpr size_t WO_OR = WO_OM + (size_t)1024 * 512 * 2;
constexpr size_t WO_OUT = WO_OR + (size_t)1024 * 512 * 2;
constexpr size_t WO_GU = WO_OUT + (size_t)1024 * 1024 * 2;
constexpr size_t WO_DN = WO_GU + (size_t)32 * 512 * 1024 * 2;
constexpr size_t WO_END = WO_DN + (size_t)32 * 1024 * 256 * 2;
constexpr size_t WO_RH = WO_END;
constexpr size_t WO_RL = WO_RH + (size_t)48 * 1024 * 2;
static_assert(WO_RL + (size_t)48 * 1024 * 2 <= 64 * MiB, "weights region");
constexpr int TR_I_IN = 16 * 144, TR_I_UQ = 6 * 24, TR_I_UKV = 4 * 32, TR_I_LORA = 4 * 48, TR_I_OM = 8 * 32, TR_I_OR = 8 * 32, TR_I_OUT = 16 * 32, TR_I_GU = 32 * 16 * 16, TR_I_DN = 32 * 4 * 32;
constexpr int TR_NITEMS = TR_I_IN + TR_I_UQ + TR_I_UKV + TR_I_LORA + TR_I_OM + TR_I_OR + TR_I_OUT + TR_I_GU + TR_I_DN;
__device__ __forceinline__ TrItem tr_desc(const Ctx& C, int it) {
    bf16_t* wb = (bf16_t*)(C.ws + WS_W);
    TrItem d; d.kind = 0; d.off = 0; d.pad = 0;
    int r = it;
    if (r < TR_I_IN) { const int kb = r / 144, nb = r % 144; d.W = C.w_in; d.ldw = IN_W; d.ksrc0 = 64 * kb; d.WT = wb + WO_IN / 2; d.ldt = 1024; d.kdst0 = 64 * kb; d.ndst0 = 32 * nb; d.kind = 1; return d; } r -= TR_I_IN;
    if (r < TR_I_UQ) { const int kb = r / 24, nb = r % 24; d.W = C.w_uq; d.ldw = 768; d.ksrc0 = 64 * kb; d.WT = wb + WO_UQ / 2; d.ldt = QR; d.kdst0 = 64 * kb; d.ndst0 = 32 * nb; d.kind = 2; return d; } r -= TR_I_UQ;
    if (r < TR_I_UKV) { const int kb = r / 32, nb = r % 32; d.W = C.w_ukv; d.ldw = 1024; d.ksrc0 = 64 * kb; d.WT = wb + WO_UKV / 2; d.ldt = KVR; d.kdst0 = 64 * kb; d.ndst0 = 32 * nb; return d; } r -= TR_I_UKV;
    if (r < TR_I_LORA) { const int kb = r / 48, nb = r % 48;
        d.W = nullptr; d.ksrc0 = 0; d.ldw = RW;
        if (nb < 16) { if (kb == 0) d.W = C.w_dec; d.off = 0; }
        else if (nb < 32) { if (kb == 1) d.W = C.w_a; d.off = 512; }
        else { if (kb >= 2) { d.W = C.w_g; d.ksrc0 = 64 * (kb - 2); } d.off = 1024; }
        d.WT = wb + WO_LORA / 2; d.ldt = 256; d.kdst0 = 64 * kb; d.ndst0 = 32 * nb; return d; } r -= TR_I_LORA;
    if (r < TR_I_OM) { const int kb = r / 32, nb = r % 32; d.W = C.w_o_mla; d.ldw = DM; d.ksrc0 = 64 * kb; d.WT = wb + WO_OM / 2; d.ldt = RW; d.kdst0 = 64 * kb; d.ndst0 = 32 * nb; return d; } r -= TR_I_OM;
    if (r < TR_I_OR) { const int kb = r / 32, nb = r % 32; d.W = C.w_o_rwkv; d.ldw = DM; d.ksrc0 = 64 * kb; d.WT = wb + WO_OR / 2; d.ldt = RW; d.kdst0 = 64 * kb; d.ndst0 = 32 * nb; return d; } r -= TR_I_OR;
    if (r < TR_I_OUT) { const int kb = r / 32, nb = r % 32; d.W = C.w_out; d.ldw = DM; d.ksrc0 = 64 * kb; d.WT = wb + WO_OUT / 2; d.ldt = DM; d.kdst0 = 64 * kb; d.ndst0 = 32 * nb; return d; } r -= TR_I_OUT;
    if (r < TR_I_GU) { const int e = r / 256, q = r % 256, kb = q / 16, nb = q % 16;
        d.W = (((32 * nb) & 128) ? C.w_eu : C.w_eg) + (size_t)e * DM * FF; d.ldw = FF; d.ksrc0 = 64 * kb; d.WT = wb + WO_GU / 2 + (size_t)e * 512 * 1024; d.ldt = 1024; d.kdst0 = 64 * kb; d.ndst0 = 32 * nb; d.kind = 3; return d; } r -= TR_I_GU;
    { const int e = r / 128, q = r % 128, kb = q / 32, nb = q % 32;
      d.W = C.w_ed + (size_t)e * FF * DM; d.ldw = DM; d.ksrc0 = 64 * kb; d.WT = wb + WO_DN / 2 + (size_t)e * 1024 * 256; d.ldt = 256; d.kdst0 = 64 * kb; d.ndst0 = 32 * nb; return d; }
}


namespace att {
constexpr int KROW = 208, KBUF = 64 * KROW, VBUF = 8192, BUF = KBUF + VBUF;
typedef short v4i16_t __attribute__((ext_vector_type(4)));
__device__ __forceinline__ v4i16_t vtr(const LAS unsigned char* p) { return __builtin_amdgcn_ds_read_tr16_b64_v4i16((LAS v4i16_t*)p); }
__device__ __forceinline__ float hmax(float x) { auto rr = __builtin_amdgcn_permlane32_swap(__float_as_uint(x), __float_as_uint(x), false, false); return fmaxf(__uint_as_float(rr[0]), __uint_as_float(rr[1])); }
__device__ __forceinline__ float hsum(float x) { auto rr = __builtin_amdgcn_permlane32_swap(__float_as_uint(x), __float_as_uint(x), false, false); return __uint_as_float(rr[0]) + __uint_as_float(rr[1]); }

__device__ __forceinline__ void attn_unit(const Ctx& C, LAS unsigned char* lds, int bh, int qb, int tid, int lane, int wave) {
    const int r32 = lane & 31, hi = lane >> 5;
    const bf16_t* qf = (const bf16_t*)(C.ws + WS_QF) + ((size_t)bh * SEQ + qb * 256 + wave * 32 + r32) * QK;
    const unsigned char* kbase = (const unsigned char*)((const bf16_t*)(C.ws + WS_KF) + (size_t)bh * SEQ * QK);
    const unsigned char* vbase = (const unsigned char*)((const bf16_t*)(C.ws + WS_VF) + (size_t)bh * SEQ * VD);
    bf16x8 qr[6];
#pragma unroll
    for (int s = 0; s < 6; ++s) qr[s] = *(const bf16x8*)(qf + 16 * s + 8 * hi);
    const int kc1 = 512 + tid;
    const int koff0 = (tid / 12) * KROW + (tid % 12) * 16, koff1 = (kc1 / 12) * KROW + (kc1 % 12) * 16;
    const int vkey = tid >> 3, vj = tid & 7;
    const int voff = KBUF + (vj >> 2) * 4096 + (vkey >> 4) * 1024 + (vkey & 15) * 64 + (vj & 3) * 16;
    const int NT = 4 * qb + 4, cw = 4 * qb + (wave >> 1);
    const bool has_k1 = tid < 256;
    u32x4 k0r, k1r = {0u, 0u, 0u, 0u}, v0r;
    k0r = *(const u32x4*)(kbase + (size_t)tid * 16); if (has_k1) k1r = *(const u32x4*)(kbase + (size_t)kc1 * 16); v0r = *(const u32x4*)(vbase + (size_t)tid * 16);
    *(LAS u32x4*)(lds + koff0) = k0r; if (has_k1) *(LAS u32x4*)(lds + koff1) = k1r; *(LAS u32x4*)(lds + voff) = v0r;
    if (NT > 1) { k0r = *(const u32x4*)(kbase + 12288 + (size_t)tid * 16); if (has_k1) k1r = *(const u32x4*)(kbase + 12288 + (size_t)kc1 * 16); v0r = *(const u32x4*)(vbase + 8192 + (size_t)tid * 16); }
    __syncthreads();
    f32x16 o0, o1, negm;
#pragma unroll
    for (int r = 0; r < 16; ++r) { o0[r] = 0.f; o1[r] = 0.f; negm[r] = 0.f; }
    float m = 0.f, l = 0.f;
    const int kfrag = r32 * KROW + hi * 16;
    const int vfrag = KBUF + ((lane >> 4) & 1) * 32 + (lane & 3) * 8 + (4 * hi + ((lane & 15) >> 2)) * 64;
    for (int t = 0; t < NT; ++t) {
        const LAS unsigned char* cur = lds + (t & 1) * BUF;
        if (t + 1 < NT) { LAS unsigned char* nb = lds + ((t + 1) & 1) * BUF;
            *(LAS u32x4*)(nb + koff0) = k0r; if (has_k1) *(LAS u32x4*)(nb + koff1) = k1r; *(LAS u32x4*)(nb + voff) = v0r; }
        if (t + 2 < NT) { const unsigned char* kb = kbase + (size_t)(t + 2) * 12288; const unsigned char* vb = vbase + (size_t)(t + 2) * 8192;
            k0r = *(const u32x4*)(kb + (size_t)tid * 16); if (has_k1) k1r = *(const u32x4*)(kb + (size_t)kc1 * 16); v0r = *(const u32x4*)(vb + (size_t)tid * 16); }
        if (t <= cw) {
            f32x16 p0, p1;
            const LAS unsigned char* kp = cur + kfrag;
#pragma unroll
            for (int s = 0; s < 6; ++s) {
                const bf16x8 a0 = *(const LAS bf16x8*)(kp + s * 32), a1 = *(const LAS bf16x8*)(kp + 32 * KROW + s * 32);
                if (s == 0) { p0 = __builtin_amdgcn_mfma_f32_32x32x16_bf16(a0, qr[0], negm, 0, 0, 0); p1 = __builtin_amdgcn_mfma_f32_32x32x16_bf16(a1, qr[0], negm, 0, 0, 0); }
                else { p0 = __builtin_amdgcn_mfma_f32_32x32x16_bf16(a0, qr[s], p0, 0, 0, 0); p1 = __builtin_amdgcn_mfma_f32_32x32x16_bf16(a1, qr[s], p1, 0, 0, 0); }
            }
            float mx = fmaxf(fmaxf(p0[0], p1[0]), fmaxf(p0[1], p1[1]));
#pragma unroll
            for (int r = 2; r < 16; r += 2) mx = fmaxf(mx, fmaxf(fmaxf(p0[r], p1[r]), fmaxf(p0[r + 1], p1[r + 1])));
            mx = hmax(mx);
            if (t == 0) {
                m = mx;
#pragma unroll
                for (int r = 0; r < 16; ++r) { p0[r] -= mx; p1[r] -= mx; negm[r] = -mx; }
            } else if (__any(mx > 8.0f)) {
                const float dl = fmaxf(mx, 0.f), alpha = __builtin_amdgcn_exp2f(-dl);
                m += dl; l *= alpha;
#pragma unroll
                for (int r = 0; r < 16; ++r) { p0[r] -= dl; p1[r] -= dl; o0[r] *= alpha; o1[r] *= alpha; negm[r] = -m; }
            }
            float ps0 = 0.f, ps1 = 0.f;
#pragma unroll
            for (int r = 0; r < 16; ++r) { p0[r] = __builtin_amdgcn_exp2f(p0[r]); p1[r] = __builtin_amdgcn_exp2f(p1[r]); ps0 += p0[r]; ps1 += p1[r]; }
            l += ps0 + ps1;
            u32x4 pw0, pw1, pw2, pw3;
            pw0 = (u32x4){cvtpk(p0[0], p0[1]), cvtpk(p0[2], p0[3]), cvtpk(p0[4], p0[5]), cvtpk(p0[6], p0[7])};
            pw1 = (u32x4){cvtpk(p0[8], p0[9]), cvtpk(p0[10], p0[11]), cvtpk(p0[12], p0[13]), cvtpk(p0[14], p0[15])};
            pw2 = (u32x4){cvtpk(p1[0], p1[1]), cvtpk(p1[2], p1[3]), cvtpk(p1[4], p1[5]), cvtpk(p1[6], p1[7])};
            pw3 = (u32x4){cvtpk(p1[8], p1[9]), cvtpk(p1[10], p1[11]), cvtpk(p1[12], p1[13]), cvtpk(p1[14], p1[15])};
            const LAS unsigned char* vp = cur + vfrag;
#define ATT_PV(OD, D0, KS, PW) do { const v4i16_t lo_ = vtr(vp + (D0) * 4096 + (KS) * 1024), hi_ = vtr(vp + (D0) * 4096 + (KS) * 1024 + 512); \
                const bf16x8 vf_ = {lo_[0], lo_[1], lo_[2], lo_[3], hi_[0], hi_[1], hi_[2], hi_[3]}; \
                OD = __builtin_amdgcn_mfma_f32_32x32x16_bf16(vf_, __builtin_bit_cast(bf16x8, PW), OD, 0, 0, 0); } while (0)
            ATT_PV(o0, 0, 0, pw0); ATT_PV(o1, 1, 0, pw0); ATT_PV(o0, 0, 1, pw1); ATT_PV(o1, 1, 1, pw1);
            ATT_PV(o0, 0, 2, pw2); ATT_PV(o1, 1, 2, pw2); ATT_PV(o0, 0, 3, pw3); ATT_PV(o1, 1, 3, pw3);
#undef ATT_PV
        }
        asm volatile("s_waitcnt lgkmcnt(0)" ::: "memory"); __builtin_amdgcn_s_barrier(); asm volatile("" ::: "memory");
    }
    const float rl = 1.f / hsum(l);
    const int b = bh / NH, h = bh - b * NH;
    bf16_t* op = (bf16_t*)(C.ws + WS_ATT) + ((size_t)b * SEQ + qb * 256 + wave * 32 + r32) * RW + h * VD + 4 * hi;
#pragma unroll
    for (int g = 0; g < 4; ++g) {
        u32x2 w0, w1;
        w0.x = cvtpk(o0[4 * g] * rl, o0[4 * g + 1] * rl); w0.y = cvtpk(o0[4 * g + 2] * rl, o0[4 * g + 3] * rl);
        w1.x = cvtpk(o1[4 * g] * rl, o1[4 * g + 1] * rl); w1.y = cvtpk(o1[4 * g + 2] * rl, o1[4 * g + 3] * rl);
        *(u32x2*)(op + 8 * g) = w0; *(u32x2*)(op + 32 + 8 * g) = w1;
    }
}
__device__ __forceinline__ void attn_phase(const Ctx& C, LAS unsigned char* lds, int G, int bx, int tid, int lane, int wave) {
    const int v0 = (G % 8 == 0) ? (bx % 8) * (G / 8) + bx / 8 : bx;
    for (int v = v0; v < 256; v += G) {
        const int bh = v >> 1, odd = v & 1;
#pragma unroll 1
        for (int i = 0; i < 4; ++i) {
            const int qb = (i == 0) ? 7 - odd : (i == 1) ? odd : (i == 2) ? 4 + odd : 3 - odd;
            attn_unit(C, lds, bh, qb, tid, lane, wave);
        }
    }
}
}


namespace cscan {
constexpr int CH = 32, NCH = SEQ / CH;
constexpr int RS = 144;
constexpr int RS2 = 80;
constexpr int L_AT = 0, L_BT = 4608, L_RT = 9216, L_KT = 13824, L_BTV = 18432, L_VV = 22528, L_MAB = 26624, L_MAK = 30720, L_GC = 34816, L_MBRT = 35072, L_WAVE = 37632;
constexpr int L_P = L_AT, L_MAKT = L_MAK;
typedef short v4i16_t __attribute__((ext_vector_type(4)));
typedef float f32x2s __attribute__((ext_vector_type(2)));
#define CS_MF(a, b, c) __builtin_amdgcn_mfma_f32_32x32x16_bf16(a, b, c, 0, 0, 0)
template <int CTRL> __device__ __forceinline__ float dpp_add(float x) { return x + __builtin_bit_cast(float, __builtin_amdgcn_update_dpp(0, __builtin_bit_cast(int, x), CTRL, 0xf, 0xf, true)); }
__device__ __forceinline__ float wsum(float x) {
    x = dpp_add<0xB1>(x); x = dpp_add<0x4E>(x); x = dpp_add<0x141>(x); x = dpp_add<0x140>(x);
    x += __builtin_bit_cast(float, __builtin_amdgcn_update_dpp(0, __builtin_bit_cast(int, x), 0x142, 0xa, 0xf, false));
    x += __builtin_bit_cast(float, __builtin_amdgcn_update_dpp(0, __builtin_bit_cast(int, x), 0x143, 0xc, 0xf, false));
    return __builtin_bit_cast(float, __builtin_amdgcn_readlane(__builtin_bit_cast(int, x), 63));
}
__device__ __forceinline__ int crow(int r, int hi) { return (r & 3) + 8 * (r >> 2) + 4 * hi; }
__device__ __forceinline__ bf16x8 pack8(const f32x16& p, int s) {
    u32x4 w; w.x = cvtpk(p[8 * s], p[8 * s + 1]); w.y = cvtpk(p[8 * s + 2], p[8 * s + 3]); w.z = cvtpk(p[8 * s + 4], p[8 * s + 5]); w.w = cvtpk(p[8 * s + 6], p[8 * s + 7]);
    return __builtin_bit_cast(bf16x8, w); }
__device__ __forceinline__ bf16x8 rd_nat(const LAS unsigned char* p) { return *(const LAS bf16x8*)p; }
__device__ __forceinline__ bf16x8 rd_perm(const LAS unsigned char* p) { const u32x2 a = *(const LAS u32x2*)p, b = *(const LAS u32x2*)(p + 16);
    u32x4 w; w.x = a.x; w.y = a.y; w.z = b.x; w.w = b.y; return __builtin_bit_cast(bf16x8, w); }
__device__ __forceinline__ bf16x8 rd_tr(const LAS unsigned char* p) { const v4i16_t lo = __builtin_amdgcn_ds_read_tr16_b64_v4i16((LAS v4i16_t*)p), hi = __builtin_amdgcn_ds_read_tr16_b64_v4i16((LAS v4i16_t*)(p + 512));
    return (bf16x8){lo[0], lo[1], lo[2], lo[3], hi[0], hi[1], hi[2], hi[3]}; }
__device__ __forceinline__ float bfl(unsigned w) { return __uint_as_float(w << 16); }
__device__ __forceinline__ float bfh(unsigned w) { return __uint_as_float(w & 0xffff0000u); }

#define CS_BAR() do { asm volatile("s_waitcnt lgkmcnt(0)" ::: "memory"); __builtin_amdgcn_s_barrier(); asm volatile("" ::: "memory"); } while (0)
__device__ __forceinline__ void pair_bar(LAS unsigned* cnt, unsigned& ord, int lane) {
    asm volatile("s_waitcnt lgkmcnt(0)" ::: "memory");
    ord += 2u;
    if (lane == 0) __hip_atomic_fetch_add(cnt, 1u, __ATOMIC_RELAXED, __HIP_MEMORY_SCOPE_WORKGROUP);
    for (unsigned spins = 0; spins < (1u << 22); ++spins) {
        const unsigned v = __builtin_amdgcn_readfirstlane(__hip_atomic_load(cnt, __ATOMIC_RELAXED, __HIP_MEMORY_SCOPE_WORKGROUP));
        if ((int)(v - ord) >= 0) break;
        __builtin_amdgcn_s_sleep(1);
    }
    asm volatile("" ::: "memory");
}
struct RawRegs { u32x4 r[2], k[2], v[2], a[2], e[2], rp, kp, vp; };
__device__ __forceinline__ void rawLoad(const Ctx& C, RawRegs& R, int task, int lane, int role) {
    const int c = task & (NCH - 1), bh = task >> 6, b = bh / NH, h = bh - b * NH;
    const size_t trow0 = (size_t)b * SEQ + (size_t)c * CH + 16 * role + (lane >> 3);
    const bf16_t* rkv = (const bf16_t*)(C.ws + WS_RKV) + trow0 * 1536 + h * 64 + (lane & 7) * 8;
    const bf16_t* av = (const bf16_t*)(C.ws + WS_AV) + trow0 * RW + h * 64 + (lane & 7) * 8;
    const bf16_t* eb = (const bf16_t*)(C.ws + WS_EBUF) + trow0 * RW + h * 64 + (lane & 7) * 8;
#pragma unroll
    for (int q = 0; q < 2; ++q) { R.r[q] = *(const u32x4*)(rkv + (size_t)q * 8 * 1536); R.k[q] = *(const u32x4*)(rkv + (size_t)q * 8 * 1536 + 512); R.v[q] = *(const u32x4*)(rkv + (size_t)q * 8 * 1536 + 1024);
        R.a[q] = *(const u32x4*)(av + (size_t)q * 8 * RW); R.e[q] = *(const u32x4*)(eb + (size_t)q * 8 * RW); }
    if (c * CH + 16 * role > 0) { const bf16_t* pv = (const bf16_t*)(C.ws + WS_RKV) + ((size_t)b * SEQ + (size_t)c * CH + 16 * role - 1) * 1536 + h * 64 + (lane & 7) * 8;
        R.rp = *(const u32x4*)pv; R.kp = *(const u32x4*)(pv + 512); R.vp = *(const u32x4*)(pv + 1024); }
    else { R.rp = (u32x4){0u, 0u, 0u, 0u}; R.kp = R.rp; R.vp = R.rp; }
}
__device__ __forceinline__ void taskA(const Ctx& C, LAS unsigned char* L, int task, int lane, int role, bool valid, RawRegs& R, int next_task, bool next_valid, LAS unsigned* pcnt, unsigned& pord) {
    asm volatile("" : "+v"(lane));
    const int c = task & (NCH - 1), bh = task >> 6, b = bh / NH, h = bh - b * NH;
    const int r32 = lane & 31, hi = lane >> 5;
    const size_t trow0 = (size_t)b * SEQ + (size_t)c * CH;
    if (valid) {
        const int jg = lane & 7;
        const float4 kw0 = *(const float4*)(C.k_k + h * 64 + 8 * jg), kw1 = *(const float4*)(C.k_k + h * 64 + 8 * jg + 4), ka0 = *(const float4*)(C.k_a + h * 64 + 8 * jg), ka1 = *(const float4*)(C.k_a + h * 64 + 8 * jg + 4);
        const float4 rk0 = *(const float4*)(C.r_k + h * 64 + 8 * jg), rk1 = *(const float4*)(C.r_k + h * 64 + 8 * jg + 4);
        const float kkw[8] = {kw0.x, kw0.y, kw0.z, kw0.w, kw1.x, kw1.y, kw1.z, kw1.w}, kaw[8] = {ka0.x, ka0.y, ka0.z, ka0.w, ka1.x, ka1.y, ka1.z, ka1.w};
        const float rkw[8] = {rk0.x, rk0.y, rk0.z, rk0.w, rk1.x, rk1.y, rk1.z, rk1.w};
        float* bonus = (float*)(C.ws + WS_BONUS) + trow0 * NH + h;
        {
            const int src = ((lane - 8) & 63) * 4; const bool top = lane >= 56;
#define CS_SHIFT(X_, P_, MU_) do { const float4 ma_ = *(const float4*)(C.mu + (MU_) + h * 64 + 8 * jg), mb_ = *(const float4*)(C.mu + (MU_) + h * 64 + 8 * jg + 4); \
            const float mm_[8] = {ma_.x, ma_.y, ma_.z, ma_.w, mb_.x, mb_.y, mb_.z, mb_.w}; \
            _Pragma("unroll") for (int q = 1; q >= 0; --q) _Pragma("unroll") for (int e = 0; e < 4; ++e) { \
                const unsigned y_ = top ? (q ? X_[0][e] : P_[e]) : X_[q][e]; \
                const unsigned p_ = (unsigned)__builtin_amdgcn_ds_bpermute(src, (int)y_); \
                const float z0_ = bfl(X_[q][e]), z1_ = bfh(X_[q][e]), p0_ = bfl(p_), p1_ = bfh(p_); \
                X_[q][e] = cvtpk(z0_ + (p0_ - z0_) * mm_[2 * e], z1_ + (p1_ - z1_) * mm_[2 * e + 1]); } } while (0)
            CS_SHIFT(R.r, R.rp, 0); CS_SHIFT(R.k, R.kp, RW); CS_SHIFT(R.v, R.vp, 2 * RW);
#undef CS_SHIFT
        }
#pragma unroll
        for (int q = 0; q < 2; ++q) { const int t = 16 * role + 8 * q + (lane >> 3);
            float kf[8], rf[8], af[8], kk0[8], kp[8];
#pragma unroll
            for (int e = 0; e < 4; ++e) { kf[2 * e] = bfl(R.k[q][e]); kf[2 * e + 1] = bfh(R.k[q][e]); rf[2 * e] = bfl(R.r[q][e]); rf[2 * e + 1] = bfh(R.r[q][e]); af[2 * e] = bfl(R.a[q][e]); af[2 * e + 1] = bfh(R.a[q][e]); }
            float n2 = 0.f, bn = 0.f;
#pragma unroll
            for (int e = 0; e < 8; ++e) { kk0[e] = kf[e] * kkw[e]; n2 += kk0[e] * kk0[e]; kp[e] = kf[e] * (1.f + (af[e] - 1.f) * kaw[e]); bn += rf[e] * kp[e] * rkw[e]; }
            n2 = sum8_dpp(n2); bn = sum8_dpp(bn);
            const float rn = __builtin_amdgcn_rsqf(fmaxf(n2, 1e-24f));
            u32x4 wkk, wkp;
            wkk.x = cvtpk(kk0[0] * rn, kk0[1] * rn); wkk.y = cvtpk(kk0[2] * rn, kk0[3] * rn); wkk.z = cvtpk(kk0[4] * rn, kk0[5] * rn); wkk.w = cvtpk(kk0[6] * rn, kk0[7] * rn);
            wkp.x = cvtpk(kp[0], kp[1]); wkp.y = cvtpk(kp[2], kp[3]); wkp.z = cvtpk(kp[4], kp[5]); wkp.w = cvtpk(kp[6], kp[7]);
            if (jg == 0) bonus[(size_t)t * NH] = bn;
            *(LAS u32x4*)(L + L_RT + t * RS + jg * 16) = R.r[q]; *(LAS u32x4*)(L + L_KT + t * RS + jg * 16) = wkp; *(LAS u32x4*)(L + L_AT + t * RS + jg * 16) = wkk;
            *(LAS u32x4*)(L + L_MAK + t * 128 + jg * 16) = R.a[q]; *(LAS u32x4*)(L + L_MAB + t * 128 + jg * 16) = R.e[q];
            *(LAS u32x4*)(L + L_VV + (jg >> 2) * 2048 + (t >> 4) * 1024 + (t & 15) * 64 + (jg & 3) * 16) = R.v[q]; }
    }
    if (next_valid) rawLoad(C, R, next_task, lane, role);
    pair_bar(pcnt, pord, lane);
    if (valid) {
        float Lc = 0.f;
        if (role == 1) {
#pragma unroll
            for (int t = 0; t < 16; ++t) Lc -= bf2f(*(const LAS bf16_t*)(L + L_MAB + t * 128 + lane * 2)); }
        float gprev = __expf(Lc);
        const int vbase = (lane >> 5) * 2048 + (lane & 31) * 2;
#pragma unroll 4
        for (int tt = 0; tt < 16; ++tt) {
            const int t = 16 * role + tt; const int ro = t * RS + lane * 2;
            const float r = bf2f(*(const LAS bf16_t*)(L + L_RT + ro)), kp = bf2f(*(const LAS bf16_t*)(L + L_KT + ro)), kk = bf2f(*(const LAS bf16_t*)(L + L_AT + ro));
            const float a = bf2f(*(const LAS bf16_t*)(L + L_MAK + t * 128 + lane * 2)), e = bf2f(*(const LAS bf16_t*)(L + L_MAB + t * 128 + lane * 2));
            Lc -= e; const float gam = __expf(Lc), ginv = __expf(-Lc);
            const unsigned w1 = cvtpk(-kk * gprev, r * gam), w2 = cvtpk(kp * ginv, kk * a * ginv);
            *(LAS bf16_t*)(L + L_AT + ro) = (bf16_t)w1; *(LAS bf16_t*)(L + L_RT + ro) = (bf16_t)(w1 >> 16); *(LAS bf16_t*)(L + L_KT + ro) = (bf16_t)w2;
            *(LAS bf16_t*)(L + L_BT + ro) = (bf16_t)(w2 >> 16); *(LAS bf16_t*)(L + L_BTV + vbase + (t >> 4) * 1024 + (t & 15) * 64) = (bf16_t)(w2 >> 16);
            gprev = gam;
        }
        if (role == 1) *(LAS float*)(L + L_GC + lane * 4) = gprev;
    }
    pair_bar(pcnt, pord, lane);
    f32x16 mkr;
#pragma unroll
    for (int q = 0; q < 16; ++q) mkr[q] = 0.f;
    if (valid) {
        f32x16 m0;
#pragma unroll
        for (int q = 0; q < 16; ++q) m0[q] = 0.f;
        const int bt_ = role == 0 ? L_AT : L_RT;
#pragma unroll
        for (int s_ = 0; s_ < 4; ++s_) {
            const int ko = r32 * RS + (16 * s_ + 8 * hi) * 2;
            const bf16x8 aB = rd_nat(L + L_BT + ko), aK = rd_nat(L + L_KT + ko), bX = rd_nat(L + bt_ + ko);
            m0 = CS_MF(aB, bX, m0); mkr = CS_MF(aK, bX, mkr);
        }
        const float base_ = (float)(r32 - 4 * hi) + (role == 0 ? 0.f : 1.f);
#pragma unroll
        for (int q = 0; q < 16; ++q) { const float mk_ = __builtin_amdgcn_fmed3f(base_ - (float)((q & 3) + 8 * (q >> 2)), 0.f, 1.f); m0[q] *= mk_; mkr[q] *= mk_; }
        if (role == 0) {
#pragma unroll
            for (int g = 0; g < 4; ++g) {
                *(LAS f32x4*)(L + L_MAB + r32 * 128 + (8 * g + 4 * hi) * 4) = (f32x4){m0[4 * g], m0[4 * g + 1], m0[4 * g + 2], m0[4 * g + 3]};
                *(LAS f32x4*)(L + L_MAK + r32 * 128 + (8 * g + 4 * hi) * 4) = (f32x4){mkr[4 * g], mkr[4 * g + 1], mkr[4 * g + 2], mkr[4 * g + 3]}; }
        } else {
#pragma unroll
            for (int g = 0; g < 4; ++g) { u32x2 w; w.x = cvtpk(m0[4 * g], m0[4 * g + 1]); w.y = cvtpk(m0[4 * g + 2], m0[4 * g + 3]);
                *(LAS u32x2*)(L + L_MBRT + r32 * RS2 + (8 * g + 4 * hi) * 2) = w; }
        }
    }
    pair_bar(pcnt, pord, lane);
    if (valid) {
        float xa[16], xb[16];
#pragma unroll
        for (int t = 0; t < 16; ++t) { xa[t] = 0.f; xb[t] = 0.f; }
#pragma unroll
        for (int t = 0; t < 16; ++t) {
            float ap = role == 0 ? bf2f(*(const LAS bf16_t*)(L + L_AT + t * RS + lane * 2)) : *(const LAS float*)(L + L_MAK + t * 128 + r32 * 4);
            float aq = 0.f;
#pragma unroll
            for (int i4 = 0; i4 < (t + 3) / 4; ++i4) { const f32x4 m4 = *(const LAS f32x4*)(L + L_MAB + t * 128 + i4 * 16);
                ap += xa[4 * i4] * m4[0]; aq += xa[4 * i4 + 1] * m4[1]; ap += xa[4 * i4 + 2] * m4[2]; aq += xa[4 * i4 + 3] * m4[3]; }
            xa[t] = ap + aq;
            asm volatile("" : "+v"(xa[t]) :: "memory");
        }
#pragma unroll
        for (int t = 0; t < 16; ++t) {
            float ap = role == 0 ? bf2f(*(const LAS bf16_t*)(L + L_AT + (16 + t) * RS + lane * 2)) : *(const LAS float*)(L + L_MAK + (16 + t) * 128 + r32 * 4);
            float aq = 0.f;
#pragma unroll
            for (int i4 = 0; i4 < 4; ++i4) { const f32x4 m4 = *(const LAS f32x4*)(L + L_MAB + (16 + t) * 128 + i4 * 16);
                ap += xa[4 * i4] * m4[0]; aq += xa[4 * i4 + 1] * m4[1]; ap += xa[4 * i4 + 2] * m4[2]; aq += xa[4 * i4 + 3] * m4[3]; }
#pragma unroll
            for (int i4 = 0; i4 < (t + 3) / 4; ++i4) { const f32x4 m4 = *(const LAS f32x4*)(L + L_MAB + (16 + t) * 128 + 64 + i4 * 16);
                ap += xb[4 * i4] * m4[0]; aq += xb[4 * i4 + 1] * m4[1]; ap += xb[4 * i4 + 2] * m4[2]; aq += xb[4 * i4 + 3] * m4[3]; }
            xb[t] = ap + aq;
            asm volatile("" : "+v"(xb[t]) :: "memory");
        }
        u32x4 w0, w1, w2, w3;
        w0.x = cvtpk(xa[0], xa[1]); w0.y = cvtpk(xa[2], xa[3]); w0.z = cvtpk(xa[4], xa[5]); w0.w = cvtpk(xa[6], xa[7]);
        w1.x = cvtpk(xa[8], xa[9]); w1.y = cvtpk(xa[10], xa[11]); w1.z = cvtpk(xa[12], xa[13]); w1.w = cvtpk(xa[14], xa[15]);
        w2.x = cvtpk(xb[0], xb[1]); w2.y = cvtpk(xb[2], xb[3]); w2.z = cvtpk(xb[4], xb[5]); w2.w = cvtpk(xb[6], xb[7]);
        w3.x = cvtpk(xb[8], xb[9]); w3.y = cvtpk(xb[10], xb[11]); w3.z = cvtpk(xb[12], xb[13]); w3.w = cvtpk(xb[14], xb[15]);
        if (role == 0) { LAS u32x4* d = (LAS u32x4*)(L + L_P + lane * RS2); d[0] = w0; d[1] = w1; d[2] = w2; d[3] = w3; }
        else if (hi == 0) { LAS u32x4* d = (LAS u32x4*)(L + L_MAKT + r32 * RS2); d[0] = w0; d[1] = w1; d[2] = w2; d[3] = w3; }
    }
    pair_bar(pcnt, pord, lane);
    if (valid) {
        const int trf = ((lane >> 4) & 1) * 32 + (lane & 3) * 8 + (4 * hi + ((lane & 15) >> 2)) * 64;
        if (role == 0) {
            bf16_t* gQT = (bf16_t*)(C.ws + WS_CQT) + (size_t)task * (CH * 64);
            bf16_t* gGT = (bf16_t*)(C.ws + WS_CGT) + (size_t)task * (64 * 64);
            {
                f32x16 q0, q1;
#pragma unroll
                for (int q = 0; q < 16; ++q) { q0[q] = 0.f; q1[q] = 0.f; }
#pragma unroll
                for (int s_ = 0; s_ < 2; ++s_) { const int ko = (16 * s_ + 8 * hi) * 2; const bf16x8 bM = rd_nat(L + L_MBRT + r32 * RS2 + ko);
                    q0 = CS_MF(rd_nat(L + L_P + r32 * RS2 + ko), bM, q0); q1 = CS_MF(rd_nat(L + L_P + (32 + r32) * RS2 + ko), bM, q1); }
#pragma unroll
                for (int g = 0; g < 4; ++g) {
                    const u32x2 ra = *(const LAS u32x2*)(L + L_RT + r32 * RS + (8 * g + 4 * hi) * 2), rb = *(const LAS u32x2*)(L + L_RT + r32 * RS + (32 + 8 * g + 4 * hi) * 2);
                    u32x2 w0, w1;
                    w0.x = cvtpk(q0[4 * g] + bfl(ra.x), q0[4 * g + 1] + bfh(ra.x)); w0.y = cvtpk(q0[4 * g + 2] + bfl(ra.y), q0[4 * g + 3] + bfh(ra.y));
                    w1.x = cvtpk(q1[4 * g] + bfl(rb.x), q1[4 * g + 1] + bfh(rb.x)); w1.y = cvtpk(q1[4 * g + 2] + bfl(rb.y), q1[4 * g + 3] + bfh(rb.y));
                    *(u32x2*)(gQT + r32 * 64 + 8 * g + 4 * hi) = w0; *(u32x2*)(gQT + r32 * 64 + 32 + 8 * g + 4 * hi) = w1; }
            }
            __builtin_amdgcn_sched_barrier(0);
#define CS_G(N_) do { const float gc_ = *(const LAS float*)(L + L_GC + ((N_) * 32 + r32) * 4); \
                f32x16 ga_, gb_; _Pragma("unroll") for (int q = 0; q < 16; ++q) { ga_[q] = 0.f; gb_[q] = 0.f; } \
                _Pragma("unroll") for (int s_ = 0; s_ < 2; ++s_) { const int ko = (16 * s_ + 4 * hi) * 2; const bf16x8 bb_ = rd_tr(L + L_BTV + trf + (N_) * 2048 + s_ * 1024); \
                    ga_ = CS_MF(rd_perm(L + L_P + r32 * RS2 + ko), bb_, ga_); gb_ = CS_MF(rd_perm(L + L_P + (32 + r32) * RS2 + ko), bb_, gb_); } \
                { const float base_ = (float)(r32 - 4 * hi); \
                _Pragma("unroll") for (int q = 0; q < 16; ++q) { const float dl_ = __builtin_amdgcn_fmed3f(1.f - __builtin_fabsf(base_ - (float)((q & 3) + 8 * (q >> 2))), 0.f, 1.f); \
                    ga_[q] = (ga_[q] + ((N_) == 0 ? dl_ : 0.f)) * gc_; gb_[q] = (gb_[q] + ((N_) == 1 ? dl_ : 0.f)) * gc_; } } \
                _Pragma("unroll") for (int g = 0; g < 4; ++g) { u32x2 w; \
                    w.x = cvtpk(ga_[4 * g], ga_[4 * g + 1]); w.y = cvtpk(ga_[4 * g + 2], ga_[4 * g + 3]); *(u32x2*)(gGT + ((N_) * 32 + r32) * 64 + 8 * g + 4 * hi) = w; \
                    w.x = cvtpk(gb_[4 * g], gb_[4 * g + 1]); w.y = cvtpk(gb_[4 * g + 2], gb_[4 * g + 3]); *(u32x2*)(gGT + ((N_) * 32 + r32) * 64 + 32 + 8 * g + 4 * hi) = w; } \
                __builtin_amdgcn_sched_barrier(0); } while (0)
            CS_G(0); CS_G(1);
#undef CS_G
        } else {
            bf16_t* gHT = (bf16_t*)(C.ws + WS_CHT) + (size_t)task * (64 * 64);
            bf16_t* gYL = (bf16_t*)(C.ws + WS_CYL) + (size_t)task * (64 * CH);
            f32x16 z = mkr, x0, x1;
#pragma unroll
            for (int s_ = 0; s_ < 2; ++s_) { const int ko = (16 * s_ + 8 * hi) * 2;
                z = CS_MF(rd_nat(L + L_MAKT + r32 * RS2 + ko), rd_nat(L + L_MBRT + r32 * RS2 + ko), z); }
#define CS_X(N_, XN_) do { const float gc_ = *(const LAS float*)(L + L_GC + ((N_) * 32 + r32) * 4); \
                _Pragma("unroll") for (int q = 0; q < 16; ++q) XN_[q] = 0.f; \
                _Pragma("unroll") for (int s_ = 0; s_ < 2; ++s_) { const int ko = (16 * s_ + 4 * hi) * 2; \
                    XN_ = CS_MF(rd_perm(L + L_MAKT + r32 * RS2 + ko), rd_tr(L + L_BTV + trf + (N_) * 2048 + s_ * 1024), XN_); } \
                { const LAS unsigned char* kb_ = L + L_KT + 4 * hi * RS + ((N_) * 32 + r32) * 2; \
                _Pragma("unroll") for (int q = 0; q < 16; ++q) XN_[q] = (XN_[q] + bf2f(*(const LAS bf16_t*)(kb_ + ((q & 3) + 8 * (q >> 2)) * RS))) * gc_; } } while (0)
            CS_X(0, x0); CS_X(1, x1);
#undef CS_X
            const bf16x8 ax00 = pack8(x0, 0), ax01 = pack8(x0, 1), ax10 = pack8(x1, 0), ax11 = pack8(x1, 1), az0 = pack8(z, 0), az1 = pack8(z, 1);
#define CS_HY(N_) do { \
                f32x16 ha_, hb_, yy_; _Pragma("unroll") for (int q = 0; q < 16; ++q) { ha_[q] = 0.f; hb_[q] = 0.f; yy_[q] = 0.f; } \
                const bf16x8 va_ = rd_tr(L + L_VV + trf + (N_) * 2048), vb_ = rd_tr(L + L_VV + trf + (N_) * 2048 + 1024); \
                ha_ = CS_MF(ax00, va_, ha_); ha_ = CS_MF(ax01, vb_, ha_); hb_ = CS_MF(ax10, va_, hb_); hb_ = CS_MF(ax11, vb_, hb_); yy_ = CS_MF(az0, va_, yy_); yy_ = CS_MF(az1, vb_, yy_); \
                _Pragma("unroll") for (int g = 0; g < 4; ++g) { u32x2 w; \
                    w.x = cvtpk(ha_[4 * g], ha_[4 * g + 1]); w.y = cvtpk(ha_[4 * g + 2], ha_[4 * g + 3]); *(u32x2*)(gHT + ((N_) * 32 + r32) * 64 + 8 * g + 4 * hi) = w; \
                    w.x = cvtpk(hb_[4 * g], hb_[4 * g + 1]); w.y = cvtpk(hb_[4 * g + 2], hb_[4 * g + 3]); *(u32x2*)(gHT + ((N_) * 32 + r32) * 64 + 32 + 8 * g + 4 * hi) = w; \
                    w.x = cvtpk(yy_[4 * g], yy_[4 * g + 1]); w.y = cvtpk(yy_[4 * g + 2], yy_[4 * g + 3]); *(u32x2*)(gYL + ((N_) * 32 + r32) * CH + 8 * g + 4 * hi) = w; } \
                __builtin_amdgcn_sched_barrier(0); } while (0)
            CS_HY(0); CS_HY(1);
#undef CS_HY
        }
    }
    pair_bar(pcnt, pord, lane);
}
__device__ __forceinline__ void phaseA(const Ctx& C, LAS unsigned char* lds, int G, int bx, int lane, int wave) {
    LAS unsigned char* L = lds + (wave >> 1) * L_WAVE; const int role = wave & 1;
    LAS unsigned* pcnt = (LAS unsigned*)(lds + 4 * L_WAVE) + (wave >> 1) * 32;
    if (role == 0 && lane == 0) *pcnt = 0u;
    __syncthreads();
    unsigned pord = 0u;
    constexpr int NTASK = NB * NH * NCH;
    const int rounds = (NTASK + 4 * G - 1) / (4 * G);
    RawRegs R;
    int task = bx * 4 + (wave >> 1);
    if (task < NTASK) rawLoad(C, R, task, lane, role);
#pragma unroll 1
    for (int k = 0; k < rounds; ++k) { const int nt = task + 4 * G; taskA(C, L, task, lane, role, task < NTASK, R, nt, (k + 1 < rounds) && nt < NTASK, pcnt, pord); task = nt; }
    __syncthreads();
}
constexpr int K_QT = 0, K_GT = 4608, K_YL = 13824, K_HT = 16384, K_BUF = 20992;
constexpr int K_FR = 2 * K_BUF;
__device__ __forceinline__ void chain_unit(const Ctx& C, LAS unsigned char* lds, int unit, int tid, int lane, int wave) {
    const int bh = unit >> 1, half = unit & 1, b = bh / NH, h = bh - b * NH;
    const int r32 = lane & 31, hi = lane >> 5;
    const unsigned char* gQT = (const unsigned char*)((const bf16_t*)(C.ws + WS_CQT) + (size_t)bh * NCH * (CH * 64));
    const unsigned char* gGT = (const unsigned char*)((const bf16_t*)(C.ws + WS_CGT) + (size_t)bh * NCH * (64 * 64));
    const unsigned char* gHT = (const unsigned char*)((const bf16_t*)(C.ws + WS_CHT) + (size_t)bh * NCH * (64 * 64) + half * 32 * 64);
    const unsigned char* gYL = (const unsigned char*)((const bf16_t*)(C.ws + WS_CYL) + (size_t)bh * NCH * (64 * CH) + half * 32 * CH);
    bf16_t* yout = (bf16_t*)(C.ws + WS_Y2) + (size_t)b * SEQ * RW + h * 64 + half * 32 + r32;
    const int lt = tid - 192;
    const unsigned char* src[4]; int dst[4]; size_t cstep[4];
#pragma unroll
    for (int q_ = 0; q_ < 4; ++q_) { const int p0_ = (lt < 0 ? 0 : lt) + 320 * q_; const int p_ = p0_ < 1152 ? p0_ : 1151;
        if (p_ < 256) { src[q_] = gQT + p_ * 16; dst[q_] = K_QT + (p_ >> 3) * 144 + (p_ & 7) * 16; cstep[q_] = 4096; }
        else if (p_ < 768) { const int r_ = p_ - 256; src[q_] = gGT + r_ * 16; dst[q_] = K_GT + (r_ >> 3) * 144 + (r_ & 7) * 16; cstep[q_] = 8192; }
        else if (p_ < 896) { const int r_ = p_ - 768; src[q_] = gYL + r_ * 16; dst[q_] = K_YL + (r_ >> 2) * 80 + (r_ & 3) * 16; cstep[q_] = 4096; }
        else { const int r_ = p_ - 896; src[q_] = gHT + r_ * 16; dst[q_] = K_HT + (r_ >> 3) * 144 + (r_ & 7) * 16; cstep[q_] = 8192; } }
    const bool ldr = lt >= 0;
    u32x4 sA[4], sB[4], sC[4];
#define CH_LD1(dst_, p_) asm volatile("global_load_dwordx4 %0, %1, off" : "=v"(dst_) : "v"(p_) : "memory")
#define CH_LD(S_, cc) do { if (ldr) { const size_t cc_ = (cc) < NCH ? (cc) : NCH - 1; CH_LD1(S_[0], src[0] + cc_ * cstep[0]); CH_LD1(S_[1], src[1] + cc_ * cstep[1]); \
        CH_LD1(S_[2], src[2] + cc_ * cstep[2]); CH_LD1(S_[3], src[3] + cc_ * cstep[3]); } } while (0)
#define CH_WR(S_, cc) do { if (ldr) { asm volatile("s_waitcnt vmcnt(8)" : "+v"(S_[0]), "+v"(S_[1]), "+v"(S_[2]), "+v"(S_[3]) :: "memory"); __builtin_amdgcn_sched_barrier(0); \
        const int bo_ = ((cc) & 1) * K_BUF; *(LAS u32x4*)(lds + bo_ + dst[0]) = S_[0]; *(LAS u32x4*)(lds + bo_ + dst[1]) = S_[1]; *(LAS u32x4*)(lds + bo_ + dst[2]) = S_[2]; \
        *(LAS u32x4*)(lds + bo_ + dst[3]) = S_[3]; } } while (0)
    if (tid < 256) *(LAS u32x4*)(lds + K_FR + tid * 16) = (u32x4){0u, 0u, 0u, 0u};
#define CH_STEP(c, SW_) do { \
        CH_WR(SW_, (c) + 1); CH_LD(SW_, (c) + 4); \
        if (wave < 3 && (c) < NCH) { \
            const LAS unsigned char* B_ = lds + ((c) & 1) * K_BUF; const LAS unsigned char* F_ = lds + K_FR + ((c) & 1) * 4096 + lane * 16; \
            const bf16x8 sb0 = *(const LAS bf16x8*)(F_), sb1 = *(const LAS bf16x8*)(F_ + 1024), sb2 = *(const LAS bf16x8*)(F_ + 2048), sb3 = *(const LAS bf16x8*)(F_ + 3072); \
            f32x16 acc_; \
            if (wave < 2) {         \
                _Pragma("unroll") for (int g = 0; g < 4; ++g) { const u32x2 i0 = *(const LAS u32x2*)(B_ + K_HT + r32 * 144 + (wave * 32 + 8 * g + 4 * hi) * 2); \
                    acc_[4 * g] = bfl(i0.x); acc_[4 * g + 1] = bfh(i0.x); acc_[4 * g + 2] = bfl(i0.y); acc_[4 * g + 3] = bfh(i0.y); } \
                const LAS unsigned char* ag_ = B_ + K_GT + (wave * 32 + r32) * 144 + 8 * hi; \
                acc_ = __builtin_amdgcn_mfma_f32_32x32x16_bf16(rd_perm(ag_), sb0, acc_, 0, 0, 0); acc_ = __builtin_amdgcn_mfma_f32_32x32x16_bf16(rd_perm(ag_ + 32), sb1, acc_, 0, 0, 0); \
                acc_ = __builtin_amdgcn_mfma_f32_32x32x16_bf16(rd_perm(ag_ + 64), sb2, acc_, 0, 0, 0); acc_ = __builtin_amdgcn_mfma_f32_32x32x16_bf16(rd_perm(ag_ + 96), sb3, acc_, 0, 0, 0); \
                LAS unsigned char* FN_ = lds + K_FR + (((c) + 1) & 1) * 4096 + wave * 2048 + lane * 16; \
                *(LAS bf16x8*)(FN_) = pack8(acc_, 0); *(LAS bf16x8*)(FN_ + 1024) = pack8(acc_, 1); \
            } else {                \
                _Pragma("unroll") for (int g = 0; g < 4; ++g) { const u32x2 iy = *(const LAS u32x2*)(B_ + K_YL + r32 * 80 + (8 * g + 4 * hi) * 2); \
                    acc_[4 * g] = bfl(iy.x); acc_[4 * g + 1] = bfh(iy.x); acc_[4 * g + 2] = bfl(iy.y); acc_[4 * g + 3] = bfh(iy.y); } \
                const LAS unsigned char* aq_ = B_ + K_QT + r32 * 144 + 8 * hi; \
                acc_ = __builtin_amdgcn_mfma_f32_32x32x16_bf16(rd_perm(aq_), sb0, acc_, 0, 0, 0); acc_ = __builtin_amdgcn_mfma_f32_32x32x16_bf16(rd_perm(aq_ + 32), sb1, acc_, 0, 0, 0); \
                acc_ = __builtin_amdgcn_mfma_f32_32x32x16_bf16(rd_perm(aq_ + 64), sb2, acc_, 0, 0, 0); acc_ = __builtin_amdgcn_mfma_f32_32x32x16_bf16(rd_perm(aq_ + 96), sb3, acc_, 0, 0, 0); \
                bf16_t* yp = yout + (size_t)(c) * CH * RW; \
                _Pragma("unroll") for (int q = 0; q < 16; ++q) yp[(size_t)crow(q, hi) * RW] = (bf16_t)cvtpk(acc_[q], acc_[q]); \
            } \
        } \
        CS_BAR(); } while (0)
    CH_LD(sA, 0); CH_LD(sB, 1); CH_LD(sC, 2);
    CH_WR(sA, 0); CH_LD(sA, 3);
    CS_BAR();
#pragma unroll 1
    for (int c3 = 0; c3 < NCH + 2; c3 += 3) { CH_STEP(c3, sB); CH_STEP(c3 + 1, sC); CH_STEP(c3 + 2, sA); }
#undef CH_STEP
#undef CH_LD
#undef CH_LD1
#undef CH_WR
}
__device__ __forceinline__ void chain_phase(const Ctx& C, LAS unsigned char* lds, int G, int bx, int tid, int lane, int wave) {
    const int v0 = (G % 8 == 0) ? (bx % 8) * (G / 8) + bx / 8 : bx;
    for (int v = v0; v < 256; v += G) chain_unit(C, lds, v, tid, lane, wave);
}
#undef CS_BAR
#undef CS_MF
}

struct Frame { LAS unsigned char* lds; int tid, lane, wave, G, bx; };

__device__ __forceinline__ void p0_prologue(const Ctx& C, const Frame& F) {
    {
        LAS float* sc = (LAS float*)F.lds;
        LAS float* red = (LAS float*)(F.lds + 65536);
        for (int i = F.tid; i < NB * DM; i += NTHR) { const float cv = C.c[i]; sc[i] = cv / (1.f + __expf(-cv)); }
        __syncthreads();
        float* mod = (float*)(C.ws + WS_MOD);
        for (int cb = F.bx; cb < 6 * DM / 24; cb += F.G) {
            const int n0 = cb * 24;
            if (F.tid < 384) {
                const int kg = F.tid / 24, j = F.tid % 24;
                float acc[NB];
#pragma unroll
                for (int b = 0; b < NB; ++b) acc[b] = 0.f;
                for (int k = kg; k < DM; k += 16) { const float w = C.w_ada[(size_t)k * 6 * DM + n0 + j];
#pragma unroll
                    for (int b = 0; b < NB; ++b) acc[b] += sc[b * DM + k] * w; }
#pragma unroll
                for (int b = 0; b < NB; ++b) red[(kg * NB + b) * 24 + j] = acc[b];
            }
            __syncthreads();
            if (F.tid < 384) { const int b = F.tid / 24, j = F.tid % 24; float s = C.b_ada[n0 + j];
#pragma unroll
                for (int kg = 0; kg < 16; ++kg) s += red[(kg * NB + b) * 24 + j];
                mod[b * 6 * DM + n0 + j] = s; }
            __syncthreads();
        }
    }
    for (int o = F.bx * NTHR + F.tid; o < T * 16; o += F.G * NTHR) {
        const int t = o >> 4, i = o & 15;
        const float inv = powf(10000.0f, -(float)(2 * i) / 32.0f);
        float s, c; sincosf((float)C.pos[t] * inv, &s, &c);
        ((float2*)(C.ws + WS_ROPE))[o] = make_float2(c, s);
    }
    for (int o = F.bx * NTHR + F.tid; o < 48 * DM; o += F.G * NTHR) {
        const int j = o & 7, ln = (o >> 3) & 63, pc = o >> 9, nb = pc % 3, ks = pc / 3;
        const int n = 16 * nb + (ln & 15), k = 32 * ks + 8 * (ln >> 4) + j;
        const float w = n < NG ? C.w_rg[k * NG + n] : (n < NG + NE ? C.w_re[k * NE + (n - NG)] : 0.f);
        const bf16_t hi = f2bf(w);
        ((bf16_t*)(C.ws + WS_W + WO_RH))[o] = hi; ((bf16_t*)(C.ws + WS_W + WO_RL))[o] = f2bf(w - bf2f(hi));
    }
    __syncthreads();
    {
        LAS float* scr = (LAS float*)(F.lds + F.wave * 16384);
        unsigned* sbm = (unsigned*)(C.ws + WS_CTL + CTL_SBMAX);
        const int gw = F.bx * NWAVES + F.wave, NGW = F.G * NWAVES;
        float va[32], vb[32];
        TrItem da, db;
        int it = gw;
        if (it < TR_NITEMS) { da = tr_desc(C, it); tr_load(da, va, F.lane); }
        for (; it < TR_NITEMS; it += 2 * NGW) {
            const bool hb = it + NGW < TR_NITEMS;
            if (hb) { db = tr_desc(C, it + NGW); tr_load(db, vb, F.lane); }
            if (it < TR_I_IN) tr_absmax(da, va, sbm, F.lane); else tr_store(da, va, scr, F.lane);
            if (hb) {
                if (it + 2 * NGW < TR_NITEMS) { da = tr_desc(C, it + 2 * NGW); tr_load(da, va, F.lane); }
                if (it + NGW < TR_I_IN) tr_absmax(db, vb, sbm, F.lane); else tr_store(db, vb, scr, F.lane);
            }
        }
    }
}

__device__ __forceinline__ void p1_modulate(const Ctx& C, const Frame& F) {
    const float* mod = (const float*)(C.ws + WS_MOD);
    unsigned char* h1 = (unsigned char*)(C.ws + WS_H);
    float* sa = (float*)(C.ws + WS_CTL + CTL_SA);
    const int lane = F.lane;
    {
        LAS float* scr = (LAS float*)(F.lds + F.wave * 16384);
        const unsigned* sbm = (const unsigned*)(C.ws + WS_CTL + CTL_SBMAX);
        float va[32];
        for (int it = F.bx * NWAVES + F.wave; it < TR_I_IN; it += F.G * NWAVES) { const TrItem da = tr_desc(C, it); tr_load(da, va, lane); tr_store_q8(da, va, sbm, scr, lane); }
    }
    for (int row0 = (F.bx * NWAVES + F.wave) * 4; row0 < T; row0 += F.G * NWAVES * 4) {
        const int b = row0 / SEQ;
        float4 v[4][4]; float ss[4];
#pragma unroll
        for (int r = 0; r < 4; ++r) { const float4* xr = (const float4*)(C.x + (size_t)(row0 + r) * DM);
#pragma unroll
            for (int j = 0; j < 4; ++j) v[r][j] = xr[lane + 64 * j]; }
#pragma unroll
        for (int r = 0; r < 4; ++r) { float a = 0.f;
#pragma unroll
            for (int j = 0; j < 4; ++j) a += v[r][j].x * v[r][j].x + v[r][j].y * v[r][j].y + v[r][j].z * v[r][j].z + v[r][j].w * v[r][j].w;
            ss[r] = a; }
#pragma unroll
        for (int r = 0; r < 4; ++r) ss[r] = rsqrtf(wsum_dpp(ss[r]) * (1.f / DM) + RMS_EPS);
        float am[4] = {0.f, 0.f, 0.f, 0.f};
#pragma unroll
        for (int j = 0; j < 4; ++j) {
            const int col = 4 * (lane + 64 * j);
            const float4 g = *(const float4*)(C.g_pre_mix + col);
            const float4 sh = *(const float4*)(mod + b * 6 * DM + col), sc = *(const float4*)(mod + b * 6 * DM + DM + col);
            const float m0 = g.x * (1.f + sc.x), m1 = g.y * (1.f + sc.y), m2 = g.z * (1.f + sc.z), m3 = g.w * (1.f + sc.w);
#pragma unroll
            for (int r = 0; r < 4; ++r) { const float rs = ss[r];
                v[r][j].x = v[r][j].x * rs * m0 + sh.x; v[r][j].y = v[r][j].y * rs * m1 + sh.y; v[r][j].z = v[r][j].z * rs * m2 + sh.z; v[r][j].w = v[r][j].w * rs * m3 + sh.w;
                am[r] = fmaxf(fmaxf(am[r], fmaxf(fabsf(v[r][j].x), fabsf(v[r][j].y))), fmaxf(fabsf(v[r][j].z), fabsf(v[r][j].w))); }
        }
#pragma unroll
        for (int r = 0; r < 4; ++r) { am[r] = wmax_dpp(am[r]);
            const float inv = am[r] > 0.f ? 127.f / am[r] : 0.f;
            if (lane == 0) sa[row0 + r] = am[r] * (1.f / 127.f);
#pragma unroll
            for (int j = 0; j < 4; ++j) *(unsigned*)(h1 + (size_t)(row0 + r) * DM + 4 * (lane + 64 * j)) = q8pack(v[r][j].x * inv, v[r][j].y * inv, v[r][j].z * inv, v[r][j].w * inv); }
    }
}

__device__ __forceinline__ void d_post_mix(const Ctx& C, int G, int bx, int tid, int lane, int wave, LAS unsigned char* lds, bool dry) {
    const float* mod = (const float*)(C.ws + WS_MOD); const bf16_t* ym = (const bf16_t*)(C.ws + WS_YMIX);
    bf16_t* h2 = (bf16_t*)(C.ws + WS_H); bf16_t* x1b = (bf16_t*)(C.ws + WS_X1B);
    const bf16_t* wrh = (const bf16_t*)(C.ws + WS_W + WO_RH); const bf16_t* wrl = (const bf16_t*)(C.ws + WS_W + WO_RL);
    float* tokw = (float*)(C.ws + WS_ROUTE);
    unsigned* gcnt = (unsigned*)(C.ws + WS_CTL) + CW_GCNT;
    int* list = (int*)(C.ws + WS_LIST);
    LAS int* le = (LAS int*)lds; LAS float* lg = (LAS float*)(lds + 1024) + wave * 16 * 48;
    LAS unsigned char* lw = lds + 25600;
    for (int q = 0; q < 16; ++q) { const int idx = wave * 16 + q, hl = idx & 1, nb = (idx >> 1) & 1, ks = idx >> 2;
        __builtin_amdgcn_global_load_lds((const unsigned*)((hl ? wrl : wrh) + (ks * 3 + nb) * 512 + lane * 8), (LAS unsigned*)(lw + idx * 1024), 16, 0, 0); }
    for (int grp = bx; grp < T / 128; grp += G) {
      const int r0 = grp * 128 + wave * 16;
      for (int rr = 0; rr < 16; rr += 4) {
        const int row = r0 + rr;
        const int b = row / SEQ; const float* mb = mod + b * 6 * DM;
        float4 yq[4][4], xq[4][4]; float rs[4], rs2[4];
#pragma unroll
        for (int u = 0; u < 4; ++u)
#pragma unroll
            for (int j = 0; j < 4; ++j) { const u32x2 yw = *(const u32x2*)(ym + (size_t)(row + u) * DM + 4 * (lane + 64 * j));
                yq[u][j] = make_float4(__uint_as_float(yw.x << 16), __uint_as_float(yw.x & 0xffff0000u), __uint_as_float(yw.y << 16), __uint_as_float(yw.y & 0xffff0000u)); xq[u][j] = *(const float4*)(C.x + (size_t)(row + u) * DM + 4 * (lane + 64 * j)); }
#pragma unroll
        for (int u = 0; u < 4; ++u) { float a = 0.f;
#pragma unroll
            for (int j = 0; j < 4; ++j) a += yq[u][j].x * yq[u][j].x + yq[u][j].y * yq[u][j].y + yq[u][j].z * yq[u][j].z + yq[u][j].w * yq[u][j].w;
            rs[u] = a; }
#pragma unroll
        for (int u = 0; u < 4; ++u) rs[u] = rsqrtf(wsum_dpp(rs[u]) * (1.f / DM) + RMS_EPS);
#pragma unroll
        for (int u = 0; u < 4; ++u) rs2[u] = 0.f;
#pragma unroll
        for (int j = 0; j < 4; ++j) { const int col = 4 * (lane + 64 * j);
            const float4 g1 = *(const float4*)(mb + 2 * DM + col), gp = *(const float4*)(C.g_post_mix + col);
            const float m0 = g1.x * gp.x, m1 = g1.y * gp.y, m2 = g1.z * gp.z, m3 = g1.w * gp.w;
#pragma unroll
            for (int u = 0; u < 4; ++u) { float4 x1 = xq[u][j];
                x1.x += m0 * (yq[u][j].x * rs[u]); x1.y += m1 * (yq[u][j].y * rs[u]); x1.z += m2 * (yq[u][j].z * rs[u]); x1.w += m3 * (yq[u][j].w * rs[u]);
                xq[u][j] = x1; rs2[u] += x1.x * x1.x + x1.y * x1.y + x1.z * x1.z + x1.w * x1.w;
                u32x2 xw; xw.x = cvtpk(x1.x, x1.y); xw.y = cvtpk(x1.z, x1.w); *(u32x2*)(x1b + (size_t)(row + u) * DM + col) = xw; } }
#pragma unroll
        for (int u = 0; u < 4; ++u) rs2[u] = rsqrtf(wsum_dpp(rs2[u]) * (1.f / DM) + RMS_EPS);
#pragma unroll
        for (int j = 0; j < 4; ++j) { const int col = 4 * (lane + 64 * j);
            const float4 gf = *(const float4*)(C.g_pre_ffn + col), sc = *(const float4*)(mb + 4 * DM + col), sh = *(const float4*)(mb + 3 * DM + col);
            const float m0 = gf.x * (1.f + sc.x), m1 = gf.y * (1.f + sc.y), m2 = gf.z * (1.f + sc.z), m3 = gf.w * (1.f + sc.w);
#pragma unroll
            for (int u = 0; u < 4; ++u) {
                const float h0 = xq[u][j].x * rs2[u] * m0 + sh.x, h1 = xq[u][j].y * rs2[u] * m1 + sh.y, h2_ = xq[u][j].z * rs2[u] * m2 + sh.z, h3 = xq[u][j].w * rs2[u] * m3 + sh.w;
                u32x2 wh; wh.x = cvtpk(h0, h1); wh.y = cvtpk(h2_, h3);
                *(u32x2*)(h2 + (size_t)(row + u) * DM + col) = wh; } }
      }
      asm volatile("s_waitcnt vmcnt(0)" ::: "memory");
      __syncthreads();
      {
        f32x4 acc0 = {0.f, 0.f, 0.f, 0.f}, acc1 = acc0, acc2 = acc0;
        const int fr = lane & 15, fq = lane >> 4;
        const bf16_t* ah = h2 + (size_t)(r0 + fr) * DM + 8 * fq;
        const bf16_t* bh = wrh + lane * 8; const bf16_t* bl = wrl + lane * 8;
#pragma unroll 8
        for (int ks = 0; ks < 32; ++ks) {
            const bf16x8 a_h = *(const bf16x8*)(ah + 32 * ks);
            const LAS unsigned char* lp = lw + ks * 4096 + lane * 16;
            const bf16x8 b0h = *(const LAS bf16x8*)(lp), b0l = *(const LAS bf16x8*)(lp + 1024), b1h = *(const LAS bf16x8*)(lp + 2048), b1l = *(const LAS bf16x8*)(lp + 3072);
            const bf16x8 b2h = *(const bf16x8*)(bh + ks * 1536 + 1024), b2l = *(const bf16x8*)(bl + ks * 1536 + 1024);
            acc0 = __builtin_amdgcn_mfma_f32_16x16x32_bf16(a_h, b0h, acc0, 0, 0, 0); acc0 = __builtin_amdgcn_mfma_f32_16x16x32_bf16(a_h, b0l, acc0, 0, 0, 0);
            acc1 = __builtin_amdgcn_mfma_f32_16x16x32_bf16(a_h, b1h, acc1, 0, 0, 0); acc1 = __builtin_amdgcn_mfma_f32_16x16x32_bf16(a_h, b1l, acc1, 0, 0, 0);
            acc2 = __builtin_amdgcn_mfma_f32_16x16x32_bf16(a_h, b2h, acc2, 0, 0, 0); acc2 = __builtin_amdgcn_mfma_f32_16x16x32_bf16(a_h, b2l, acc2, 0, 0, 0);
        }
#pragma unroll
        for (int e = 0; e < 4; ++e) { lg[(4 * fq + e) * 48 + fr] = acc0[e]; lg[(4 * fq + e) * 48 + 16 + fr] = acc1[e]; lg[(4 * fq + e) * 48 + 32 + fr] = acc2[e]; }
      }
      asm volatile("s_waitcnt lgkmcnt(0)" ::: "memory");
      if (lane < 16) {
            float gl[NG], el[NE];
#pragma unroll
            for (int c = 0; c < NG; ++c) gl[c] = lg[lane * 48 + c] + C.b_rg[c];
#pragma unroll
            for (int c = 0; c < NE; ++c) el[c] = lg[lane * 48 + NG + c] + C.b_re[c];
            int gs = 0; float gm = gl[0];
#pragma unroll
            for (int c = 1; c < NG; ++c) if (gl[c] > gm) { gm = gl[c]; gs = c; }
            float den = 0.f;
#pragma unroll
            for (int c = 0; c < NG; ++c) den += __expf(gl[c] - gm);
            const float psel = 1.f / den;
            float eg[EPG];
#pragma unroll
            for (int c = 0; c < EPG; ++c) eg[c] = gs == 0 ? el[c] : (gs == 1 ? el[EPG + c] : (gs == 2 ? el[2 * EPG + c] : el[3 * EPG + c]));
            int i0 = 0; float v0 = eg[0];
#pragma unroll
            for (int c = 1; c < EPG; ++c) if (eg[c] > v0) { v0 = eg[c]; i0 = c; }
            int i1 = -1; float v1 = -INFINITY;
#pragma unroll
            for (int c = 0; c < EPG; ++c) if (c != i0 && eg[c] > v1) { v1 = eg[c]; i1 = c; }
            const float e1 = __expf(v1 - v0), w0 = 1.f / (1.f + e1), w1 = e1 / (1.f + e1);
            le[(wave * 16 + lane) * 2] = gs * EPG + i0; le[(wave * 16 + lane) * 2 + 1] = gs * EPG + i1;
            *(float2*)(tokw + (size_t)(r0 + lane) * 2) = make_float2(psel * w0, psel * w1);
      }
      __syncthreads();
      if (tid < NE && !dry) {
          int cnt = 0;
          for (int k = 0; k < 256; ++k) cnt += (le[k] == tid) ? 1 : 0;
          if (cnt) { const unsigned base = __hip_atomic_fetch_add(gcnt + tid, (unsigned)cnt, __ATOMIC_RELAXED, __HIP_MEMORY_SCOPE_AGENT);
              int j = 0;
              for (int k = 0; k < 256; ++k) if (le[k] == tid) { list[(size_t)tid * T + base + j] = grp * 256 + k; ++j; } }
      }
      __syncthreads();
    }
}
template <int NPN, bool BAL = false>
__device__ __forceinline__ pg8::MoeTab moe_setup(const Ctx& C, int G, int bx, int tid, __attribute__((address_space(3))) int* ctl) {
    const unsigned* gcnt = (const unsigned*)(C.ws + WS_CTL) + CW_GCNT;
    const int* list = (const int*)(C.ws + WS_LIST);
    __syncthreads();
    if (tid == 0) { int acc = 0; for (int e = 0; e < NE; ++e) { const int c = (int)__hip_atomic_load(gcnt + e, __ATOMIC_RELAXED, __HIP_MEMORY_SCOPE_AGENT); ctl[64 + e] = c; ctl[e] = acc; acc += (c + 255) >> 8; } ctl[NE] = acc; }
    __syncthreads();
    if (tid < pg8::MOE_MAXU) {
        const int total = ctl[NE] * NPN; long L = (long)tid * G + bx;
        if constexpr (BAL) { const int s_ = (ctl[NE] * 2) % G;
            constexpr int SK = MOE_SKIP;
            if (s_ > 0) { if (bx >= s_) L = tid < SK ? (long)tid * (G - s_) + (bx - s_) : (long)SK * (G - s_) + (long)(tid - SK) * G + (bx - s_);
                          else L = (long)SK * (G - s_) + (long)tid * G + (G - s_ + bx); } }
        int* d = nullptr; (void)d;
        if (L < total) { const int pn = (int)(L % NPN), rt = (int)(L / NPN); int e = 0;
            for (int q = 1; q < NE; ++q) if (ctl[q] <= rt) e = q;
            const int m = rt - ctl[e]; int nv = ctl[64 + e] - m * 256; nv = nv > 256 ? 256 : nv;
            ctl[128 + tid * 8 + 0] = e; ctl[128 + tid * 8 + 1] = m; ctl[128 + tid * 8 + 2] = pn; ctl[128 + tid * 8 + 3] = nv; ctl[128 + tid * 8 + 4] = rt * 256; ctl[128 + tid * 8 + 5] = 1; }
        else ctl[128 + tid * 8 + 5] = 0;
    }
    __syncthreads();
    for (int i = 0; i < pg8::MOE_MAXU; ++i) {
        if (ctl[128 + i * 8 + 5] && tid < 256) { const int e = ctl[128 + i * 8 + 0], m = ctl[128 + i * 8 + 1], nv = ctl[128 + i * 8 + 3];
            const int r = tid < nv ? tid : nv - 1;
            ctl[256 + i * 256 + tid] = list[(size_t)e * T + m * 256 + r]; }
    }
    __syncthreads();
    pg8::MoeTab tb; tb.desc = ctl + 128; tb.rowtab = ctl + 256; return tb;
}
__device__ __forceinline__ void d_final(const Ctx& C, int gw, int ngw, int lane) {
    const float* mod = (const float*)(C.ws + WS_MOD); const bf16_t* ys = (const bf16_t*)(C.ws + WS_YSLOT); const bf16_t* x1b = (const bf16_t*)(C.ws + WS_X1B);
    for (int row0 = gw * 4; row0 < T; row0 += ngw * 4) {
        const int b = row0 / SEQ; const float* mb = mod + b * 6 * DM;
        u32x2 ya[4][4], yb[4][4]; float4 x1[4][4]; float rs[4];
#pragma unroll
        for (int r = 0; r < 4; ++r)
#pragma unroll
            for (int j = 0; j < 4; ++j) { const int col = 4 * (lane + 64 * j);
                ya[r][j] = *(const u32x2*)(ys + (size_t)(row0 + r) * 2 * DM + col); yb[r][j] = *(const u32x2*)(ys + (size_t)(row0 + r) * 2 * DM + DM + col);
                { const u32x2 xw = *(const u32x2*)(x1b + (size_t)(row0 + r) * DM + col); x1[r][j] = make_float4(__uint_as_float(xw.x << 16), __uint_as_float(xw.x & 0xffff0000u), __uint_as_float(xw.y << 16), __uint_as_float(xw.y & 0xffff0000u)); } }
        float yv[4][16];
#pragma unroll
        for (int r = 0; r < 4; ++r) { float a = 0.f;
#pragma unroll
            for (int j = 0; j < 4; ++j) {
                yv[r][4 * j] = __uint_as_float(ya[r][j].x << 16) + __uint_as_float(yb[r][j].x << 16); yv[r][4 * j + 1] = __uint_as_float(ya[r][j].x & 0xffff0000u) + __uint_as_float(yb[r][j].x & 0xffff0000u);
                yv[r][4 * j + 2] = __uint_as_float(ya[r][j].y << 16) + __uint_as_float(yb[r][j].y << 16); yv[r][4 * j + 3] = __uint_as_float(ya[r][j].y & 0xffff0000u) + __uint_as_float(yb[r][j].y & 0xffff0000u);
                a += yv[r][4 * j] * yv[r][4 * j] + yv[r][4 * j + 1] * yv[r][4 * j + 1] + yv[r][4 * j + 2] * yv[r][4 * j + 2] + yv[r][4 * j + 3] * yv[r][4 * j + 3]; }
            rs[r] = a; }
#pragma unroll
        for (int r = 0; r < 4; ++r) rs[r] = rsqrtf(wsum_dpp(rs[r]) * (1.f / DM) + RMS_EPS);
#pragma unroll
        for (int j = 0; j < 4; ++j) { const int col = 4 * (lane + 64 * j);
            const float4 g = *(const float4*)(C.g_post_ffn + col), g2 = *(const float4*)(mb + 5 * DM + col);
            const float m0 = g.x * g2.x, m1 = g.y * g2.y, m2 = g.z * g2.z, m3 = g.w * g2.w;
#pragma unroll
            for (int r = 0; r < 4; ++r) { float4 o = x1[r][j];
                o.x += m0 * (yv[r][4 * j] * rs[r]); o.y += m1 * (yv[r][4 * j + 1] * rs[r]); o.z += m2 * (yv[r][4 * j + 2] * rs[r]); o.w += m3 * (yv[r][4 * j + 3] * rs[r]);
                *(float4*)(C.out + (size_t)(row0 + r) * DM + col) = o; } }
    }
}

#define XB_TMO      128
#define XB_XCNT(j)  (256  + 64 * (j))
#define XB_XSUB(j)  (1280 + 64 * (j))
#define XB_XGEN(j)  (2304 + 64 * (j))
#define XB_TOP      3328
#define XB_TOPGEN   3392
#define XCD_BAR_WORDS 3456
#define XB_SPIN_CAP (1u << 18)
__device__ __forceinline__ unsigned xb_ld(unsigned* p)              { return __hip_atomic_load(p, __ATOMIC_RELAXED, __HIP_MEMORY_SCOPE_AGENT); }
__device__ __forceinline__ unsigned xb_add(unsigned* p, unsigned v) { return __hip_atomic_fetch_add(p, v, __ATOMIC_RELAXED, __HIP_MEMORY_SCOPE_AGENT); }
__device__ __forceinline__ unsigned xb_xcc_id() { return (unsigned)__builtin_amdgcn_s_getreg((3 << 11) | 20) & 0xFu; }
#define XB_SPIN(cond, bar) do { unsigned _sp = 0; while (cond) { __builtin_amdgcn_s_sleep(1); \
    if ((++_sp & 255u) == 0u) { if (xb_ld(&(bar)[XB_TMO])) break; if (_sp > XB_SPIN_CAP) { atomicAdd(&(bar)[XB_TMO], 1u); break; } } } } while (0)
struct XcdBarrier { unsigned* bar; unsigned x; volatile LAS unsigned* st; };
__device__ __forceinline__ XcdBarrier xcd_barrier_post(unsigned* bar, volatile LAS unsigned* st) {
    XcdBarrier b; b.bar = bar; b.x = xb_xcc_id(); b.st = st;
    if (threadIdx.x == 0) (void)xb_add(&bar[XB_XCNT(b.x)], 1u);
    return b;
}
__device__ __forceinline__ void xcd_barrier_complete(unsigned* bar, unsigned x, unsigned& nloc, unsigned& nx) {
    const unsigned G = gridDim.x * gridDim.y * gridDim.z;
    unsigned sum, cnt, mine, sp = 0u;
    for (;;) {
        sum = 0u; cnt = 0u; mine = 0u;
#pragma unroll
        for (unsigned j = 0; j < 16; ++j) { const unsigned c = xb_ld(&bar[XB_XCNT(j)]); sum += c; cnt += (c > 0u) ? 1u : 0u; mine = (j == x) ? c : mine; }
        if (sum == G) break;
        __builtin_amdgcn_s_sleep(1);
        if ((++sp & 255u) == 0u) { if (xb_ld(&bar[XB_TMO])) break; if (sp > XB_SPIN_CAP) { atomicAdd(&bar[XB_TMO], 1u); break; } }
    }
    nloc = mine > 0u ? mine : 1u; nx = cnt > 0u ? cnt : 1u;
}
__device__ __forceinline__ void xcd_barrier(const XcdBarrier& b) {
    asm volatile("s_waitcnt vmcnt(0)" ::: "memory");
    __syncthreads();
    if (threadIdx.x == 0) {
        unsigned* bar = b.bar;
        __builtin_amdgcn_s_waitcnt(0);
        unsigned nloc = b.st[0], nx = b.st[1];
        if (nloc == 0u) { xcd_barrier_complete(bar, b.x, nloc, nx); b.st[0] = nloc; b.st[1] = nx; }
        const unsigned old = xb_add(&bar[XB_XSUB(b.x)], 1u);
        const unsigned gen = old / nloc;
        if (old + 1u == (gen + 1u) * nloc) {
            __builtin_amdgcn_fence(__ATOMIC_RELEASE, "agent");
            asm volatile("s_waitcnt vmcnt(0)" ::: "memory");
            const unsigned og = xb_add(&bar[XB_TOP], 1u);
            const unsigned tg = og / nx;
            if (og + 1u == (tg + 1u) * nx) xb_add(&bar[XB_TOPGEN], 1u);
            else XB_SPIN(xb_ld(&bar[XB_TOPGEN]) == tg, bar);
            __builtin_amdgcn_fence(__ATOMIC_ACQUIRE, "agent");
            xb_add(&bar[XB_XGEN(b.x)], 1u);
            asm volatile("s_waitcnt vmcnt(0)" ::: "memory");
        } else {
            XB_SPIN(xb_ld(&bar[XB_XGEN(b.x)]) == gen, bar);
            __builtin_amdgcn_fence(__ATOMIC_ACQUIRE, "agent");
            asm volatile("s_waitcnt vmcnt(0)" ::: "memory");
        }
    }
    __syncthreads();
}

struct Args { Ctx C; int ph_lo, ph_hi, sub, breg; };
__global__ void __launch_bounds__(NTHR, 2) mk(Args args) {
    extern __shared__ __attribute__((aligned(16))) unsigned char lds_raw[];
    const Ctx& C = args.C;
    Frame F; F.lds = (LAS unsigned char*)lds_raw; F.tid = threadIdx.x; F.lane = F.tid & 63; F.wave = __builtin_amdgcn_readfirstlane(F.tid >> 6); F.G = gridDim.x; F.bx = blockIdx.x;
    const int lo = args.ph_lo, hi = args.ph_hi;
    volatile LAS unsigned* xbw = (volatile LAS unsigned*)(F.lds + LDS_BYTES - 16);
    if (F.tid < 4) xbw[F.tid] = 0u;
    __syncthreads();
    unsigned* barw = (unsigned*)(C.ws + WS_CTL) + args.breg * XCD_BAR_WORDS;
    XcdBarrier bar; bar.bar = barw; bar.x = 0; bar.st = xbw;
    if (hi - lo > 1) bar = xcd_barrier_post(barw, xbw);
#define IN(k) (lo <= (k) && (k) < hi)
#define SEAM(k) do { if (IN(k) && IN((k) + 1)) xcd_barrier(bar); } while (0)
    if (IN(0)) { p0_prologue(C, F); }
    SEAM(0);
    if (IN(1)) { p1_modulate(C, F); }
    SEAM(1);
    if (IN(2)) {
        pg8::Dense P{(const bf16_t*)(C.ws + WS_H), (const bf16_t*)(C.ws + WS_W + WO_IN), DM / 2, DM / 2, DM / 2};
        pg8::StaticOrder S; S.init(T, 4608, F.G, F.bx);
        pg8::EpiZ E{(bf16_t*)(C.ws + WS_ZM), (bf16_t*)(C.ws + WS_RKV), (bf16_t*)(C.ws + WS_ZL), (bf16_t*)C.out, (const float*)(C.ws + WS_CTL + CTL_SA), (const unsigned*)(C.ws + WS_CTL + CTL_SBMAX)};
        pg8::gemm_phase<true, true>(F.lds, P, S, E);
    }
    SEAM(2);
    if (IN(3)) { d_prep(C, F.bx * NWAVES + F.wave, F.G * NWAVES, F.lane); }
    SEAM(3);
    if (IN(4)) {
        const bf16_t* wb = (const bf16_t*)(C.ws + WS_W);
        {   pg8::Dense P{(const bf16_t*)(C.ws + WS_CQN), wb + WO_UQ / 2, QR, QR, QR};
            pg8::StaticOrder S; S.init(T, 768, F.G, F.bx);
            pg8::EpiQ E{(bf16_t*)(C.ws + WS_QF), (const float2*)(C.ws + WS_ROPE)};
            pg8::gemm_phase(F.lds, P, S, E); }
        {   rsg::DenseRS P{(const bf16_t*)(C.ws + WS_CKVN), wb + WO_UKV / 2, KVR, KVR, 512, F.G, F.bx};
            rsg::EpiKVrs E{(bf16_t*)(C.ws + WS_KF), (bf16_t*)(C.ws + WS_VF), F.G, F.bx};
            rsg::rs_gemm_phase<KVR / 16>(F.lds, P, E, F.tid, F.lane, F.wave); }
        {   const bf16_t* la = (const bf16_t*)(C.ws + WS_LORA); const bf16_t* lw = wb + WO_LORA / 2;
            {   rsg::DenseRS P{la, lw, 256, 256, 256, F.G, F.bx};
                rsg::EpiLoraRS<0> E{(bf16_t*)(C.ws + WS_EBUF), C.dec_bias, F.G, F.bx};
                rsg::rs_gemm_phase<DR / 16>(F.lds, P, E, F.tid, F.lane, F.wave); }
            {   rsg::DenseRS P{la + DR, lw + (size_t)512 * 256 + DR, 256, 256, 256, F.G, F.bx};
                rsg::EpiLoraRS<1> E{(bf16_t*)(C.ws + WS_AV), C.a_bias, F.G, F.bx};
                rsg::rs_gemm_phase<AR / 16>(F.lds, P, E, F.tid, F.lane, F.wave); }
            {   rsg::DenseRS P{la + DR + AR, lw + (size_t)1024 * 256 + DR + AR, 256, 256, 256, F.G, F.bx};
                rsg::EpiLoraRS<2> E{(bf16_t*)(C.ws + WS_G), nullptr, F.G, F.bx};
                rsg::rs_gemm_phase<GR / 16>(F.lds, P, E, F.tid, F.lane, F.wave); } }
    }
    SEAM(4);
    if (IN(5)) { att::attn_phase(C, F.lds, F.G, F.bx, F.tid, F.lane, F.wave); }
    SEAM(5);
    if (IN(6)) { cscan::phaseA(C, F.lds, F.G, F.bx, F.lane, F.wave); }
    SEAM(6);
    if (IN(7)) { cscan::chain_phase(C, F.lds, F.G, F.bx, F.tid, F.lane, F.wave); }
    SEAM(7);
    if (IN(8)) { d_rwkv_post(C, F.bx * NWAVES + F.wave, F.G * NWAVES, F.lane); }
    SEAM(8);
    if (IN(9)) {
        const bf16_t* wb = (const bf16_t*)(C.ws + WS_W);
        pg8::MixProb P{(const bf16_t*)(C.ws + WS_ATT), (const bf16_t*)(C.ws + WS_RWO), wb + WO_OM / 2, wb + WO_OR / 2, RW, RW, RW};
        pg8::StaticOrder S; S.init(T, DM, F.G, F.bx, 2);
        pg8::EpiMix E{(const bf16_t*)C.out, (bf16_t*)(C.ws + WS_MIXED), (unsigned*)(C.ws + WS_CTL) + CW_PFLAG};
        pg8::gemm_phase(F.lds, P, S, E);
    }
    if (IN(10)) {
        const bf16_t* wb = (const bf16_t*)(C.ws + WS_W);
        pg8::DenseSC P{(const bf16_t*)(C.ws + WS_MIXED), wb + WO_OUT / 2, DM, DM, DM};
        pg8::StaticOrderW S; S.so.init(T, DM, F.G, F.bx); S.flag = (unsigned*)(C.ws + WS_CTL) + CW_PFLAG; S.need = 4u;
        pg8::EpiOutF E{(bf16_t*)(C.ws + WS_YMIX)};
        pg8::gemm_phase(F.lds, P, S, E);
    }
    SEAM(10);
    if (IN(11)) { d_post_mix(C, F.G, F.bx, F.tid, F.lane, F.wave, F.lds, (args.sub & 4) != 0); }
    SEAM(11);
    if (IN(12)) {
        const pg8::MoeTab tb = moe_setup<2>(C, F.G, F.bx, F.tid, (LAS int*)(F.lds + LDSCTL_OFF));
        pg8::MoeProb1 P{(const bf16_t*)(C.ws + WS_H), (const bf16_t*)(C.ws + WS_W + WO_GU), tb, DM, DM, DM};
        pg8::MoeSched S{tb};
        pg8::EpiMoe1 E{(bf16_t*)(C.ws + WS_ACT), (const float*)(C.ws + WS_ROUTE), tb, (unsigned*)(C.ws + WS_CTL) + CW_RTFLAG};
        pg8::gemm_phase(F.lds, P, S, E);
    }
    if (IN(13)) {
        const pg8::MoeTab tb = moe_setup<4, true>(C, F.G, F.bx, F.tid, (LAS int*)(F.lds + LDSCTL_OFF));
        pg8::MoeProb2 P{(const bf16_t*)(C.ws + WS_ACT), (const bf16_t*)(C.ws + WS_W + WO_DN), tb, FF, FF, FF};
        pg8::MoeSched2 S{tb, (unsigned*)(C.ws + WS_CTL) + CW_RTFLAG};
        pg8::EpiMoe2 E{(bf16_t*)(C.ws + WS_YSLOT), tb};
        pg8::gemm_phase(F.lds, P, S, E);
    }
    SEAM(13);
    if (IN(14)) { d_final(C, F.bx * NWAVES + F.wave, F.G * NWAVES, F.lane); }
#undef IN
#undef SEAM
}

static int g_grid = 0;
static int g_breg = 0;
static void launch_mk(const Ctx& C, int lo, int hi, hipStream_t stream, int sub = 3) {
    Args a{}; a.C = C; a.ph_lo = lo; a.ph_hi = hi; a.sub = sub; a.breg = g_breg++;
    hipLaunchKernelGGL(mk, dim3(g_grid), dim3(NTHR), LDS_BYTES, stream, a);
}
extern "C" void kernel_launch(void* const* d_in, const int* in_sizes, int n_in, void* d_out, int out_size, void* d_ws, size_t ws_size, hipStream_t stream) {
    if (g_grid == 0) {
        int dev = 0, cus = 0; hipGetDevice(&dev); hipDeviceGetAttribute(&cus, hipDeviceAttributeMultiprocessorCount, dev);
        hipFuncSetAttribute((const void*)mk, hipFuncAttributeMaxDynamicSharedMemorySize, LDS_BYTES);
        g_grid = cus > 0 ? cus : 256;
    }
    Ctx C{};
    const float* const* f = (const float* const*)d_in;
    C.x = f[0]; C.c = f[1]; C.pos = (const int*)d_in[2];
    C.w_ada = f[3]; C.b_ada = f[4]; C.g_pre_mix = f[5]; C.g_post_mix = f[6]; C.g_pre_ffn = f[7]; C.g_post_ffn = f[8];
    C.w_in = f[9]; C.g_cq = f[10]; C.w_uq = f[11]; C.g_ckv = f[12]; C.w_ukv = f[13]; C.w_o_mla = f[14];
    C.mu = f[15]; C.w_dec = f[16]; C.dec_bias = f[17]; C.w_a = f[18]; C.a_bias = f[19]; C.w_g = f[20];
    C.k_k = f[21]; C.k_a = f[22]; C.r_k = f[23]; C.lnx_w = f[24]; C.lnx_b = f[25]; C.w_o_rwkv = f[26]; C.w_out = f[27];
    C.w_rg = f[28]; C.b_rg = f[29]; C.w_re = f[30]; C.b_re = f[31]; C.w_eg = f[32]; C.w_eu = f[33]; C.w_ed = f[34];
    C.out = (float*)d_out; C.ws = (unsigned char*)d_ws;

    g_breg = 0;
    hipMemsetAsync((char*)d_ws + WS_CTL, 0, CTL_ZERO_BYTES, stream);
    launch_mk(C, 0, 15, stream);
}
```

```cpp
#include <hip/hip_runtime.h>
#include <stdint.h>
#include <math.h>
#include <type_traits>

constexpr int NB = 16, SEQ = 2048, DM = 1024, T = NB * SEQ;
constexpr int NH = 8;
constexpr int QR = 384, KVR = 256, ROPE = 32, NOPE = 64, VD = 64, QK = NOPE + ROPE;
constexpr int RW = 512, DR = 64, AR = 64, GR = 128;
constexpr int MLA_IN = QR + KVR + ROPE;
constexpr int RWKV_IN = 3 * RW + DR + AR + GR;
constexpr int IN_W = MLA_IN + RWKV_IN + 2 * DM;
constexpr int NE = 32, EPG = 8, NG = 4, FF = 256;
constexpr float RMS_EPS = 1e-6f, GN_EPS = 64e-5f;
constexpr float QSCALE = 0.10206207261596577f * 1.4426950408889634f;

typedef unsigned short bf16_t;
__device__ __forceinline__ float bf2f(bf16_t h) { return __uint_as_float(((unsigned)h) << 16); }
__device__ __forceinline__ bf16_t f2bf(float f) { unsigned u = __float_as_uint(f); return (bf16_t)((u + 0x7fffu + ((u >> 16) & 1u)) >> 16); }
__device__ __forceinline__ float sigmoidf_(float x) { return 1.f / (1.f + __expf(-x)); }
typedef unsigned u32x2 __attribute__((ext_vector_type(2)));
typedef float f32x2_t __attribute__((ext_vector_type(2)));
typedef __bf16 bf16x2_t __attribute__((ext_vector_type(2)));
__device__ __forceinline__ unsigned cvtpk(float lo, float hi) { f32x2_t v = {lo, hi}; bf16x2_t b = __builtin_convertvector(v, bf16x2_t); return __builtin_bit_cast(unsigned, b); }
__device__ __forceinline__ float fsigmoid(float x) { return __builtin_amdgcn_rcpf(1.f + __expf(-x)); }
template <int CTRL> __device__ __forceinline__ float dpp_add_(float x) { return x + __builtin_bit_cast(float, __builtin_amdgcn_update_dpp(0, __builtin_bit_cast(int, x), CTRL, 0xf, 0xf, true)); }
template <int CTRL> __device__ __forceinline__ float dpp_max_(float x) { return fmaxf(x, __builtin_bit_cast(float, __builtin_amdgcn_update_dpp(0, __builtin_bit_cast(int, x), CTRL, 0xf, 0xf, true))); }
__device__ __forceinline__ float wmax_dpp(float x) {
    x = dpp_max_<0xB1>(x); x = dpp_max_<0x4E>(x); x = dpp_max_<0x141>(x); x = dpp_max_<0x140>(x);
    x = fmaxf(x, __builtin_bit_cast(float, __builtin_amdgcn_update_dpp(0, __builtin_bit_cast(int, x), 0x142, 0xa, 0xf, false)));
    x = fmaxf(x, __builtin_bit_cast(float, __builtin_amdgcn_update_dpp(0, __builtin_bit_cast(int, x), 0x143, 0xc, 0xf, false)));
    return __builtin_bit_cast(float, __builtin_amdgcn_readlane(__builtin_bit_cast(int, x), 63));
}
__device__ __forceinline__ unsigned q8pack(float a, float b, float c, float d) {
    const int i0 = (int)__builtin_rintf(a), i1 = (int)__builtin_rintf(b), i2 = (int)__builtin_rintf(c), i3 = (int)__builtin_rintf(d);
    return (unsigned)(i0 & 255) | ((unsigned)(i1 & 255) << 8) | ((unsigned)(i2 & 255) << 16) | ((unsigned)i3 << 24); }
__device__ __forceinline__ float wsum_dpp(float x) {
    x = dpp_add_<0xB1>(x); x = dpp_add_<0x4E>(x); x = dpp_add_<0x141>(x); x = dpp_add_<0x140>(x);
    x += __builtin_bit_cast(float, __builtin_amdgcn_update_dpp(0, __builtin_bit_cast(int, x), 0x142, 0xa, 0xf, false));
    x += __builtin_bit_cast(float, __builtin_amdgcn_update_dpp(0, __builtin_bit_cast(int, x), 0x143, 0xc, 0xf, false));
    return __builtin_bit_cast(float, __builtin_amdgcn_readlane(__builtin_bit_cast(int, x), 63));
}
__device__ __forceinline__ float sum8_dpp(float x) { x = dpp_add_<0xB1>(x); x = dpp_add_<0x4E>(x); x = dpp_add_<0x141>(x); return x; }
__device__ __forceinline__ float wave_sum(float v) {
#pragma unroll
    for (int o = 1; o < 64; o <<= 1) v += __shfl_xor(v, o);
    return v;
}

constexpr size_t MiB = 1u << 20;
constexpr size_t WS_MOD = 5 * MiB;
constexpr size_t WS_ROPE = 1 * MiB;
constexpr size_t WS_CTL = 0;
constexpr size_t CTL_ZERO_BYTES = 65536;
constexpr size_t CTL_SBMAX = 65536;
constexpr size_t CTL_SBGU = 98304;
constexpr size_t CTL_SA = 196608;
constexpr size_t CTL_SA2 = 327680;
constexpr size_t WS_H2Q = 392 * MiB;
constexpr int MOE_SKIP = 1;
constexpr int CW_PFLAG = 15744;
constexpr int CW_RTFLAG = 15424;
constexpr int CW_GCNT = 15360;
constexpr size_t WS_H = 8 * MiB;
constexpr size_t WS_QF = 8 * MiB;
constexpr size_t WS_RWO = 8 * MiB;
constexpr size_t WS_ZM = 72 * MiB;
constexpr size_t WS_VF = 72 * MiB;
constexpr size_t WS_EBUF = 104 * MiB;
constexpr size_t WS_MIXED = 72 * MiB;
constexpr size_t WS_ACT = 72 * MiB;
constexpr size_t WS_ZL = 120 * MiB;
constexpr size_t WS_AV = 136 * MiB;
constexpr size_t WS_G = 168 * MiB;
constexpr size_t WS_Y = 200 * MiB;
constexpr size_t WS_YMIX = 136 * MiB;
constexpr size_t WS_CQN = 232 * MiB;
constexpr size_t WS_CKVN = 256 * MiB;
constexpr size_t WS_LORA = 272 * MiB;
constexpr size_t WS_ATT = 264 * MiB;
constexpr size_t WS_YSLOT = 264 * MiB;
constexpr size_t WS_H2LO = 264 * MiB;
constexpr size_t WS_X1B = 200 * MiB;
constexpr size_t WS_CGT = 8 * MiB, WS_CQT = 72 * MiB, WS_CHT = 200 * MiB, WS_CYL = 392 * MiB, WS_Y2 = 104 * MiB;
constexpr size_t WS_RKV = 296 * MiB;
constexpr size_t WS_KF = 392 * MiB;
constexpr size_t WS_MIX1 = 296 * MiB;
constexpr size_t WS_BONUS = 440 * MiB;
constexpr size_t WS_ROUTE = 442 * MiB;
constexpr size_t WS_LIST = 444 * MiB;
constexpr size_t WS_W = 448 * MiB;
constexpr size_t WS_QRAW = 448 * MiB;

struct Ctx {
    const float *x, *c; const int* pos;
    const float *w_ada, *b_ada, *g_pre_mix, *g_post_mix, *g_pre_ffn, *g_post_ffn;
    const float *w_in, *g_cq, *w_uq, *g_ckv, *w_ukv, *w_o_mla;
    const float *mu, *w_dec, *dec_bias, *w_a, *a_bias, *w_g, *k_k, *k_a, *r_k, *lnx_w, *lnx_b, *w_o_rwkv, *w_out;
    const float *w_rg, *b_rg, *w_re, *b_re, *w_eg, *w_eu, *w_ed;
    float* out; unsigned char* ws;
};

__device__ __forceinline__ void d_prep(const Ctx& C, int gw, int ngw, int lane) {
    typedef unsigned u32x4_ __attribute__((ext_vector_type(4)));
    const bf16_t* zm = (const bf16_t*)(C.ws + WS_ZM); const bf16_t* zl = (const bf16_t*)(C.ws + WS_ZL);
    bf16_t* cqn = (bf16_t*)(C.ws + WS_CQN); bf16_t* ckvn = (bf16_t*)(C.ws + WS_CKVN); bf16_t* lora = (bf16_t*)(C.ws + WS_LORA);
    bf16_t* kf = (bf16_t*)(C.ws + WS_KF);
    const float2* rope = (const float2*)(C.ws + WS_ROPE);
#define UNPK8(W_, F_) do { F_[0] = __uint_as_float(W_[0] << 16); F_[1] = __uint_as_float(W_[0] & 0xffff0000u); F_[2] = __uint_as_float(W_[1] << 16); F_[3] = __uint_as_float(W_[1] & 0xffff0000u); \
        F_[4] = __uint_as_float(W_[2] << 16); F_[5] = __uint_as_float(W_[2] & 0xffff0000u); F_[6] = __uint_as_float(W_[3] << 16); F_[7] = __uint_as_float(W_[3] & 0xffff0000u); } while (0)
    const int l48 = lane < 48 ? lane : 47, l32 = lane < 32 ? lane : 31;
    const float4 gq0 = *(const float4*)(C.g_cq + 8 * l48), gq1 = *(const float4*)(C.g_cq + 8 * l48 + 4);
    const float4 gk0 = *(const float4*)(C.g_ckv + 8 * l32), gk1 = *(const float4*)(C.g_ckv + 8 * l32 + 4);
    const int cmu = 3 * RW / 8 + l32;
    const float4 mu0 = *(const float4*)(C.mu + 8 * cmu), mu1 = *(const float4*)(C.mu + 8 * cmu + 4);
    const unsigned mq = lane < 48 ? 0xffffffffu : 0u, mk = lane < 32 ? 0xffffffffu : 0u;
    for (int t0 = gw * 4; t0 < T; t0 += ngw * 4) {
        const int b = t0 / SEQ, s0 = t0 % SEQ;
        u32x4_ wq[4], wk[4], wz[5]; unsigned rpa[4], rpb[4]; float4 rcc[4];
        const int i2r = (lane & 7) * 2;
#pragma unroll
        for (int r = 0; r < 4; ++r) { const bf16_t* zrow = zm + (size_t)(t0 + r) * 768;
            wq[r] = __builtin_nontemporal_load((const u32x4_*)(zrow + 8 * l48)); wk[r] = __builtin_nontemporal_load((const u32x4_*)(zrow + QR + 8 * l32));
            rpa[r] = *(const unsigned*)(zrow + QR + KVR + i2r); rpb[r] = *(const unsigned*)(zrow + QR + KVR + 16 + i2r);
            rcc[r] = *(const float4*)(rope + (size_t)(t0 + r) * 16 + i2r); }
#pragma unroll
        for (int r = 0; r < 5; ++r) { const int tr = t0 + r - 1; wz[r] = __builtin_nontemporal_load((const u32x4_*)(zl + (size_t)(tr < 0 ? 0 : tr) * 256 + 8 * l32)); }
        __builtin_amdgcn_sched_barrier(0);
#pragma unroll
        for (int r = 0; r < 4; ++r) { wq[r] = wq[r] & (u32x4_){mq, mq, mq, mq}; wk[r] = wk[r] & (u32x4_){mk, mk, mk, mk}; }
#pragma unroll
        for (int r = 0; r < 5; ++r) { const unsigned mz = (lane < 32 && (r > 0 || s0 > 0)) ? 0xffffffffu : 0u; wz[r] = wz[r] & (u32x4_){mz, mz, mz, mz}; }
        float rs1[4], rs2[4];
#pragma unroll
        for (int r = 0; r < 4; ++r) { float v[8], u[8]; UNPK8(wq[r], v); UNPK8(wk[r], u); float ss = 0.f, su = 0.f;
#pragma unroll
            for (int e = 0; e < 8; ++e) { ss += v[e] * v[e]; su += u[e] * u[e]; }
            rs1[r] = ss; rs2[r] = su; }
#pragma unroll
        for (int r = 0; r < 4; ++r) { rs1[r] = rsqrtf(wsum_dpp(rs1[r]) * (1.f / QR) + RMS_EPS); rs2[r] = rsqrtf(wsum_dpp(rs2[r]) * (1.f / KVR) + RMS_EPS); }
        if (lane < 48) { const float4 g0 = gq0, g1 = gq1;
#pragma unroll
            for (int r = 0; r < 4; ++r) { float v[8]; UNPK8(wq[r], v); const float q = rs1[r];
                u32x4_ o; o.x = cvtpk(v[0] * q * g0.x, v[1] * q * g0.y); o.y = cvtpk(v[2] * q * g0.z, v[3] * q * g0.w); o.z = cvtpk(v[4] * q * g1.x, v[5] * q * g1.y); o.w = cvtpk(v[6] * q * g1.z, v[7] * q * g1.w);
                *(u32x4_*)(cqn + (size_t)(t0 + r) * QR + 8 * lane) = o; } }
        if (lane < 32) { const float4 g0 = gk0, g1 = gk1;
#pragma unroll
            for (int r = 0; r < 4; ++r) { float u[8]; UNPK8(wk[r], u); const float q = rs2[r];
                u32x4_ o; o.x = cvtpk(u[0] * q * g0.x, u[1] * q * g0.y); o.y = cvtpk(u[2] * q * g0.z, u[3] * q * g0.w); o.z = cvtpk(u[4] * q * g1.x, u[5] * q * g1.y); o.w = cvtpk(u[6] * q * g1.z, u[7] * q * g1.w);
                *(u32x4_*)(ckvn + (size_t)(t0 + r) * KVR + 8 * lane) = o; } }
        {   const int h = lane >> 3, i2 = (lane & 7) * 2;
#pragma unroll
            for (int r = 0; r < 4; ++r) {
                const unsigned pa = rpa[r], pb = rpb[r];
                const float x1a = __uint_as_float(pa << 16), x1b = __uint_as_float(pa & 0xffff0000u), x2a = __uint_as_float(pb << 16), x2b = __uint_as_float(pb & 0xffff0000u);
                const float4 cc = rcc[r];
                u32x2 o; o.x = cvtpk(x1a * cc.x - x2a * cc.y, x2a * cc.x + x1a * cc.y); o.y = cvtpk(x1b * cc.z - x2b * cc.w, x2b * cc.z + x1b * cc.w);
                *(u32x2*)(kf + (((size_t)b * NH + h) * SEQ + (s0 + r)) * QK + NOPE + 2 * i2) = o; } }
        if (lane < 32) {
            const int c = 3 * RW / 8 + lane;
            const float4 m0 = mu0, m1 = mu1;
            const float mm[8] = {m0.x, m0.y, m0.z, m0.w, m1.x, m1.y, m1.z, m1.w};
            float p[8]; UNPK8(wz[0], p);
#pragma unroll
            for (int r = 0; r < 4; ++r) {
                float z[8]; UNPK8(wz[r + 1], z);
                float zs[8];
#pragma unroll
                for (int e = 0; e < 8; ++e) { zs[e] = z[e] + (p[e] - z[e]) * mm[e]; p[e] = z[e]; }
                if (c < (3 * RW + DR) / 8) {
#pragma unroll
                    for (int e = 0; e < 8; ++e) { const float ex = __expf(2.f * zs[e]); zs[e] = 1.f - 2.f * __builtin_amdgcn_rcpf(ex + 1.f); } }
                else if (c >= (3 * RW + DR + AR) / 8) {
#pragma unroll
                    for (int e = 0; e < 8; ++e) zs[e] = fsigmoid(zs[e]); }
                u32x4_ o; o.x = cvtpk(zs[0], zs[1]); o.y = cvtpk(zs[2], zs[3]); o.z = cvtpk(zs[4], zs[5]); o.w = cvtpk(zs[6], zs[7]);
                *(u32x4_*)(lora + (size_t)(t0 + r) * 256 + 8 * lane) = o;
            }
        }
    }
#undef UNPK8
}

__device__ __forceinline__ void d_rwkv_post(const Ctx& C, int gw, int ngw, int lane) {
    typedef unsigned u32x4_ __attribute__((ext_vector_type(4)));
    const bf16_t* y = (const bf16_t*)(C.ws + WS_Y2); const float* bonus = (const float*)(C.ws + WS_BONUS);
    const bf16_t* rkv = (const bf16_t*)(C.ws + WS_RKV); const bf16_t* g = (const bf16_t*)(C.ws + WS_G);
    bf16_t* rwo = (bf16_t*)(C.ws + WS_RWO);
    const int c0 = 8 * lane, h = lane >> 3;
    const float4 lw0 = *(const float4*)(C.lnx_w + c0), lw1 = *(const float4*)(C.lnx_w + c0 + 4), lb0 = *(const float4*)(C.lnx_b + c0), lb1 = *(const float4*)(C.lnx_b + c0 + 4);
    const float lw[8] = {lw0.x, lw0.y, lw0.z, lw0.w, lw1.x, lw1.y, lw1.z, lw1.w}, lb[8] = {lb0.x, lb0.y, lb0.z, lb0.w, lb1.x, lb1.y, lb1.z, lb1.w};
    const float4 mv0 = *(const float4*)(C.mu + 2 * RW + c0), mv1 = *(const float4*)(C.mu + 2 * RW + c0 + 4);
    const float mv[8] = {mv0.x, mv0.y, mv0.z, mv0.w, mv1.x, mv1.y, mv1.z, mv1.w};
    for (int t0 = gw * 4; t0 < T; t0 += ngw * 4) {
        float4 ya[4], yb[4]; u32x4_ vv[4], gg[4]; float bn[4];
        u32x4_ vprev = (t0 % SEQ) ? *(const u32x4_*)(rkv + (size_t)(t0 - 1) * 1536 + 1024 + c0) : (u32x4_){0u, 0u, 0u, 0u};
#pragma unroll
        for (int r = 0; r < 4; ++r) { const size_t t = t0 + r;
            { const u32x4_ yw = *(const u32x4_*)(y + t * RW + c0);
              ya[r] = make_float4(__uint_as_float(yw[0] << 16), __uint_as_float(yw[0] & 0xffff0000u), __uint_as_float(yw[1] << 16), __uint_as_float(yw[1] & 0xffff0000u));
              yb[r] = make_float4(__uint_as_float(yw[2] << 16), __uint_as_float(yw[2] & 0xffff0000u), __uint_as_float(yw[3] << 16), __uint_as_float(yw[3] & 0xffff0000u)); }
            vv[r] = *(const u32x4_*)(rkv + t * 1536 + 1024 + c0); gg[r] = *(const u32x4_*)(g + t * RW + c0); bn[r] = bonus[t * NH + h]; }
#pragma unroll
        for (int r = 0; r < 4; ++r) {
            const float yv[8] = {ya[r].x, ya[r].y, ya[r].z, ya[r].w, yb[r].x, yb[r].y, yb[r].z, yb[r].w};
            float sm = 0.f;
#pragma unroll
            for (int e = 0; e < 8; ++e) sm += yv[e];
            const float mean = sum8_dpp(sm) * (1.f / 64.f);
            float sq = 0.f;
#pragma unroll
            for (int e = 0; e < 8; ++e) { const float d = yv[e] - mean; sq += d * d; }
            const float rstd = rsqrtf(sum8_dpp(sq) * (1.f / 64.f) + GN_EPS);
            float o[8];
#pragma unroll
            for (int e = 0; e < 4; ++e) {
                const unsigned pw = r == 0 ? vprev[e] : vv[r - 1][e];
                const float z0 = __uint_as_float(vv[r][e] << 16), z1 = __uint_as_float(vv[r][e] & 0xffff0000u), p0 = __uint_as_float(pw << 16), p1 = __uint_as_float(pw & 0xffff0000u);
                const unsigned sw = cvtpk(z0 + (p0 - z0) * mv[2 * e], z1 + (p1 - z1) * mv[2 * e + 1]);
                const float v0 = __uint_as_float(sw << 16), v1 = __uint_as_float(sw & 0xffff0000u), g0 = __uint_as_float(gg[r][e] << 16), g1 = __uint_as_float(gg[r][e] & 0xffff0000u);
                o[2 * e] = ((yv[2 * e] - mean) * rstd * lw[2 * e] + lb[2 * e] + bn[r] * v0) * g0;
                o[2 * e + 1] = ((yv[2 * e + 1] - mean) * rstd * lw[2 * e + 1] + lb[2 * e + 1] + bn[r] * v1) * g1; }
            u32x4_ w; w.x = cvtpk(o[0], o[1]); w.y = cvtpk(o[2], o[3]); w.z = cvtpk(o[4], o[5]); w.w = cvtpk(o[6], o[7]);
            *(u32x4_*)(rwo + (size_t)(t0 + r) * RW + c0) = w;
        }
    }
}

#define LAS __attribute__((address_space(3)))
typedef short bf16x8 __attribute__((ext_vector_type(8)));
typedef float f32x4 __attribute__((ext_vector_type(4)));
typedef int i32x4 __attribute__((ext_vector_type(4)));
typedef float f32x16 __attribute__((ext_vector_type(16)));
typedef unsigned u32x4 __attribute__((ext_vector_type(4)));

constexpr int NWAVES = 8, NTHR = NWAVES * 64;
constexpr int RING_BYTES = 131072;
constexpr int LDSCTL_OFF = RING_BYTES;
constexpr int LDS_BYTES = 163840;

namespace pg8 {
constexpr int BM = 256, BK = 64, HALF = 128, HTB = HALF * BK * 2, NXCD = 8, WGM = 8;
__host__ __device__ __forceinline__ int lds_byte(int r, int c) { const int st = (r >> 4) * 2 + (c >> 5), rr = r & 15, cc = c & 31, ob = rr * 64 + cc * 2; return st * 1024 + (ob ^ (((ob >> 9) & 1) << 5)); }
__host__ __device__ __forceinline__ void stage_rc(int b, int& R, int& C) { const int st = b / 1024, sb = b % 1024, swz = sb ^ (((sb >> 9) & 1) << 5); R = (st >> 1) * 16 + swz / 64; C = (st & 1) * 32 + (swz % 64) / 2; }
__host__ __device__ __forceinline__ int perm32(int rho) { const int n = rho >> 4, i = rho & 15; return 8 * (i >> 2) + 4 * n + (i & 3); }

struct Unit { int pm, pn, z; };

struct StaticOrder {
    int nM, nN, nwg, G, c, parts;
    __device__ void init(int M, int N, int G_, int c_, int parts_ = 1) { nM = M / BM; nN = N / BM; nwg = nM * nN; G = G_; c = c_; parts = parts_; }
    __device__ bool next(int i, Unit& u) const {
        const int it = i / parts; u.z = i - it * parts;
        const long L = (long)it * G + c; if (L >= nwg) return false;
        int wgid = (int)L; { const int q = nwg / NXCD, r = nwg % NXCD, xcd = wgid % NXCD, off = wgid / NXCD; wgid = (xcd < r ? xcd * (q + 1) : r * (q + 1) + (xcd - r) * q) + off; }
        const int nig = WGM * nN, gid = wgid / nig, fm = gid * WGM, gsz = (nM - fm) < WGM ? (nM - fm) : WGM;
        u.pm = fm + ((wgid % nig) % gsz); u.pn = (wgid % nig) / gsz; return true;
    }
};
struct Dense { static constexpr bool GATHER = false; const bf16_t* A; const bf16_t* Bt; int lda, ldb, K;
    __device__ __forceinline__ unsigned a_off(const Unit&, int R) const { return (unsigned)(R * lda) * 2u; }
    __device__ __forceinline__ const char* a_ptr(const Unit& u) const { return (const char*)(A + (size_t)u.pm * BM * lda); }
    __device__ __forceinline__ const char* b_ptr(const Unit& u) const { return (const char*)(Bt + (size_t)u.pn * BM * ldb); } };

template <class T, class = void> struct has_signal : std::false_type {};
template <class T> struct has_signal<T, std::void_t<decltype(T::SIGNAL)>> : std::true_type {};
template <class T, class = void> struct a_aux { static constexpr int value = 0; };
template <class T> struct a_aux<T, std::void_t<decltype(T::A_AUX)>> { static constexpr int value = T::A_AUX; };
template <bool ALIGN_EPI = true, bool I8 = false, class Epi, class Prob, class Sched>
__device__ __forceinline__ void gemm_phase(LAS unsigned char* lds, const Prob& P, const Sched& S, const Epi& E) {
    const int tid = threadIdx.x, wid = __builtin_amdgcn_readfirstlane(tid >> 6), lane = tid & 63, wr = wid >> 2, wc = wid & 3, fr = lane & 15, fq = lane >> 4;
    const int K = P.K, nt = K / BK;
    unsigned voffB[2]; int RA[2], CA[2];
#pragma unroll
    for (int i = 0; i < 2; ++i) { int R, C; stage_rc(tid * 16 + i * 8192, R, C); const int Rb = Epi::PERM ? ((R & ~31) + perm32(R & 31)) : R;
        RA[i] = R; CA[i] = C * 2; voffB[i] = (unsigned)(Rb * P.ldb + C) * 2u; }
    unsigned vAc[2][2], vAn[2][2];
#define PG8_FILLA(v, u) do { _Pragma("unroll") for (int h_ = 0; h_ < 2; ++h_) _Pragma("unroll") for (int i_ = 0; i_ < 2; ++i_) v[h_][i_] = P.a_off(u, RA[i_] + h_ * HALF) + (unsigned)CA[i_]; } while (0)
    const size_t kstep = (size_t)(BK * 2);
    const size_t hstepB = (size_t)HALF * P.ldb * 2;
    const unsigned ldsw = (unsigned)wid * 1024u;
    const int aoff = lds_byte(wr * 64 + fr, fq * 8), boff = lds_byte(wc * 32 + fr, fq * 8);
#define PG8_SA(b, h) (((b) * 2 + (h)) * HTB)
#define PG8_SB(b, h) ((4 + (b) * 2 + (h)) * HTB)
#define PG8_STAGE(bufoff, gbase, voff) do { _Pragma("unroll") for (int _i = 0; _i < 2; ++_i) \
        __builtin_amdgcn_global_load_lds((const unsigned*)((const char*)(gbase) + (voff)[_i]), (LAS unsigned*)(lds + (bufoff) + ldsw + _i * 8192), 16, 0, 0); } while (0)
#define PG8_STAGEA(bufoff, gbase, voff) do { _Pragma("unroll") for (int _i = 0; _i < 2; ++_i) \
        __builtin_amdgcn_global_load_lds((const unsigned*)((const char*)(gbase) + (voff)[_i]), (LAS unsigned*)(lds + (bufoff) + ldsw + _i * 8192), 16, 0, a_aux<Prob>::value); } while (0)
#define PG8_LDA(dst, b, h) do { _Pragma("unroll") for (int m = 0; m < 4; ++m) _Pragma("unroll") for (int k = 0; k < 2; ++k) dst[m][k] = *(const LAS bf16x8*)(lds + PG8_SA(b, h) + aoff + m * 2048 + k * 1024); } while (0)
#define PG8_LDB(dst, b, h) do { _Pragma("unroll") for (int n = 0; n < 2; ++n) _Pragma("unroll") for (int k = 0; k < 2; ++k) dst[n][k] = *(const LAS bf16x8*)(lds + PG8_SB(b, h) + boff + n * 2048 + k * 1024); } while (0)
#define PG8_MMA(ai, bj, At, Bt) do { __builtin_amdgcn_s_setprio(1); _Pragma("unroll") for (int m = 0; m < 4; ++m) _Pragma("unroll") for (int n = 0; n < 2; ++n) _Pragma("unroll") for (int k = 0; k < 2; ++k) \
        { if constexpr (I8) acc[ai][bj][m][n] = __builtin_bit_cast(f32x4, __builtin_amdgcn_mfma_i32_16x16x64_i8(__builtin_bit_cast(i32x4, Bt[n][k]), __builtin_bit_cast(i32x4, At[m][k]), __builtin_bit_cast(i32x4, acc[ai][bj][m][n]), 0, 0, 0)); \
          else acc[ai][bj][m][n] = __builtin_amdgcn_mfma_f32_16x16x32_bf16(Bt[n][k], At[m][k], acc[ai][bj][m][n], 0, 0, 0); } __builtin_amdgcn_s_setprio(0); } while (0)
#define PG8_WAIT_V(n) asm volatile("s_waitcnt vmcnt(" #n ")" ::: "memory")
#define PG8_WAIT_L(n) asm volatile("s_waitcnt lgkmcnt(" #n ")" ::: "memory")
#define PG8_BAR __builtin_amdgcn_s_barrier()
#define PG8_SCHED __builtin_amdgcn_sched_barrier(0)
    Unit cur, nxt; int ui = 0;
    if (!S.next(0, cur)) return;
    f32x4 acc[2][2][4][2];
#pragma unroll
    for (int a = 0; a < 2; ++a)
#pragma unroll
        for (int b = 0; b < 2; ++b)
#pragma unroll
            for (int m = 0; m < 4; ++m)
#pragma unroll
                for (int n = 0; n < 2; ++n) acc[a][b][m][n] = (f32x4){0.f, 0.f, 0.f, 0.f};
    bf16x8 At[4][2], B0[2][2], B1[2][2];
    const char* cA = P.a_ptr(cur); const char* cB = P.b_ptr(cur);
    PG8_FILLA(vAc, cur);
    PG8_STAGE(PG8_SB(0, 0), cB, voffB); PG8_STAGE(PG8_SB(0, 1), cB + hstepB, voffB); PG8_STAGEA(PG8_SA(0, 0), cA, vAc[0]); PG8_STAGEA(PG8_SA(0, 1), cA, vAc[1]);
    if (wr == 1) PG8_BAR;
    PG8_WAIT_V(2); PG8_BAR;
    PG8_STAGE(PG8_SB(1, 0), cB + kstep, voffB); PG8_STAGEA(PG8_SA(1, 0), cA + kstep, vAc[0]); PG8_STAGE(PG8_SB(1, 1), cB + hstepB + kstep, voffB);
    PG8_WAIT_V(6); PG8_BAR;
    for (;;) {
        const bool has_next = S.next(ui + 1, nxt);
        const char* nA = has_next ? P.a_ptr(nxt) : cA; const char* nB = has_next ? P.b_ptr(nxt) : cB;
        if (Prob::GATHER && has_next) { PG8_FILLA(vAn, nxt); }
        else {
#pragma unroll
            for (int h_ = 0; h_ < 2; ++h_)
#pragma unroll
                for (int i_ = 0; i_ < 2; ++i_) vAn[h_][i_] = vAc[h_][i_]; }
        for (int t = 0; t < nt; t += 2) {
            const bool last = (t == nt - 2);
            const char* a1 = cA + (size_t)(t + 1) * kstep;
            const char* a2 = last ? nA : cA + (size_t)(t + 2) * kstep; const char* b2 = last ? nB : cB + (size_t)(t + 2) * kstep;
            const char* a3 = a2 + kstep; const char* b3 = b2 + kstep;
            unsigned vA2[2][2];
#pragma unroll
            for (int h_ = 0; h_ < 2; ++h_)
#pragma unroll
                for (int i_ = 0; i_ < 2; ++i_) vA2[h_][i_] = (Prob::GATHER && last) ? vAn[h_][i_] : vAc[h_][i_];
            PG8_LDB(B0, 0, 0); PG8_LDB(B1, 0, 1); PG8_SCHED; PG8_LDA(At, 0, 0); PG8_STAGEA(PG8_SA(1, 1), a1, vAc[1]);
            PG8_WAIT_V(8); PG8_WAIT_L(0); PG8_BAR; PG8_MMA(0, 0, At, B0); PG8_MMA(0, 1, At, B1); PG8_BAR; PG8_SCHED;
            PG8_LDA(At, 0, 1); PG8_STAGE(PG8_SB(0, 0), b2, voffB); PG8_STAGE(PG8_SB(0, 1), b2 + hstepB, voffB); PG8_STAGEA(PG8_SA(0, 0), a2, vA2[0]);
            PG8_WAIT_V(8); PG8_WAIT_L(0); PG8_BAR; PG8_MMA(1, 0, At, B0); PG8_MMA(1, 1, At, B1); PG8_BAR; PG8_SCHED;
            PG8_LDB(B0, 1, 0); PG8_LDB(B1, 1, 1); PG8_SCHED; PG8_LDA(At, 1, 0); PG8_STAGEA(PG8_SA(0, 1), a2, vA2[1]);
            PG8_WAIT_V(8); PG8_WAIT_L(0); PG8_BAR; PG8_MMA(0, 0, At, B0); PG8_MMA(0, 1, At, B1); PG8_BAR; PG8_SCHED;
            PG8_LDA(At, 1, 1); PG8_STAGE(PG8_SB(1, 0), b3, voffB); PG8_STAGE(PG8_SB(1, 1), b3 + hstepB, voffB); PG8_STAGEA(PG8_SA(1, 0), a3, vA2[0]);
            PG8_WAIT_V(8); PG8_WAIT_L(0); PG8_BAR; PG8_MMA(1, 0, At, B0); PG8_MMA(1, 1, At, B1); PG8_BAR; PG8_SCHED;
        }
        if constexpr (ALIGN_EPI) { if (wr == 0) PG8_BAR; }
        if constexpr (I8) {
#pragma unroll
            for (int a = 0; a < 2; ++a)
#pragma unroll
                for (int b = 0; b < 2; ++b)
#pragma unroll
                    for (int m = 0; m < 4; ++m)
#pragma unroll
                        for (int n = 0; n < 2; ++n) acc[a][b][m][n] = __builtin_convertvector(__builtin_bit_cast(i32x4, acc[a][b][m][n]), f32x4); }
        E(acc, cur, wr, wc, fr, fq);
        if constexpr (has_signal<Epi>::value) { if (E.sig_now(cur)) { PG8_WAIT_V(0); PG8_BAR; if (tid == 0) E.signal(cur); } }
        if (!has_next) break;
        if (!E.keep(cur)) {
#pragma unroll
            for (int a = 0; a < 2; ++a)
#pragma unroll
                for (int b = 0; b < 2; ++b)
#pragma unroll
                    for (int m = 0; m < 4; ++m)
#pragma unroll
                        for (int n = 0; n < 2; ++n) acc[a][b][m][n] = (f32x4){0.f, 0.f, 0.f, 0.f};
        }
        cur = nxt; cA = nA; cB = nB; ++ui;
#pragma unroll
        for (int h_ = 0; h_ < 2; ++h_)
#pragma unroll
            for (int i_ = 0; i_ < 2; ++i_) vAc[h_][i_] = vAn[h_][i_];
        if constexpr (ALIGN_EPI) { if (wr == 1) PG8_BAR; }
    }
    PG8_WAIT_V(0);
    if constexpr (!ALIGN_EPI) { if (wr == 0) PG8_BAR; }
    PG8_BAR;
#undef PG8_FILLA
#undef PG8_SA
#undef PG8_SB
#undef PG8_STAGE
#undef PG8_STAGEA
#undef PG8_LDA
#undef PG8_LDB
#undef PG8_MMA
#undef PG8_WAIT_V
#undef PG8_WAIT_L
#undef PG8_BAR
#undef PG8_SCHED
}

struct EpiZ { static constexpr bool PERM = true; bf16_t *zm, *zrkv, *zl, *gates; const float* sa; const unsigned* sbmax;
    __device__ __forceinline__ bool keep(const Unit&) const { return false; }
    __device__ __forceinline__ void operator()(f32x4 (&acc)[2][2][4][2], const Unit& u, int wr, int wc, int fr, int fq) const {
        bf16_t* base; int ldc, colt; bool sig = false;
        if (u.pn < 3) { base = zm; ldc = 768; colt = u.pn * 256; } else if (u.pn < 9) { base = zrkv; ldc = 3 * RW; colt = (u.pn - 3) * 256; } else if (u.pn == 9) { base = zl; ldc = 256; colt = 0; } else { base = gates; ldc = 2048; colt = (u.pn - 10) * 256; sig = true; }
        const int row0 = u.pm * BM + wr * 64 + fr, col0 = colt + wc * 32 + 8 * fq;
        float sb[2][8];
#pragma unroll
        for (int bj = 0; bj < 2; ++bj) { const u32x4 q0 = *(const u32x4*)(sbmax + u.pn * BM + bj * HALF + wc * 32 + 8 * fq), q1 = *(const u32x4*)(sbmax + u.pn * BM + bj * HALF + wc * 32 + 8 * fq + 4);
#pragma unroll
            for (int e = 0; e < 4; ++e) { sb[bj][e] = __uint_as_float(q0[e]) * (1.f / 127.f); sb[bj][4 + e] = __uint_as_float(q1[e]) * (1.f / 127.f); } }
#pragma unroll
        for (int ai = 0; ai < 2; ++ai)
#pragma unroll
            for (int m = 0; m < 4; ++m) { bf16_t* rowp = base + (size_t)(row0 + ai * HALF + m * 16) * ldc + col0;
                const float sr_ = sa[row0 + ai * HALF + m * 16];
                if (sig) {
                    f32x4 a0 = acc[ai][0][m][0], a1 = acc[ai][0][m][1], b0 = acc[ai][1][m][0], b1 = acc[ai][1][m][1];
                    { const float sn = -1.4426950408889634f * sr_;
#pragma unroll
                    for (int e = 0; e < 4; ++e) {
                        const float ea0 = __builtin_amdgcn_exp2f(fminf(a0[e] * (sn * sb[0][e]), 58.f)), ea1 = __builtin_amdgcn_exp2f(fminf(a1[e] * (sn * sb[0][4 + e]), 58.f));
                        const float eb0 = __builtin_amdgcn_exp2f(fminf(b0[e] * (sn * sb[1][e]), 58.f)), eb1 = __builtin_amdgcn_exp2f(fminf(b1[e] * (sn * sb[1][4 + e]), 58.f));
                        const float pa0 = 1.f + ea0, pb0 = 1.f + eb0, pa1 = 1.f + ea1, pb1 = 1.f + eb1;
                        const float r0 = __builtin_amdgcn_rcpf(pa0 * pb0), r1 = __builtin_amdgcn_rcpf(pa1 * pb1);
                        a0[e] = pb0 * pb0 * r0; a1[e] = pb1 * pb1 * r1; b0[e] = pa0 * r0; b1[e] = pa1 * r1; } }
                    u32x4 wr_, wg_; wr_.x = cvtpk(a0[0], a0[1]); wr_.y = cvtpk(a0[2], a0[3]); wr_.z = cvtpk(a1[0], a1[1]); wr_.w = cvtpk(a1[2], a1[3]);
                    wg_.x = cvtpk(b0[0], b0[1]); wg_.y = cvtpk(b0[2], b0[3]); wg_.z = cvtpk(b1[0], b1[1]); wg_.w = cvtpk(b1[2], b1[3]);
                    __builtin_nontemporal_store(wr_, (u32x4*)rowp); __builtin_nontemporal_store(wg_, (u32x4*)(rowp + HALF));
                    continue; }
#pragma unroll
                for (int bj = 0; bj < 2; ++bj) { f32x4 v0 = acc[ai][bj][m][0], v1 = acc[ai][bj][m][1];
#pragma unroll
                    for (int e = 0; e < 4; ++e) { v0[e] *= sr_ * sb[bj][e]; v1[e] *= sr_ * sb[bj][4 + e]; }
                    u32x4 w; w.x = cvtpk(v0[0], v0[1]); w.y = cvtpk(v0[2], v0[3]); w.z = cvtpk(v1[0], v1[1]); w.w = cvtpk(v1[2], v1[3]);
                    __builtin_nontemporal_store(w, (u32x4*)(rowp + bj * HALF)); } }
    } };

struct EpiQ { static constexpr bool PERM = true; bf16_t* qf; const float2* rope;
    __device__ __forceinline__ bool keep(const Unit&) const { return false; }
    __device__ __forceinline__ void operator()(f32x4 (&acc)[2][2][4][2], const Unit& u, int wr, int wc, int fr, int fq) const {
#pragma unroll
        for (int bj = 0; bj < 2; ++bj) {
            const int c0 = u.pn * BM + bj * HALF + wc * 32 + 8 * fq, h = c0 / QK, d0 = c0 - h * QK;
            const bool rp = ((u.pn * 8 + bj * 4 + wc) % 3) == 2;
            float4 cw[2][4][2];
#pragma unroll
            for (int ai = 0; ai < 2; ++ai)
#pragma unroll
                for (int m = 0; m < 4; ++m) { cw[ai][m][0] = make_float4(1.f, 0.f, 1.f, 0.f); cw[ai][m][1] = make_float4(1.f, 0.f, 1.f, 0.f); }
            if (rp) { const int i0 = (d0 - NOPE) >> 1;
#pragma unroll
                for (int ai = 0; ai < 2; ++ai)
#pragma unroll
                    for (int m = 0; m < 4; ++m) { const int t = u.pm * BM + ai * HALF + wr * 64 + m * 16 + fr; const float4* cs4 = (const float4*)(rope + (size_t)t * 16 + i0);
                        cw[ai][m][0] = cs4[0]; cw[ai][m][1] = cs4[1]; } }
            __builtin_amdgcn_sched_barrier(0);
#pragma unroll
            for (int ai = 0; ai < 2; ++ai)
#pragma unroll
                for (int m = 0; m < 4; ++m) {
                    const int t = u.pm * BM + ai * HALF + wr * 64 + m * 16 + fr, b = t / SEQ, s_ = t - b * SEQ;
                    f32x4 v0 = acc[ai][bj][m][0], v1 = acc[ai][bj][m][1];
                    { const float4 ca = cw[ai][m][0], cb = cw[ai][m][1];
                        const f32x4 w0 = {v0[0] * ca.x - v0[1] * ca.y, v0[1] * ca.x + v0[0] * ca.y, v0[2] * ca.z - v0[3] * ca.w, v0[3] * ca.z + v0[2] * ca.w};
                        const f32x4 w1 = {v1[0] * cb.x - v1[1] * cb.y, v1[1] * cb.x + v1[0] * cb.y, v1[2] * cb.z - v1[3] * cb.w, v1[3] * cb.z + v1[2] * cb.w};
                        v0 = w0; v1 = w1; }
                    v0 = v0 * QSCALE; v1 = v1 * QSCALE;
                    u32x4 w; w.x = cvtpk(v0[0], v0[1]); w.y = cvtpk(v0[2], v0[3]); w.z = cvtpk(v1[0], v1[1]); w.w = cvtpk(v1[2], v1[3]);
                    *(u32x4*)(qf + (((size_t)b * NH + h) * SEQ + s_) * QK + d0) = w; } }
    } };
struct EpiKVp { static constexpr bool PERM = true; bf16_t *kf, *vf;
    __device__ __forceinline__ bool keep(const Unit&) const { return false; }
    __device__ __forceinline__ void operator()(f32x4 (&acc)[2][2][4][2], const Unit& u, int wr, int wc, int fr, int fq) const {
#pragma unroll
        for (int bj = 0; bj < 2; ++bj) {
            const int c0 = u.pn * BM + bj * HALF + wc * 32 + 8 * fq, h = c0 >> 7, c = c0 & 127;
#pragma unroll
            for (int ai = 0; ai < 2; ++ai)
#pragma unroll
                for (int m = 0; m < 4; ++m) {
                    const int t = u.pm * BM + ai * HALF + wr * 64 + m * 16 + fr, b = t / SEQ, s_ = t - b * SEQ;
                    const f32x4 v0 = acc[ai][bj][m][0], v1 = acc[ai][bj][m][1];
                    u32x4 w; w.x = cvtpk(v0[0], v0[1]); w.y = cvtpk(v0[2], v0[3]); w.z = cvtpk(v1[0], v1[1]); w.w = cvtpk(v1[2], v1[3]);
                    const size_t rowi = ((size_t)b * NH + h) * SEQ + s_;
                    if (c < 64) *(u32x4*)(kf + rowi * QK + c) = w; else *(u32x4*)(vf + rowi * VD + (c - 64)) = w; } }
    } };
struct EpiLora { static constexpr bool PERM = true; bf16_t *eb; const float *dbias, *abias;
    __device__ __forceinline__ bool keep(const Unit&) const { return false; }
    __device__ __forceinline__ void operator()(f32x4 (&acc)[2][2][4][2], const Unit& u, int wr, int wc, int fr, int fq) const {
        const int kind = u.pn >> 1; bf16_t* base = eb + (size_t)kind * ((size_t)T * RW);
        const float* bp = kind == 0 ? dbias : abias;
#pragma unroll
        for (int bj = 0; bj < 2; ++bj) {
            const int c0 = (u.pn & 1) * BM + bj * HALF + wc * 32 + 8 * fq;
            float bs[8];
#pragma unroll
            for (int e = 0; e < 8; ++e) bs[e] = kind < 2 ? bp[c0 + e] : 0.f;
#pragma unroll
            for (int ai = 0; ai < 2; ++ai)
#pragma unroll
                for (int m = 0; m < 4; ++m) {
                    const int t = u.pm * BM + ai * HALF + wr * 64 + m * 16 + fr;
                    float v[8];
#pragma unroll
                    for (int e = 0; e < 4; ++e) { v[e] = acc[ai][bj][m][0][e] + bs[e]; v[4 + e] = acc[ai][bj][m][1][e] + bs[4 + e]; }
                    if (kind == 0) {
#pragma unroll
                        for (int e = 0; e < 8; ++e) v[e] = 0.60653065971263342f * fsigmoid(v[e]); }
                    else if (kind == 1) {
#pragma unroll
                        for (int e = 0; e < 8; ++e) v[e] = fsigmoid(v[e]); }
                    u32x4 w; w.x = cvtpk(v[0], v[1]); w.y = cvtpk(v[2], v[3]); w.z = cvtpk(v[4], v[5]); w.w = cvtpk(v[6], v[7]);
                    *(u32x4*)(base + (size_t)t * RW + c0) = w; } }
    } };
struct DenseSC { static constexpr bool GATHER = false; static constexpr int A_AUX = 16; const bf16_t* A; const bf16_t* Bt; int lda, ldb, K;
    __device__ __forceinline__ unsigned a_off(const Unit&, int R) const { return (unsigned)(R * lda) * 2u; }
    __device__ __forceinline__ const char* a_ptr(const Unit& u) const { return (const char*)(A + (size_t)u.pm * BM * lda); }
    __device__ __forceinline__ const char* b_ptr(const Unit& u) const { return (const char*)(Bt + (size_t)u.pn * BM * ldb); } };
struct StaticOrderW { StaticOrder so; unsigned* flag; unsigned need;
    __device__ bool next(int i, Unit& u) const { if (!so.next(i, u)) return false;
        unsigned* f = flag + u.pm;
        for (unsigned sp = 0; __hip_atomic_load(f, __ATOMIC_RELAXED, __HIP_MEMORY_SCOPE_AGENT) < need && sp < (1u << 20); ++sp) __builtin_amdgcn_s_sleep(2);
        asm volatile("" ::: "memory");
        return true; } };
struct MixProb { static constexpr bool GATHER = false; const bf16_t *A0, *A1, *B0, *B1; int lda, ldb, K;
    __device__ __forceinline__ unsigned a_off(const Unit&, int R) const { return (unsigned)(R * lda) * 2u; }
    __device__ __forceinline__ const char* a_ptr(const Unit& u) const { return (const char*)((u.z ? A1 : A0) + (size_t)u.pm * BM * lda); }
    __device__ __forceinline__ const char* b_ptr(const Unit& u) const { return (const char*)((u.z ? B1 : B0) + (size_t)u.pn * BM * ldb); } };
struct EpiMix { static constexpr bool PERM = true; static constexpr bool SIGNAL = true; const bf16_t* gates; bf16_t* mixed; unsigned* flag;
    __device__ __forceinline__ bool keep(const Unit& u) const { return u.z == 0; }
    __device__ __forceinline__ bool sig_now(const Unit& u) const { return u.z != 0; }
    __device__ __forceinline__ void signal(const Unit& u) const { __hip_atomic_fetch_add(flag + u.pm, 1u, __ATOMIC_RELAXED, __HIP_MEMORY_SCOPE_AGENT); }
    __device__ __forceinline__ void operator()(f32x4 (&acc)[2][2][4][2], const Unit& u, int wr, int wc, int fr, int fq) const {
        u32x4 gw[2][2][4];
        const bf16_t* gp = gates + (size_t)(u.pm * BM + wr * 64 + fr) * 2048 + (2 * u.pn) * 256 + wc * 32 + 8 * fq + (u.z ? HALF : 0);
#pragma unroll
        for (int bj = 0; bj < 2; ++bj)
#pragma unroll
            for (int ai = 0; ai < 2; ++ai)
#pragma unroll
                for (int m = 0; m < 4; ++m) gw[bj][ai][m] = __builtin_nontemporal_load((const u32x4*)(gp + (size_t)(ai * HALF + m * 16) * 2048 + bj * 256));
#pragma unroll
        for (int bj = 0; bj < 2; ++bj) {
            const int c0 = u.pn * BM + bj * HALF + wc * 32 + 8 * fq;
#pragma unroll
            for (int ai = 0; ai < 2; ++ai)
#pragma unroll
                for (int m = 0; m < 4; ++m) {
                    const int t = u.pm * BM + ai * HALF + wr * 64 + m * 16 + fr;
                    const u32x4 g = gw[bj][ai][m];
                    float gv[8];
#pragma unroll
                    for (int e = 0; e < 4; ++e) { gv[2 * e] = __uint_as_float(g[e] << 16); gv[2 * e + 1] = __uint_as_float(g[e] & 0xffff0000u); }
                    if (u.z == 0) {
#pragma unroll
                        for (int e = 0; e < 4; ++e) { acc[ai][bj][m][0][e] *= gv[e]; acc[ai][bj][m][1][e] *= gv[4 + e]; }
                    } else {
                        float v[8];
#pragma unroll
                        for (int e = 0; e < 4; ++e) { v[e] = acc[ai][bj][m][0][e] * gv[e]; v[4 + e] = acc[ai][bj][m][1][e] * gv[4 + e]; }
                        u32x4 w; w.x = cvtpk(v[0], v[1]); w.y = cvtpk(v[2], v[3]); w.z = cvtpk(v[4], v[5]); w.w = cvtpk(v[6], v[7]);
                        asm volatile("global_store_dwordx4 %0, %1, off sc1\n\ts_nop 1" :: "v"(mixed + (size_t)t * DM + c0), "v"(w) : "memory"); } } }
    } };
struct EpiOutF { static constexpr bool PERM = true; bf16_t* y;
    __device__ __forceinline__ bool keep(const Unit&) const { return false; }
    __device__ __forceinline__ void operator()(f32x4 (&acc)[2][2][4][2], const Unit& u, int wr, int wc, int fr, int fq) const {
#pragma unroll
        for (int bj = 0; bj < 2; ++bj) {
            const int c0 = u.pn * BM + bj * HALF + wc * 32 + 8 * fq;
#pragma unroll
            for (int ai = 0; ai < 2; ++ai)
#pragma unroll
                for (int m = 0; m < 4; ++m) {
                    const int t = u.pm * BM + ai * HALF + wr * 64 + m * 16 + fr;
                    const f32x4 v0 = acc[ai][bj][m][0], v1 = acc[ai][bj][m][1];
                    u32x4 w; w.x = cvtpk(v0[0], v0[1]); w.y = cvtpk(v0[2], v0[3]); w.z = cvtpk(v1[0], v1[1]); w.w = cvtpk(v1[2], v1[3]);
                    *(u32x4*)(y + (size_t)t * DM + c0) = w; } }
    } };

constexpr int MOE_MAXU = 8;
struct MoeTab { const LAS int* desc; const LAS int* rowtab; };
struct MoeSched { MoeTab tb;
    __device__ __forceinline__ bool next(int i, Unit& u) const { if (i >= MOE_MAXU || tb.desc[i * 8 + 5] == 0) return false; u.pm = i; u.pn = tb.desc[i * 8 + 2]; u.z = tb.desc[i * 8 + 0]; return true; } };
struct MoeSched2 { MoeTab tb; unsigned* flag;
    __device__ __forceinline__ bool next(int i, Unit& u) const { if (i >= MOE_MAXU || tb.desc[i * 8 + 5] == 0) return false; u.pm = i; u.pn = tb.desc[i * 8 + 2]; u.z = tb.desc[i * 8 + 0];
        unsigned* f = flag + (tb.desc[i * 8 + 4] >> 8);
        for (unsigned sp = 0; __hip_atomic_load(f, __ATOMIC_RELAXED, __HIP_MEMORY_SCOPE_AGENT) < 2u && sp < (1u << 20); ++sp) __builtin_amdgcn_s_sleep(2);
        asm volatile("" ::: "memory");
        return true; } };
struct MoeProb1 { static constexpr bool GATHER = true; const bf16_t* h2; const bf16_t* wgu; MoeTab tb; int lda, ldb, K;
    __device__ __forceinline__ unsigned a_off(const Unit& u, int R) const { return (unsigned)((tb.rowtab[u.pm * 256 + R] >> 1) * lda) * 2u; }
    __device__ __forceinline__ const char* a_ptr(const Unit&) const { return (const char*)h2; }
    __device__ __forceinline__ const char* b_ptr(const Unit& u) const { return (const char*)(wgu + ((size_t)u.z * 512 + u.pn * BM) * ldb); } };
struct MoeProb2 { static constexpr bool GATHER = false; static constexpr int A_AUX = 16  ; const bf16_t* act; const bf16_t* wdn; MoeTab tb; int lda, ldb, K;
    __device__ __forceinline__ unsigned a_off(const Unit&, int R) const { return (unsigned)(R * lda) * 2u; }
    __device__ __forceinline__ const char* a_ptr(const Unit& u) const { return (const char*)(act + (size_t)tb.desc[u.pm * 8 + 4] * lda); }
    __device__ __forceinline__ const char* b_ptr(const Unit& u) const { return (const char*)(wdn + ((size_t)u.z * 1024 + u.pn * BM) * ldb); } };
struct EpiMoe1 { static constexpr bool PERM = true; static constexpr bool SIGNAL = true; bf16_t* act; const float* tokw; MoeTab tb; unsigned* flag; const float* sa2; const unsigned* sbg;
    __device__ __forceinline__ bool keep(const Unit&) const { return false; }
    __device__ __forceinline__ bool sig_now(const Unit&) const { return true; }
    __device__ __forceinline__ void signal(const Unit& u) const {
        __hip_atomic_fetch_add(flag + (tb.desc[u.pm * 8 + 4] >> 8), 1u, __ATOMIC_RELAXED, __HIP_MEMORY_SCOPE_AGENT); }
    __device__ __forceinline__ void operator()(f32x4 (&acc)[2][2][4][2], const Unit& u, int wr, int wc, int fr, int fq) const {
        const int nvalid = tb.desc[u.pm * 8 + 3], arow0 = tb.desc[u.pm * 8 + 4];
        const int f0 = u.pn * HALF + wc * 32 + 8 * fq;
        float sg[8], su[8];
        {   const unsigned* sp = sbg + u.z * 512 + u.pn * BM + wc * 32 + 8 * fq;
            const u32x4 a0 = *(const u32x4*)sp, a1 = *(const u32x4*)(sp + 4), b0 = *(const u32x4*)(sp + HALF), b1 = *(const u32x4*)(sp + HALF + 4);
#pragma unroll
            for (int e = 0; e < 4; ++e) { sg[e] = __uint_as_float(a0[e]) * (1.f / 127.f); sg[4 + e] = __uint_as_float(a1[e]) * (1.f / 127.f); su[e] = __uint_as_float(b0[e]) * (1.f / 127.f); su[4 + e] = __uint_as_float(b1[e]) * (1.f / 127.f); } }
        int ts8[2][4]; float w8[2][4], sr8[2][4];
#pragma unroll
        for (int ai = 0; ai < 2; ++ai)
#pragma unroll
            for (int m = 0; m < 4; ++m) ts8[ai][m] = tb.rowtab[u.pm * 256 + ai * HALF + wr * 64 + m * 16 + fr];
#pragma unroll
        for (int ai = 0; ai < 2; ++ai)
#pragma unroll
            for (int m = 0; m < 4; ++m) { w8[ai][m] = tokw[ts8[ai][m]]; sr8[ai][m] = sa2[ts8[ai][m] >> 1]; }
#pragma unroll
        for (int ai = 0; ai < 2; ++ai)
#pragma unroll
            for (int m = 0; m < 4; ++m) {
                const int r = ai * HALF + wr * 64 + m * 16 + fr;
                if (r < nvalid) {
                    const float w = w8[ai][m], sr_ = sr8[ai][m];
                    float v[8];
#pragma unroll
                    for (int e = 0; e < 4; ++e) { const float g0 = acc[ai][0][m][0][e] * (sr_ * sg[e]), g1 = acc[ai][0][m][1][e] * (sr_ * sg[4 + e]);
                        v[e] = g0 * fsigmoid(g0) * (acc[ai][1][m][0][e] * (sr_ * su[e])) * w; v[4 + e] = g1 * fsigmoid(g1) * (acc[ai][1][m][1][e] * (sr_ * su[4 + e])) * w; }
                    u32x4 o; o.x = cvtpk(v[0], v[1]); o.y = cvtpk(v[2], v[3]); o.z = cvtpk(v[4], v[5]); o.w = cvtpk(v[6], v[7]);
                    asm volatile("global_store_dwordx4 %0, %1, off sc1\n\ts_nop 1" :: "v"(act + (size_t)(arow0 + r) * FF + f0), "v"(o) : "memory"); } }
    } };
struct EpiMoe2 { static constexpr bool PERM = true; bf16_t* ys; MoeTab tb;
    __device__ __forceinline__ bool keep(const Unit&) const { return false; }
    __device__ __forceinline__ void operator()(f32x4 (&acc)[2][2][4][2], const Unit& u, int wr, int wc, int fr, int fq) const {
        const int nvalid = tb.desc[u.pm * 8 + 3];
        int ts8[2][4];
#pragma unroll
        for (int ai = 0; ai < 2; ++ai)
#pragma unroll
            for (int m = 0; m < 4; ++m) ts8[ai][m] = tb.rowtab[u.pm * 256 + ai * HALF + wr * 64 + m * 16 + fr];
#pragma unroll
        for (int ai = 0; ai < 2; ++ai)
#pragma unroll
            for (int m = 0; m < 4; ++m) {
                const int r = ai * HALF + wr * 64 + m * 16 + fr;
                if (r < nvalid) {
                    bf16_t* rowp = ys + (size_t)ts8[ai][m] * DM + u.pn * BM + wc * 32 + 8 * fq;
#pragma unroll
                    for (int bj = 0; bj < 2; ++bj) { const f32x4 v0 = acc[ai][bj][m][0], v1 = acc[ai][bj][m][1];
                        u32x4 o; o.x = cvtpk(v0[0], v0[1]); o.y = cvtpk(v0[2], v0[3]); o.z = cvtpk(v1[0], v1[1]); o.w = cvtpk(v1[2], v1[3]);
                        *(u32x4*)(rowp + bj * HALF) = o; } } }
    } };
}


namespace rsg {
#define RS_LD1(dst_, p_) asm volatile("global_load_dwordx4 %0, %1, off" : "=v"(dst_) : "v"(p_) : "memory")
template <int N> struct WaitVm;
#define RS_DEFWAIT(N_) template <> struct WaitVm<N_> { template <int P> static __device__ __forceinline__ void w(u32x4 (&r)[P]) { \
    if constexpr (P == 1) asm volatile("s_waitcnt vmcnt(" #N_ ")" : "+v"(r[0]) :: "memory"); \
    else if constexpr (P == 2) asm volatile("s_waitcnt vmcnt(" #N_ ")" : "+v"(r[0]), "+v"(r[1]) :: "memory"); \
    else if constexpr (P == 4) asm volatile("s_waitcnt vmcnt(" #N_ ")" : "+v"(r[0]), "+v"(r[1]), "+v"(r[2]), "+v"(r[3]) :: "memory"); \
    else asm volatile("s_waitcnt vmcnt(" #N_ ")" : "+v"(r[0]), "+v"(r[1]), "+v"(r[2]), "+v"(r[3]), "+v"(r[4]), "+v"(r[5]) :: "memory"); } };
RS_DEFWAIT(0) RS_DEFWAIT(1) RS_DEFWAIT(2) RS_DEFWAIT(3) RS_DEFWAIT(4) RS_DEFWAIT(5) RS_DEFWAIT(6) RS_DEFWAIT(7) RS_DEFWAIT(8) RS_DEFWAIT(9) RS_DEFWAIT(10) RS_DEFWAIT(11) RS_DEFWAIT(12)
RS_DEFWAIT(13) RS_DEFWAIT(14) RS_DEFWAIT(15) RS_DEFWAIT(16)
template <int KT, class Prob, class Epi>
__device__ __forceinline__ void rs_gemm_phase(LAS unsigned char* lds, const Prob& P, const Epi& E, int tid, int lane, int wave) {
    constexpr int K = KT * 16, ROWB = 2 * K + 16, SLAB = 64 * ROWB, CPR = K / 8, NPC = 64 * CPR, PPT = NPC / NTHR, NST = Epi::NST;
    constexpr int TROW = 144, TBUF = 32 * TROW;
    static_assert(NPC % NTHR == 0 && 2 * SLAB + 8 * TBUF <= LDS_BYTES - 64, "slab ring");
    LAS unsigned char* tbuf = lds + 2 * SLAB + wave * TBUF;
    const int r32 = lane & 31, hi = lane >> 5;
    int goff[PPT], loff[PPT];
    const int ldb = P.ldb;
#pragma unroll
    for (int q = 0; q < PPT; ++q) { const int p = tid + NTHR * q; goff[q] = (p / CPR) * ldb + 8 * (p % CPR); loff[q] = (p / CPR) * ROWB + (p % CPR) * 16; }
    for (int ui = 0; P.valid(ui); ++ui) {
        const int NT = P.ntiles(ui);
        const bf16_t* bt = P.b_ptr(ui);
        typename Epi::St st = E.prep(ui, wave, lane);
        u32x4 afr[KT];
        {   const bf16_t* rowp = P.a_row(ui, 32 * wave + r32) + 8 * hi;
#pragma unroll
            for (int s_ = 0; s_ < KT; ++s_) RS_LD1(afr[s_], rowp + 16 * s_); }
        u32x4 sr0[PPT], sr1[PPT];
#define RS_LOAD(S_, j_) do { const int jj_ = (j_) < NT ? (j_) : NT - 1; const bf16_t* bp_ = bt + (size_t)jj_ * 64 * ldb; \
        _Pragma("unroll") for (int q = 0; q < PPT; ++q) RS_LD1(S_[q], bp_ + goff[q]); } while (0)
#define RS_WRITE(S_, j_) do { LAS unsigned char* sb_ = lds + ((j_) & 1) * SLAB; _Pragma("unroll") for (int q = 0; q < PPT; ++q) *(LAS u32x4*)(sb_ + loff[q]) = S_[q]; } while (0)
#define RS_BODY(j_, S_, WN_) do { \
        WaitVm<WN_>::w(S_); \
        asm volatile("s_waitcnt lgkmcnt(0)" ::: "memory"); __builtin_amdgcn_s_barrier(); asm volatile("" ::: "memory"); \
        RS_WRITE(S_, (j_) + 1); RS_LOAD(S_, (j_) + 3); \
        f32x16 acc0, acc1; \
        _Pragma("unroll") for (int q = 0; q < 16; ++q) { acc0[q] = 0.f; acc1[q] = 0.f; } \
        const LAS unsigned char* sp_ = lds + ((j_) & 1) * SLAB + r32 * ROWB + hi * 16; \
        _Pragma("unroll") for (int s_ = 0; s_ < KT; ++s_) { \
            acc0 = __builtin_amdgcn_mfma_f32_32x32x16_bf16(*(const LAS bf16x8*)(sp_ + s_ * 32), __builtin_bit_cast(bf16x8, afr[s_]), acc0, 0, 0, 0); \
            acc1 = __builtin_amdgcn_mfma_f32_32x32x16_bf16(*(const LAS bf16x8*)(sp_ + 32 * ROWB + s_ * 32), __builtin_bit_cast(bf16x8, afr[s_]), acc1, 0, 0, 0); } \
        E.xf(st, acc0, (j_), 0, r32, hi); E.xf(st, acc1, (j_), 1, r32, hi); \
        { LAS unsigned char* tw_ = tbuf + r32 * TROW + hi * 8; \
          _Pragma("unroll") for (int g = 0; g < 4; ++g) { \
              u32x2 w0_, w1_; w0_.x = cvtpk(acc0[4 * g], acc0[4 * g + 1]); w0_.y = cvtpk(acc0[4 * g + 2], acc0[4 * g + 3]); w1_.x = cvtpk(acc1[4 * g], acc1[4 * g + 1]); w1_.y = cvtpk(acc1[4 * g + 2], acc1[4 * g + 3]); \
              *(LAS u32x2*)(tw_ + 16 * g) = w0_; *(LAS u32x2*)(tw_ + 64 + 16 * g) = w1_; } \
          u32x4 o_[4]; \
          _Pragma("unroll") for (int i = 0; i < 4; ++i) o_[i] = *(const LAS u32x4*)(tbuf + (8 * i + (lane >> 3)) * TROW + (lane & 7) * 16); \
          E.store(st, (j_), o_, lane); } } while (0)
        RS_LOAD(sr0, 0); RS_LOAD(sr1, 1);
        WaitVm<PPT>::w(sr0); RS_WRITE(sr0, 0); RS_LOAD(sr0, 2);
        RS_BODY(0, sr1, PPT);
        RS_BODY(1, sr0, PPT + NST);
        for (int j = 2; j < NT; j += 2) { RS_BODY(j, sr1, PPT + 2 * NST); RS_BODY(j + 1, sr0, PPT + 2 * NST); }
        WaitVm<0>::w(sr0); WaitVm<0>::w(sr1);
        asm volatile("s_waitcnt lgkmcnt(0)" ::: "memory"); __builtin_amdgcn_s_barrier(); asm volatile("" ::: "memory");
#undef RS_LOAD
#undef RS_WRITE
#undef RS_BODY
    }
}
struct DenseRS { const bf16_t* A; const bf16_t* Bt; int lda, ldb, ncols, G, bx;
    __device__ __forceinline__ bool valid(int ui) const { return bx + ui * G < 2 * (T / 256); }
    __device__ __forceinline__ int ntiles(int) const { return ncols / 64; }
    __device__ __forceinline__ const bf16_t* a_row(int ui, int row) const { return A + ((size_t)((bx + ui * G) >> 1) * 256 + row) * lda; }
    __device__ __forceinline__ const bf16_t* b_ptr(int ui) const { return Bt + (size_t)((bx + ui * G) & 1) * ncols * ldb; } };
struct EpiKVrs { bf16_t *kf, *vf; int G, bx;
    static constexpr int NST = 4;
    struct St { int half; size_t rowi[4]; };
    __device__ __forceinline__ St prep(int ui, int wave, int lane) const { St s_; const int L = bx + ui * G; s_.half = L & 1;
#pragma unroll
        for (int i = 0; i < 4; ++i) { const int t = (L >> 1) * 256 + 32 * wave + 8 * i + (lane >> 3), b = t / SEQ; s_.rowi[i] = (size_t)b * NH * SEQ + (t - b * SEQ); }
        return s_; }
    __device__ __forceinline__ void xf(const St&, f32x16&, int, int, int, int) const {}
    __device__ __forceinline__ void store(const St& s_, int j, const u32x4 (&o)[4], int lane) const {
        const int c = s_.half * 512 + 64 * j + 8 * (lane & 7), h = c >> 7, cc = c & 127;
#pragma unroll
        for (int i = 0; i < 4; ++i) { const size_t rowi = s_.rowi[i] + (size_t)h * SEQ;
            bf16_t* dp = cc < 64 ? kf + rowi * QK + cc : vf + rowi * VD + (cc - 64);
            *(u32x4*)dp = o[i]; }
    } };
template <int KIND>
struct EpiLoraRS { bf16_t* base; const float* bias; int G, bx;
    static constexpr int NST = 4;
    struct St { int half; bf16_t* dp[4]; };
    __device__ __forceinline__ St prep(int ui, int wave, int lane) const { St s_; const int L = bx + ui * G; s_.half = L & 1;
#pragma unroll
        for (int i = 0; i < 4; ++i) { const int t = (L >> 1) * 256 + 32 * wave + 8 * i + (lane >> 3); s_.dp[i] = base + (size_t)t * RW + s_.half * 256 + 8 * (lane & 7); }
        return s_; }
    __device__ __forceinline__ void xf(const St& s_, f32x16& acc, int j, int tile, int, int hi) const {
        if constexpr (KIND < 2) {
#pragma unroll
            for (int g = 0; g < 4; ++g) { const float4 bs = *(const float4*)(bias + s_.half * 256 + 64 * j + 32 * tile + 8 * g + 4 * hi);
                const float bv[4] = {bs.x, bs.y, bs.z, bs.w};
#pragma unroll
                for (int e = 0; e < 4; ++e) { const float v = fsigmoid(acc[4 * g + e] + bv[e]); acc[4 * g + e] = KIND == 0 ? 0.60653065971263342f * v : v; } }
        }
    }
    __device__ __forceinline__ void store(const St& s_, int j, const u32x4 (&o)[4], int) const {
#pragma unroll
        for (int i = 0; i < 4; ++i) *(u32x4*)(s_.dp[i] + 64 * j) = o[i];
    } };
}

struct TrItem { const float* W; bf16_t* WT; int ldw, ksrc0, ldt, kdst0, ndst0, kind, off, pad; };
__device__ __forceinline__ int tr_map(int kind, int off, int r) {
    if (kind == 0) return r - off;
    if (kind == 1) { if (r < MLA_IN) return r; if (r < 768) return -1; if (r < 768 + RWKV_IN) return r - 96;
        const int q = r - (768 + RWKV_IN), w = q & 255; return MLA_IN + RWKV_IN + (w < 128 ? 0 : DM) + (q >> 8) * 128 + (w & 127); }
    if (kind == 2) { const int h = r / QK, d = r % QK; if (d < NOPE) return r; const int i = (d - NOPE) >> 1, odd = (d - NOPE) & 1; return h * QK + NOPE + i + 16 * odd; }
    if (kind == 4) return -1;
    return ((r >> 8) << 7) + (r & 127);
}
__device__ __forceinline__ void tr_load(const TrItem& d, float (&v)[32], int lane) {
    const int n = lane & 31; const int sc = tr_map(d.kind, d.off, d.ndst0 + n);
    const float* p = d.W + (size_t)(d.ksrc0 + (lane >> 5)) * d.ldw + (sc >= 0 ? sc : 0);
#pragma unroll
    for (int i = 0; i < 32; ++i) v[i] = __builtin_nontemporal_load(p + (size_t)(2 * i) * d.ldw);
}
__device__ __forceinline__ void tr_mask(const TrItem& d, float (&v)[32], int lane) {
    const unsigned msk = tr_map(d.kind, d.off, d.ndst0 + (lane & 31)) >= 0 ? 0xffffffffu : 0u;
#pragma unroll
    for (int i = 0; i < 32; ++i) v[i] = __uint_as_float(__float_as_uint(v[i]) & msk);
}
__device__ __forceinline__ float tr_absmax(const float (&v)[32]) {
    float m = 0.f;
#pragma unroll
    for (int i = 0; i < 32; ++i) m = fmaxf(m, fabsf(v[i]));
    auto rr = __builtin_amdgcn_permlane32_swap(__float_as_uint(m), __float_as_uint(m), false, false);
    return fmaxf(__uint_as_float(rr[0]), __uint_as_float(rr[1]));
}
__device__ __forceinline__ void tr_store_q8(unsigned char* dst  , int kdst0, const float (&v)[32], const LAS float* cmax, LAS float* scr, int lane) {
    const int n = lane & 31;
#pragma unroll
    for (int i = 0; i < 32; ++i) scr[(2 * i + (lane >> 5)) * 33 + n] = v[i];
    asm volatile("s_waitcnt lgkmcnt(0)" ::: "memory");
    const int c = lane & 3;
#pragma unroll
    for (int j = 0; j < 2; ++j) { const int nn = (lane >> 2) + 16 * j; const LAS float* s_ = scr + (16 * c) * 33 + nn;
        const float am = cmax[nn], inv = am > 0.f ? 127.f / am : 0.f;
        u32x4 o;
        o.x = q8pack(s_[0 * 33] * inv, s_[1 * 33] * inv, s_[2 * 33] * inv, s_[3 * 33] * inv); o.y = q8pack(s_[4 * 33] * inv, s_[5 * 33] * inv, s_[6 * 33] * inv, s_[7 * 33] * inv);
        o.z = q8pack(s_[8 * 33] * inv, s_[9 * 33] * inv, s_[10 * 33] * inv, s_[11 * 33] * inv); o.w = q8pack(s_[12 * 33] * inv, s_[13 * 33] * inv, s_[14 * 33] * inv, s_[15 * 33] * inv);
        *(u32x4*)(dst + (size_t)nn * 1024 + kdst0 + 16 * c) = o; }
    asm volatile("s_waitcnt lgkmcnt(0)" ::: "memory");
}
__device__ __forceinline__ void tr_store(const TrItem& d, const float (&v)[32], LAS float* scr, int lane) {
    const int n = lane & 31;
#pragma unroll
    for (int i = 0; i < 32; ++i) scr[(2 * i + (lane >> 5)) * 33 + n] = v[i];
    asm volatile("s_waitcnt lgkmcnt(0)" ::: "memory");
    const int c = lane & 7;
#pragma unroll
    for (int j = 0; j < 4; ++j) { const int nn = (lane >> 3) + 8 * j; const LAS float* s_ = scr + (8 * c) * 33 + nn;
        u32x4 o; o.x = cvtpk(s_[0 * 33], s_[1 * 33]); o.y = cvtpk(s_[2 * 33], s_[3 * 33]); o.z = cvtpk(s_[4 * 33], s_[5 * 33]); o.w = cvtpk(s_[6 * 33], s_[7 * 33]);
        *(u32x4*)(d.WT + (size_t)(d.ndst0 + nn) * d.ldt + d.kdst0 + 8 * c) = o; }
    asm volatile("s_waitcnt lgkmcnt(0)" ::: "memory");
}

constexpr size_t WO_IN = 0;
constexpr size_t WO_UQ = WO_IN + (size_t)4608 * 1024 * 2;
constexpr size_t WO_UKV = WO_UQ + (size_t)768 * 384 * 2;
constexpr size_t WO_LORA = WO_UKV + (size_t)1024 * 256 * 2;
constexpr size_t WO_OM = WO_LORA + (size_t)1536 * 256 * 2;
constexpr size_t WO_OR = WO_OM + (size_t)1024 * 512 * 2;
constexpr size_t WO_OUT = WO_OR + (size_t)1024 * 512 * 2;
constexpr size_t WO_GU = WO_OUT + (size_t)1024 * 1024 * 2;
constexpr size_t WO_DN = WO_GU + (size_t)32 * 512 * 1024 * 2;
constexpr size_t WO_END = WO_DN + (size_t)32 * 1024 * 256 * 2;
constexpr size_t WO_RH = WO_END;
constexpr size_t WO_RL = WO_RH + (size_t)48 * 1024 * 2;
static_assert(WO_RL + (size_t)48 * 1024 * 2 <= 64 * MiB, "weights region");
constexpr int TR_I_IN = 16 * 144, TR_I_UQ = 6 * 24, TR_I_UKV = 4 * 32, TR_I_LORA = 4 * 48, TR_I_OM = 8 * 32, TR_I_OR = 8 * 32, TR_I_OUT = 16 * 32, TR_I_GU = 32 * 16 * 16, TR_I_DN = 32 * 4 * 32;
constexpr int TR_NITEMS = TR_I_IN + TR_I_UQ + TR_I_UKV + TR_I_LORA + TR_I_OM + TR_I_OR + TR_I_OUT + TR_I_GU + TR_I_DN;
__device__ __forceinline__ TrItem tr_desc(const Ctx& C, int it) {
    bf16_t* wb = (bf16_t*)(C.ws + WS_W);
    TrItem d; d.kind = 0; d.off = 0; d.pad = 0;
    int r = it;
    if (r < TR_I_IN) { const int kb = r / 144, nb = r % 144; d.W = C.w_in; d.ldw = IN_W; d.ksrc0 = 64 * kb; d.WT = wb + WO_IN / 2; d.ldt = 1024; d.kdst0 = 64 * kb; d.ndst0 = 32 * nb; d.kind = 1; return d; } r -= TR_I_IN;
    if (r < TR_I_UQ) { const int kb = r / 24, nb = r % 24; d.W = C.w_uq; d.ldw = 768; d.ksrc0 = 64 * kb; d.WT = wb + WO_UQ / 2; d.ldt = QR; d.kdst0 = 64 * kb; d.ndst0 = 32 * nb; d.kind = 2; return d; } r -= TR_I_UQ;
    if (r < TR_I_UKV) { const int kb = r / 32, nb = r % 32; d.W = C.w_ukv; d.ldw = 1024; d.ksrc0 = 64 * kb; d.WT = wb + WO_UKV / 2; d.ldt = KVR; d.kdst0 = 64 * kb; d.ndst0 = 32 * nb; return d; } r -= TR_I_UKV;
    if (r < TR_I_LORA) { const int kb = r / 48, nb = r % 48;
        d.W = C.w_dec; d.kind = 4; d.ksrc0 = 0; d.ldw = RW;
        if (nb < 16) { if (kb == 0) d.kind = 0; d.off = 0; }
        else if (nb < 32) { if (kb == 1) { d.W = C.w_a; d.kind = 0; } d.off = 512; }
        else { if (kb >= 2) { d.W = C.w_g; d.kind = 0; d.ksrc0 = 64 * (kb - 2); } d.off = 1024; }
        d.WT = wb + WO_LORA / 2; d.ldt = 256; d.kdst0 = 64 * kb; d.ndst0 = 32 * nb; return d; } r -= TR_I_LORA;
    if (r < TR_I_OM) { const int kb = r / 32, nb = r % 32; d.W = C.w_o_mla; d.ldw = DM; d.ksrc0 = 64 * kb; d.WT = wb + WO_OM / 2; d.ldt = RW; d.kdst0 = 64 * kb; d.ndst0 = 32 * nb; return d; } r -= TR_I_OM;
    if (r < TR_I_OR) { const int kb = r / 32, nb = r % 32; d.W = C.w_o_rwkv; d.ldw = DM; d.ksrc0 = 64 * kb; d.WT = wb + WO_OR / 2; d.ldt = RW; d.kdst0 = 64 * kb; d.ndst0 = 32 * nb; return d; } r -= TR_I_OR;
    if (r < TR_I_OUT) { const int kb = r / 32, nb = r % 32; d.W = C.w_out; d.ldw = DM; d.ksrc0 = 64 * kb; d.WT = wb + WO_OUT / 2; d.ldt = DM; d.kdst0 = 64 * kb; d.ndst0 = 32 * nb; return d; } r -= TR_I_OUT;
    if (r < TR_I_GU) { const int e = r / 256, q = r % 256, kb = q / 16, nb = q % 16;
        d.W = (((32 * nb) & 128) ? C.w_eu : C.w_eg) + (size_t)e * DM * FF; d.ldw = FF; d.ksrc0 = 64 * kb; d.WT = wb + WO_GU / 2 + (size_t)e * 512 * 1024; d.ldt = 1024; d.kdst0 = 64 * kb; d.ndst0 = 32 * nb; d.kind = 3; return d; } r -= TR_I_GU;
    { const int e = r / 128, q = r % 128, kb = q / 32, nb = q % 32;
      d.W = C.w_ed + (size_t)e * FF * DM; d.ldw = DM; d.ksrc0 = 64 * kb; d.WT = wb + WO_DN / 2 + (size_t)e * 1024 * 256; d.ldt = 256; d.kdst0 = 64 * kb; d.ndst0 = 32 * nb; return d; }
}


namespace att {
constexpr int KROW = 208, KBUF = 64 * KROW, VBUF = 8192, BUF = KBUF + VBUF;
typedef short v4i16_t __attribute__((ext_vector_type(4)));
__device__ __forceinline__ v4i16_t vtr(const LAS unsigned char* p) { return __builtin_amdgcn_ds_read_tr16_b64_v4i16((LAS v4i16_t*)p); }
__device__ __forceinline__ float hmax(float x) { auto rr = __builtin_amdgcn_permlane32_swap(__float_as_uint(x), __float_as_uint(x), false, false); return fmaxf(__uint_as_float(rr[0]), __uint_as_float(rr[1])); }
__device__ __forceinline__ float hsum(float x) { auto rr = __builtin_amdgcn_permlane32_swap(__float_as_uint(x), __float_as_uint(x), false, false); return __uint_as_float(rr[0]) + __uint_as_float(rr[1]); }

__device__ __forceinline__ void attn_unit(const Ctx& C, LAS unsigned char* lds, int bh, int qb, int tid, int lane, int wave) {
    const int r32 = lane & 31, hi = lane >> 5;
    const bf16_t* qf = (const bf16_t*)(C.ws + WS_QF) + ((size_t)bh * SEQ + qb * 256 + wave * 32 + r32) * QK;
    const unsigned char* kbase = (const unsigned char*)((const bf16_t*)(C.ws + WS_KF) + (size_t)bh * SEQ * QK);
    const unsigned char* vbase = (const unsigned char*)((const bf16_t*)(C.ws + WS_VF) + (size_t)bh * SEQ * VD);
    bf16x8 qr[6];
#pragma unroll
    for (int s = 0; s < 6; ++s) qr[s] = *(const bf16x8*)(qf + 16 * s + 8 * hi);
    const int kc1 = 512 + tid;
    const int koff0 = (tid / 12) * KROW + (tid % 12) * 16, koff1 = (kc1 / 12) * KROW + (kc1 % 12) * 16;
    const int vkey = tid >> 3, vj = tid & 7;
    const int voff = KBUF + (vj >> 2) * 4096 + (vkey >> 4) * 1024 + (vkey & 15) * 64 + (vj & 3) * 16;
    const int NT = 4 * qb + 4, cw = 4 * qb + (wave >> 1);
    const bool has_k1 = tid < 256;
    u32x4 k0r, k1r = {0u, 0u, 0u, 0u}, v0r;
    {
        u32x4 k0a, k1a = {0u, 0u, 0u, 0u}, v0a;
        k0a = *(const u32x4*)(kbase + (size_t)tid * 16); if (has_k1) k1a = *(const u32x4*)(kbase + (size_t)kc1 * 16); v0a = *(const u32x4*)(vbase + (size_t)tid * 16);
        k0r = *(const u32x4*)(kbase + 12288 + (size_t)tid * 16); if (has_k1) k1r = *(const u32x4*)(kbase + 12288 + (size_t)kc1 * 16); v0r = *(const u32x4*)(vbase + 8192 + (size_t)tid * 16);
        __builtin_amdgcn_sched_barrier(0);
        *(LAS u32x4*)(lds + koff0) = k0a; if (has_k1) *(LAS u32x4*)(lds + koff1) = k1a; *(LAS u32x4*)(lds + voff) = v0a; }
    __syncthreads();
    f32x16 o0, o1, negm;
#pragma unroll
    for (int r = 0; r < 16; ++r) { o0[r] = 0.f; o1[r] = 0.f; negm[r] = 0.f; }
    float m = 0.f, l = 0.f;
    const int kfrag = r32 * KROW + hi * 16;
    const int vfrag = KBUF + ((lane >> 4) & 1) * 32 + (lane & 3) * 8 + (4 * hi + ((lane & 15) >> 2)) * 64;
    for (int t = 0; t < NT; ++t) {
        const LAS unsigned char* cur = lds + (t & 1) * BUF;
        if (t + 1 < NT) { LAS unsigned char* nb = lds + ((t + 1) & 1) * BUF;
            *(LAS u32x4*)(nb + koff0) = k0r; if (has_k1) *(LAS u32x4*)(nb + koff1) = k1r; *(LAS u32x4*)(nb + voff) = v0r; }
        if (t + 2 < NT) { const unsigned char* kb = kbase + (size_t)(t + 2) * 12288; const unsigned char* vb = vbase + (size_t)(t + 2) * 8192;
            k0r = *(const u32x4*)(kb + (size_t)tid * 16); if (has_k1) k1r = *(const u32x4*)(kb + (size_t)kc1 * 16); v0r = *(const u32x4*)(vb + (size_t)tid * 16); }
        if (t <= cw) {
            f32x16 p0, p1;
            const LAS unsigned char* kp = cur + kfrag;
#pragma unroll
            for (int s = 0; s < 6; ++s) {
                const bf16x8 a0 = *(const LAS bf16x8*)(kp + s * 32), a1 = *(const LAS bf16x8*)(kp + 32 * KROW + s * 32);
                if (s == 0) { p0 = __builtin_amdgcn_mfma_f32_32x32x16_bf16(a0, qr[0], negm, 0, 0, 0); p1 = __builtin_amdgcn_mfma_f32_32x32x16_bf16(a1, qr[0], negm, 0, 0, 0); }
                else { p0 = __builtin_amdgcn_mfma_f32_32x32x16_bf16(a0, qr[s], p0, 0, 0, 0); p1 = __builtin_amdgcn_mfma_f32_32x32x16_bf16(a1, qr[s], p1, 0, 0, 0); }
            }
            float mx = fmaxf(fmaxf(p0[0], p1[0]), fmaxf(p0[1], p1[1]));
#pragma unroll
            for (int r = 2; r < 16; r += 2) mx = fmaxf(mx, fmaxf(fmaxf(p0[r], p1[r]), fmaxf(p0[r + 1], p1[r + 1])));
            mx = hmax(mx);
            if (t == 0) {
                m = mx;
#pragma unroll
                for (int r = 0; r < 16; ++r) { p0[r] -= mx; p1[r] -= mx; negm[r] = -mx; }
            } else if (__any(mx > 8.0f)) {
                const float dl = fmaxf(mx, 0.f), alpha = __builtin_amdgcn_exp2f(-dl);
                m += dl; l *= alpha;
#pragma unroll
                for (int r = 0; r < 16; ++r) { p0[r] -= dl; p1[r] -= dl; o0[r] *= alpha; o1[r] *= alpha; negm[r] = -m; }
            }
            float ps0 = 0.f, ps1 = 0.f;
#pragma unroll
            for (int r = 0; r < 16; ++r) { p0[r] = __builtin_amdgcn_exp2f(p0[r]); p1[r] = __builtin_amdgcn_exp2f(p1[r]); ps0 += p0[r]; ps1 += p1[r]; }
            l += ps0 + ps1;
            u32x4 pw0, pw1, pw2, pw3;
            pw0 = (u32x4){cvtpk(p0[0], p0[1]), cvtpk(p0[2], p0[3]), cvtpk(p0[4], p0[5]), cvtpk(p0[6], p0[7])};
            pw1 = (u32x4){cvtpk(p0[8], p0[9]), cvtpk(p0[10], p0[11]), cvtpk(p0[12], p0[13]), cvtpk(p0[14], p0[15])};
            pw2 = (u32x4){cvtpk(p1[0], p1[1]), cvtpk(p1[2], p1[3]), cvtpk(p1[4], p1[5]), cvtpk(p1[6], p1[7])};
            pw3 = (u32x4){cvtpk(p1[8], p1[9]), cvtpk(p1[10], p1[11]), cvtpk(p1[12], p1[13]), cvtpk(p1[14], p1[15])};
            const LAS unsigned char* vp = cur + vfrag;
#define ATT_PV(OD, D0, KS, PW) do { const v4i16_t lo_ = vtr(vp + (D0) * 4096 + (KS) * 1024), hi_ = vtr(vp + (D0) * 4096 + (KS) * 1024 + 512); \
                const bf16x8 vf_ = {lo_[0], lo_[1], lo_[2], lo_[3], hi_[0], hi_[1], hi_[2], hi_[3]}; \
                OD = __builtin_amdgcn_mfma_f32_32x32x16_bf16(vf_, __builtin_bit_cast(bf16x8, PW), OD, 0, 0, 0); } while (0)
            ATT_PV(o0, 0, 0, pw0); ATT_PV(o1, 1, 0, pw0); ATT_PV(o0, 0, 1, pw1); ATT_PV(o1, 1, 1, pw1);
            ATT_PV(o0, 0, 2, pw2); ATT_PV(o1, 1, 2, pw2); ATT_PV(o0, 0, 3, pw3); ATT_PV(o1, 1, 3, pw3);
#undef ATT_PV
        }
        asm volatile("s_waitcnt lgkmcnt(0)" ::: "memory"); __builtin_amdgcn_s_barrier(); asm volatile("" ::: "memory");
    }
    const float rl = 1.f / hsum(l);
    const int b = bh / NH, h = bh - b * NH;
    bf16_t* op = (bf16_t*)(C.ws + WS_ATT) + ((size_t)b * SEQ + qb * 256 + wave * 32 + r32) * RW + h * VD + 4 * hi;
#pragma unroll
    for (int g = 0; g < 4; ++g) {
        u32x2 w0, w1;
        w0.x = cvtpk(o0[4 * g] * rl, o0[4 * g + 1] * rl); w0.y = cvtpk(o0[4 * g + 2] * rl, o0[4 * g + 3] * rl);
        w1.x = cvtpk(o1[4 * g] * rl, o1[4 * g + 1] * rl); w1.y = cvtpk(o1[4 * g + 2] * rl, o1[4 * g + 3] * rl);
        *(u32x2*)(op + 8 * g) = w0; *(u32x2*)(op + 32 + 8 * g) = w1;
    }
}
__device__ __forceinline__ void attn_phase(const Ctx& C, LAS unsigned char* lds, int G, int bx, int tid, int lane, int wave) {
    const int v0 = (G % 8 == 0) ? (bx % 8) * (G / 8) + bx / 8 : bx;
    for (int v = v0; v < 256; v += G) {
        const int bh = v >> 1, odd = v & 1;
#pragma unroll 1
        for (int i = 0; i < 4; ++i) {
            const int qb = (i == 0) ? 7 - odd : (i == 1) ? odd : (i == 2) ? 4 + odd : 3 - odd;
            attn_unit(C, lds, bh, qb, tid, lane, wave);
        }
    }
}
}


namespace cscan {
constexpr int CH = 32, NCH = SEQ / CH;
constexpr int RS = 144;
constexpr int RS2 = 80;
constexpr int L_AT = 0, L_BT = 4608, L_RT = 9216, L_KT = 13824, L_BTV = 18432, L_VV = 22528, L_MAB = 26624, L_MAK = 30720, L_GC = 34816, L_MBRT = 35072, L_WAVE = 37632;
constexpr int L_P = L_AT, L_MAKT = L_MAK;
typedef short v4i16_t __attribute__((ext_vector_type(4)));
typedef float f32x2s __attribute__((ext_vector_type(2)));
#define CS_MF(a, b, c) __builtin_amdgcn_mfma_f32_32x32x16_bf16(a, b, c, 0, 0, 0)
template <int CTRL> __device__ __forceinline__ float dpp_add(float x) { return x + __builtin_bit_cast(float, __builtin_amdgcn_update_dpp(0, __builtin_bit_cast(int, x), CTRL, 0xf, 0xf, true)); }
__device__ __forceinline__ float wsum(float x) {
    x = dpp_add<0xB1>(x); x = dpp_add<0x4E>(x); x = dpp_add<0x141>(x); x = dpp_add<0x140>(x);
    x += __builtin_bit_cast(float, __builtin_amdgcn_update_dpp(0, __builtin_bit_cast(int, x), 0x142, 0xa, 0xf, false));
    x += __builtin_bit_cast(float, __builtin_amdgcn_update_dpp(0, __builtin_bit_cast(int, x), 0x143, 0xc, 0xf, false));
    return __builtin_bit_cast(float, __builtin_amdgcn_readlane(__builtin_bit_cast(int, x), 63));
}
__device__ __forceinline__ int crow(int r, int hi) { return (r & 3) + 8 * (r >> 2) + 4 * hi; }
__device__ __forceinline__ bf16x8 pack8(const f32x16& p, int s) {
    u32x4 w; w.x = cvtpk(p[8 * s], p[8 * s + 1]); w.y = cvtpk(p[8 * s + 2], p[8 * s + 3]); w.z = cvtpk(p[8 * s + 4], p[8 * s + 5]); w.w = cvtpk(p[8 * s + 6], p[8 * s + 7]);
    return __builtin_bit_cast(bf16x8, w); }
__device__ __forceinline__ bf16x8 rd_nat(const LAS unsigned char* p) { return *(const LAS bf16x8*)p; }
__device__ __forceinline__ bf16x8 rd_perm(const LAS unsigned char* p) { const u32x2 a = *(const LAS u32x2*)p, b = *(const LAS u32x2*)(p + 16);
    u32x4 w; w.x = a.x; w.y = a.y; w.z = b.x; w.w = b.y; return __builtin_bit_cast(bf16x8, w); }
__device__ __forceinline__ bf16x8 rd_tr(const LAS unsigned char* p) { const v4i16_t lo = __builtin_amdgcn_ds_read_tr16_b64_v4i16((LAS v4i16_t*)p), hi = __builtin_amdgcn_ds_read_tr16_b64_v4i16((LAS v4i16_t*)(p + 512));
    return (bf16x8){lo[0], lo[1], lo[2], lo[3], hi[0], hi[1], hi[2], hi[3]}; }
__device__ __forceinline__ float bfl(unsigned w) { return __uint_as_float(w << 16); }
__device__ __forceinline__ float bfh(unsigned w) { return __uint_as_float(w & 0xffff0000u); }

__device__ __forceinline__ void st_tile_w(bf16_t* rowp  , const f32x16& a, int hi) {
#pragma unroll
    for (int g = 0; g < 4; g += 2) {
        unsigned ax = cvtpk(a[4 * g], a[4 * g + 1]), ay = cvtpk(a[4 * g + 2], a[4 * g + 3]), bx_ = cvtpk(a[4 * g + 4], a[4 * g + 5]), by = cvtpk(a[4 * g + 6], a[4 * g + 7]);
        auto sx = __builtin_amdgcn_permlane32_swap(ax, bx_, false, false); auto sy = __builtin_amdgcn_permlane32_swap(ay, by, false, false);
        u32x4 w;
        w.x = sx[0]; w.y = sy[0]; w.z = sx[1]; w.w = sy[1];
        *(u32x4*)(rowp + 8 * g + 8 * hi) = w;
    }
}
#define CS_BAR() do { asm volatile("s_waitcnt lgkmcnt(0)" ::: "memory"); __builtin_amdgcn_s_barrier(); asm volatile("" ::: "memory"); } while (0)
__device__ __forceinline__ void pair_bar(LAS unsigned* cnt, unsigned& ord, int lane) {
    asm volatile("s_waitcnt lgkmcnt(0)" ::: "memory");
    ord += 2u;
    if (lane == 0) __hip_atomic_fetch_add(cnt, 1u, __ATOMIC_RELAXED, __HIP_MEMORY_SCOPE_WORKGROUP);
    for (unsigned spins = 0; spins < (1u << 22); ++spins) {
        const unsigned v = __builtin_amdgcn_readfirstlane(__hip_atomic_load(cnt, __ATOMIC_RELAXED, __HIP_MEMORY_SCOPE_WORKGROUP));
        if ((int)(v - ord) >= 0) break;
        __builtin_amdgcn_s_sleep(1);
    }
    asm volatile("" ::: "memory");
}
struct RawRegs { u32x4 r[2], k[2], v[2], a[2], e[2], rp, kp, vp; };
__device__ __forceinline__ void rawLoad(const Ctx& C, RawRegs& R, int task, int lane, int role) {
    const int c = task & (NCH - 1), bh = task >> 6, b = bh / NH, h = bh - b * NH;
    const size_t trow0 = (size_t)b * SEQ + (size_t)c * CH + 16 * role + (lane >> 3);
    const bf16_t* rkv = (const bf16_t*)(C.ws + WS_RKV) + trow0 * 1536 + h * 64 + (lane & 7) * 8;
    const bf16_t* av = (const bf16_t*)(C.ws + WS_AV) + trow0 * RW + h * 64 + (lane & 7) * 8;
    const bf16_t* eb = (const bf16_t*)(C.ws + WS_EBUF) + trow0 * RW + h * 64 + (lane & 7) * 8;
#pragma unroll
    for (int q = 0; q < 2; ++q) { R.r[q] = *(const u32x4*)(rkv + (size_t)q * 8 * 1536); R.k[q] = *(const u32x4*)(rkv + (size_t)q * 8 * 1536 + 512); R.v[q] = *(const u32x4*)(rkv + (size_t)q * 8 * 1536 + 1024);
        R.a[q] = *(const u32x4*)(av + (size_t)q * 8 * RW); R.e[q] = *(const u32x4*)(eb + (size_t)q * 8 * RW); }
    if (c * CH + 16 * role > 0) { const bf16_t* pv = (const bf16_t*)(C.ws + WS_RKV) + ((size_t)b * SEQ + (size_t)c * CH + 16 * role - 1) * 1536 + h * 64 + (lane & 7) * 8;
        R.rp = *(const u32x4*)pv; R.kp = *(const u32x4*)(pv + 512); R.vp = *(const u32x4*)(pv + 1024); }
    else { R.rp = (u32x4){0u, 0u, 0u, 0u}; R.kp = R.rp; R.vp = R.rp; }
}
__device__ __forceinline__ void taskA(const Ctx& C, LAS unsigned char* L, int task, int lane, int role, bool valid, RawRegs& R, int next_task, bool next_valid, LAS unsigned* pcnt, unsigned& pord) {
    asm volatile("" : "+v"(lane));
    const int c = task & (NCH - 1), bh = task >> 6, b = bh / NH, h = bh - b * NH;
    const int r32 = lane & 31, hi = lane >> 5;
    const size_t trow0 = (size_t)b * SEQ + (size_t)c * CH;
    if (valid) {
        const int jg = lane & 7;
        const float4 kw0 = *(const float4*)(C.k_k + h * 64 + 8 * jg), kw1 = *(const float4*)(C.k_k + h * 64 + 8 * jg + 4), ka0 = *(const float4*)(C.k_a + h * 64 + 8 * jg), ka1 = *(const float4*)(C.k_a + h * 64 + 8 * jg + 4);
        const float4 rk0 = *(const float4*)(C.r_k + h * 64 + 8 * jg), rk1 = *(const float4*)(C.r_k + h * 64 + 8 * jg + 4);
        const float kkw[8] = {kw0.x, kw0.y, kw0.z, kw0.w, kw1.x, kw1.y, kw1.z, kw1.w}, kaw[8] = {ka0.x, ka0.y, ka0.z, ka0.w, ka1.x, ka1.y, ka1.z, ka1.w};
        const float rkw[8] = {rk0.x, rk0.y, rk0.z, rk0.w, rk1.x, rk1.y, rk1.z, rk1.w};
        float* bonus = (float*)(C.ws + WS_BONUS) + trow0 * NH + h;
        {
            const int src = ((lane - 8) & 63) * 4; const bool top = lane >= 56;
#define CS_SHIFT(X_, P_, MU_) do { const float4 ma_ = *(const float4*)(C.mu + (MU_) + h * 64 + 8 * jg), mb_ = *(const float4*)(C.mu + (MU_) + h * 64 + 8 * jg + 4); \
            const float mm_[8] = {ma_.x, ma_.y, ma_.z, ma_.w, mb_.x, mb_.y, mb_.z, mb_.w}; \
            _Pragma("unroll") for (int q = 1; q >= 0; --q) _Pragma("unroll") for (int e = 0; e < 4; ++e) { \
                const unsigned y_ = top ? (q ? X_[0][e] : P_[e]) : X_[q][e]; \
                const unsigned p_ = (unsigned)__builtin_amdgcn_ds_bpermute(src, (int)y_); \
                const float z0_ = bfl(X_[q][e]), z1_ = bfh(X_[q][e]), p0_ = bfl(p_), p1_ = bfh(p_); \
                X_[q][e] = cvtpk(z0_ + (p0_ - z0_) * mm_[2 * e], z1_ + (p1_ - z1_) * mm_[2 * e + 1]); } } while (0)
            CS_SHIFT(R.r, R.rp, 0); CS_SHIFT(R.k, R.kp, RW); CS_SHIFT(R.v, R.vp, 2 * RW);
#undef CS_SHIFT
        }
#pragma unroll
        for (int q = 0; q < 2; ++q) { const int t = 16 * role + 8 * q + (lane >> 3);
            float kf[8], rf[8], af[8], kk0[8], kp[8];
#pragma unroll
            for (int e = 0; e < 4; ++e) { kf[2 * e] = bfl(R.k[q][e]); kf[2 * e + 1] = bfh(R.k[q][e]); rf[2 * e] = bfl(R.r[q][e]); rf[2 * e + 1] = bfh(R.r[q][e]); af[2 * e] = bfl(R.a[q][e]); af[2 * e + 1] = bfh(R.a[q][e]); }
            float n2 = 0.f, bn = 0.f;
#pragma unroll
            for (int e = 0; e < 8; ++e) { kk0[e] = kf[e] * kkw[e]; n2 += kk0[e] * kk0[e]; kp[e] = kf[e] * (1.f + (af[e] - 1.f) * kaw[e]); bn += rf[e] * kp[e] * rkw[e]; }
            n2 = sum8_dpp(n2); bn = sum8_dpp(bn);
            const float rn = __builtin_amdgcn_rsqf(fmaxf(n2, 1e-24f));
            u32x4 wkk, wkp;
            wkk.x = cvtpk(kk0[0] * rn, kk0[1] * rn); wkk.y = cvtpk(kk0[2] * rn, kk0[3] * rn); wkk.z = cvtpk(kk0[4] * rn, kk0[5] * rn); wkk.w = cvtpk(kk0[6] * rn, kk0[7] * rn);
            wkp.x = cvtpk(kp[0], kp[1]); wkp.y = cvtpk(kp[2], kp[3]); wkp.z = cvtpk(kp[4], kp[5]); wkp.w = cvtpk(kp[6], kp[7]);
            if (jg == 0) bonus[(size_t)t * NH] = bn;
            *(LAS u32x4*)(L + L_RT + t * RS + jg * 16) = R.r[q]; *(LAS u32x4*)(L + L_KT + t * RS + jg * 16) = wkp; *(LAS u32x4*)(L + L_AT + t * RS + jg * 16) = wkk;
            *(LAS u32x4*)(L + L_MAK + t * 128 + jg * 16) = R.a[q]; *(LAS u32x4*)(L + L_MAB + t * 128 + jg * 16) = R.e[q];
            *(LAS u32x4*)(L + L_VV + (jg >> 2) * 2048 + (t >> 4) * 1024 + (t & 15) * 64 + (jg & 3) * 16) = R.v[q]; }
    }
    if (next_valid) rawLoad(C, R, next_task, lane, role);
    pair_bar(pcnt, pord, lane);
    if (valid) {
        float Lc = 0.f;
        if (role == 1) {
#pragma unroll
            for (int t = 0; t < 16; ++t) Lc -= bf2f(*(const LAS bf16_t*)(L + L_MAB + t * 128 + lane * 2)); }
        float gprev = __expf(Lc);
        const int vbase = (lane >> 5) * 2048 + (lane & 31) * 2;
#pragma unroll 4
        for (int tt = 0; tt < 16; ++tt) {
            const int t = 16 * role + tt; const int ro = t * RS + lane * 2;
            const float r = bf2f(*(const LAS bf16_t*)(L + L_RT + ro)), kp = bf2f(*(const LAS bf16_t*)(L + L_KT + ro)), kk = bf2f(*(const LAS bf16_t*)(L + L_AT + ro));
            const float a = bf2f(*(const LAS bf16_t*)(L + L_MAK + t * 128 + lane * 2)), e = bf2f(*(const LAS bf16_t*)(L + L_MAB + t * 128 + lane * 2));
            Lc -= e; const float gam = __expf(Lc), ginv = __expf(-Lc);
            const unsigned w1 = cvtpk(-kk * gprev, r * gam), w2 = cvtpk(kp * ginv, kk * a * ginv);
            *(LAS bf16_t*)(L + L_AT + ro) = (bf16_t)w1; *(LAS bf16_t*)(L + L_RT + ro) = (bf16_t)(w1 >> 16); *(LAS bf16_t*)(L + L_KT + ro) = (bf16_t)w2;
            *(LAS bf16_t*)(L + L_BT + ro) = (bf16_t)(w2 >> 16); *(LAS bf16_t*)(L + L_BTV + vbase + (t >> 4) * 1024 + (t & 15) * 64) = (bf16_t)(w2 >> 16);
            gprev = gam;
        }
        if (role == 1) *(LAS float*)(L + L_GC + lane * 4) = gprev;
    }
    pair_bar(pcnt, pord, lane);
    f32x16 mkr;
#pragma unroll
    for (int q = 0; q < 16; ++q) mkr[q] = 0.f;
    if (valid) {
        f32x16 m0;
#pragma unroll
        for (int q = 0; q < 16; ++q) m0[q] = 0.f;
        const int bt_ = role == 0 ? L_AT : L_RT;
#pragma unroll
        for (int s_ = 0; s_ < 4; ++s_) {
            const int ko = r32 * RS + (16 * s_ + 8 * hi) * 2;
            const bf16x8 aB = rd_nat(L + L_BT + ko), aK = rd_nat(L + L_KT + ko), bX = rd_nat(L + bt_ + ko);
            m0 = CS_MF(aB, bX, m0); mkr = CS_MF(aK, bX, mkr);
        }
        const float base_ = (float)(r32 - 4 * hi) + (role == 0 ? 0.f : 1.f);
#pragma unroll
        for (int q = 0; q < 16; ++q) { const float mk_ = __builtin_amdgcn_fmed3f(base_ - (float)((q & 3) + 8 * (q >> 2)), 0.f, 1.f); m0[q] *= mk_; mkr[q] *= mk_; }
        if (role == 0) {
#pragma unroll
            for (int g = 0; g < 4; ++g) {
                *(LAS f32x4*)(L + L_MAB + r32 * 128 + (8 * g + 4 * hi) * 4) = (f32x4){m0[4 * g], m0[4 * g + 1], m0[4 * g + 2], m0[4 * g + 3]};
                *(LAS f32x4*)(L + L_MAK + r32 * 128 + (8 * g + 4 * hi) * 4) = (f32x4){mkr[4 * g], mkr[4 * g + 1], mkr[4 * g + 2], mkr[4 * g + 3]}; }
        } else {
#pragma unroll
            for (int g = 0; g < 4; ++g) { u32x2 w; w.x = cvtpk(m0[4 * g], m0[4 * g + 1]); w.y = cvtpk(m0[4 * g + 2], m0[4 * g + 3]);
                *(LAS u32x2*)(L + L_MBRT + r32 * RS2 + (8 * g + 4 * hi) * 2) = w; }
        }
    }
    pair_bar(pcnt, pord, lane);
    if (valid) {
        float xa[16], xb[16];
#pragma unroll
        for (int t = 0; t < 16; ++t) { xa[t] = 0.f; xb[t] = 0.f; }
#pragma unroll
        for (int t = 0; t < 16; ++t) {
            float ap = role == 0 ? bf2f(*(const LAS bf16_t*)(L + L_AT + t * RS + lane * 2)) : *(const LAS float*)(L + L_MAK + t * 128 + r32 * 4);
            float aq = 0.f;
#pragma unroll
            for (int i4 = 0; i4 < (t + 3) / 4; ++i4) { const f32x4 m4 = *(const LAS f32x4*)(L + L_MAB + t * 128 + i4 * 16);
                ap += xa[4 * i4] * m4[0]; aq += xa[4 * i4 + 1] * m4[1]; ap += xa[4 * i4 + 2] * m4[2]; aq += xa[4 * i4 + 3] * m4[3]; }
            xa[t] = ap + aq;
            asm volatile("" : "+v"(xa[t]) :: "memory");
        }
#pragma unroll
        for (int t = 0; t < 16; ++t) {
            float ap = role == 0 ? bf2f(*(const LAS bf16_t*)(L + L_AT + (16 + t) * RS + lane * 2)) : *(const LAS float*)(L + L_MAK + (16 + t) * 128 + r32 * 4);
            float aq = 0.f;
#pragma unroll
            for (int i4 = 0; i4 < 4; ++i4) { const f32x4 m4 = *(const LAS f32x4*)(L + L_MAB + (16 + t) * 128 + i4 * 16);
                ap += xa[4 * i4] * m4[0]; aq += xa[4 * i4 + 1] * m4[1]; ap += xa[4 * i4 + 2] * m4[2]; aq += xa[4 * i4 + 3] * m4[3]; }
#pragma unroll
            for (int i4 = 0; i4 < (t + 3) / 4; ++i4) { const f32x4 m4 = *(const LAS f32x4*)(L + L_MAB + (16 + t) * 128 + 64 + i4 * 16);
                ap += xb[4 * i4] * m4[0]; aq += xb[4 * i4 + 1] * m4[1]; ap += xb[4 * i4 + 2] * m4[2]; aq += xb[4 * i4 + 3] * m4[3]; }
            xb[t] = ap + aq;
            asm volatile("" : "+v"(xb[t]) :: "memory");
        }
        u32x4 w0, w1, w2, w3;
        w0.x = cvtpk(xa[0], xa[1]); w0.y = cvtpk(xa[2], xa[3]); w0.z = cvtpk(xa[4], xa[5]); w0.w = cvtpk(xa[6], xa[7]);
        w1.x = cvtpk(xa[8], xa[9]); w1.y = cvtpk(xa[10], xa[11]); w1.z = cvtpk(xa[12], xa[13]); w1.w = cvtpk(xa[14], xa[15]);
        w2.x = cvtpk(xb[0], xb[1]); w2.y = cvtpk(xb[2], xb[3]); w2.z = cvtpk(xb[4], xb[5]); w2.w = cvtpk(xb[6], xb[7]);
        w3.x = cvtpk(xb[8], xb[9]); w3.y = cvtpk(xb[10], xb[11]); w3.z = cvtpk(xb[12], xb[13]); w3.w = cvtpk(xb[14], xb[15]);
        if (role == 0) { LAS u32x4* d = (LAS u32x4*)(L + L_P + lane * RS2); d[0] = w0; d[1] = w1; d[2] = w2; d[3] = w3; }
        else if (hi == 0) { LAS u32x4* d = (LAS u32x4*)(L + L_MAKT + r32 * RS2); d[0] = w0; d[1] = w1; d[2] = w2; d[3] = w3; }
    }
    pair_bar(pcnt, pord, lane);
    if (valid) {
        const int trf = ((lane >> 4) & 1) * 32 + (lane & 3) * 8 + (4 * hi + ((lane & 15) >> 2)) * 64;
        if (role == 0) {
            bf16_t* gQT = (bf16_t*)(C.ws + WS_CQT) + (size_t)task * (CH * 64);
            bf16_t* gGT = (bf16_t*)(C.ws + WS_CGT) + (size_t)task * (64 * 64);
            {
                f32x16 q0, q1;
#pragma unroll
                for (int q = 0; q < 16; ++q) { q0[q] = 0.f; q1[q] = 0.f; }
#pragma unroll
                for (int s_ = 0; s_ < 2; ++s_) { const int ko = (16 * s_ + 8 * hi) * 2; const bf16x8 bM = rd_nat(L + L_MBRT + r32 * RS2 + ko);
                    q0 = CS_MF(rd_nat(L + L_P + r32 * RS2 + ko), bM, q0); q1 = CS_MF(rd_nat(L + L_P + (32 + r32) * RS2 + ko), bM, q1); }
#pragma unroll
                for (int g = 0; g < 4; ++g) {
                    const u32x2 ra = *(const LAS u32x2*)(L + L_RT + r32 * RS + (8 * g + 4 * hi) * 2), rb = *(const LAS u32x2*)(L + L_RT + r32 * RS + (32 + 8 * g + 4 * hi) * 2);
                    q0[4 * g] += bfl(ra.x); q0[4 * g + 1] += bfh(ra.x); q0[4 * g + 2] += bfl(ra.y); q0[4 * g + 3] += bfh(ra.y);
                    q1[4 * g] += bfl(rb.x); q1[4 * g + 1] += bfh(rb.x); q1[4 * g + 2] += bfl(rb.y); q1[4 * g + 3] += bfh(rb.y); }
                st_tile_w(gQT + r32 * 64, q0, hi); st_tile_w(gQT + r32 * 64 + 32, q1, hi);
            }
            __builtin_amdgcn_sched_barrier(0);
#define CS_G(N_) do { const float gc_ = *(const LAS float*)(L + L_GC + ((N_) * 32 + r32) * 4); \
                f32x16 ga_, gb_; _Pragma("unroll") for (int q = 0; q < 16; ++q) { ga_[q] = 0.f; gb_[q] = 0.f; } \
                _Pragma("unroll") for (int s_ = 0; s_ < 2; ++s_) { const int ko = (16 * s_ + 4 * hi) * 2; const bf16x8 bb_ = rd_tr(L + L_BTV + trf + (N_) * 2048 + s_ * 1024); \
                    ga_ = CS_MF(rd_perm(L + L_P + r32 * RS2 + ko), bb_, ga_); gb_ = CS_MF(rd_perm(L + L_P + (32 + r32) * RS2 + ko), bb_, gb_); } \
                { const float base_ = (float)(r32 - 4 * hi); \
                _Pragma("unroll") for (int q = 0; q < 16; ++q) { const float dl_ = __builtin_amdgcn_fmed3f(1.f - __builtin_fabsf(base_ - (float)((q & 3) + 8 * (q >> 2))), 0.f, 1.f); \
                    ga_[q] = (ga_[q] + ((N_) == 0 ? dl_ : 0.f)) * gc_; gb_[q] = (gb_[q] + ((N_) == 1 ? dl_ : 0.f)) * gc_; } } \
                st_tile_w(gGT + ((N_) * 32 + r32) * 64, ga_, hi); st_tile_w(gGT + ((N_) * 32 + r32) * 64 + 32, gb_, hi); \
                __builtin_amdgcn_sched_barrier(0); } while (0)
            CS_G(0); CS_G(1);
#undef CS_G
        } else {
            bf16_t* gHT = (bf16_t*)(C.ws + WS_CHT) + (size_t)task * (64 * 64);
            bf16_t* gYL = (bf16_t*)(C.ws + WS_CYL) + (size_t)task * (64 * CH);
            f32x16 z = mkr, x0, x1;
#pragma unroll
            for (int s_ = 0; s_ < 2; ++s_) { const int ko = (16 * s_ + 8 * hi) * 2;
                z = CS_MF(rd_nat(L + L_MAKT + r32 * RS2 + ko), rd_nat(L + L_MBRT + r32 * RS2 + ko), z); }
#define CS_X(N_, XN_) do { const float gc_ = *(const LAS float*)(L + L_GC + ((N_) * 32 + r32) * 4); \
                _Pragma("unroll") for (int q = 0; q < 16; ++q) XN_[q] = 0.f; \
                _Pragma("unroll") for (int s_ = 0; s_ < 2; ++s_) { const int ko = (16 * s_ + 4 * hi) * 2; \
                    XN_ = CS_MF(rd_perm(L + L_MAKT + r32 * RS2 + ko), rd_tr(L + L_BTV + trf + (N_) * 2048 + s_ * 1024), XN_); } \
                { const LAS unsigned char* kb_ = L + L_KT + 4 * hi * RS + ((N_) * 32 + r32) * 2; \
                _Pragma("unroll") for (int q = 0; q < 16; ++q) XN_[q] = (XN_[q] + bf2f(*(const LAS bf16_t*)(kb_ + ((q & 3) + 8 * (q >> 2)) * RS))) * gc_; } } while (0)
            CS_X(0, x0); CS_X(1, x1);
#undef CS_X
            const bf16x8 ax00 = pack8(x0, 0), ax01 = pack8(x0, 1), ax10 = pack8(x1, 0), ax11 = pack8(x1, 1), az0 = pack8(z, 0), az1 = pack8(z, 1);
#define CS_HY(N_) do { \
                f32x16 ha_, hb_, yy_; _Pragma("unroll") for (int q = 0; q < 16; ++q) { ha_[q] = 0.f; hb_[q] = 0.f; yy_[q] = 0.f; } \
                const bf16x8 va_ = rd_tr(L + L_VV + trf + (N_) * 2048), vb_ = rd_tr(L + L_VV + trf + (N_) * 2048 + 1024); \
                ha_ = CS_MF(ax00, va_, ha_); ha_ = CS_MF(ax01, vb_, ha_); hb_ = CS_MF(ax10, va_, hb_); hb_ = CS_MF(ax11, vb_, hb_); yy_ = CS_MF(az0, va_, yy_); yy_ = CS_MF(az1, vb_, yy_); \
                st_tile_w(gHT + ((N_) * 32 + r32) * 64, ha_, hi); st_tile_w(gHT + ((N_) * 32 + r32) * 64 + 32, hb_, hi); st_tile_w(gYL + ((N_) * 32 + r32) * CH, yy_, hi); \
                __builtin_amdgcn_sched_barrier(0); } while (0)
            CS_HY(0); CS_HY(1);
#undef CS_HY
        }
    }
    pair_bar(pcnt, pord, lane);
}
__device__ __forceinline__ void phaseA(const Ctx& C, LAS unsigned char* lds, int G, int bx, int lane, int wave) {
    LAS unsigned char* L = lds + (wave >> 1) * L_WAVE; const int role = wave & 1;
    LAS unsigned* pcnt = (LAS unsigned*)(lds + 4 * L_WAVE) + (wave >> 1) * 32;
    if (role == 0 && lane == 0) *pcnt = 0u;
    __syncthreads();
    unsigned pord = 0u;
    constexpr int NTASK = NB * NH * NCH;
    const int rounds = (NTASK + 4 * G - 1) / (4 * G);
    RawRegs R;
    int task = bx * 4 + (wave >> 1);
    if (task < NTASK) rawLoad(C, R, task, lane, role);
#pragma unroll 1
    for (int k = 0; k < rounds; ++k) { const int nt = task + 4 * G; taskA(C, L, task, lane, role, task < NTASK, R, nt, (k + 1 < rounds) && nt < NTASK, pcnt, pord); task = nt; }
    __syncthreads();
}
constexpr int K_QT = 0, K_GT = 4608, K_YL = 13824, K_HT = 16384, K_BUF = 20992;
constexpr int K_FR = 2 * K_BUF;
__device__ __forceinline__ void chain_unit(const Ctx& C, LAS unsigned char* lds, int unit, int tid, int lane, int wave) {
    const int bh = unit >> 1, half = unit & 1, b = bh / NH, h = bh - b * NH;
    const int r32 = lane & 31, hi = lane >> 5;
    const unsigned char* gQT = (const unsigned char*)((const bf16_t*)(C.ws + WS_CQT) + (size_t)bh * NCH * (CH * 64));
    const unsigned char* gGT = (const unsigned char*)((const bf16_t*)(C.ws + WS_CGT) + (size_t)bh * NCH * (64 * 64));
    const unsigned char* gHT = (const unsigned char*)((const bf16_t*)(C.ws + WS_CHT) + (size_t)bh * NCH * (64 * 64) + half * 32 * 64);
    const unsigned char* gYL = (const unsigned char*)((const bf16_t*)(C.ws + WS_CYL) + (size_t)bh * NCH * (64 * CH) + half * 32 * CH);
    bf16_t* yout = (bf16_t*)(C.ws + WS_Y2) + (size_t)b * SEQ * RW + h * 64 + half * 32 + r32;
    const int lt = tid - 192;
    const unsigned char* src[4]; int dst[4]; size_t cstep[4];
#pragma unroll
    for (int q_ = 0; q_ < 4; ++q_) { const int p0_ = (lt < 0 ? 0 : lt) + 320 * q_; const int p_ = p0_ < 1152 ? p0_ : 1151;
        if (p_ < 256) { src[q_] = gQT + p_ * 16; dst[q_] = K_QT + (p_ >> 3) * 144 + (p_ & 7) * 16; cstep[q_] = 4096; }
        else if (p_ < 768) { const int r_ = p_ - 256; src[q_] = gGT + r_ * 16; dst[q_] = K_GT + (r_ >> 3) * 144 + (r_ & 7) * 16; cstep[q_] = 8192; }
        else if (p_ < 896) { const int r_ = p_ - 768; src[q_] = gYL + r_ * 16; dst[q_] = K_YL + (r_ >> 2) * 80 + (r_ & 3) * 16; cstep[q_] = 4096; }
        else { const int r_ = p_ - 896; src[q_] = gHT + r_ * 16; dst[q_] = K_HT + (r_ >> 3) * 144 + (r_ & 7) * 16; cstep[q_] = 8192; } }
    const bool ldr = lt >= 0;
    u32x4 sA[4], sB[4], sC[4];
#define CH_LD1(dst_, p_) asm volatile("global_load_dwordx4 %0, %1, off" : "=v"(dst_) : "v"(p_) : "memory")
#define CH_LD(S_, cc) do { if (ldr) { const size_t cc_ = (cc) < NCH ? (cc) : NCH - 1; CH_LD1(S_[0], src[0] + cc_ * cstep[0]); CH_LD1(S_[1], src[1] + cc_ * cstep[1]); \
        CH_LD1(S_[2], src[2] + cc_ * cstep[2]); CH_LD1(S_[3], src[3] + cc_ * cstep[3]); } } while (0)
#define CH_WR(S_, cc) do { if (ldr) { asm volatile("s_waitcnt vmcnt(8)" : "+v"(S_[0]), "+v"(S_[1]), "+v"(S_[2]), "+v"(S_[3]) :: "memory"); __builtin_amdgcn_sched_barrier(0); \
        const int bo_ = ((cc) & 1) * K_BUF; *(LAS u32x4*)(lds + bo_ + dst[0]) = S_[0]; *(LAS u32x4*)(lds + bo_ + dst[1]) = S_[1]; *(LAS u32x4*)(lds + bo_ + dst[2]) = S_[2]; \
        *(LAS u32x4*)(lds + bo_ + dst[3]) = S_[3]; } } while (0)
    if (tid < 256) *(LAS u32x4*)(lds + K_FR + tid * 16) = (u32x4){0u, 0u, 0u, 0u};
#define CH_STEP(c, SW_) do { \
        CH_WR(SW_, (c) + 1); CH_LD(SW_, (c) + 4); \
        if (wave < 3 && (c) < NCH) { \
            const LAS unsigned char* B_ = lds + ((c) & 1) * K_BUF; const LAS unsigned char* F_ = lds + K_FR + ((c) & 1) * 4096 + lane * 16; \
            const bf16x8 sb0 = *(const LAS bf16x8*)(F_), sb1 = *(const LAS bf16x8*)(F_ + 1024), sb2 = *(const LAS bf16x8*)(F_ + 2048), sb3 = *(const LAS bf16x8*)(F_ + 3072); \
            f32x16 acc_; \
            if (wave < 2) {         \
                _Pragma("unroll") for (int g = 0; g < 4; ++g) { const u32x2 i0 = *(const LAS u32x2*)(B_ + K_HT + r32 * 144 + (wave * 32 + 8 * g + 4 * hi) * 2); \
                    acc_[4 * g] = bfl(i0.x); acc_[4 * g + 1] = bfh(i0.x); acc_[4 * g + 2] = bfl(i0.y); acc_[4 * g + 3] = bfh(i0.y); } \
                const LAS unsigned char* ag_ = B_ + K_GT + (wave * 32 + r32) * 144 + 8 * hi; \
                acc_ = __builtin_amdgcn_mfma_f32_32x32x16_bf16(rd_perm(ag_), sb0, acc_, 0, 0, 0); acc_ = __builtin_amdgcn_mfma_f32_32x32x16_bf16(rd_perm(ag_ + 32), sb1, acc_, 0, 0, 0); \
                acc_ = __builtin_amdgcn_mfma_f32_32x32x16_bf16(rd_perm(ag_ + 64), sb2, acc_, 0, 0, 0); acc_ = __builtin_amdgcn_mfma_f32_32x32x16_bf16(rd_perm(ag_ + 96), sb3, acc_, 0, 0, 0); \
                LAS unsigned char* FN_ = lds + K_FR + (((c) + 1) & 1) * 4096 + wave * 2048 + lane * 16; \
                *(LAS bf16x8*)(FN_) = pack8(acc_, 0); *(LAS bf16x8*)(FN_ + 1024) = pack8(acc_, 1); \
            } else {                \
                _Pragma("unroll") for (int g = 0; g < 4; ++g) { const u32x2 iy = *(const LAS u32x2*)(B_ + K_YL + r32 * 80 + (8 * g + 4 * hi) * 2); \
                    acc_[4 * g] = bfl(iy.x); acc_[4 * g + 1] = bfh(iy.x); acc_[4 * g + 2] = bfl(iy.y); acc_[4 * g + 3] = bfh(iy.y); } \
                const LAS unsigned char* aq_ = B_ + K_QT + r32 * 144 + 8 * hi; \
                acc_ = __builtin_amdgcn_mfma_f32_32x32x16_bf16(rd_perm(aq_), sb0, acc_, 0, 0, 0); acc_ = __builtin_amdgcn_mfma_f32_32x32x16_bf16(rd_perm(aq_ + 32), sb1, acc_, 0, 0, 0); \
                acc_ = __builtin_amdgcn_mfma_f32_32x32x16_bf16(rd_perm(aq_ + 64), sb2, acc_, 0, 0, 0); acc_ = __builtin_amdgcn_mfma_f32_32x32x16_bf16(rd_perm(aq_ + 96), sb3, acc_, 0, 0, 0); \
                bf16_t* yp = yout + (size_t)(c) * CH * RW; \
                _Pragma("unroll") for (int q = 0; q < 16; ++q) yp[(size_t)crow(q, hi) * RW] = (bf16_t)cvtpk(acc_[q], acc_[q]); \
            } \
        } \
        CS_BAR(); } while (0)
    CH_LD(sA, 0); CH_LD(sB, 1); CH_LD(sC, 2);
    CH_WR(sA, 0); CH_LD(sA, 3);
    CS_BAR();
#pragma unroll 1
    for (int c3 = 0; c3 < NCH + 2; c3 += 3) { CH_STEP(c3, sB); CH_STEP(c3 + 1, sC); CH_STEP(c3 + 2, sA); }
#undef CH_STEP
#undef CH_LD
#undef CH_LD1
#undef CH_WR
}
__device__ __forceinline__ void chain_phase(const Ctx& C, LAS unsigned char* lds, int G, int bx, int tid, int lane, int wave) {
    const int v0 = (G % 8 == 0) ? (bx % 8) * (G / 8) + bx / 8 : bx;
    for (int v = v0; v < 256; v += G) chain_unit(C, lds, v, tid, lane, wave);
}
#undef CS_BAR
#undef CS_MF
}

struct Frame { LAS unsigned char* lds; int tid, lane, wave, G, bx; };

__device__ __forceinline__ void p0_prologue(const Ctx& C, const Frame& F) {
    {
        LAS float* sc = (LAS float*)F.lds;
        LAS float* red = (LAS float*)(F.lds + 65536);
        float* mod = (float*)(C.ws + WS_MOD);
        if (F.bx < 6 * DM / 32) {
            static_assert(NB * DM == 32 * NTHR, "silu table: 32 values per thread");
            float cv[32];
#pragma unroll
            for (int q = 0; q < 32; ++q) cv[q] = C.c[F.tid + q * NTHR];
            __builtin_amdgcn_sched_barrier(0);
#pragma unroll
            for (int q = 0; q < 32; ++q) { const int i = F.tid + q * NTHR; sc[(i & (DM - 1)) * NB + (i >> 10)] = cv[q] / (1.f + __expf(-cv[q])); }
            __syncthreads();
        }
        for (int cb = F.bx; cb < 6 * DM / 32; cb += F.G) {
            const int n0 = cb * 32;
            {   const int kg = F.tid >> 5, j = F.tid & 31;
                float acc[NB];
#pragma unroll
                for (int b = 0; b < NB; ++b) acc[b] = 0.f;
                float w[4][16];
#pragma unroll
                for (int kk = 0; kk < 4; ++kk)
#pragma unroll
                    for (int q = 0; q < 16; ++q) w[kk][q] = __builtin_nontemporal_load(C.w_ada + (size_t)(kg + 256 * kk + 16 * q) * 6 * DM + n0 + j);
                __builtin_amdgcn_sched_barrier(0);
#pragma unroll
                for (int kk = 0; kk < 4; ++kk) {
#pragma unroll
                    for (int q = 0; q < 16; ++q) { const LAS f32x4* sp = (const LAS f32x4*)(sc + (kg + 256 * kk + 16 * q) * NB);
#pragma unroll
                        for (int b4 = 0; b4 < 4; ++b4) { const f32x4 s4 = sp[b4]; acc[4 * b4] += s4[0] * w[kk][q]; acc[4 * b4 + 1] += s4[1] * w[kk][q]; acc[4 * b4 + 2] += s4[2] * w[kk][q]; acc[4 * b4 + 3] += s4[3] * w[kk][q]; } } }
#pragma unroll
                for (int b = 0; b < NB; ++b) red[(kg * NB + b) * 32 + j] = acc[b];
            }
            __syncthreads();
            {   const int b = F.tid >> 5, j = F.tid & 31; float s_ = C.b_ada[n0 + j];
#pragma unroll
                for (int kg = 0; kg < 16; ++kg) s_ += red[(kg * NB + b) * 32 + j];
                mod[b * 6 * DM + n0 + j] = s_; }
            __syncthreads();
        }
    }
    for (int o = F.bx * NTHR + F.tid; o < T * 16; o += F.G * NTHR) {
        const int t = o >> 4, i = o & 15;
        const float inv = powf(10000.0f, -(float)(2 * i) / 32.0f);
        float s, c; sincosf((float)C.pos[t] * inv, &s, &c);
        ((float2*)(C.ws + WS_ROPE))[o] = make_float2(c, s);
    }
    for (int o = F.bx * NTHR + F.tid; o < 48 * DM; o += F.G * NTHR) {
        const int j = o & 7, ln = (o >> 3) & 63, pc = o >> 9, nb = pc % 3, ks = pc / 3;
        const int n = 16 * nb + (ln & 15), k = 32 * ks + 8 * (ln >> 4) + j;
        const float w = n < NG ? C.w_rg[k * NG + n] : (n < NG + NE ? C.w_re[k * NE + (n - NG)] : 0.f);
        const bf16_t hi = f2bf(w);
        ((bf16_t*)(C.ws + WS_W + WO_RH))[o] = hi; ((bf16_t*)(C.ws + WS_W + WO_RL))[o] = f2bf(w - bf2f(hi));
    }
    __syncthreads();
    {
        LAS float* scr = (LAS float*)(F.lds + F.wave * 16384);
        unsigned* sbm = (unsigned*)(C.ws + WS_CTL + CTL_SBMAX);
        const int gw = F.bx * NWAVES + F.wave, NGW = F.G * NWAVES;
        float va[32], vb[32];
        TrItem da, db;
        {   LAS float* wm = (LAS float*)(F.lds + 8 * 16384); LAS float* cm = wm + 8 * 32;
            constexpr int GU0 = TR_I_IN + TR_I_UQ + TR_I_UKV + TR_I_LORA + TR_I_OM + TR_I_OR + TR_I_OUT;
            unsigned* sbg = (unsigned*)(C.ws + WS_CTL + CTL_SBGU);
            float vc[32], vd[32]; TrItem dc, dd;
#define QB_DESC(cb_, d0_, d1_) do { const bool gu_ = (cb_) >= 144; const int e_ = ((cb_) - 144) >> 4, nb_ = gu_ ? ((cb_) - 144) & 15 : (cb_); \
                d0_ = tr_desc(C, gu_ ? GU0 + e_ * 256 + (2 * F.wave) * 16 + nb_ : (2 * F.wave) * 144 + nb_); \
                d1_ = tr_desc(C, gu_ ? GU0 + e_ * 256 + (2 * F.wave + 1) * 16 + nb_ : (2 * F.wave + 1) * 144 + nb_); } while (0)
            int cb = F.bx;
            if (cb < 144 + 512) { QB_DESC(cb, da, db); tr_load(da, va, F.lane); tr_load(db, vb, F.lane); }
            __builtin_amdgcn_sched_barrier(0);
            while (cb < 144 + 512) {
                const bool gu = cb >= 144; const int e = (cb - 144) >> 4, nb = gu ? (cb - 144) & 15 : cb;
                tr_mask(da, va, F.lane); tr_mask(db, vb, F.lane);
                const float m = fmaxf(tr_absmax(va), tr_absmax(vb));
                if (F.lane < 32) wm[F.wave * 32 + F.lane] = m;
                __syncthreads();
                if (F.tid < 32) { float q = 0.f;
                    for (int w = 0; w < 8; ++w) q = fmaxf(q, wm[w * 32 + F.tid]);
                    cm[F.tid] = q; if (gu) sbg[e * 512 + 32 * nb + F.tid] = __float_as_uint(q); else sbm[32 * nb + F.tid] = __float_as_uint(q); }
                __syncthreads();
                const int nx = cb + F.G; const bool hn = nx < 144 + 512;
                if (hn) { QB_DESC(nx, dc, dd); tr_load(dc, vc, F.lane); tr_load(dd, vd, F.lane); }
                __builtin_amdgcn_sched_barrier(0);
                unsigned char* dst = gu ? (unsigned char*)(C.ws + WS_W + WO_GU) + ((size_t)e * 512 + 32 * nb) * 1024 : (unsigned char*)(C.ws + WS_W + WO_IN) + (size_t)(32 * nb) * 1024;
                tr_store_q8(dst, da.kdst0, va, cm, scr, F.lane); tr_store_q8(dst, db.kdst0, vb, cm, scr, F.lane);
                __syncthreads();
                if (hn) { da = dc; db = dd;
#pragma unroll
                    for (int i = 0; i < 32; ++i) { va[i] = vc[i]; vb[i] = vd[i]; } }
                cb = nx;
            }
#undef QB_DESC
        }
        constexpr int GU0_ = TR_I_IN + TR_I_UQ + TR_I_UKV + TR_I_LORA + TR_I_OM + TR_I_OR + TR_I_OUT, NGEN = TR_NITEMS - TR_I_IN - TR_I_GU;
#define TR_IT(j_) ((j_) < GU0_ - TR_I_IN ? (j_) + TR_I_IN : (j_) + TR_I_IN + TR_I_GU)
        int j = gw;
        if (j < NGEN) { da = tr_desc(C, TR_IT(j)); tr_load(da, va, F.lane); }
        __builtin_amdgcn_sched_barrier(0);
        for (; j < NGEN; j += 2 * NGW) {
            const bool hb = j + NGW < NGEN;
            if (hb) { db = tr_desc(C, TR_IT(j + NGW)); tr_load(db, vb, F.lane); }
            __builtin_amdgcn_sched_barrier(0);
            tr_mask(da, va, F.lane); tr_store(da, va, scr, F.lane);
            if (hb) {
                __builtin_amdgcn_sched_barrier(0);
                if (j + 2 * NGW < NGEN) { da = tr_desc(C, TR_IT(j + 2 * NGW)); tr_load(da, va, F.lane); }
                __builtin_amdgcn_sched_barrier(0);
                tr_mask(db, vb, F.lane); tr_store(db, vb, scr, F.lane);
            }
        }
#undef TR_IT
    }
}

__device__ __forceinline__ void p1_modulate(const Ctx& C, const Frame& F) {
    const float* mod = (const float*)(C.ws + WS_MOD);
    unsigned char* h1 = (unsigned char*)(C.ws + WS_H);
    float* sa = (float*)(C.ws + WS_CTL + CTL_SA);
    const int lane = F.lane;
    for (int row0 = (F.bx * NWAVES + F.wave) * 4; row0 < T; row0 += F.G * NWAVES * 4) {
        const int b = row0 / SEQ;
        float4 v[4][4]; float ss[4]; float4 pg[4], psh[4], psc[4];
#pragma unroll
        for (int r = 0; r < 4; ++r) { const f32x4* xr = (const f32x4*)(C.x + (size_t)(row0 + r) * DM);
#pragma unroll
            for (int j = 0; j < 4; ++j) { const f32x4 xv = __builtin_nontemporal_load(xr + lane + 64 * j); v[r][j] = make_float4(xv[0], xv[1], xv[2], xv[3]); } }
#pragma unroll
        for (int j = 0; j < 4; ++j) { const int col = 4 * (lane + 64 * j);
            pg[j] = *(const float4*)(C.g_pre_mix + col); psh[j] = *(const float4*)(mod + b * 6 * DM + col); psc[j] = *(const float4*)(mod + b * 6 * DM + DM + col); }
        __builtin_amdgcn_sched_barrier(0);
#pragma unroll
        for (int r = 0; r < 4; ++r) { float a = 0.f;
#pragma unroll
            for (int j = 0; j < 4; ++j) a += v[r][j].x * v[r][j].x + v[r][j].y * v[r][j].y + v[r][j].z * v[r][j].z + v[r][j].w * v[r][j].w;
            ss[r] = a; }
#pragma unroll
        for (int r = 0; r < 4; ++r) ss[r] = rsqrtf(wsum_dpp(ss[r]) * (1.f / DM) + RMS_EPS);
        float am[4] = {0.f, 0.f, 0.f, 0.f};
#pragma unroll
        for (int j = 0; j < 4; ++j) {
            const int col = 4 * (lane + 64 * j);
            const float4 g = pg[j], sh = psh[j], sc = psc[j];
            const float m0 = g.x * (1.f + sc.x), m1 = g.y * (1.f + sc.y), m2 = g.z * (1.f + sc.z), m3 = g.w * (1.f + sc.w);
#pragma unroll
            for (int r = 0; r < 4; ++r) { const float rs = ss[r];
                v[r][j].x = v[r][j].x * rs * m0 + sh.x; v[r][j].y = v[r][j].y * rs * m1 + sh.y; v[r][j].z = v[r][j].z * rs * m2 + sh.z; v[r][j].w = v[r][j].w * rs * m3 + sh.w;
                am[r] = fmaxf(fmaxf(am[r], fmaxf(fabsf(v[r][j].x), fabsf(v[r][j].y))), fmaxf(fabsf(v[r][j].z), fabsf(v[r][j].w))); }
        }
#pragma unroll
        for (int r = 0; r < 4; ++r) { am[r] = wmax_dpp(am[r]);
            const float inv = am[r] > 0.f ? 127.f / am[r] : 0.f;
            if (lane == 0) sa[row0 + r] = am[r] * (1.f / 127.f);
#pragma unroll
            for (int j = 0; j < 4; ++j) *(unsigned*)(h1 + (size_t)(row0 + r) * DM + 4 * (lane + 64 * j)) = q8pack(v[r][j].x * inv, v[r][j].y * inv, v[r][j].z * inv, v[r][j].w * inv); }
    }
}

__device__ __forceinline__ void d_post_mix(const Ctx& C, int G, int bx, int tid, int lane, int wave, LAS unsigned char* lds, bool dry) {
    const float* mod = (const float*)(C.ws + WS_MOD); const bf16_t* ym = (const bf16_t*)(C.ws + WS_YMIX);
    bf16_t* h2 = (bf16_t*)(C.ws + WS_H); bf16_t* x1b = (bf16_t*)(C.ws + WS_X1B);
    unsigned char* h2q = (unsigned char*)(C.ws + WS_H2Q); float* sa2 = (float*)(C.ws + WS_CTL + CTL_SA2);
    const bf16_t* wrh = (const bf16_t*)(C.ws + WS_W + WO_RH); const bf16_t* wrl = (const bf16_t*)(C.ws + WS_W + WO_RL);
    float* tokw = (float*)(C.ws + WS_ROUTE);
    unsigned* gcnt = (unsigned*)(C.ws + WS_CTL) + CW_GCNT;
    int* list = (int*)(C.ws + WS_LIST);
    LAS int* le = (LAS int*)lds; LAS float* lg = (LAS float*)(lds + 1024) + wave * 16 * 48;
    LAS unsigned char* lw = lds + 25600;
    for (int q = 0; q < 16; ++q) { const int idx = wave * 16 + q, hl = idx & 1, nb = (idx >> 1) & 1, ks = idx >> 2;
        __builtin_amdgcn_global_load_lds((const unsigned*)((hl ? wrl : wrh) + (ks * 3 + nb) * 512 + lane * 8), (LAS unsigned*)(lw + idx * 1024), 16, 0, 0); }
    for (int grp = bx; grp < T / 128; grp += G) {
      const int r0 = grp * 128 + wave * 16;
      float4 mpost[4], mffn[4], shf[4];
      { const float* mb = mod + (r0 / SEQ) * 6 * DM;
        unsigned z2 = 0; asm volatile("" : "+s"(z2));
        const float* gpm = C.g_post_mix + z2; const float* gpf = C.g_pre_ffn + z2;
#pragma unroll
        for (int j = 0; j < 4; ++j) { const int col = 4 * (lane + 64 * j);
            const float4 g1 = *(const float4*)(mb + 2 * DM + col), gp = *(const float4*)(gpm + col);
            const float4 gf = *(const float4*)(gpf + col), sc = *(const float4*)(mb + 4 * DM + col);
            shf[j] = *(const float4*)(mb + 3 * DM + col);
            mpost[j] = make_float4(g1.x * gp.x, g1.y * gp.y, g1.z * gp.z, g1.w * gp.w);
            mffn[j] = make_float4(gf.x * (1.f + sc.x), gf.y * (1.f + sc.y), gf.z * (1.f + sc.z), gf.w * (1.f + sc.w)); } }
      for (int rr = 0; rr < 16; rr += 4) {
        const int row = r0 + rr;
        u32x2 yr[4][4]; float4 xq[4][4]; float rs[4], rs2[4];
#define YQ(u_, j_) make_float4(__uint_as_float(yr[u_][j_].x << 16), __uint_as_float(yr[u_][j_].x & 0xffff0000u), __uint_as_float(yr[u_][j_].y << 16), __uint_as_float(yr[u_][j_].y & 0xffff0000u))
#pragma unroll
        for (int u = 0; u < 4; ++u)
#pragma unroll
            for (int j = 0; j < 4; ++j) { const f32x4 xv = __builtin_nontemporal_load((const f32x4*)(C.x + (size_t)(row + u) * DM + 4 * (lane + 64 * j)));
                xq[u][j] = make_float4(xv[0], xv[1], xv[2], xv[3]); }
        __builtin_amdgcn_sched_barrier(0);
#pragma unroll
        for (int u = 0; u < 4; ++u)
#pragma unroll
            for (int j = 0; j < 4; ++j) yr[u][j] = __builtin_nontemporal_load((const u32x2*)(ym + (size_t)(row + u) * DM + 4 * (lane + 64 * j)));
        __builtin_amdgcn_sched_barrier(0);
#pragma unroll
        for (int u = 0; u < 4; ++u) { float a = 0.f;
#pragma unroll
            for (int j = 0; j < 4; ++j) { const float4 y = YQ(u, j); a += y.x * y.x + y.y * y.y + y.z * y.z + y.w * y.w; }
            rs[u] = a; }
#pragma unroll
        for (int u = 0; u < 4; ++u) rs[u] = rsqrtf(wsum_dpp(rs[u]) * (1.f / DM) + RMS_EPS);
#pragma unroll
        for (int u = 0; u < 4; ++u) rs2[u] = 0.f;
#pragma unroll
        for (int j = 0; j < 4; ++j) { const int col = 4 * (lane + 64 * j);
            const float m0 = mpost[j].x, m1 = mpost[j].y, m2 = mpost[j].z, m3 = mpost[j].w;
#pragma unroll
            for (int u = 0; u < 4; ++u) { float4 x1 = xq[u][j];
                const float4 y = YQ(u, j);
                x1.x += m0 * (y.x * rs[u]); x1.y += m1 * (y.y * rs[u]); x1.z += m2 * (y.z * rs[u]); x1.w += m3 * (y.w * rs[u]);
                xq[u][j] = x1; rs2[u] += x1.x * x1.x + x1.y * x1.y + x1.z * x1.z + x1.w * x1.w;
                u32x2 xw; xw.x = cvtpk(x1.x, x1.y); xw.y = cvtpk(x1.z, x1.w); __builtin_nontemporal_store(xw, (u32x2*)(x1b + (size_t)(row + u) * DM + col)); } }
#pragma unroll
        for (int u = 0; u < 4; ++u) rs2[u] = rsqrtf(wsum_dpp(rs2[u]) * (1.f / DM) + RMS_EPS);
        float am2[4] = {0.f, 0.f, 0.f, 0.f};
#pragma unroll
        for (int j = 0; j < 4; ++j) { const int col = 4 * (lane + 64 * j);
            const float4 sh = shf[j];
            const float m0 = mffn[j].x, m1 = mffn[j].y, m2 = mffn[j].z, m3 = mffn[j].w;
#pragma unroll
            for (int u = 0; u < 4; ++u) {
                const float h0 = xq[u][j].x * rs2[u] * m0 + sh.x, h1 = xq[u][j].y * rs2[u] * m1 + sh.y, h2_ = xq[u][j].z * rs2[u] * m2 + sh.z, h3 = xq[u][j].w * rs2[u] * m3 + sh.w;
                xq[u][j] = make_float4(h0, h1, h2_, h3);
                am2[u] = fmaxf(fmaxf(am2[u], fmaxf(fabsf(h0), fabsf(h1))), fmaxf(fabsf(h2_), fabsf(h3)));
                u32x2 wh; wh.x = cvtpk(h0, h1); wh.y = cvtpk(h2_, h3);
                *(u32x2*)(h2 + (size_t)(row + u) * DM + col) = wh; } }
#pragma unroll
        for (int u = 0; u < 4; ++u) { const float am = wmax_dpp(am2[u]), inv = am > 0.f ? 127.f / am : 0.f;
            if (lane == 0) sa2[row + u] = am * (1.f / 127.f);
#pragma unroll
            for (int j = 0; j < 4; ++j) *(unsigned*)(h2q + (size_t)(row + u) * DM + 4 * (lane + 64 * j)) = q8pack(xq[u][j].x * inv, xq[u][j].y * inv, xq[u][j].z * inv, xq[u][j].w * inv); }
      }
#undef YQ
      asm volatile("s_waitcnt vmcnt(0)" ::: "memory");
      float brg[NG], bre[NE];
      {
        f32x4 acc0 = {0.f, 0.f, 0.f, 0.f}, acc1 = acc0, acc2 = acc0;
        const int fr = lane & 15, fq = lane >> 4;
        const bf16_t* ah = h2 + (size_t)(r0 + fr) * DM + 8 * fq;
        unsigned zs = 0; asm volatile("" : "+s"(zs));
        const char* bh = (const char*)(wrh + 1024) + zs; const char* bl = (const char*)(wrl + 1024) + zs; const unsigned lo16 = lane * 16;
        bf16x8 A[8], Bh[8], Bl[8], L[2][4];
#pragma unroll
        for (int i = 0; i < 8; ++i) { A[i] = *(const bf16x8*)(ah + 32 * i); Bh[i] = *(const bf16x8*)(bh + i * 3072 + lo16); Bl[i] = *(const bf16x8*)(bl + i * 3072 + lo16); }
#pragma unroll
        for (int c = 0; c < NG; ++c) brg[c] = C.b_rg[c];
#pragma unroll
        for (int c = 0; c < NE; ++c) bre[c] = C.b_re[c];
        __builtin_amdgcn_sched_barrier(0);
        __syncthreads();
        { const LAS unsigned char* lp = lw + lane * 16;
          L[0][0] = *(const LAS bf16x8*)(lp); L[0][1] = *(const LAS bf16x8*)(lp + 1024); L[0][2] = *(const LAS bf16x8*)(lp + 2048); L[0][3] = *(const LAS bf16x8*)(lp + 3072); }
#pragma unroll
        for (int ks = 0; ks < 32; ++ks) { const int i = ks & 7, c = ks & 1;
            if (ks + 1 < 32) { const LAS unsigned char* lp = lw + (ks + 1) * 4096 + lane * 16;
                L[c ^ 1][0] = *(const LAS bf16x8*)(lp); L[c ^ 1][1] = *(const LAS bf16x8*)(lp + 1024); L[c ^ 1][2] = *(const LAS bf16x8*)(lp + 2048); L[c ^ 1][3] = *(const LAS bf16x8*)(lp + 3072); }
            acc0 = __builtin_amdgcn_mfma_f32_16x16x32_bf16(A[i], L[c][0], acc0, 0, 0, 0); acc0 = __builtin_amdgcn_mfma_f32_16x16x32_bf16(A[i], L[c][1], acc0, 0, 0, 0);
            acc1 = __builtin_amdgcn_mfma_f32_16x16x32_bf16(A[i], L[c][2], acc1, 0, 0, 0); acc1 = __builtin_amdgcn_mfma_f32_16x16x32_bf16(A[i], L[c][3], acc1, 0, 0, 0);
            acc2 = __builtin_amdgcn_mfma_f32_16x16x32_bf16(A[i], Bh[i], acc2, 0, 0, 0); acc2 = __builtin_amdgcn_mfma_f32_16x16x32_bf16(A[i], Bl[i], acc2, 0, 0, 0);
            if (ks + 8 < 32) { A[i] = *(const bf16x8*)(ah + 32 * (ks + 8)); Bh[i] = *(const bf16x8*)(bh + (ks + 8) * 3072 + lo16); Bl[i] = *(const bf16x8*)(bl + (ks + 8) * 3072 + lo16); }
            __builtin_amdgcn_sched_barrier(0);
        }
#pragma unroll
        for (int e = 0; e < 4; ++e) { lg[(4 * fq + e) * 48 + fr] = acc0[e]; lg[(4 * fq + e) * 48 + 16 + fr] = acc1[e]; lg[(4 * fq + e) * 48 + 32 + fr] = acc2[e]; }
      }
      asm volatile("s_waitcnt lgkmcnt(0)" ::: "memory");
      if (lane < 16) {
            float gl[NG], el[NE];
#pragma unroll
            for (int c = 0; c < NG; ++c) gl[c] = lg[lane * 48 + c] + brg[c];
#pragma unroll
            for (int c = 0; c < NE; ++c) el[c] = lg[lane * 48 + NG + c] + bre[c];
            int gs = 0; float gm = gl[0];
#pragma unroll
            for (int c = 1; c < NG; ++c) if (gl[c] > gm) { gm = gl[c]; gs = c; }
            float den = 0.f;
#pragma unroll
            for (int c = 0; c < NG; ++c) den += __expf(gl[c] - gm);
            const float psel = 1.f / den;
            float eg[EPG];
#pragma unroll
            for (int c = 0; c < EPG; ++c) eg[c] = gs == 0 ? el[c] : (gs == 1 ? el[EPG + c] : (gs == 2 ? el[2 * EPG + c] : el[3 * EPG + c]));
            int i0 = 0; float v0 = eg[0];
#pragma unroll
            for (int c = 1; c < EPG; ++c) if (eg[c] > v0) { v0 = eg[c]; i0 = c; }
            int i1 = -1; float v1 = -INFINITY;
#pragma unroll
            for (int c = 0; c < EPG; ++c) if (c != i0 && eg[c] > v1) { v1 = eg[c]; i1 = c; }
            const float e1 = __expf(v1 - v0), w0 = 1.f / (1.f + e1), w1 = e1 / (1.f + e1);
            le[(wave * 16 + lane) * 2] = gs * EPG + i0; le[(wave * 16 + lane) * 2 + 1] = gs * EPG + i1;
            *(float2*)(tokw + (size_t)(r0 + lane) * 2) = make_float2(psel * w0, psel * w1);
      }
      __syncthreads();
      if (tid < NE && !dry) {
          int cnt = 0;
          const LAS i32x4* le4 = (const LAS i32x4*)le;
#pragma unroll 16
          for (int k4 = 0; k4 < 64; ++k4) { const i32x4 v = le4[k4]; cnt += (v[0] == tid ? 1 : 0) + (v[1] == tid ? 1 : 0) + (v[2] == tid ? 1 : 0) + (v[3] == tid ? 1 : 0); }
          int tl = tid; asm volatile("" : "+v"(tl));
          if (cnt) { const unsigned base = __hip_atomic_fetch_add(gcnt + tl, (unsigned)cnt, __ATOMIC_RELAXED, __HIP_MEMORY_SCOPE_AGENT);
              int j = 0;
              int* lp = list + (size_t)tl * T + base;
#pragma unroll 8
              for (int k4 = 0; k4 < 64; ++k4) { const i32x4 v = le4[k4]; const int k = grp * 256 + 4 * k4;
                  if (v[0] == tid) { lp[j] = k; ++j; } if (v[1] == tid) { lp[j] = k + 1; ++j; } if (v[2] == tid) { lp[j] = k + 2; ++j; } if (v[3] == tid) { lp[j] = k + 3; ++j; } } }
      }
      __syncthreads();
    }
}
template <int NPN, bool BAL = false>
__device__ __forceinline__ pg8::MoeTab moe_setup(const Ctx& C, int G, int bx, int tid, __attribute__((address_space(3))) int* ctl) {
    const unsigned* gcnt = (const unsigned*)(C.ws + WS_CTL) + CW_GCNT;
    const int* list = (const int*)(C.ws + WS_LIST);
    __syncthreads();
    if (tid < NE) ctl[64 + tid] = (int)__hip_atomic_load(gcnt + tid, __ATOMIC_RELAXED, __HIP_MEMORY_SCOPE_AGENT);
    __syncthreads();
    if (tid < 64) {
        const int c = tid < NE ? (ctl[64 + tid] + 255) >> 8 : 0; int inc = c;
#pragma unroll
        for (int d = 1; d < 32; d <<= 1) { const int o = __shfl_up(inc, d, 64); if (tid >= d) inc += o; }
        if (tid < NE) ctl[tid] = inc - c;
        if (tid == NE - 1) ctl[NE] = inc; }
    __syncthreads();
    if (tid < pg8::MOE_MAXU) {
        const int total = ctl[NE] * NPN; long L = (long)tid * G + bx;
        if constexpr (BAL) { const int s_ = (ctl[NE] * 2) % G;
            constexpr int SK = MOE_SKIP;
            if (s_ > 0) { if (bx >= s_) L = tid < SK ? (long)tid * (G - s_) + (bx - s_) : (long)SK * (G - s_) + (long)(tid - SK) * G + (bx - s_);
                          else L = (long)SK * (G - s_) + (long)tid * G + (G - s_ + bx); } }
        int* d = nullptr; (void)d;
        if (L < total) { const int pn = (int)(L % NPN), rt = (int)(L / NPN); int e = 0;
            { const LAS i32x4* c4 = (const LAS i32x4*)ctl;
#pragma unroll
              for (int q4 = 0; q4 < NE / 4; ++q4) { const i32x4 v = c4[q4];
#pragma unroll
                  for (int k = 0; k < 4; ++k) if (4 * q4 + k >= 1 && v[k] <= rt) e = 4 * q4 + k; } }
            const int m = rt - ctl[e]; int nv = ctl[64 + e] - m * 256; nv = nv > 256 ? 256 : nv;
            ctl[128 + tid * 8 + 0] = e; ctl[128 + tid * 8 + 1] = m; ctl[128 + tid * 8 + 2] = pn; ctl[128 + tid * 8 + 3] = nv; ctl[128 + tid * 8 + 4] = rt * 256; ctl[128 + tid * 8 + 5] = 1; }
        else ctl[128 + tid * 8 + 5] = 0;
    }
    __syncthreads();
    {
        int v4[4];
#pragma unroll
        for (int q = 0; q < 4; ++q) { const int idx = tid + NTHR * q, i = idx >> 8, t_ = idx & 255; v4[q] = 0;
            if (ctl[128 + i * 8 + 5]) { const int e = ctl[128 + i * 8 + 0], m = ctl[128 + i * 8 + 1], nv = ctl[128 + i * 8 + 3];
                const int r = t_ < nv ? t_ : nv - 1;
                v4[q] = list[(size_t)e * T + m * 256 + r]; } }
#pragma unroll
        for (int q = 0; q < 4; ++q) { const int idx = tid + NTHR * q; if (ctl[128 + (idx >> 8) * 8 + 5]) ctl[256 + idx] = v4[q]; }
    }
    __syncthreads();
    pg8::MoeTab tb; tb.desc = ctl + 128; tb.rowtab = ctl + 256; return tb;
}
__device__ __forceinline__ void d_final(const Ctx& C, int gw, int ngw, int lane) {
    const float* mod = (const float*)(C.ws + WS_MOD); const bf16_t* ys = (const bf16_t*)(C.ws + WS_YSLOT); const bf16_t* x1b = (const bf16_t*)(C.ws + WS_X1B);
    for (int row0 = gw * 4; row0 < T; row0 += ngw * 4) {
        const int b = row0 / SEQ; const float* mb = mod + b * 6 * DM;
        u32x2 ya[4][4], yb[4][4]; float4 x1[4][4]; float rs[4]; float4 pgf[4], pg2[4];
#pragma unroll
        for (int j = 0; j < 4; ++j) { const int col = 4 * (lane + 64 * j); pgf[j] = *(const float4*)(C.g_post_ffn + col); pg2[j] = *(const float4*)(mb + 5 * DM + col); }
#pragma unroll
        for (int r = 0; r < 4; ++r)
#pragma unroll
            for (int j = 0; j < 4; ++j) { const int col = 4 * (lane + 64 * j);
                ya[r][j] = __builtin_nontemporal_load((const u32x2*)(ys + (size_t)(row0 + r) * 2 * DM + col)); yb[r][j] = __builtin_nontemporal_load((const u32x2*)(ys + (size_t)(row0 + r) * 2 * DM + DM + col));
                { const u32x2 xw = __builtin_nontemporal_load((const u32x2*)(x1b + (size_t)(row0 + r) * DM + col)); x1[r][j] = make_float4(__uint_as_float(xw.x << 16), __uint_as_float(xw.x & 0xffff0000u), __uint_as_float(xw.y << 16), __uint_as_float(xw.y & 0xffff0000u)); } }
        __builtin_amdgcn_sched_barrier(0);
        float yv[4][16];
#pragma unroll
        for (int r = 0; r < 4; ++r) { float a = 0.f;
#pragma unroll
            for (int j = 0; j < 4; ++j) {
                yv[r][4 * j] = __uint_as_float(ya[r][j].x << 16) + __uint_as_float(yb[r][j].x << 16); yv[r][4 * j + 1] = __uint_as_float(ya[r][j].x & 0xffff0000u) + __uint_as_float(yb[r][j].x & 0xffff0000u);
                yv[r][4 * j + 2] = __uint_as_float(ya[r][j].y << 16) + __uint_as_float(yb[r][j].y << 16); yv[r][4 * j + 3] = __uint_as_float(ya[r][j].y & 0xffff0000u) + __uint_as_float(yb[r][j].y & 0xffff0000u);
                a += yv[r][4 * j] * yv[r][4 * j] + yv[r][4 * j + 1] * yv[r][4 * j + 1] + yv[r][4 * j + 2] * yv[r][4 * j + 2] + yv[r][4 * j + 3] * yv[r][4 * j + 3]; }
            rs[r] = a; }
#pragma unroll
        for (int r = 0; r < 4; ++r) rs[r] = rsqrtf(wsum_dpp(rs[r]) * (1.f / DM) + RMS_EPS);
#pragma unroll
        for (int j = 0; j < 4; ++j) { const int col = 4 * (lane + 64 * j);
            const float4 g = pgf[j], g2 = pg2[j];
            const float m0 = g.x * g2.x, m1 = g.y * g2.y, m2 = g.z * g2.z, m3 = g.w * g2.w;
#pragma unroll
            for (int r = 0; r < 4; ++r) { float4 o = x1[r][j];
                o.x += m0 * (yv[r][4 * j] * rs[r]); o.y += m1 * (yv[r][4 * j + 1] * rs[r]); o.z += m2 * (yv[r][4 * j + 2] * rs[r]); o.w += m3 * (yv[r][4 * j + 3] * rs[r]);
                { const f32x4 ov = {o.x, o.y, o.z, o.w}; __builtin_nontemporal_store(ov, (f32x4*)(C.out + (size_t)(row0 + r) * DM + col)); } } }
    }
}

#define XB_TMO      128
#define XB_XCNT(j)  (256  + 64 * (j))
#define XB_XSUB(j)  (1280 + 64 * (j))
#define XB_XGEN(j)  (2304 + 64 * (j))
#define XB_TOP      3328
#define XB_TOPGEN   3392
#define XCD_BAR_WORDS 3456
#define XB_SPIN_CAP (1u << 18)
__device__ __forceinline__ unsigned xb_ld(unsigned* p)              { return __hip_atomic_load(p, __ATOMIC_RELAXED, __HIP_MEMORY_SCOPE_AGENT); }
__device__ __forceinline__ unsigned xb_add(unsigned* p, unsigned v) { return __hip_atomic_fetch_add(p, v, __ATOMIC_RELAXED, __HIP_MEMORY_SCOPE_AGENT); }
__device__ __forceinline__ unsigned xb_xcc_id() { return (unsigned)__builtin_amdgcn_s_getreg((3 << 11) | 20) & 0xFu; }
#define XB_SPIN(cond, bar) do { unsigned _sp = 0; while (cond) { __builtin_amdgcn_s_sleep(1); \
    if ((++_sp & 255u) == 0u) { if (xb_ld(&(bar)[XB_TMO])) break; if (_sp > XB_SPIN_CAP) { atomicAdd(&(bar)[XB_TMO], 1u); break; } } } } while (0)
struct XcdBarrier { unsigned* bar; unsigned x; volatile LAS unsigned* st; };
__device__ __forceinline__ XcdBarrier xcd_barrier_post(unsigned* bar, volatile LAS unsigned* st) {
    XcdBarrier b; b.bar = bar; b.x = xb_xcc_id(); b.st = st;
    if (threadIdx.x == 0) (void)xb_add(&bar[XB_XCNT(b.x)], 1u);
    return b;
}
__device__ __forceinline__ void xcd_barrier_complete(unsigned* bar, unsigned x, unsigned& nloc, unsigned& nx) {
    const unsigned G = gridDim.x * gridDim.y * gridDim.z;
    unsigned sum, cnt, mine, sp = 0u;
    for (;;) {
        sum = 0u; cnt = 0u; mine = 0u;
#pragma unroll
        for (unsigned j = 0; j < 16; ++j) { const unsigned c = xb_ld(&bar[XB_XCNT(j)]); sum += c; cnt += (c > 0u) ? 1u : 0u; mine = (j == x) ? c : mine; }
        if (sum == G) break;
        __builtin_amdgcn_s_sleep(1);
        if ((++sp & 255u) == 0u) { if (xb_ld(&bar[XB_TMO])) break; if (sp > XB_SPIN_CAP) { atomicAdd(&bar[XB_TMO], 1u); break; } }
    }
    nloc = mine > 0u ? mine : 1u; nx = cnt > 0u ? cnt : 1u;
}
__device__ __forceinline__ void xcd_barrier(const XcdBarrier& b) {
    asm volatile("s_waitcnt vmcnt(0)" ::: "memory");
    __syncthreads();
    if (threadIdx.x == 0) {
        unsigned* bar = b.bar;
        __builtin_amdgcn_s_waitcnt(0);
        unsigned nloc = b.st[0], nx = b.st[1];
        if (nloc == 0u) { xcd_barrier_complete(bar, b.x, nloc, nx); b.st[0] = nloc; b.st[1] = nx; }
        const unsigned old = xb_add(&bar[XB_XSUB(b.x)], 1u);
        const unsigned gen = old / nloc;
        if (old + 1u == (gen + 1u) * nloc) {
            __builtin_amdgcn_fence(__ATOMIC_RELEASE, "agent");
            asm volatile("s_waitcnt vmcnt(0)" ::: "memory");
            const unsigned og = xb_add(&bar[XB_TOP], 1u);
            const unsigned tg = og / nx;
            if (og + 1u == (tg + 1u) * nx) xb_add(&bar[XB_TOPGEN], 1u);
            else XB_SPIN(xb_ld(&bar[XB_TOPGEN]) == tg, bar);
            __builtin_amdgcn_fence(__ATOMIC_ACQUIRE, "agent");
            asm volatile("s_waitcnt vmcnt(0)" ::: "memory");
        } else {
            XB_SPIN(xb_ld(&bar[XB_TOPGEN]) == gen, bar);
            __builtin_amdgcn_fence(__ATOMIC_ACQUIRE, "agent");
            asm volatile("s_waitcnt vmcnt(0)" ::: "memory");
        }
    }
    __syncthreads();
}

struct Args { Ctx C; int ph_lo, ph_hi, sub, breg; };
__global__ void __launch_bounds__(NTHR, 2) mk(Args args) {
    extern __shared__ __attribute__((aligned(16))) unsigned char lds_raw[];
    const Ctx& C = args.C;
    Frame F; F.lds = (LAS unsigned char*)lds_raw; F.tid = threadIdx.x; F.lane = F.tid & 63; F.wave = __builtin_amdgcn_readfirstlane(F.tid >> 6); F.G = gridDim.x; F.bx = blockIdx.x;
    const int lo = args.ph_lo, hi = args.ph_hi;
    volatile LAS unsigned* xbw = (volatile LAS unsigned*)(F.lds + LDS_BYTES - 16);
    if (F.tid < 4) xbw[F.tid] = 0u;
    __syncthreads();
    unsigned* barw = (unsigned*)(C.ws + WS_CTL) + args.breg * XCD_BAR_WORDS;
    XcdBarrier bar; bar.bar = barw; bar.x = 0; bar.st = xbw;
    if (hi - lo > 1) bar = xcd_barrier_post(barw, xbw);
#define IN(k) (lo <= (k) && (k) < hi)
#define SEAM(k) do { if (IN(k) && IN((k) + 1)) xcd_barrier(bar); } while (0)
    if (IN(0)) { p0_prologue(C, F); }
    SEAM(0);
    if (IN(1)) { p1_modulate(C, F); }
    SEAM(1);
    if (IN(2)) {
        pg8::Dense P{(const bf16_t*)(C.ws + WS_H), (const bf16_t*)(C.ws + WS_W + WO_IN), DM / 2, DM / 2, DM / 2};
        pg8::StaticOrder S; S.init(T, 4608, F.G, F.bx);
        pg8::EpiZ E{(bf16_t*)(C.ws + WS_ZM), (bf16_t*)(C.ws + WS_RKV), (bf16_t*)(C.ws + WS_ZL), (bf16_t*)C.out, (const float*)(C.ws + WS_CTL + CTL_SA), (const unsigned*)(C.ws + WS_CTL + CTL_SBMAX)};
        pg8::gemm_phase<true, true>(F.lds, P, S, E);
    }
    SEAM(2);
    if (IN(3)) { d_prep(C, F.bx * NWAVES + F.wave, F.G * NWAVES, F.lane); }
    SEAM(3);
    if (IN(4)) {
        const bf16_t* wb = (const bf16_t*)(C.ws + WS_W);
        {   pg8::Dense P{(const bf16_t*)(C.ws + WS_CQN), wb + WO_UQ / 2, QR, QR, QR};
            pg8::StaticOrder S; S.init(T, 768, F.G, F.bx);
            pg8::EpiQ E{(bf16_t*)(C.ws + WS_QF), (const float2*)(C.ws + WS_ROPE)};
            pg8::gemm_phase(F.lds, P, S, E); }
        {   rsg::DenseRS P{(const bf16_t*)(C.ws + WS_CKVN), wb + WO_UKV / 2, KVR, KVR, 512, F.G, F.bx};
            rsg::EpiKVrs E{(bf16_t*)(C.ws + WS_KF), (bf16_t*)(C.ws + WS_VF), F.G, F.bx};
            rsg::rs_gemm_phase<KVR / 16>(F.lds, P, E, F.tid, F.lane, F.wave); }
        {   const bf16_t* la = (const bf16_t*)(C.ws + WS_LORA); const bf16_t* lw = wb + WO_LORA / 2;
            {   rsg::DenseRS P{la, lw, 256, 256, 256, F.G, F.bx};
                rsg::EpiLoraRS<0> E{(bf16_t*)(C.ws + WS_EBUF), C.dec_bias, F.G, F.bx};
                rsg::rs_gemm_phase<DR / 16>(F.lds, P, E, F.tid, F.lane, F.wave); }
            {   rsg::DenseRS P{la + DR, lw + (size_t)512 * 256 + DR, 256, 256, 256, F.G, F.bx};
                rsg::EpiLoraRS<1> E{(bf16_t*)(C.ws + WS_AV), C.a_bias, F.G, F.bx};
                rsg::rs_gemm_phase<AR / 16>(F.lds, P, E, F.tid, F.lane, F.wave); }
            {   rsg::DenseRS P{la + DR + AR, lw + (size_t)1024 * 256 + DR + AR, 256, 256, 256, F.G, F.bx};
                rsg::EpiLoraRS<2> E{(bf16_t*)(C.ws + WS_G), nullptr, F.G, F.bx};
                rsg::rs_gemm_phase<GR / 16>(F.lds, P, E, F.tid, F.lane, F.wave); } }
    }
    SEAM(4);
    if (IN(5)) { att::attn_phase(C, F.lds, F.G, F.bx, F.tid, F.lane, F.wave); }
    SEAM(5);
    if (IN(6)) { cscan::phaseA(C, F.lds, F.G, F.bx, F.lane, F.wave); }
    SEAM(6);
    if (IN(7)) { cscan::chain_phase(C, F.lds, F.G, F.bx, F.tid, F.lane, F.wave); }
    SEAM(7);
    if (IN(8)) { d_rwkv_post(C, F.bx * NWAVES + F.wave, F.G * NWAVES, F.lane); }
    SEAM(8);
    if (IN(9)) {
        const bf16_t* wb = (const bf16_t*)(C.ws + WS_W);
        pg8::MixProb P{(const bf16_t*)(C.ws + WS_ATT), (const bf16_t*)(C.ws + WS_RWO), wb + WO_OM / 2, wb + WO_OR / 2, RW, RW, RW};
        pg8::StaticOrder S; S.init(T, DM, F.G, F.bx, 2);
        pg8::EpiMix E{(const bf16_t*)C.out, (bf16_t*)(C.ws + WS_MIXED), (unsigned*)(C.ws + WS_CTL) + CW_PFLAG};
        pg8::gemm_phase(F.lds, P, S, E);
    }
    if (IN(10)) {
        const bf16_t* wb = (const bf16_t*)(C.ws + WS_W);
        pg8::DenseSC P{(const bf16_t*)(C.ws + WS_MIXED), wb + WO_OUT / 2, DM, DM, DM};
        pg8::StaticOrderW S; S.so.init(T, DM, F.G, F.bx); S.flag = (unsigned*)(C.ws + WS_CTL) + CW_PFLAG; S.need = 4u;
        pg8::EpiOutF E{(bf16_t*)(C.ws + WS_YMIX)};
        pg8::gemm_phase(F.lds, P, S, E);
    }
    SEAM(10);
    if (IN(11)) { d_post_mix(C, F.G, F.bx, F.tid, F.lane, F.wave, F.lds, (args.sub & 4) != 0); }
    SEAM(11);
    if (IN(12)) {
        const pg8::MoeTab tb = moe_setup<2>(C, F.G, F.bx, F.tid, (LAS int*)(F.lds + LDSCTL_OFF));
        pg8::MoeProb1 P{(const bf16_t*)(C.ws + WS_H2Q), (const bf16_t*)(C.ws + WS_W + WO_GU), tb, DM / 2, DM / 2, DM / 2};
        pg8::MoeSched S{tb};
        pg8::EpiMoe1 E{(bf16_t*)(C.ws + WS_ACT), (const float*)(C.ws + WS_ROUTE), tb, (unsigned*)(C.ws + WS_CTL) + CW_RTFLAG, (const float*)(C.ws + WS_CTL + CTL_SA2), (const unsigned*)(C.ws + WS_CTL + CTL_SBGU)};
        pg8::gemm_phase<true, true>(F.lds, P, S, E);
    }
    if (IN(13)) {
        const pg8::MoeTab tb = moe_setup<4, true>(C, F.G, F.bx, F.tid, (LAS int*)(F.lds + LDSCTL_OFF));
        pg8::MoeProb2 P{(const bf16_t*)(C.ws + WS_ACT), (const bf16_t*)(C.ws + WS_W + WO_DN), tb, FF, FF, FF};
        pg8::MoeSched2 S{tb, (unsigned*)(C.ws + WS_CTL) + CW_RTFLAG};
        pg8::EpiMoe2 E{(bf16_t*)(C.ws + WS_YSLOT), tb};
        pg8::gemm_phase(F.lds, P, S, E);
    }
    SEAM(13);
    if (IN(14)) { d_final(C, F.bx * NWAVES + F.wave, F.G * NWAVES, F.lane); }
#undef IN
#undef SEAM
}

static int g_grid = 0;
static int g_breg = 0;
static void launch_mk(const Ctx& C, int lo, int hi, hipStream_t stream, int sub = 3) {
    Args a{}; a.C = C; a.ph_lo = lo; a.ph_hi = hi; a.sub = sub; a.breg = g_breg++;
    hipLaunchKernelGGL(mk, dim3(g_grid), dim3(NTHR), LDS_BYTES, stream, a);
}
extern "C" void kernel_launch(void* const* d_in, const int* in_sizes, int n_in, void* d_out, int out_size, void* d_ws, size_t ws_size, hipStream_t stream) {
    if (g_grid == 0) {
        int dev = 0, cus = 0; hipGetDevice(&dev); hipDeviceGetAttribute(&cus, hipDeviceAttributeMultiprocessorCount, dev);
        hipFuncSetAttribute((const void*)mk, hipFuncAttributeMaxDynamicSharedMemorySize, LDS_BYTES);
        g_grid = cus > 0 ? cus : 256;
    }
    Ctx C{};
    const float* const* f = (const float* const*)d_in;
    C.x = f[0]; C.c = f[1]; C.pos = (const int*)d_in[2];
    C.w_ada = f[3]; C.b_ada = f[4]; C.g_pre_mix = f[5]; C.g_post_mix = f[6]; C.g_pre_ffn = f[7]; C.g_post_ffn = f[8];
    C.w_in = f[9]; C.g_cq = f[10]; C.w_uq = f[11]; C.g_ckv = f[12]; C.w_ukv = f[13]; C.w_o_mla = f[14];
    C.mu = f[15]; C.w_dec = f[16]; C.dec_bias = f[17]; C.w_a = f[18]; C.a_bias = f[19]; C.w_g = f[20];
    C.k_k = f[21]; C.k_a = f[22]; C.r_k = f[23]; C.lnx_w = f[24]; C.lnx_b = f[25]; C.w_o_rwkv = f[26]; C.w_out = f[27];
    C.w_rg = f[28]; C.b_rg = f[29]; C.w_re = f[30]; C.b_re = f[31]; C.w_eg = f[32]; C.w_eu = f[33]; C.w_ed = f[34];
    C.out = (float*)d_out; C.ws = (unsigned char*)d_ws;

    g_breg = 0;
    hipMemsetAsync((char*)d_ws + WS_CTL, 0, CTL_ZERO_BYTES, stream);
    launch_mk(C, 0, 15, stream);
}
```
